# Optimizing an MI355X kernel written in HIP

```python
import jax
import jax.numpy as jnp
from jax import lax
import numpy as np

D_MODEL = 1024
BATCH = 2
SEQ = 16384
DEPTH = 2

GRID_W = 64
CTX_LEN = 256
EPS = 1e-6
NEG_INF = -1e30

HEAD_DIM = 64
N_HEADS = (D_MODEL // 2) // HEAD_DIM
KV_HEADS = N_HEADS // 4
GROUP = N_HEADS // KV_HEADS
WINDOW = 128
ATTN_BLOCK = 128
ROPE_BASE = 10000.0
ROPE_FREQS = HEAD_DIM // 4

LRU_WIDTH = D_MODEL // 4
LRU_BLOCKS = 4
LRU_BLOCK_W = LRU_WIDTH // LRU_BLOCKS
LRU_C = 8.0
CONV_W = 4
CONV_PAD = (CONV_W // 2, CONV_W - 1 - CONV_W // 2)
SQRT_FLOOR = 1e-12

HG_HEADS = 4
HG_DK = (D_MODEL // 4) // HG_HEADS
HG_DV = (D_MODEL // 4) // HG_HEADS
HG_CHUNK = 32

ATTN_Q_W = N_HEADS * HEAD_DIM
ATTN_KV_W = KV_HEADS * HEAD_DIM
HG_K_W = HG_HEADS * HG_DK
HG_V_W = HG_HEADS * HG_DV
MIX_W = ATTN_Q_W + LRU_WIDTH + HG_V_W
IN_SPLITS = (ATTN_Q_W, ATTN_KV_W, ATTN_KV_W, LRU_WIDTH, LRU_WIDTH, HG_K_W, HG_K_W, HG_K_W, HG_V_W, HG_V_W)
IN_W = ATTN_Q_W + 2 * ATTN_KV_W + 2 * LRU_WIDTH + 3 * HG_K_W + 2 * HG_V_W

N_EXPERTS = 32
TOP_K = 4
D_FF = D_MODEL
SWIGLU_LIMIT = 7.0
SWIGLU_ALPHA = 1.702
MOE_BLOCK = 128

kernel_name = 'hybrid_dit_swa_rglru_hgrn2_moe'


def rms_norm(x, g):
    xf = x.astype(jnp.float32)
    y = xf * lax.rsqrt(jnp.mean(xf * xf, axis=-1, keepdims=True) + EPS)
    return (y * g.astype(jnp.float32)).astype(x.dtype)


def modulate(h, shift, scale):
    return h * (1.0 + scale) + shift


def axial_rope_tables(n_tokens, dtype):
    n_rows = n_tokens // GRID_W
    rows = jnp.repeat(jnp.arange(n_rows, dtype=jnp.float32), GRID_W)
    cols = jnp.tile(jnp.arange(GRID_W, dtype=jnp.float32), n_rows)
    inv_freq = ROPE_BASE ** (-jnp.arange(ROPE_FREQS, dtype=jnp.float32) / ROPE_FREQS)
    ang = jnp.stack([rows[:, None] * inv_freq, cols[:, None] * inv_freq], axis=1)
    return jnp.cos(ang).astype(dtype), jnp.sin(ang).astype(dtype)


def apply_axial_rope(x, cos, sin):
    b, t, h, _ = x.shape
    xr = x.reshape(b, t, h, 2, 2, ROPE_FREQS)
    x1, x2 = xr[..., 0, :], xr[..., 1, :]
    cs, sn = cos[:, None], sin[:, None]
    out = jnp.stack([x1 * cs - x2 * sn, x1 * sn + x2 * cs], axis=-2)
    return out.reshape(b, t, h, HEAD_DIM)


def sink_softmax(parts, sink):
    snk = jnp.broadcast_to(sink[None, :, :, None, None], parts[0].shape[:-1] + (1,))
    p = jax.nn.softmax(jnp.concatenate(parts + [snk], axis=-1), axis=-1)
    return p[..., :-1]


def window_attention(q_l, k_l, v_l, q_c, k_c, v_c, sink, cos, sin, with_ctx_out):
    bsz, seq, _ = q_l.shape
    ctx_len = k_c.shape[1]
    nb = seq // ATTN_BLOCK
    scale = HEAD_DIM ** -0.5

    def heads(t, n):
        return t.reshape(t.shape[0], t.shape[1], n, HEAD_DIM)

    ql = apply_axial_rope(heads(q_l, N_HEADS), cos, sin) * scale
    kl = apply_axial_rope(heads(k_l, KV_HEADS), cos, sin)
    vl = heads(v_l, KV_HEADS)
    kc = heads(k_c, KV_HEADS)
    vc = heads(v_c, KV_HEADS)
    snk = sink.astype(jnp.float32).reshape(KV_HEADS, GROUP)

    def band(t):
        tp = jnp.pad(t, ((0, 0), (ATTN_BLOCK, ATTN_BLOCK), (0, 0), (0, 0)))
        tp = tp.reshape(bsz, nb + 2, ATTN_BLOCK, KV_HEADS, HEAD_DIM)
        return jnp.concatenate([tp[:, :-2], tp[:, 1:-1], tp[:, 2:]], axis=2)

    start = jnp.arange(nb)[:, None, None] * ATTN_BLOCK
    qpos = start + jnp.arange(ATTN_BLOCK)[None, :, None]
    kpos = start - ATTN_BLOCK + jnp.arange(3 * ATTN_BLOCK)[None, None, :]
    valid = (jnp.abs(qpos - kpos) <= WINDOW) & (kpos >= 0) & (kpos < seq)
    n_loc = 3 * ATTN_BLOCK

    def block(args):
        qb, kb, vb, mb = args
        s_loc = jnp.where(mb, jnp.einsum('bqhgd,bkhd->bhgqk', qb, kb).astype(jnp.float32), NEG_INF)
        s_ctx = jnp.einsum('bqhgd,bchd->bhgqc', qb, kc).astype(jnp.float32)
        p = sink_softmax([s_loc, s_ctx], snk).astype(vb.dtype)
        return (jnp.einsum('bhgqk,bkhd->bqhgd', p[..., :n_loc], vb)
                + jnp.einsum('bhgqc,bchd->bqhgd', p[..., n_loc:], vc))

    qb = jnp.moveaxis(ql.reshape(bsz, nb, ATTN_BLOCK, KV_HEADS, GROUP, HEAD_DIM), 1, 0)
    o = lax.map(block, (qb, jnp.moveaxis(band(kl), 1, 0), jnp.moveaxis(band(vl), 1, 0), valid))
    out_l = jnp.moveaxis(o, 0, 1).reshape(bsz, seq, ATTN_Q_W)
    out_c = None
    if with_ctx_out:
        qc = heads(q_c, N_HEADS).reshape(bsz, ctx_len, KV_HEADS, GROUP, HEAD_DIM) * scale
        s = jnp.einsum('bqhgd,bkhd->bhgqk', qc, kc).astype(jnp.float32)
        p = sink_softmax([s], snk).astype(vc.dtype)
        out_c = jnp.einsum('bhgqk,bkhd->bqhgd', p, vc).reshape(bsz, ctx_len, ATTN_Q_W)
    return out_l, out_c


def short_conv(x, w, b):
    y = lax.conv_general_dilated(x, w[:, None, :].astype(x.dtype), window_strides=(1,),
                                 padding=[CONV_PAD], dimension_numbers=('NWC', 'WIO', 'NWC'),
                                 feature_group_count=x.shape[-1])
    return y + b


def linear_scan(a, b, h0):
    def combine(l, r):
        return l[0] * r[0], r[0] * l[1] + r[1]
    a_cum, h = lax.associative_scan(combine, (a, b), axis=1)
    h = h + a_cum * h0[:, None, :]
    return h, h[:, -1]


def prefix_scan(scan_fn, ctx_args, lat_args, init, reverse):
    flip = (lambda t: jnp.flip(t, axis=1)) if reverse else (lambda t: t)
    o_c, s_c = scan_fn(*[flip(t) for t in ctx_args], init)
    o_l, _ = scan_fn(*[flip(t) for t in lat_args], s_c)
    return flip(o_c), flip(o_l)


def rglru_gates(u, wr, br, wi, bi, lam):
    bsz, t, ch = u.shape
    ub = u.reshape(bsz, t, LRU_BLOCKS, LRU_BLOCK_W)
    r = jax.nn.sigmoid(jnp.einsum('btnc,ncd->btnd', ub, wr).reshape(bsz, t, ch) + br)
    i = jax.nn.sigmoid(jnp.einsum('btnc,ncd->btnd', ub, wi).reshape(bsz, t, ch) + bi)
    log_a = -LRU_C * r.astype(jnp.float32) * jax.nn.softplus(-lam.astype(jnp.float32))
    mult = jnp.sqrt(jnp.maximum(-jnp.expm1(2.0 * log_a), SQRT_FLOOR))
    b = mult * (i * u).astype(jnp.float32)
    return jnp.exp(log_a), b


def rglru_mixer(xl, gl, xc, gc, conv_w, conv_b, wr, br, wi, bi, lam, with_ctx_out):
    ul = short_conv(xl, conv_w, conv_b)
    uc = short_conv(xc, conv_w, conv_b)
    h0 = jnp.zeros((xl.shape[0], LRU_WIDTH), jnp.float32)
    outs = [prefix_scan(linear_scan,
                        rglru_gates(uc, wr[d], br[d], wi[d], bi[d], lam[d]),
                        rglru_gates(ul, wr[d], br[d], wi[d], bi[d], lam[d]),
                        h0, reverse=(d == 1)) for d in range(2)]
    yl = (outs[0][1] + outs[1][1]).astype(xl.dtype) * jax.nn.gelu(gl)
    yc = (outs[0][0] + outs[1][0]).astype(xc.dtype) * jax.nn.gelu(gc) if with_ctx_out else None
    return yl, yc


def gla_chunked(q, k, v, log_f, s0):
    bsz, t, h, _ = q.shape
    n = t // HG_CHUNK

    def r(a):
        return a.reshape(bsz, n, HG_CHUNK, h, a.shape[-1])

    q, k, v = r(q).astype(jnp.float32), r(k).astype(jnp.float32), r(v)
    b = jnp.cumsum(r(log_f).astype(jnp.float32), axis=2)
    b_last = b[:, :, -1:]
    b_ref = 0.5 * b_last
    q_i = q * jnp.exp(b - b_ref)
    k_i = k * jnp.exp(b_ref - b)
    q_s = q * jnp.exp(b)
    k_e = k * jnp.exp(b_last - b)
    causal = jnp.tril(jnp.ones((HG_CHUNK, HG_CHUNK), dtype=bool))
    att = jnp.where(causal, jnp.einsum('bnthk,bnshk->bnhts', q_i, k_i), 0.0)
    vf = v.astype(jnp.float32)
    o = jnp.einsum('bnhts,bnshv->bnthv', att, vf)
    kv = jnp.einsum('bnshk,bnshv->nbhkv', k_e, vf)
    decay = jnp.moveaxis(jnp.exp(b_last[:, :, 0]), 1, 0)

    def step(s, xs):
        dcy, kvc = xs
        return dcy[..., None] * s + kvc, s

    s_fin, s_start = lax.scan(step, s0.astype(jnp.float32), (decay, kv))
    o = o + jnp.einsum('bnthk,nbhkv->bnthv', q_s, s_start)
    return o.reshape(bsz, t, h, v.shape[-1]).astype(v.dtype), s_fin


def hgrn2_mixer(pl, pc, lb, norm_g, with_ctx_out):
    def prep(p, d):
        q, zf, zb, v, _ = p
        bsz, t, _ = q.shape
        z = (zf, zb)[d].reshape(bsz, t, HG_HEADS, HG_DK).astype(jnp.float32)
        lbd = lb[d].reshape(HG_HEADS, HG_DK)
        log_f = jnp.log(lbd + (1.0 - lbd) * jax.nn.sigmoid(z))
        k = (1.0 - lbd) * jax.nn.sigmoid(-z)
        return (q.reshape(bsz, t, HG_HEADS, HG_DK), k,
                v.reshape(bsz, t, HG_HEADS, HG_DV), log_f)

    s0 = jnp.zeros((pl[0].shape[0], HG_HEADS, HG_DK, HG_DV), jnp.float32)
    outs = [prefix_scan(gla_chunked, prep(pc, d), prep(pl, d), s0, reverse=(d == 1)) for d in range(2)]

    def readout(o, g):
        bsz, t = g.shape[:2]
        return rms_norm(o, norm_g.reshape(HG_HEADS, HG_DV)).reshape(bsz, t, HG_V_W) * jax.nn.silu(g)

    yl = readout(outs[0][1] + outs[1][1], pl[4])
    yc = readout(outs[0][0] + outs[1][0], pc[4]) if with_ctx_out else None
    return yl, yc


def clamped_swiglu(h, w_gu, b_gu, w_down, b_down):
    gu = h @ w_gu + b_gu
    gate = jnp.minimum(gu[:, :D_FF], SWIGLU_LIMIT)
    up = jnp.clip(gu[:, D_FF:], -SWIGLU_LIMIT, SWIGLU_LIMIT)
    glu = gate * jax.nn.sigmoid(SWIGLU_ALPHA * gate)
    return ((up + 1.0) * glu) @ w_down + b_down


def moe_ffn(h, router_w, router_b, w_gu, b_gu, w_down, b_down):
    n_tok, d = h.shape
    logits = (h @ router_w + router_b).astype(jnp.float32)
    top_val, top_idx = lax.top_k(logits, TOP_K)
    gates = jax.nn.softmax(top_val, axis=-1).astype(h.dtype)
    m = n_tok * TOP_K
    flat_e = top_idx.reshape(m)
    order = jnp.argsort(flat_e)
    sorted_e = flat_e[order]
    sorted_tok = (order // TOP_K).astype(jnp.int32)
    sorted_g = gates.reshape(m)[order]
    counts = jnp.bincount(flat_e, length=N_EXPERTS)
    starts = jnp.cumsum(counts) - counts
    padded = (counts + MOE_BLOCK - 1) // MOE_BLOCK * MOE_BLOCK
    pends = jnp.cumsum(padded)
    pstarts = pends - padded
    dest = pstarts[sorted_e] + jnp.arange(m) - starts[sorted_e]
    n_blocks = -(-m // MOE_BLOCK) + N_EXPERTS
    p_rows = n_blocks * MOE_BLOCK
    tok_buf = jnp.full((p_rows,), n_tok, jnp.int32).at[dest].set(sorted_tok)
    gate_buf = jnp.zeros((p_rows,), h.dtype).at[dest].set(sorted_g)
    blk_e = jnp.minimum(jnp.searchsorted(pends, jnp.arange(n_blocks) * MOE_BLOCK, side='right'), N_EXPERTS - 1)
    h_pad = jnp.concatenate([h, jnp.zeros((1, d), h.dtype)], axis=0)

    def run(args):
        tok, g, e = args
        return clamped_swiglu(h_pad[tok], w_gu[e], b_gu[e], w_down[e], b_down[e]) * g[:, None]

    y = lax.map(run, (tok_buf.reshape(n_blocks, MOE_BLOCK), gate_buf.reshape(n_blocks, MOE_BLOCK), blk_e))
    return jax.ops.segment_sum(y.reshape(p_rows, d), tok_buf, num_segments=n_tok + 1)[:n_tok]


def setup_inputs(seed: int = 0) -> dict:
    key = jax.random.key(seed)
    keys = iter(jax.random.split(key, 32))
    f32 = jnp.float32

    def nrm(shape, scale):
        return jax.random.normal(next(keys), shape, f32) * scale

    def gain(shape):
        return 1.0 + nrm(shape, 0.02)

    L, D = DEPTH, D_MODEL
    a0 = jax.random.uniform(next(keys), (L, 2, LRU_WIDTH), f32, 0.9, 0.999)
    root = a0 ** (1.0 / LRU_C)
    return {
        'x': nrm((BATCH, SEQ, D), 1.0),
        'c': nrm((BATCH, D), 1.0),
        'ctx': nrm((BATCH, CTX_LEN, D), 1.0),
        'c_ctx': nrm((D,), 1.0),
        'ada_w': nrm((L, D, 6 * D), 0.5 * D ** -0.5),
        'ada_b': nrm((L, 6 * D), 0.01),
        'norm1_g': gain((L, D)),
        'w_in': nrm((L, D, IN_W), D ** -0.5),
        'attn_sink': nrm((L, N_HEADS), 0.5),
        'conv_w': nrm((L, CONV_W, LRU_WIDTH), CONV_W ** -0.5),
        'conv_b': nrm((L, LRU_WIDTH), 0.01),
        'lru_wr': nrm((L, 2, LRU_BLOCKS, LRU_BLOCK_W, LRU_BLOCK_W), LRU_BLOCK_W ** -0.5),
        'lru_br': nrm((L, 2, LRU_WIDTH), 0.01),
        'lru_wi': nrm((L, 2, LRU_BLOCKS, LRU_BLOCK_W, LRU_BLOCK_W), LRU_BLOCK_W ** -0.5),
        'lru_bi': nrm((L, 2, LRU_WIDTH), 0.01),
        'lru_lambda': jnp.log(root) - jnp.log1p(-root),
        'hgrn_lb_logits': nrm((L, 2, HG_K_W), 0.5),
        'hgrn_norm_g': gain((L, HG_V_W)),
        'w_out': nrm((L, MIX_W, D), MIX_W ** -0.5),
        'norm2_g': gain((L, D)),
        'router_w': nrm((L, D, N_EXPERTS), D ** -0.5),
        'router_b': nrm((L, N_EXPERTS), 0.01),
        'moe_w_gu': nrm((L, N_EXPERTS, D, 2 * D_FF), D ** -0.5),
        'moe_b_gu': nrm((L, N_EXPERTS, 2 * D_FF), 0.01),
        'moe_w_down': nrm((L, N_EXPERTS, D_FF, D), D_FF ** -0.5),
        'moe_b_down': nrm((L, N_EXPERTS, D), 0.01),
        'final_g': gain((D,)),
    }


def reference(x, c, ctx, c_ctx, ada_w, ada_b, norm1_g, w_in, attn_sink, conv_w, conv_b,
              lru_wr, lru_br, lru_wi, lru_bi, lru_lambda, hgrn_lb_logits, hgrn_norm_g, w_out,
              norm2_g, router_w, router_b, moe_w_gu, moe_b_gu, moe_w_down, moe_b_down, final_g):
    bsz, seq, d = x.shape
    ctx_len = ctx.shape[1]
    cos, sin = axial_rope_tables(seq, x.dtype)
    lb_p = jax.nn.softmax(hgrn_lb_logits.astype(jnp.float32), axis=0)
    lower_bounds = jnp.cumsum(lb_p, axis=0) - lb_p[0]
    cond_l = jax.nn.silu(c)
    cond_c = jax.nn.silu(c_ctx)
    cuts = np.cumsum(IN_SPLITS)[:-1].tolist()
    xl, xc = x, ctx
    for layer in range(DEPTH):
        ctx_out = layer < DEPTH - 1
        mod_l = jnp.split((cond_l @ ada_w[layer] + ada_b[layer])[:, None, :], 6, axis=-1)
        mod_c = jnp.split(cond_c @ ada_w[layer] + ada_b[layer], 6, axis=-1)
        hl = modulate(rms_norm(xl, norm1_g[layer]), mod_l[0], mod_l[1])
        hc = modulate(rms_norm(xc, norm1_g[layer]), mod_c[0], mod_c[1])
        pl = jnp.split(hl @ w_in[layer], cuts, axis=-1)
        pc = jnp.split(hc @ w_in[layer], cuts, axis=-1)
        att_l, att_c = window_attention(pl[0], pl[1], pl[2], pc[0], pc[1], pc[2],
                                        attn_sink[layer], cos, sin, ctx_out)
        lru_l, lru_c = rglru_mixer(pl[3], pl[4], pc[3], pc[4], conv_w[layer], conv_b[layer],
                                   lru_wr[layer], lru_br[layer], lru_wi[layer], lru_bi[layer],
                                   lru_lambda[layer], ctx_out)
        hg_l, hg_c = hgrn2_mixer(pl[5:], pc[5:], lower_bounds[layer], hgrn_norm_g[layer], ctx_out)
        xl = xl + mod_l[2] * (jnp.concatenate([att_l, lru_l, hg_l], axis=-1) @ w_out[layer])
        hl = modulate(rms_norm(xl, norm2_g[layer]), mod_l[3], mod_l[4])
        tokens = hl.reshape(bsz * seq, d)
        if ctx_out:
            xc = xc + mod_c[2] * (jnp.concatenate([att_c, lru_c, hg_c], axis=-1) @ w_out[layer])
            hc = modulate(rms_norm(xc, norm2_g[layer]), mod_c[3], mod_c[4])
            tokens = jnp.concatenate([tokens, hc.reshape(bsz * ctx_len, d)], axis=0)
        ffn = moe_ffn(tokens, router_w[layer], router_b[layer], moe_w_gu[layer], moe_b_gu[layer],
                      moe_w_down[layer], moe_b_down[layer])
        xl = xl + mod_l[5] * ffn[:bsz * seq].reshape(bsz, seq, d)
        if ctx_out:
            xc = xc + mod_c[5] * ffn[bsz * seq:].reshape(bsz, ctx_len, d)
    return rms_norm(xl, final_g)
```

```cpp
#include <hip/hip_runtime.h>
#include <stdint.h>
#include <stdio.h>

#ifndef MK_N_LAUNCHES
#define MK_N_LAUNCHES 20
#endif

#define GAS __attribute__((address_space(1)))
#define LAS __attribute__((address_space(3)))
typedef unsigned short bf16;
typedef short bf16x8 __attribute__((ext_vector_type(8)));
typedef float f32x4 __attribute__((ext_vector_type(4)));
typedef float f32x2 __attribute__((ext_vector_type(2)));
typedef float f32x16 __attribute__((ext_vector_type(16)));
typedef unsigned u32x4 __attribute__((ext_vector_type(4)));
typedef unsigned u32x2 __attribute__((ext_vector_type(2)));
typedef GAS unsigned gu32;

constexpr int D = 1024, NB = 2, SEQ = 16384, CTXL = 256, NL = 2;
constexpr int ML = NB * SEQ, MC = NB * CTXL, MA = ML + MC;
constexpr int INW = 2560;
constexpr int C_Q = 0, C_K = 512, C_V = 640, C_LX = 768, C_LG = 1024, C_HQ = 1280, C_HF = 1536, C_HB = 1792, C_HV = 2048, C_HO = 2304;
constexpr int NE = 32, FF = 1024, CAP = MA;
constexpr float EPS = 1e-6f;
constexpr float LOG2E = 1.4426950408889634f;
constexpr float QSCALE = 0.125f * LOG2E;
constexpr int NWAVES = 8, NTHR = 512;
constexpr int N_PH = 20;

constexpr size_t MiB = 1u << 20;
constexpr size_t WS_CTL = 0, CTL_ZERO_BYTES = 1 * MiB;
constexpr size_t WS_MODS = 1 * MiB;
constexpr size_t WS_ROPE = 2 * MiB;
constexpr size_t WS_LRUW = 3 * MiB;
constexpr size_t WS_WIN = 4 * MiB;
constexpr size_t WS_WOUT = 16 * MiB;
constexpr size_t WS_WGU = 20 * MiB;
constexpr size_t WS_WD = 276 * MiB;
constexpr size_t WS_XL = 404 * MiB;
constexpr size_t WS_H1 = 534 * MiB;
constexpr size_t WS_P = 599 * MiB;
constexpr size_t WS_VT = 762 * MiB;
constexpr size_t WS_MIX = 771 * MiB;
constexpr size_t WS_HD = 836 * MiB;
constexpr size_t WS_OHG = 901 * MiB;
constexpr size_t WS_GA = 966 * MiB;
constexpr size_t WS_GB = 1031 * MiB;
constexpr size_t WS_AGG = 1096 * MiB;
constexpr size_t WS_LIST = 1136 * MiB;
constexpr size_t WS_HMOE = 1152 * MiB;
constexpr size_t WS_Y2 = 1428 * MiB;
constexpr size_t WS_END = 1688 * MiB;
constexpr size_t VT_CTX_OFF = (size_t)NB * 2 * 64 * SEQ;
constexpr int CW_CNT = 64;
constexpr int CW_BAR = 4096;

__device__ __forceinline__ float bf2f(bf16 x) { return __uint_as_float(((unsigned)x) << 16); }
__device__ __forceinline__ unsigned f2bf(float f) { unsigned u = __float_as_uint(f); return (u + 0x7fffu + ((u >> 16) & 1u)) >> 16; }
__device__ __forceinline__ unsigned pk2(float lo, float hi) { return f2bf(lo) | (f2bf(hi) << 16); }
__device__ __forceinline__ float wave_sum(float v) {
#pragma unroll
    for (int o = 1; o < 64; o <<= 1) v += __shfl_xor(v, o);
    return v;
}
__device__ __forceinline__ float wave_max(float v) {
#pragma unroll
    for (int o = 1; o < 64; o <<= 1) v = fmaxf(v, __shfl_xor(v, o));
    return v;
}
__device__ __forceinline__ float sigmoidf_(float x) { return 1.0f / (1.0f + __expf(-x)); }
__device__ __forceinline__ float siluf_(float x) { return x / (1.0f + __expf(-x)); }
__device__ __forceinline__ float gelu_tanh(float x) { const float u = 0.7978845608028654f * (x + 0.044715f * x * x * x); const float t = 1.0f - 2.0f / (__expf(2.0f * u) + 1.0f); return 0.5f * x * (1.0f + t); }
__device__ __forceinline__ int crow(int r, int hi) { return (r & 3) + 8 * (r >> 2) + 4 * hi; }

struct Args { const float* in[27]; float* out; unsigned char* ws; int ph_lo, ph_hi; };
struct Ctx {
    LAS unsigned char* lds;
    int tid, lane, wave, G, bid;
    const float* const* in;
    float* out; unsigned char* ws;
    gu32* ctl;
    float* mods; f32x2* rope; bf16* lruw; bf16* WinT; bf16* WoutT; bf16* WguT; bf16* WdT;
    float* XL; bf16* H1; bf16* P; bf16* Vt; bf16* MIX; float* HD; float* OHG; float* GA; float* GB; float* AGG;
    int* list_tok; int* list_dst; float* list_gate; bf16* HMOE; bf16* Y2;
};
enum { I_X = 0, I_C, I_CTX, I_CCTX, I_ADAW, I_ADAB, I_N1G, I_WIN, I_SINK, I_CONVW, I_CONVB, I_WR, I_BR, I_WI, I_BI, I_LAM, I_LBL, I_HNG, I_WOUT, I_N2G, I_RW, I_RB, I_WGU, I_BGU, I_WD, I_BD, I_FG };

__device__ __forceinline__ int row_b(int m) { return m < ML ? m / SEQ : (m - ML) / CTXL; }
__device__ __forceinline__ int row_t(int m) { return m < ML ? m % SEQ : (m - ML) % CTXL; }
__device__ __forceinline__ int mod_row(int m) { return m < ML ? m / SEQ : 2; }

__device__ __forceinline__ int dest_win(int n) {
    if (n >= C_V) return n;
    const int d = n & 63, p = d >> 5, half = (d >> 4) & 1, f = d & 15;
    return (n & ~63) + 2 * (p * 16 + f) + half;
}
__device__ __forceinline__ int dest_gu(int n) {
    const int up = n >= FF ? 1 : 0, ff = n & (FF - 1);
    return (ff >> 7) * 256 + up * 128 + (ff & 127);
}
template <int MAP>
__device__ __forceinline__ void tr_item(const float* W, int K, int N, bf16* WT, LAS float* scr, int item, int lane) {
    const int nblk = N / 32, kb = item / nblk, nb = item % nblk, k0 = 64 * kb, n0 = 32 * nb;
#pragma unroll 8
    for (int i = 0; i < 32; ++i) { const int kk = 2 * i + (lane >> 5); scr[kk * 33 + (lane & 31)] = W[(size_t)(k0 + kk) * N + n0 + (lane & 31)]; }
    asm volatile("s_waitcnt lgkmcnt(0)" ::: "memory");
    const int c = lane & 7;
#pragma unroll
    for (int j = 0; j < 4; ++j) {
        const int n = (lane >> 3) + 8 * j; const LAS float* s = scr + (8 * c) * 33 + n;
        u32x4 o; o.x = pk2(s[0 * 33], s[1 * 33]); o.y = pk2(s[2 * 33], s[3 * 33]); o.z = pk2(s[4 * 33], s[5 * 33]); o.w = pk2(s[6 * 33], s[7 * 33]);
        const int nn = n0 + n; const int dr = MAP == 1 ? dest_win(nn) : (MAP == 2 ? dest_gu(nn) : nn);
        *(u32x4*)(WT + (size_t)dr * K + k0 + 8 * c) = o;
    }
    asm volatile("s_waitcnt lgkmcnt(0)" ::: "memory");
}
__device__ __forceinline__ void ph_prologue(Ctx& F) {
    LAS float* scr = (LAS float*)(F.lds + F.wave * 8704);
    const int gw = F.bid * NWAVES + F.wave, NGW = F.G * NWAVES;
    constexpr int I_IN = 16 * 80, I_OUT = 16 * 32, I_GU = 16 * 64, I_DN = 16 * 32;
    constexpr int N_IN = NL * I_IN, N_OUT = NL * I_OUT, N_GU = NL * NE * I_GU, N_DN = NL * NE * I_DN;
    for (int it = gw; it < N_IN + N_OUT + N_GU + N_DN; it += NGW) {
        int r = it;
        if (r < N_IN) { const int l = r / I_IN; tr_item<1>(F.in[I_WIN] + (size_t)l * D * INW, D, INW, F.WinT + (size_t)l * INW * D, scr, r % I_IN, F.lane); continue; } r -= N_IN;
        if (r < N_OUT) { const int l = r / I_OUT; tr_item<0>(F.in[I_WOUT] + (size_t)l * D * D, D, D, F.WoutT + (size_t)l * D * D, scr, r % I_OUT, F.lane); continue; } r -= N_OUT;
        if (r < N_GU) { const int le = r / I_GU; tr_item<2>(F.in[I_WGU] + (size_t)le * D * 2 * FF, D, 2 * FF, F.WguT + (size_t)le * 2 * FF * D, scr, r % I_GU, F.lane); continue; } r -= N_GU;
        { const int le = r / I_DN; tr_item<0>(F.in[I_WD] + (size_t)le * FF * D, FF, D, F.WdT + (size_t)le * D * FF, scr, r % I_DN, F.lane); }
    }
    const int gt = F.bid * NTHR + F.tid, NGT = F.G * NTHR;
    for (int i = gt; i < NL * 2 * 2 * 4 * 4096; i += NGT) {
        const int c = i & 63, dd = (i >> 6) & 63, n = (i >> 12) & 3, g = (i >> 14) & 1, d = (i >> 15) & 1, l = i >> 16;
        const float* src = g ? F.in[I_WI] : F.in[I_WR];
        F.lruw[i] = (bf16)f2bf(src[((((size_t)l * 2 + d) * 4 + n) * 64 + c) * 64 + dd]);
    }
    for (int i = gt; i < 256 * 16; i += NGT) {
        const int pos = i >> 4, f = i & 15;
        const float invf[16] = {1.000000000e+00f, 5.623413324e-01f, 3.162277639e-01f, 1.778279394e-01f, 1.000000015e-01f, 5.623413250e-02f, 3.162277490e-02f, 1.778279431e-02f,
                                9.999999776e-03f, 5.623413250e-03f, 3.162277630e-03f, 1.778279431e-03f, 1.000000047e-03f, 5.623413017e-04f, 3.162277571e-04f, 1.778279402e-04f};
        float fr = 1.0f;
#pragma unroll
        for (int q = 0; q < 16; ++q) fr = (f == q) ? invf[q] : fr;
        const float ang = (float)pos * fr;
        double rev = (double)ang * 0.15915494309189535; rev -= floor(rev);
        F.rope[i] = (f32x2){__builtin_amdgcn_cosf((float)rev), __builtin_amdgcn_sinf((float)rev)};
    }
    LAS float* cond = (LAS float*)(F.lds + 72 * 1024);
    LAS float* red = (LAS float*)(F.lds + 88 * 1024);
    __syncthreads();
    for (int i = F.tid; i < 3 * D; i += NTHR) { const int r = i / D, k = i % D; const float v = r < 2 ? F.in[I_C][r * D + k] : F.in[I_CCTX][k]; cond[i] = siluf_(v); }
    __syncthreads();
    for (int unit = F.bid; unit < NL * 192; unit += F.G) {
        const int l = unit / 192, col0 = (unit % 192) * 32, cl = F.tid & 31, ks = F.tid >> 5;
        const float* W = F.in[I_ADAW] + (size_t)l * D * 6 * D + col0 + cl;
        float a0 = 0.f, a1 = 0.f, a2 = 0.f;
#pragma unroll 8
        for (int k = ks * 64; k < ks * 64 + 64; ++k) { const float w = W[(size_t)k * 6 * D]; a0 += cond[k] * w; a1 += cond[D + k] * w; a2 += cond[2 * D + k] * w; }
        red[(ks * 3 + 0) * 32 + cl] = a0; red[(ks * 3 + 1) * 32 + cl] = a1; red[(ks * 3 + 2) * 32 + cl] = a2;
        __syncthreads();
        if (F.tid < 96) { const int i = F.tid >> 5; float s = F.in[I_ADAB][l * 6 * D + col0 + cl];
            for (int q = 0; q < 16; ++q) s += red[(q * 3 + i) * 32 + cl];
            F.mods[((size_t)l * 3 + i) * 6 * D + col0 + cl] = s; }
        __syncthreads();
    }
}

__device__ __forceinline__ void ph_norm1(Ctx& F, int l) {
    const int gw = F.bid * NWAVES + F.wave, NGW = F.G * NWAVES;
    const int M = (l == 2) ? ML : MA;
    for (int m = gw; m < M; m += NGW) {
        const float* src = (l == 0) ? (m < ML ? F.in[I_X] + (size_t)m * D : F.in[I_CTX] + (size_t)(m - ML) * D) : F.XL + (size_t)m * D;
        const int mr = mod_row(m);
        f32x4 v[4];
#pragma unroll
        for (int j = 0; j < 4; ++j) v[j] = *(const f32x4*)(src + 4 * F.lane + 256 * j);
        if (l > 0) {
            const float* g5 = F.mods + ((size_t)(l - 1) * 3 + mr) * 6 * D + 5 * D;
#pragma unroll
            for (int j = 0; j < 4; ++j) {
                const int col = 4 * F.lane + 256 * j; f32x4 s = {0.f, 0.f, 0.f, 0.f};
#pragma unroll
                for (int q = 0; q < 4; ++q) { const u32x2 w = *(const u32x2*)(F.Y2 + ((size_t)m * 4 + q) * D + col);
                    s.x += __uint_as_float(w.x << 16); s.y += __uint_as_float(w.x & 0xffff0000u); s.z += __uint_as_float(w.y << 16); s.w += __uint_as_float(w.y & 0xffff0000u); }
                const f32x4 g = *(const f32x4*)(g5 + col);
                v[j] += g * s;
            }
        }
        if (l < 2) {
#pragma unroll
            for (int j = 0; j < 4; ++j) *(f32x4*)(F.XL + (size_t)m * D + 4 * F.lane + 256 * j) = v[j];
        }
        float ss = 0.f;
#pragma unroll
        for (int j = 0; j < 4; ++j) ss += (v[j].x * v[j].x + v[j].y * v[j].y) + (v[j].z * v[j].z + v[j].w * v[j].w);
        const float rstd = 1.0f / sqrtf(wave_sum(ss) * (1.0f / D) + EPS);
        if (l == 2) {
#pragma unroll
            for (int j = 0; j < 4; ++j) { const int col = 4 * F.lane + 256 * j; const f32x4 g = *(const f32x4*)(F.in[I_FG] + col); *(f32x4*)(F.out + (size_t)m * D + col) = v[j] * rstd * g; }
        } else {
            const float* mo = F.mods + ((size_t)l * 3 + mr) * 6 * D;
            const float* g1 = F.in[I_N1G] + l * D;
#pragma unroll
            for (int j = 0; j < 4; ++j) { const int col = 4 * F.lane + 256 * j;
                const f32x4 g = *(const f32x4*)(g1 + col), sh = *(const f32x4*)(mo + col), sc = *(const f32x4*)(mo + D + col);
                const f32x4 h = v[j] * rstd * g * (sc + 1.0f) + sh;
                u32x2 w; w.x = pk2(h.x, h.y); w.y = pk2(h.z, h.w);
                *(u32x2*)(F.H1 + (size_t)m * D + col) = w; }
        }
    }
}

__device__ __forceinline__ void sg_kloop(f32x16 (&acc)[2][2], const bf16* a0, const bf16* a1, const bf16* b0, const bf16* b1, int K) {
#pragma unroll
    for (int i = 0; i < 2; ++i)
#pragma unroll
        for (int j = 0; j < 2; ++j)
#pragma unroll
            for (int r = 0; r < 16; ++r) acc[i][j][r] = 0.f;
#pragma unroll 4
    for (int k = 0; k < K; k += 16) {
        const bf16x8 fa0 = *(const bf16x8*)(a0 + k), fa1 = *(const bf16x8*)(a1 + k), fb0 = *(const bf16x8*)(b0 + k), fb1 = *(const bf16x8*)(b1 + k);
        acc[0][0] = __builtin_amdgcn_mfma_f32_32x32x16_bf16(fa0, fb0, acc[0][0], 0, 0, 0);
        acc[0][1] = __builtin_amdgcn_mfma_f32_32x32x16_bf16(fa0, fb1, acc[0][1], 0, 0, 0);
        acc[1][0] = __builtin_amdgcn_mfma_f32_32x32x16_bf16(fa1, fb0, acc[1][0], 0, 0, 0);
        acc[1][1] = __builtin_amdgcn_mfma_f32_32x32x16_bf16(fa1, fb1, acc[1][1], 0, 0, 0);
    }
}

__device__ __forceinline__ float inproj_fix(const Ctx& F, int m, int c, float v, float partner) {
    float o = v;
    if (c < C_V) {
        if (m < ML) {
            const int t = m % SEQ, dp = c & 63, pr = dp >> 1, p = pr >> 4, f = pr & 15, pos = p ? (t & 63) : (t >> 6);
            const f32x2 cs = F.rope[pos * 16 + f];
            o = (dp & 1) ? (partner * cs.y + v * cs.x) : (v * cs.x - partner * cs.y);
        }
        if (c < C_K) o *= QSCALE;
    }
    return o;
}
__device__ __forceinline__ size_t vt_index(int m, int cv  ) {
    const int kvh = cv >> 6, d = cv & 63;
    if (m < ML) { const int b = m / SEQ, t = m % SEQ; return ((size_t)((b * 2 + kvh) * 64 + d)) * SEQ + t; }
    const int b = (m - ML) / CTXL, t = (m - ML) % CTXL; return VT_CTX_OFF + ((size_t)((b * 2 + kvh) * 64 + d)) * CTXL + t;
}
__device__ __forceinline__ void ph_inproj_naive(Ctx& F, int l) {
    const int gw = F.bid * NWAVES + F.wave, NGW = F.G * NWAVES, r = F.lane & 31, h = F.lane >> 5;
    const bf16* Bt = F.WinT + (size_t)l * INW * D;
    for (int ti = gw; ti < (MA / 64) * (INW / 64); ti += NGW) {
        const int rt = ti / (INW / 64), ct = ti % (INW / 64), m0 = rt * 64, c0 = ct * 64;
        f32x16 acc[2][2];
        sg_kloop(acc, F.H1 + (size_t)(m0 + r) * D + 8 * h, F.H1 + (size_t)(m0 + 32 + r) * D + 8 * h, Bt + (size_t)(c0 + r) * D + 8 * h, Bt + (size_t)(c0 + 32 + r) * D + 8 * h, D);
#pragma unroll
        for (int mt = 0; mt < 2; ++mt)
#pragma unroll
            for (int nt = 0; nt < 2; ++nt)
#pragma unroll
                for (int q = 0; q < 16; ++q) {
                    const int m = m0 + 32 * mt + crow(q, h), c = c0 + 32 * nt + r;
                    const float v = acc[mt][nt][q], pa = __shfl_xor(v, 1);
                    const float o = inproj_fix(F, m, c, v, pa);
                    F.P[(size_t)m * INW + c] = (bf16)f2bf(o);
                    if (c >= C_V && c < C_LX) F.Vt[vt_index(m, c - C_V)] = (bf16)f2bf(o);
                }
    }
}

__device__ __forceinline__ float dot64(const float (&q)[64], const bf16* kp) {
    float s = 0.f;
#pragma unroll
    for (int i = 0; i < 8; ++i) { const u32x4 w = *(const u32x4*)(kp + 8 * i);
        s += q[8 * i + 0] * __uint_as_float(w.x << 16) + q[8 * i + 1] * __uint_as_float(w.x & 0xffff0000u) + q[8 * i + 2] * __uint_as_float(w.y << 16) + q[8 * i + 3] * __uint_as_float(w.y & 0xffff0000u)
           + q[8 * i + 4] * __uint_as_float(w.z << 16) + q[8 * i + 5] * __uint_as_float(w.z & 0xffff0000u) + q[8 * i + 6] * __uint_as_float(w.w << 16) + q[8 * i + 7] * __uint_as_float(w.w & 0xffff0000u); }
    return s;
}
__device__ __forceinline__ void ph_attn_naive(Ctx& F, int l) {
    const int gw = F.bid * NWAVES + F.wave, NGW = F.G * NWAVES;
    const int Mq = (l == 0) ? MA : ML;
    LAS float* pbuf = (LAS float*)(F.lds) + F.wave * 640;
    for (int u = gw; u < Mq * 8; u += NGW) {
        const int m = u >> 3, hq = u & 7, kvh = hq >> 2;
        const bool isc = m >= ML; const int b = row_b(m), t = row_t(m);
        float q[64];
        { const bf16* qp = F.P + (size_t)m * INW + C_Q + hq * 64;
#pragma unroll
          for (int i = 0; i < 8; ++i) { const u32x4 w = *(const u32x4*)(qp + 8 * i);
              q[8 * i + 0] = __uint_as_float(w.x << 16); q[8 * i + 1] = __uint_as_float(w.x & 0xffff0000u); q[8 * i + 2] = __uint_as_float(w.y << 16); q[8 * i + 3] = __uint_as_float(w.y & 0xffff0000u);
              q[8 * i + 4] = __uint_as_float(w.z << 16); q[8 * i + 5] = __uint_as_float(w.z & 0xffff0000u); q[8 * i + 6] = __uint_as_float(w.w << 16); q[8 * i + 7] = __uint_as_float(w.w & 0xffff0000u); } }
        const int lo = isc ? 0 : (t - 128 < 0 ? 0 : t - 128), hi = isc ? -1 : (t + 128 > SEQ - 1 ? SEQ - 1 : t + 128);
        const int nloc = hi - lo + 1, nk = nloc + CTXL;
        const float sink2 = F.in[I_SINK][l * 8 + hq] * LOG2E;
        float s[9]; float mx = sink2;
#pragma unroll
        for (int i = 0; i < 9; ++i) { const int kk = F.lane + 64 * i; s[i] = -3.0e38f;
            if (kk < nk) { const int krow = kk < nloc ? b * SEQ + lo + kk : ML + b * CTXL + (kk - nloc);
                s[i] = dot64(q, F.P + (size_t)krow * INW + C_K + kvh * 64); mx = fmaxf(mx, s[i]); } }
        mx = wave_max(mx);
        float lsum = 0.f;
#pragma unroll
        for (int i = 0; i < 9; ++i) { const int kk = F.lane + 64 * i; const float p = (kk < nk) ? exp2f(s[i] - mx) : 0.f; lsum += p; pbuf[kk] = p; }
        lsum = wave_sum(lsum) + exp2f(sink2 - mx);
        asm volatile("s_waitcnt lgkmcnt(0)" ::: "memory");
        float o = 0.f;
        for (int kk = 0; kk < nk; ++kk) { const int krow = kk < nloc ? b * SEQ + lo + kk : ML + b * CTXL + (kk - nloc);
            o += pbuf[kk] * bf2f(F.P[(size_t)krow * INW + C_V + kvh * 64 + F.lane]); }
        F.MIX[(size_t)m * D + hq * 64 + F.lane] = (bf16)f2bf(o / lsum);
        asm volatile("s_waitcnt lgkmcnt(0)" ::: "memory");
    }
}
__device__ __forceinline__ void ph_lru_gates_naive(Ctx& F, int l) {
    const size_t gt = (size_t)F.bid * NTHR + F.tid, NGT = (size_t)F.G * NTHR;
    for (size_t i = gt; i < (size_t)MA * 512; i += NGT) {
        const int m = (int)(i >> 9), d = (int)(i >> 8) & 1, c = (int)i & 255, n = c >> 6, cc0 = c & 63;
        const int t = row_t(m), T = m < ML ? SEQ : CTXL, rb = m - t;
        const float* wr = F.in[I_WR] + (((size_t)l * 2 + d) * 4 + n) * 4096;
        const float* wi = F.in[I_WI] + (((size_t)l * 2 + d) * 4 + n) * 4096;
        float rp = F.in[I_BR][(l * 2 + d) * 256 + c], ip = F.in[I_BI][(l * 2 + d) * 256 + c], us = 0.f;
        for (int cc = 0; cc < 64; ++cc) {
            const int ch = n * 64 + cc; float u = F.in[I_CONVB][l * 256 + ch];
#pragma unroll
            for (int j = 0; j < 4; ++j) { const int tt = t - 2 + j; if (tt >= 0 && tt < T) u += F.in[I_CONVW][(l * 4 + j) * 256 + ch] * bf2f(F.P[(size_t)(rb + tt) * INW + C_LX + ch]); }
            rp += u * wr[cc * 64 + cc0]; ip += u * wi[cc * 64 + cc0];
            if (cc == cc0) us = u;
        }
        const float r = sigmoidf_(rp), ig = sigmoidf_(ip);
        const float lam = F.in[I_LAM][(l * 2 + d) * 256 + c];
        const float la = -8.0f * r * log1pf(expf(-lam));
        const float a = expf(la), mult = sqrtf(fmaxf(-expm1f(2.0f * la), 1e-12f));
        F.GA[i] = a; F.GB[i] = mult * ig * us;
    }
}
__device__ __forceinline__ void ph_lru_scan_naive(Ctx& F) {
    const int gt = F.bid * NTHR + F.tid;
    if (gt >= NB * 512) return;
    const int b = gt >> 9, d = (gt >> 8) & 1, c = gt & 255;
    float h = 0.f;
    for (int s = 0; s < CTXL + SEQ; ++s) {
        int m;
        if (s < CTXL) m = ML + b * CTXL + (d ? CTXL - 1 - s : s); else { const int t = s - CTXL; m = b * SEQ + (d ? SEQ - 1 - t : t); }
        const size_t i = (size_t)m * 512 + d * 256 + c;
        h = F.GA[i] * h + F.GB[i];
        F.HD[i] = h;
    }
}
__device__ __forceinline__ void ph_lru_out_naive(Ctx& F, int l) {
    const size_t gt = (size_t)F.bid * NTHR + F.tid, NGT = (size_t)F.G * NTHR;
    const int Mq = (l == 0) ? MA : ML;
    for (size_t i = gt; i < (size_t)Mq * 256; i += NGT) {
        const int m = (int)(i >> 8), c = (int)i & 255;
        const float y = (F.HD[(size_t)m * 512 + c] + F.HD[(size_t)m * 512 + 256 + c]) * gelu_tanh(bf2f(F.P[(size_t)m * INW + C_LG + c]));
        F.MIX[(size_t)m * D + 512 + c] = (bf16)f2bf(y);
    }
}
__device__ __forceinline__ float hg_lb(const Ctx& F, int l, int d, int hk) {
    if (l == 0) return 0.f;
    const float l0 = F.in[I_LBL][(0 * 2 + d) * 256 + hk], l1 = F.in[I_LBL][(1 * 2 + d) * 256 + hk];
    return 1.0f / (1.0f + expf(l0 - l1));
}
__device__ __forceinline__ void ph_hgrn_scan_naive(Ctx& F, int l) {
    if (F.bid >= NB * 2 * 4) return;
    const int b = F.bid >> 3, d = (F.bid >> 2) & 1, hh = F.bid & 3;
    const int v = F.tid & 63, kq = F.tid >> 6;
    LAS float* part = (LAS float*)F.lds;
    float lb[8], S[8];
#pragma unroll
    for (int i = 0; i < 8; ++i) { lb[i] = hg_lb(F, l, d, hh * 64 + kq * 8 + i); S[i] = 0.f; }
    int buf = 0;
    for (int s = 0; s < CTXL + SEQ; ++s) {
        int m;
        if (s < CTXL) m = ML + b * CTXL + (d ? CTXL - 1 - s : s); else { const int t = s - CTXL; m = b * SEQ + (d ? SEQ - 1 - t : t); }
        const bf16* pr = F.P + (size_t)m * INW;
        const u32x4 zw = *(const u32x4*)(pr + (d ? C_HB : C_HF) + hh * 64 + kq * 8), qw = *(const u32x4*)(pr + C_HQ + hh * 64 + kq * 8);
        const float vv = bf2f(pr[C_HV + hh * 64 + v]);
        float z[8], q[8];
        z[0] = __uint_as_float(zw.x << 16); z[1] = __uint_as_float(zw.x & 0xffff0000u); z[2] = __uint_as_float(zw.y << 16); z[3] = __uint_as_float(zw.y & 0xffff0000u);
        z[4] = __uint_as_float(zw.z << 16); z[5] = __uint_as_float(zw.z & 0xffff0000u); z[6] = __uint_as_float(zw.w << 16); z[7] = __uint_as_float(zw.w & 0xffff0000u);
        q[0] = __uint_as_float(qw.x << 16); q[1] = __uint_as_float(qw.x & 0xffff0000u); q[2] = __uint_as_float(qw.y << 16); q[3] = __uint_as_float(qw.y & 0xffff0000u);
        q[4] = __uint_as_float(qw.z << 16); q[5] = __uint_as_float(qw.z & 0xffff0000u); q[6] = __uint_as_float(qw.w << 16); q[7] = __uint_as_float(qw.w & 0xffff0000u);
        float pa = 0.f;
#pragma unroll
        for (int i = 0; i < 8; ++i) { const float sg = sigmoidf_(z[i]); const float f = lb[i] + (1.0f - lb[i]) * sg, kk = (1.0f - lb[i]) * (1.0f - sg);
            S[i] = f * S[i] + kk * vv; pa += S[i] * q[i]; }
        part[(buf * 8 + kq) * 64 + v] = pa;
        __syncthreads();
        if (kq == 0) { float o = 0.f;
#pragma unroll
            for (int i = 0; i < 8; ++i) o += part[(buf * 8 + i) * 64 + v];
            F.OHG[(size_t)m * 512 + d * 256 + hh * 64 + v] = o; }
        buf ^= 1;
    }
}
__device__ __forceinline__ void ph_hgrn_out_naive(Ctx& F, int l) {
    const int gw = F.bid * NWAVES + F.wave, NGW = F.G * NWAVES;
    const int Mq = (l == 0) ? MA : ML;
    for (int m = gw; m < Mq; m += NGW) {
        const int col = 4 * F.lane;
        const f32x4 a = *(const f32x4*)(F.OHG + (size_t)m * 512 + col), bb = *(const f32x4*)(F.OHG + (size_t)m * 512 + 256 + col);
        const f32x4 o = a + bb;
        float ss = (o.x * o.x + o.y * o.y) + (o.z * o.z + o.w * o.w);
        ss += __shfl_xor(ss, 1); ss += __shfl_xor(ss, 2); ss += __shfl_xor(ss, 4); ss += __shfl_xor(ss, 8);
        const float rstd = 1.0f / sqrtf(ss * (1.0f / 64.0f) + EPS);
        const f32x4 g = *(const f32x4*)(F.in[I_HNG] + l * 256 + col);
        const u32x2 ow = *(const u32x2*)(F.P + (size_t)m * INW + C_HO + col);
        const float g0 = siluf_(__uint_as_float(ow.x << 16)), g1 = siluf_(__uint_as_float(ow.x & 0xffff0000u)), g2 = siluf_(__uint_as_float(ow.y << 16)), g3 = siluf_(__uint_as_float(ow.y & 0xffff0000u));
        u32x2 w; w.x = pk2(o.x * rstd * g.x * g0, o.y * rstd * g.y * g1); w.y = pk2(o.z * rstd * g.z * g2, o.w * rstd * g.w * g3);
        *(u32x2*)(F.MIX + (size_t)m * D + 768 + col) = w;
    }
}

__device__ __forceinline__ void ph_outproj_naive(Ctx& F, int l) {
    const int gw = F.bid * NWAVES + F.wave, NGW = F.G * NWAVES, r = F.lane & 31, h = F.lane >> 5;
    const int Mq = (l == 0) ? MA : ML;
    const bf16* Bt = F.WoutT + (size_t)l * D * D;
    for (int ti = gw; ti < (Mq / 64) * (D / 64); ti += NGW) {
        const int rt = ti / (D / 64), ct = ti % (D / 64), m0 = rt * 64, c0 = ct * 64;
        f32x16 acc[2][2];
        sg_kloop(acc, F.MIX + (size_t)(m0 + r) * D + 8 * h, F.MIX + (size_t)(m0 + 32 + r) * D + 8 * h, Bt + (size_t)(c0 + r) * D + 8 * h, Bt + (size_t)(c0 + 32 + r) * D + 8 * h, D);
#pragma unroll
        for (int mt = 0; mt < 2; ++mt)
#pragma unroll
            for (int nt = 0; nt < 2; ++nt)
#pragma unroll
                for (int q = 0; q < 16; ++q) {
                    const int m = m0 + 32 * mt + crow(q, h), c = c0 + 32 * nt + r;
                    const float g2 = F.mods[((size_t)l * 3 + mod_row(m)) * 6 * D + 2 * D + c];
                    F.XL[(size_t)m * D + c] += g2 * acc[mt][nt][q];
                }
    }
}

__device__ __forceinline__ void ph_norm2_router(Ctx& F, int l) {
    const int Mq = (l == 0) ? MA : ML;
    LAS float* hs = (LAS float*)F.lds;
    LAS float* part = (LAS float*)(F.lds + 32768);
    LAS float* lg = (LAS float*)(F.lds + 32768 + 16384);
    const int e = F.tid & 31, ds = F.tid >> 5;
    float wreg[64];
#pragma unroll
    for (int i = 0; i < 64; ++i) wreg[i] = F.in[I_RW][((size_t)l * D + ds * 64 + i) * NE + e];
    const float* g2 = F.in[I_N2G] + l * D;
    unsigned* cnt = (unsigned*)(F.ctl + CW_CNT + l * 64);
    for (int base = F.bid * 8; base < Mq; base += F.G * 8) {
        { const int m = base + F.wave;
          const float* mo = F.mods + ((size_t)l * 3 + mod_row(m)) * 6 * D;
          f32x4 v[4]; float ss = 0.f;
#pragma unroll
          for (int j = 0; j < 4; ++j) { v[j] = *(const f32x4*)(F.XL + (size_t)m * D + 4 * F.lane + 256 * j); ss += (v[j].x * v[j].x + v[j].y * v[j].y) + (v[j].z * v[j].z + v[j].w * v[j].w); }
          const float rstd = 1.0f / sqrtf(wave_sum(ss) * (1.0f / D) + EPS);
#pragma unroll
          for (int j = 0; j < 4; ++j) { const int col = 4 * F.lane + 256 * j;
              const f32x4 g = *(const f32x4*)(g2 + col), sh = *(const f32x4*)(mo + 3 * D + col), sc = *(const f32x4*)(mo + 4 * D + col);
              const f32x4 h = v[j] * rstd * g * (sc + 1.0f) + sh;
              u32x2 w; w.x = pk2(h.x, h.y); w.y = pk2(h.z, h.w);
              *(u32x2*)(F.H1 + (size_t)m * D + col) = w;
              *(LAS f32x4*)(hs + F.wave * D + col) = h; } }
        __syncthreads();
#pragma unroll
        for (int rr = 0; rr < 8; ++rr) { float a = 0.f;
#pragma unroll
            for (int i = 0; i < 16; ++i) { const f32x4 hv = *(const LAS f32x4*)(hs + rr * D + ds * 64 + 4 * i);
                a += hv.x * wreg[4 * i] + hv.y * wreg[4 * i + 1] + hv.z * wreg[4 * i + 2] + hv.w * wreg[4 * i + 3]; }
            part[(rr * 16 + ds) * 32 + e] = a; }
        __syncthreads();
        if (F.tid < 256) { const int rr = F.tid >> 5; float s = F.in[I_RB][l * NE + e];
#pragma unroll
            for (int q = 0; q < 16; ++q) s += part[(rr * 16 + q) * 32 + e];
            lg[rr * 32 + e] = s; }
        __syncthreads();
        if (F.tid < 8) { const int m = base + F.tid; unsigned chosen = 0u; float tv[4]; int tix[4];
#pragma unroll
            for (int j = 0; j < 4; ++j) { float best = -3.0e38f; int bi = 0;
                for (int q = 0; q < 32; ++q) { const float x = lg[F.tid * 32 + q]; if (!((chosen >> q) & 1u) && x > best) { best = x; bi = q; } }
                chosen |= 1u << bi; tv[j] = best; tix[j] = bi; }
            float den = 0.f, pe[4];
#pragma unroll
            for (int j = 0; j < 4; ++j) { pe[j] = __expf(tv[j] - tv[0]); den += pe[j]; }
#pragma unroll
            for (int j = 0; j < 4; ++j) { const int ee = tix[j]; const unsigned pos = atomicAdd(cnt + ee, 1u);
                F.list_tok[(size_t)ee * CAP + pos] = m; F.list_dst[(size_t)ee * CAP + pos] = m * 4 + j; F.list_gate[(size_t)ee * CAP + pos] = pe[j] / den; } }
        __syncthreads();
    }
}

__device__ __forceinline__ void ph_moe_gu_naive(Ctx& F, int l) {
    const int gw = F.bid * NWAVES + F.wave, NGW = F.G * NWAVES, r = F.lane & 31, h = F.lane >> 5;
    const unsigned* cnt = (const unsigned*)(F.ctl + CW_CNT + l * 64);
    int id0 = 0, ts256 = 0;
    for (int e = 0; e < NE; ++e) {
        const int ce = (int)__hip_atomic_load(cnt + e, __ATOMIC_RELAXED, __HIP_MEMORY_SCOPE_AGENT);
        const int nrt = (ce + 63) / 64, n = nrt * 32;
        const bf16* Bt = F.WguT + ((size_t)l * NE + e) * 2 * FF * D;
        const float* bg = F.in[I_BGU] + ((size_t)l * NE + e) * 2 * FF;
        int id = id0 + ((gw - id0 % NGW) + NGW) % NGW;
        for (; id < id0 + n; id += NGW) {
            const int rt = (id - id0) / 32, ft = (id - id0) % 32, pos0 = rt * 64, ff0 = ft * 32;
            const int p0 = pos0 + r, p1 = pos0 + 32 + r;
            const int t0 = p0 < ce ? F.list_tok[(size_t)e * CAP + p0] : 0, t1 = p1 < ce ? F.list_tok[(size_t)e * CAP + p1] : 0;
            const int ng = (ff0 >> 7) * 256 + (ff0 & 127) + r;
            f32x16 acc[2][2];
            sg_kloop(acc, F.H1 + (size_t)t0 * D + 8 * h, F.H1 + (size_t)t1 * D + 8 * h, Bt + (size_t)ng * D + 8 * h, Bt + (size_t)(ng + 128) * D + 8 * h, D);
            const float bgate = bg[ff0 + r], bup = bg[FF + ff0 + r];
#pragma unroll
            for (int mt = 0; mt < 2; ++mt)
#pragma unroll
                for (int q = 0; q < 16; ++q) {
                    const int pos = pos0 + 32 * mt + crow(q, h);
                    if (pos < ce) {
                        const float gate = fminf(acc[mt][0][q] + bgate, 7.0f), up = fminf(fmaxf(acc[mt][1][q] + bup, -7.0f), 7.0f);
                        const float glu = gate * sigmoidf_(1.702f * gate);
                        F.HMOE[((size_t)ts256 * 256 + pos) * FF + ff0 + r] = (bf16)f2bf((up + 1.0f) * glu);
                    }
                }
        }
        id0 += n; ts256 += (ce + 255) / 256;
    }
}
__device__ __forceinline__ void ph_moe_down_naive(Ctx& F, int l) {
    const int gw = F.bid * NWAVES + F.wave, NGW = F.G * NWAVES, r = F.lane & 31, h = F.lane >> 5;
    const unsigned* cnt = (const unsigned*)(F.ctl + CW_CNT + l * 64);
    int id0 = 0, ts256 = 0;
    for (int e = 0; e < NE; ++e) {
        const int ce = (int)__hip_atomic_load(cnt + e, __ATOMIC_RELAXED, __HIP_MEMORY_SCOPE_AGENT);
        const int nrt = (ce + 63) / 64, n = nrt * 16;
        const bf16* Bt = F.WdT + ((size_t)l * NE + e) * D * FF;
        const float* bd = F.in[I_BD] + ((size_t)l * NE + e) * D;
        int id = id0 + ((gw - id0 % NGW) + NGW) % NGW;
        for (; id < id0 + n; id += NGW) {
            const int rt = (id - id0) / 16, ct = (id - id0) % 16, pos0 = rt * 64, c0 = ct * 64;
            const bf16* A = F.HMOE + ((size_t)ts256 * 256 + pos0) * FF;
            f32x16 acc[2][2];
            sg_kloop(acc, A + (size_t)r * FF + 8 * h, A + (size_t)(32 + r) * FF + 8 * h, Bt + (size_t)(c0 + r) * FF + 8 * h, Bt + (size_t)(c0 + 32 + r) * FF + 8 * h, FF);
#pragma unroll
            for (int mt = 0; mt < 2; ++mt)
#pragma unroll
                for (int q = 0; q < 16; ++q) {
                    const int pos = pos0 + 32 * mt + crow(q, h);
                    if (pos < ce) {
                        const int dst = F.list_dst[(size_t)e * CAP + pos]; const float g = F.list_gate[(size_t)e * CAP + pos];
#pragma unroll
                        for (int nt = 0; nt < 2; ++nt) { const int c = c0 + 32 * nt + r;
                            F.Y2[(size_t)dst * D + c] = (bf16)f2bf(g * (acc[mt][nt][q] + bd[c])); }
                    }
                }
        }
        id0 += n; ts256 += (ce + 255) / 256;
    }
}

#define XB_TMO      128
#define XB_XCNT(j)  (256  + 64 * (j))
#define XB_XSUB(j)  (1280 + 64 * (j))
#define XB_XGEN(j)  (2304 + 64 * (j))
#define XB_TOP      3328
#define XB_TOPGEN   3392
#define XCD_BAR_WORDS 3456
#define XB_SPIN_CAP (1u << 22)
__device__ __forceinline__ unsigned xb_ld(unsigned* p)              { return __hip_atomic_load(p, __ATOMIC_RELAXED, __HIP_MEMORY_SCOPE_AGENT); }
__device__ __forceinline__ unsigned xb_add(unsigned* p, unsigned v) { return __hip_atomic_fetch_add(p, v, __ATOMIC_RELAXED, __HIP_MEMORY_SCOPE_AGENT); }
__device__ __forceinline__ unsigned xb_xcc_id() { return (unsigned)__builtin_amdgcn_s_getreg((3 << 11) | 20) & 0xFu; }
#define XB_SPIN(cond, bar) do { unsigned _sp = 0; while (cond) { __builtin_amdgcn_s_sleep(1); \
    if ((++_sp & 255u) == 0u) { if (xb_ld(&(bar)[XB_TMO])) break; if (_sp > XB_SPIN_CAP) { atomicAdd(&(bar)[XB_TMO], 1u); break; } } } } while (0)
struct XcdBarrier { unsigned* bar; unsigned x; volatile LAS unsigned* st; };
__device__ __forceinline__ XcdBarrier xcd_barrier_post(unsigned* bar, volatile LAS unsigned* st) {
    XcdBarrier b; b.bar = bar; b.x = xb_xcc_id(); b.st = st;
    if (threadIdx.x == 0) (void)xb_add(&bar[XB_XCNT(b.x)], 1u);
    return b;
}
__device__ __forceinline__ void xcd_barrier_complete(unsigned* bar, unsigned x, unsigned& nloc, unsigned& nx) {
    const unsigned G = gridDim.x * gridDim.y * gridDim.z;
    unsigned sum, cnt, mine, sp = 0u;
    for (;;) {
        sum = 0u; cnt = 0u; mine = 0u;
#pragma unroll
        for (unsigned j = 0; j < 16; ++j) { const unsigned c = xb_ld(&bar[XB_XCNT(j)]); sum += c; cnt += (c > 0u) ? 1u : 0u; mine = (j == x) ? c : mine; }
        if (sum == G) break;
        __builtin_amdgcn_s_sleep(1);
        if ((++sp & 255u) == 0u) { if (xb_ld(&bar[XB_TMO])) break; if (sp > XB_SPIN_CAP) { atomicAdd(&bar[XB_TMO], 1u); break; } }
    }
    nloc = mine > 0u ? mine : 1u; nx = cnt > 0u ? cnt : 1u;
}
__device__ __forceinline__ void xcd_barrier(const XcdBarrier& b) {
    asm volatile("s_waitcnt vmcnt(0)" ::: "memory");
    __syncthreads();
    if (threadIdx.x == 0) {
        unsigned* bar = b.bar;
        __builtin_amdgcn_s_waitcnt(0);
        unsigned nloc = b.st[0], nx = b.st[1];
        if (nloc == 0u) { xcd_barrier_complete(bar, b.x, nloc, nx); b.st[0] = nloc; b.st[1] = nx; }
        const unsigned old = xb_add(&bar[XB_XSUB(b.x)], 1u);
        const unsigned gen = old / nloc;
        if (old + 1u == (gen + 1u) * nloc) {
            __builtin_amdgcn_fence(__ATOMIC_RELEASE, "agent");
            asm volatile("s_waitcnt vmcnt(0)" ::: "memory");
            const unsigned og = xb_add(&bar[XB_TOP], 1u);
            const unsigned tg = og / nx;
            if (og + 1u == (tg + 1u) * nx) xb_add(&bar[XB_TOPGEN], 1u);
            else XB_SPIN(xb_ld(&bar[XB_TOPGEN]) == tg, bar);
            __builtin_amdgcn_fence(__ATOMIC_ACQUIRE, "agent");
            xb_add(&bar[XB_XGEN(b.x)], 1u);
            asm volatile("s_waitcnt vmcnt(0)" ::: "memory");
        } else {
            XB_SPIN(xb_ld(&bar[XB_XGEN(b.x)]) == gen, bar);
            __builtin_amdgcn_fence(__ATOMIC_ACQUIRE, "agent");
            asm volatile("s_waitcnt vmcnt(0)" ::: "memory");
        }
    }
    __syncthreads();
}

constexpr int LDS_BYTES = 147456;
constexpr int MISC_OFF = 147456 - 256;

__global__ void __launch_bounds__(NTHR, 2) fwd(Args args) {
    extern __shared__ __attribute__((aligned(16))) unsigned char lds[];
    Ctx F;
    F.lds = (LAS unsigned char*)lds;
    F.tid = threadIdx.x; F.lane = F.tid & 63; F.wave = __builtin_amdgcn_readfirstlane(F.tid >> 6); F.G = gridDim.x; F.bid = blockIdx.x;
    F.in = args.in; F.out = args.out; F.ws = args.ws;
    unsigned char* ws = args.ws;
    F.ctl = (gu32*)(ws + WS_CTL);
    F.mods = (float*)(ws + WS_MODS); F.rope = (f32x2*)(ws + WS_ROPE); F.lruw = (bf16*)(ws + WS_LRUW);
    F.WinT = (bf16*)(ws + WS_WIN); F.WoutT = (bf16*)(ws + WS_WOUT); F.WguT = (bf16*)(ws + WS_WGU); F.WdT = (bf16*)(ws + WS_WD);
    F.XL = (float*)(ws + WS_XL); F.H1 = (bf16*)(ws + WS_H1); F.P = (bf16*)(ws + WS_P); F.Vt = (bf16*)(ws + WS_VT); F.MIX = (bf16*)(ws + WS_MIX);
    F.HD = (float*)(ws + WS_HD); F.OHG = (float*)(ws + WS_OHG); F.GA = (float*)(ws + WS_GA); F.GB = (float*)(ws + WS_GB); F.AGG = (float*)(ws + WS_AGG);
    F.list_tok = (int*)(ws + WS_LIST); F.list_dst = F.list_tok + (size_t)NE * CAP; F.list_gate = (float*)(F.list_dst + (size_t)NE * CAP);
    F.HMOE = (bf16*)(ws + WS_HMOE); F.Y2 = (bf16*)(ws + WS_Y2);
    volatile LAS unsigned* MISC = (volatile LAS unsigned*)(F.lds + MISC_OFF);
    if (F.tid < 64) MISC[F.tid] = 0u;
    __syncthreads();
    XcdBarrier bar; bar.bar = (unsigned*)(F.ctl + CW_BAR); bar.x = 0; bar.st = nullptr;
    if (MK_N_LAUNCHES == 1) bar = xcd_barrier_post((unsigned*)(F.ctl + CW_BAR), MISC + 8);
    const int lo = args.ph_lo, hi = args.ph_hi;
#define IN(k) (lo <= (k) && (k) < hi)
#define SEAM(k) do { if (IN(k) && IN((k) + 1)) xcd_barrier(bar); } while (0)

    if (IN(0)) { ph_prologue(F); } SEAM(0);
    for (int l = 0; l < NL; ++l) {
        const int pb = 1 + 9 * l;
        if (IN(pb + 0)) { ph_norm1(F, l); } SEAM(pb + 0);
        if (IN(pb + 1)) { ph_inproj_naive(F, l); } SEAM(pb + 1);
        if (IN(pb + 2)) { ph_attn_naive(F, l); ph_lru_gates_naive(F, l); } SEAM(pb + 2);
        if (IN(pb + 3)) { ph_lru_scan_naive(F); ph_hgrn_scan_naive(F, l); } SEAM(pb + 3);
        if (IN(pb + 4)) { ph_lru_out_naive(F, l); ph_hgrn_out_naive(F, l); } SEAM(pb + 4);
        if (IN(pb + 5)) { ph_outproj_naive(F, l); } SEAM(pb + 5);
        if (IN(pb + 6)) { ph_norm2_router(F, l); } SEAM(pb + 6);
        if (IN(pb + 7)) { ph_moe_gu_naive(F, l); } SEAM(pb + 7);
        if (IN(pb + 8)) { ph_moe_down_naive(F, l); } SEAM(pb + 8);
    }
    if (IN(19)) { ph_norm1(F, 2); }
#undef IN
#undef SEAM
}

extern "C" void kernel_launch(void* const* d_in, const int* in_sizes, int n_in, void* d_out, int out_size, void* d_ws, size_t ws_size, hipStream_t stream) {
    static int grid = 0;
    if (grid == 0) {
        if (n_in != 27 || out_size != ML * D || ws_size < WS_END) { fprintf(stderr, "kernel_launch: unexpected shapes (n_in %d out %d ws %zu)\n", n_in, out_size, ws_size); grid = -1; return; }
        int dev = 0, cus = 0, per_cu = 0;
        if (hipGetDevice(&dev) != hipSuccess || hipDeviceGetAttribute(&cus, hipDeviceAttributeMultiprocessorCount, dev) != hipSuccess) { grid = -1; return; }
        if (hipFuncSetAttribute((const void*)fwd, hipFuncAttributeMaxDynamicSharedMemorySize, LDS_BYTES) != hipSuccess) { fprintf(stderr, "kernel_launch: hipFuncSetAttribute failed\n"); grid = -1; return; }
        if (hipOccupancyMaxActiveBlocksPerMultiprocessor(&per_cu, (const void*)fwd, NTHR, LDS_BYTES) != hipSuccess || per_cu < 1) { fprintf(stderr, "kernel_launch: occupancy query says %d\n", per_cu); }
        (void)hipGetLastError();
        grid = cus;
    }
    if (grid < 0) return;
    (void)hipMemsetAsync((char*)d_ws + WS_CTL, 0, CTL_ZERO_BYTES, stream);
    Args a{};
    for (int i = 0; i < 27; ++i) a.in[i] = (const float*)d_in[i];
    a.out = (float*)d_out; a.ws = (unsigned char*)d_ws;
    if (MK_N_LAUNCHES == 1) { a.ph_lo = 0; a.ph_hi = N_PH; hipLaunchKernelGGL(fwd, dim3(grid), dim3(NTHR), LDS_BYTES, stream, a); }
    else for (int p = 0; p < N_PH; ++p) { a.ph_lo = p; a.ph_hi = p + 1; hipLaunchKernelGGL(fwd, dim3(grid), dim3(NTHR), LDS_BYTES, stream, a); }
}
```

```cpp
#include <hip/hip_runtime.h>
#include <stdint.h>
#include <stdio.h>

#ifndef MK_N_LAUNCHES
#define MK_N_LAUNCHES 1
#endif

#ifndef MOE_FP8
#define MOE_FP8 1
#endif
#ifndef Y2_FP8
#define Y2_FP8 1
#endif
#ifndef FAST_GEMM
#define FAST_GEMM 1
#endif
#ifndef REP_PRO
#define REP_PRO 1
#endif
#ifndef REP_INP
#define REP_INP 1
#endif
#ifndef REP_ATT
#define REP_ATT 1
#endif
#ifndef REP_LA
#define REP_LA 1
#endif
#ifndef REP_HA
#define REP_HA 1
#endif
#ifndef REP_LC
#define REP_LC 1
#endif
#ifndef REP_HC
#define REP_HC 1
#endif
#ifndef REP_N10
#define REP_N10 1
#endif
#ifndef REP_FIN
#define REP_FIN 1
#endif
#ifndef REP_OP0
#define REP_OP0 1
#endif
#ifndef REP_RT
#define REP_RT 1
#endif
#ifndef REP_CAR
#define REP_CAR 1
#endif
#ifndef REP_GU
#define REP_GU 1
#endif
#ifndef REP_DN
#define REP_DN 1
#endif
#define REPEAT(n, ...) do { _Pragma("unroll 1") for (int rep_ = 0; rep_ < (n); ++rep_) { __VA_ARGS__; } } while (0)
#ifndef FAST_ATTN
#define FAST_ATTN 1
#endif
#ifndef FAST_LRU
#define FAST_LRU 1
#endif
#ifndef FAST_HG
#define FAST_HG 1
#endif
#define GAS __attribute__((address_space(1)))
#define LAS __attribute__((address_space(3)))
typedef unsigned short bf16;
typedef short bf16x8 __attribute__((ext_vector_type(8)));
typedef float f32x4 __attribute__((ext_vector_type(4)));
typedef float f32x2 __attribute__((ext_vector_type(2)));
typedef float f32x16 __attribute__((ext_vector_type(16)));
typedef unsigned u32x4 __attribute__((ext_vector_type(4)));
typedef unsigned u32x2 __attribute__((ext_vector_type(2)));
typedef GAS unsigned gu32;

constexpr int D = 1024, NB = 2, SEQ = 16384, CTXL = 256, NL = 2;
constexpr int ML = NB * SEQ, MC = NB * CTXL, MA = ML + MC;
constexpr int INW = 2560;
constexpr int C_Q = 0, C_K = 512, C_V = 640, C_LX = 768, C_LG = 1024, C_HQ = 1280, C_HF = 1536, C_HB = 1792, C_HV = 2048, C_HO = 2304;
constexpr int NE = 32, FF = 1024, CAP = MA;
constexpr float EPS = 1e-6f;
constexpr float LOG2E = 1.4426950408889634f;
constexpr float QSCALE = 0.125f * LOG2E;
constexpr int NWAVES = 8, NTHR = 512;
constexpr int N_PH = 20;

constexpr size_t MiB = 1u << 20;
constexpr size_t WS_CTL = 0, CTL_ZERO_BYTES = 65536;
constexpr size_t WS_MODS = 1 * MiB;
constexpr size_t WS_ROPE = 2 * MiB;
constexpr size_t WS_LRUW = 3 * MiB;
constexpr size_t WS_WIN = 4 * MiB;
constexpr size_t WS_WOUT = 16 * MiB;
constexpr size_t WS_WGU = 20 * MiB;
constexpr size_t WS_WD = 276 * MiB;
constexpr size_t WS_XL = 404 * MiB;
constexpr size_t WS_H1 = 534 * MiB;
constexpr size_t WS_P = 599 * MiB;
constexpr size_t WS_VT = 762 * MiB;
constexpr size_t WS_MIX = 771 * MiB;
constexpr size_t WS_HD = 836 * MiB;
constexpr size_t WS_OHG = 901 * MiB;
constexpr size_t WS_GA = 966 * MiB;
constexpr size_t WS_GB = 1031 * MiB;
constexpr size_t WS_AGG = 1096 * MiB;
constexpr size_t WS_LIST = 1136 * MiB;
constexpr size_t WS_HMOE = 1152 * MiB;
constexpr size_t WS_Y2 = 1428 * MiB;
constexpr size_t WS_QI = 1688 * MiB;
constexpr size_t WS_KI = 1721 * MiB;
constexpr size_t WS_SAGG = 1754 * MiB;
constexpr size_t WS_SIN = 1788 * MiB;
constexpr size_t WS_DUMMY = 1823 * MiB;
constexpr size_t WS_END = 1824 * MiB;
constexpr size_t Y2_DUMMY_ROW = (WS_DUMMY - WS_Y2) / (D * ((Y2_FP8 && MOE_FP8) ? 1 : 2));
constexpr size_t VT_CTX_OFF = (size_t)NB * 2 * 64 * SEQ;
constexpr int CW_CNT = 64;
constexpr int CW_BAR = 4096;

__device__ __forceinline__ float bf2f(bf16 x) { return __uint_as_float(((unsigned)x) << 16); }
__device__ __forceinline__ unsigned pk2(float lo, float hi) { unsigned r; asm("v_cvt_pk_bf16_f32 %0, %1, %2" : "=v"(r) : "v"(lo), "v"(hi)); return r; }
__device__ __forceinline__ unsigned f2bf(float f) { return pk2(f, f) & 0xffffu; }
__device__ __forceinline__ float shx(float v, int mask, int lane) { return __int_as_float(__builtin_amdgcn_ds_bpermute((lane ^ mask) << 2, __float_as_int(v))); }
__device__ __forceinline__ float wave_sum(float v, int lane) {
#pragma unroll
    for (int o = 1; o < 64; o <<= 1) v += shx(v, o, lane);
    return v;
}
__device__ __forceinline__ float wave_max(float v, int lane) {
#pragma unroll
    for (int o = 1; o < 64; o <<= 1) v = fmaxf(v, shx(v, o, lane));
    return v;
}
__device__ __forceinline__ float frcp(float x) { return __builtin_amdgcn_rcpf(x); }
__device__ __forceinline__ float sigmoidf_(float x) { return frcp(1.0f + __expf(-x)); }
__device__ __forceinline__ float siluf_(float x) { return x * frcp(1.0f + __expf(-x)); }
__device__ __forceinline__ float gelu_tanh(float x) { const float u = 0.7978845608028654f * (x + 0.044715f * x * x * x); const float t = 1.0f - 2.0f * frcp(__expf(2.0f * u) + 1.0f); return 0.5f * x * (1.0f + t); }
__device__ __forceinline__ unsigned pk_fp8x4(float a, float b, float c, float d) { int w = 0; w = __builtin_amdgcn_cvt_pk_fp8_f32(a, b, w, false); w = __builtin_amdgcn_cvt_pk_fp8_f32(c, d, w, true); return (unsigned)w; }
constexpr float Y2_SCALE = 16.0f;
constexpr float W8_SCALE = 64.0f;
__device__ __forceinline__ int crow(int r, int hi) { return (r & 3) + 8 * (r >> 2) + 4 * hi; }

struct Args { const float* in[27]; float* out; unsigned char* ws; int ph_lo, ph_hi; };
struct Ctx {
    LAS unsigned char* lds;
    int tid, lane, wave, G, bid;
    const float* const* in;
    float* out; unsigned char* ws;
#define WSACC(T, name, off) __device__ __forceinline__ T* name() const { return (T*)(ws + (off)); }
    WSACC(gu32, ctl, WS_CTL) WSACC(float, mods, WS_MODS) WSACC(f32x2, rope, WS_ROPE) WSACC(bf16, lruw, WS_LRUW) WSACC(bf16, WinT, WS_WIN) WSACC(bf16, WoutT, WS_WOUT)
    WSACC(bf16, WguT, WS_WGU) WSACC(bf16, WdT, WS_WD) WSACC(bf16, XL, WS_XL) WSACC(bf16, H1, WS_H1) WSACC(bf16, P, WS_P) WSACC(bf16, Vt, WS_VT) WSACC(bf16, MIX, WS_MIX)
    WSACC(float, HD, WS_HD) WSACC(float, OHG, WS_OHG) WSACC(float, GA, WS_GA) WSACC(float, GB, WS_GB) WSACC(float, AGG, WS_AGG)
    WSACC(int, list_tok, WS_LIST) WSACC(int, list_dst, WS_LIST + (size_t)NE * CAP * 4) WSACC(float, list_gate, WS_LIST + (size_t)NE * CAP * 8)
    WSACC(bf16, HMOE, WS_HMOE) WSACC(bf16, Y2, WS_Y2)
    __device__ __forceinline__ bf16* ws_bf16(size_t off) const { return (bf16*)(ws + off); }
    __device__ __forceinline__ const float* inp(int i) const { return (const float*)(const GAS float*)in[i]; }
    __device__ __forceinline__ float* outp() const { return (float*)(GAS float*)out; }
#undef WSACC
};
__device__ __forceinline__ Ctx fresh(const Ctx& F0) {
    Ctx F = F0; int wv = F0.wave, g = F0.G, bi = F0.bid; asm volatile("" : "+s"(wv), "+s"(g), "+s"(bi));
    int ln; asm volatile("v_mbcnt_lo_u32_b32 %0, -1, 0\n\tv_mbcnt_hi_u32_b32 %0, -1, %0" : "=v"(ln));
    F.wave = wv; F.lane = ln; F.tid = wv * 64 + ln; F.G = g; F.bid = bi;
    unsigned long long w = (unsigned long long)F0.ws;
    asm volatile("" : "+s"(w)); F.ws = (unsigned char*)(GAS unsigned char*)w;
    return F;
}
enum { I_X = 0, I_C, I_CTX, I_CCTX, I_ADAW, I_ADAB, I_N1G, I_WIN, I_SINK, I_CONVW, I_CONVB, I_WR, I_BR, I_WI, I_BI, I_LAM, I_LBL, I_HNG, I_WOUT, I_N2G, I_RW, I_RB, I_WGU, I_BGU, I_WD, I_BD, I_FG };

__device__ __forceinline__ int row_b(int m) { return m < ML ? m / SEQ : (m - ML) / CTXL; }
__device__ __forceinline__ int row_t(int m) { return m < ML ? m % SEQ : (m - ML) % CTXL; }
__device__ __forceinline__ int mod_row(int m) { return m < ML ? m / SEQ : 2; }

__device__ __forceinline__ int dest_win(int n) {
    if (n >= C_V) return n;
    const int d = n & 63, p = d >> 5, half = (d >> 4) & 1, f = d & 15;
    return (n & ~63) + 2 * (p * 16 + f) + half;
}
__device__ __forceinline__ int dest_gu(int n) {
    const int up = n >= FF ? 1 : 0, ff = n & (FF - 1);
    return (ff >> 7) * 256 + up * 128 + (ff & 127);
}
template <int MAP>
__device__ __forceinline__ void tr_item(const float* W, int K, int N, bf16* WT, LAS float* scr, int item, int lane) {
    const int nblk = N / 32, kb = item / nblk, nb = item % nblk, k0 = 64 * kb, n0 = 32 * nb;
#pragma unroll 8
    for (int i = 0; i < 32; ++i) { const int kk = 2 * i + (lane >> 5); scr[kk * 33 + (lane & 31)] = W[(size_t)(k0 + kk) * N + n0 + (lane & 31)]; }
    asm volatile("s_waitcnt lgkmcnt(0)" ::: "memory");
    const int c = lane & 7;
#pragma unroll
    for (int j = 0; j < 4; ++j) {
        const int n = (lane >> 3) + 8 * j; const LAS float* s = scr + (8 * c) * 33 + n;
        u32x4 o; o.x = pk2(s[0 * 33], s[1 * 33]); o.y = pk2(s[2 * 33], s[3 * 33]); o.z = pk2(s[4 * 33], s[5 * 33]); o.w = pk2(s[6 * 33], s[7 * 33]);
        const int nn = n0 + n; const int dr = MAP == 1 ? dest_win(nn) : (MAP == 2 ? dest_gu(nn) : nn);
        *(u32x4*)(WT + (size_t)dr * K + k0 + 8 * c) = o;
    }
    asm volatile("s_waitcnt lgkmcnt(0)" ::: "memory");
}
template <int MAP>
__device__ __forceinline__ void tr_item8(const float* W, int K, int N, unsigned char* WT, LAS float* scr, int item, int lane) {
    const int nblk = N / 32, kb = item / nblk, nb = item % nblk, k0 = 64 * kb, n0 = 32 * nb;
#pragma unroll 8
    for (int i = 0; i < 32; ++i) { const int kk = 2 * i + (lane >> 5); scr[kk * 33 + (lane & 31)] = W[(size_t)(k0 + kk) * N + n0 + (lane & 31)]; }
    asm volatile("s_waitcnt lgkmcnt(0)" ::: "memory");
    const int c = lane & 7;
#pragma unroll
    for (int j = 0; j < 4; ++j) {
        const int n = (lane >> 3) + 8 * j; const LAS float* s = scr + (8 * c) * 33 + n;
        u32x2 o; o.x = pk_fp8x4(s[0 * 33] * W8_SCALE, s[1 * 33] * W8_SCALE, s[2 * 33] * W8_SCALE, s[3 * 33] * W8_SCALE); o.y = pk_fp8x4(s[4 * 33] * W8_SCALE, s[5 * 33] * W8_SCALE, s[6 * 33] * W8_SCALE, s[7 * 33] * W8_SCALE);
        const int nn = n0 + n; const int dr = MAP == 2 ? dest_gu(nn) : nn;
        *(u32x2*)(WT + (size_t)dr * K + k0 + 8 * c) = o;
    }
    asm volatile("s_waitcnt lgkmcnt(0)" ::: "memory");
}
__device__ __forceinline__ void tr_load(const float* W, int N, int item, int lane, float (&r)[32]) {
    const int nblk = N / 32, kb = item / nblk, nb = item % nblk, k0 = 64 * kb, n0 = 32 * nb;
    const float* p = W + (size_t)(k0 + (lane >> 5)) * N + n0 + (lane & 31);
#pragma unroll
    for (int i = 0; i < 32; ++i) r[i] = p[(size_t)(2 * i) * N];
}
template <int MAP>
__device__ __forceinline__ void tr_finish(int K, int N, bf16* WT, LAS float* scr, int item, int lane, const float (&r)[32]) {
    const int nblk = N / 32, kb = item / nblk, nb = item % nblk, k0 = 64 * kb, n0 = 32 * nb;
#pragma unroll
    for (int i = 0; i < 32; ++i) scr[(2 * i + (lane >> 5)) * 33 + (lane & 31)] = r[i];
    asm volatile("s_waitcnt lgkmcnt(0)" ::: "memory");
    const int c = lane & 7;
#pragma unroll
    for (int j = 0; j < 4; ++j) {
        const int n = (lane >> 3) + 8 * j; const LAS float* s = scr + (8 * c) * 33 + n;
        u32x4 o; o.x = pk2(s[0 * 33], s[1 * 33]); o.y = pk2(s[2 * 33], s[3 * 33]); o.z = pk2(s[4 * 33], s[5 * 33]); o.w = pk2(s[6 * 33], s[7 * 33]);
        const int nn = n0 + n; const int dr = MAP == 1 ? dest_win(nn) : (MAP == 2 ? dest_gu(nn) : nn);
        *(u32x4*)(WT + (size_t)dr * K + k0 + 8 * c) = o;
    }
    asm volatile("s_waitcnt lgkmcnt(0)" ::: "memory");
}
__device__ __forceinline__ void ph_prologue(Ctx& F) {
    LAS float* scr = (LAS float*)(F.lds + F.wave * 8704);
    const int gw = F.bid * NWAVES + F.wave, NGW = F.G * NWAVES;
    constexpr int I_IN = 16 * 80, I_OUT = 16 * 32;
    constexpr int N_IN = NL * I_IN, N_OUT = NL * I_OUT;
    for (int it = gw; it < N_IN + N_OUT; it += NGW) {
        int r = it;
        if (r < N_IN) { const int l = r / I_IN; tr_item<1>(F.inp(I_WIN) + (size_t)l * D * INW, D, INW, F.WinT() + (size_t)l * INW * D, scr, r % I_IN, F.lane); continue; } r -= N_IN;
        { const int l = r / I_OUT; tr_item<0>(F.inp(I_WOUT) + (size_t)l * D * D, D, D, F.WoutT() + (size_t)l * D * D, scr, r % I_OUT, F.lane); }
    }
    const int gt = F.bid * NTHR + F.tid, NGT = F.G * NTHR;
    for (int i = gt; i < NL * 2 * 2 * 4 * 4096; i += NGT) {
        const int c = i & 63, dd = (i >> 6) & 63, n = (i >> 12) & 3, g = (i >> 14) & 1, d = (i >> 15) & 1, l = i >> 16;
        const float* src = g ? F.inp(I_WI) : F.inp(I_WR);
        F.lruw()[i] = (bf16)f2bf(src[((((size_t)l * 2 + d) * 4 + n) * 64 + c) * 64 + dd]);
    }
    for (int i = gt; i < 256 * 16; i += NGT) {
        const int pos = i >> 4, f = i & 15;
        const float invf[16] = {1.000000000e+00f, 5.623413324e-01f, 3.162277639e-01f, 1.778279394e-01f, 1.000000015e-01f, 5.623413250e-02f, 3.162277490e-02f, 1.778279431e-02f,
                                9.999999776e-03f, 5.623413250e-03f, 3.162277630e-03f, 1.778279431e-03f, 1.000000047e-03f, 5.623413017e-04f, 3.162277571e-04f, 1.778279402e-04f};
        float fr = 1.0f;
#pragma unroll
        for (int q = 0; q < 16; ++q) fr = (f == q) ? invf[q] : fr;
        const float ang = (float)pos * fr;
        double rev = (double)ang * 0.15915494309189535; rev -= floor(rev);
        F.rope()[i] = (f32x2){__builtin_amdgcn_cosf((float)rev), __builtin_amdgcn_sinf((float)rev)};
    }
    LAS float* cond = (LAS float*)(F.lds + 72 * 1024);
    LAS float* red = (LAS float*)(F.lds + 88 * 1024);
    __syncthreads();
    for (int i = F.tid; i < 3 * D; i += NTHR) { const int r = i / D, k = i % D; const float v = r < 2 ? F.inp(I_C)[r * D + k] : F.inp(I_CCTX)[k]; cond[i] = siluf_(v); }
    __syncthreads();
    for (int unit = F.bid; unit < NL * 192; unit += F.G) {
        const int l = unit / 192, col0 = (unit % 192) * 32, cl = F.tid & 31, ks = F.tid >> 5;
        const float* W = F.inp(I_ADAW) + (size_t)l * D * 6 * D + col0 + cl;
        float a0 = 0.f, a1 = 0.f, a2 = 0.f;
#pragma unroll 8
        for (int k = ks * 64; k < ks * 64 + 64; ++k) { const float w = W[(size_t)k * 6 * D]; a0 += cond[k] * w; a1 += cond[D + k] * w; a2 += cond[2 * D + k] * w; }
        red[(ks * 3 + 0) * 32 + cl] = a0; red[(ks * 3 + 1) * 32 + cl] = a1; red[(ks * 3 + 2) * 32 + cl] = a2;
        __syncthreads();
        if (F.tid < 96) { const int i = F.tid >> 5; float s = F.inp(I_ADAB)[l * 6 * D + col0 + cl];
            for (int q = 0; q < 16; ++q) s += red[(q * 3 + i) * 32 + cl];
            F.mods()[((size_t)l * 3 + i) * 6 * D + col0 + cl] = s; }
        __syncthreads();
    }
}

__device__ __forceinline__ void ph_norm1(Ctx& F, int l) {
    const int gw = F.bid * NWAVES + F.wave, NGW = F.G * NWAVES;
    const int M = (l == 2) ? ML : MA;
    for (int m = gw; m < M; m += NGW) {
        const int mr = mod_row(m);
        f32x4 v[4];
        if (l == 0) { const float* src = m < ML ? F.inp(I_X) + (size_t)m * D : F.inp(I_CTX) + (size_t)(m - ML) * D;
#pragma unroll
            for (int j = 0; j < 4; ++j) v[j] = *(const f32x4*)(src + 4 * F.lane + 256 * j); }
        else {
#pragma unroll
            for (int j = 0; j < 4; ++j) { const u32x2 w = *(const u32x2*)(F.XL() + (size_t)m * D + 4 * F.lane + 256 * j);
                v[j] = (f32x4){__uint_as_float(w.x << 16), __uint_as_float(w.x & 0xffff0000u), __uint_as_float(w.y << 16), __uint_as_float(w.y & 0xffff0000u)}; } }
        if (l > 0) {
            const float* g5 = F.mods() + ((size_t)(l - 1) * 3 + mr) * 6 * D + 5 * D;
#pragma unroll
            for (int j = 0; j < 4; ++j) {
                const int col = 4 * F.lane + 256 * j; f32x4 s = {0.f, 0.f, 0.f, 0.f};
#pragma unroll
                for (int q = 0; q < 4; ++q) {
                    if (Y2_FP8 && MOE_FP8) { const unsigned w = *(const unsigned*)((const unsigned char*)F.Y2() + ((size_t)m * 4 + q) * D + col);
                        const f32x2 lo = __builtin_amdgcn_cvt_pk_f32_fp8((int)w, false), hi = __builtin_amdgcn_cvt_pk_f32_fp8((int)w, true);
                        s.x += lo.x; s.y += lo.y; s.z += hi.x; s.w += hi.y; }
                    else { const u32x2 w = *(const u32x2*)(F.Y2() + ((size_t)m * 4 + q) * D + col);
                        s.x += __uint_as_float(w.x << 16); s.y += __uint_as_float(w.x & 0xffff0000u); s.z += __uint_as_float(w.y << 16); s.w += __uint_as_float(w.y & 0xffff0000u); } }
                const f32x4 g = *(const f32x4*)(g5 + col) * ((Y2_FP8 && MOE_FP8) ? (1.0f / Y2_SCALE) : 1.0f);
                v[j] += g * s;
            }
        }
        if (l == 1) {
#pragma unroll
            for (int j = 0; j < 4; ++j) { u32x2 w; w.x = pk2(v[j].x, v[j].y); w.y = pk2(v[j].z, v[j].w); *(u32x2*)(F.XL() + (size_t)m * D + 4 * F.lane + 256 * j) = w; }
        }
        float ss = 0.f;
#pragma unroll
        for (int j = 0; j < 4; ++j) ss += (v[j].x * v[j].x + v[j].y * v[j].y) + (v[j].z * v[j].z + v[j].w * v[j].w);
        const float rstd = 1.0f / sqrtf(wave_sum(ss, F.lane) * (1.0f / D) + EPS);
        if (l == 2) {
#pragma unroll
            for (int j = 0; j < 4; ++j) { const int col = 4 * F.lane + 256 * j; const f32x4 g = *(const f32x4*)(F.inp(I_FG) + col); *(f32x4*)(F.outp() + (size_t)m * D + col) = v[j] * rstd * g; }
        } else {
            const float* mo = F.mods() + ((size_t)l * 3 + mr) * 6 * D;
            const float* g1 = F.inp(I_N1G) + l * D;
#pragma unroll
            for (int j = 0; j < 4; ++j) { const int col = 4 * F.lane + 256 * j;
                const f32x4 g = *(const f32x4*)(g1 + col), sh = *(const f32x4*)(mo + col), sc = *(const f32x4*)(mo + D + col);
                const f32x4 h = v[j] * rstd * g * (sc + 1.0f) + sh;
                u32x2 w; w.x = pk2(h.x, h.y); w.y = pk2(h.z, h.w);
                *(u32x2*)(F.H1() + (size_t)m * D + col) = w; }
        }
    }
}

__device__ __forceinline__ void sg_kloop(f32x16 (&acc)[2][2], const bf16* a0, const bf16* a1, const bf16* b0, const bf16* b1, int K) {
#pragma unroll
    for (int i = 0; i < 2; ++i)
#pragma unroll
        for (int j = 0; j < 2; ++j)
#pragma unroll
            for (int r = 0; r < 16; ++r) acc[i][j][r] = 0.f;
#pragma unroll 4
    for (int k = 0; k < K; k += 16) {
        const bf16x8 fa0 = *(const bf16x8*)(a0 + k), fa1 = *(const bf16x8*)(a1 + k), fb0 = *(const bf16x8*)(b0 + k), fb1 = *(const bf16x8*)(b1 + k);
        acc[0][0] = __builtin_amdgcn_mfma_f32_32x32x16_bf16(fa0, fb0, acc[0][0], 0, 0, 0);
        acc[0][1] = __builtin_amdgcn_mfma_f32_32x32x16_bf16(fa0, fb1, acc[0][1], 0, 0, 0);
        acc[1][0] = __builtin_amdgcn_mfma_f32_32x32x16_bf16(fa1, fb0, acc[1][0], 0, 0, 0);
        acc[1][1] = __builtin_amdgcn_mfma_f32_32x32x16_bf16(fa1, fb1, acc[1][1], 0, 0, 0);
    }
}

__device__ __forceinline__ float inproj_fix(const Ctx& F, int m, int c, float v, float partner) {
    float o = v;
    if (c < C_V) {
        if (m < ML) {
            const int t = m % SEQ, dp = c & 63, pr = dp >> 1, p = pr >> 4, f = pr & 15, pos = p ? (t & 63) : (t >> 6);
            const f32x2 cs = F.rope()[pos * 16 + f];
            o = (dp & 1) ? (partner * cs.y + v * cs.x) : (v * cs.x - partner * cs.y);
        }
        if (c < C_K) o *= QSCALE;
    }
    return o;
}
__device__ __forceinline__ size_t vt_index(int m, int cv  ) {
    const int kvh = cv >> 6, d = cv & 63;
    if (m < ML) { const int b = m / SEQ, t = m % SEQ; return ((size_t)((b * 2 + kvh) * 64 + d)) * SEQ + t; }
    const int b = (m - ML) / CTXL, t = (m - ML) % CTXL; return VT_CTX_OFF + ((size_t)((b * 2 + kvh) * 64 + d)) * CTXL + t;
}
__device__ __forceinline__ void ph_inproj_naive(Ctx& F, int l) {
    const int gw = F.bid * NWAVES + F.wave, NGW = F.G * NWAVES, r = F.lane & 31, h = F.lane >> 5;
    const bf16* Bt = F.WinT() + (size_t)l * INW * D;
    for (int ti = gw; ti < (MA / 64) * (INW / 64); ti += NGW) {
        const int rt = ti / (INW / 64), ct = ti % (INW / 64), m0 = rt * 64, c0 = ct * 64;
        f32x16 acc[2][2];
        sg_kloop(acc, F.H1() + (size_t)(m0 + r) * D + 8 * h, F.H1() + (size_t)(m0 + 32 + r) * D + 8 * h, Bt + (size_t)(c0 + r) * D + 8 * h, Bt + (size_t)(c0 + 32 + r) * D + 8 * h, D);
#pragma unroll
        for (int mt = 0; mt < 2; ++mt)
#pragma unroll
            for (int nt = 0; nt < 2; ++nt)
#pragma unroll
                for (int q = 0; q < 16; ++q) {
                    const int m = m0 + 32 * mt + crow(q, h), c = c0 + 32 * nt + r;
                    const float v = acc[mt][nt][q], pa = shx(v, 1, F.lane);
                    const float o = inproj_fix(F, m, c, v, pa);
                    F.P()[(size_t)m * INW + c] = (bf16)f2bf(o);
                    if (c >= C_V && c < C_LX) F.Vt()[vt_index(m, c - C_V)] = (bf16)f2bf(o);
                }
    }
}

__device__ __forceinline__ float dot64(const float (&q)[64], const bf16* kp) {
    float s = 0.f;
#pragma unroll
    for (int i = 0; i < 8; ++i) { const u32x4 w = *(const u32x4*)(kp + 8 * i);
        s += q[8 * i + 0] * __uint_as_float(w.x << 16) + q[8 * i + 1] * __uint_as_float(w.x & 0xffff0000u) + q[8 * i + 2] * __uint_as_float(w.y << 16) + q[8 * i + 3] * __uint_as_float(w.y & 0xffff0000u)
           + q[8 * i + 4] * __uint_as_float(w.z << 16) + q[8 * i + 5] * __uint_as_float(w.z & 0xffff0000u) + q[8 * i + 6] * __uint_as_float(w.w << 16) + q[8 * i + 7] * __uint_as_float(w.w & 0xffff0000u); }
    return s;
}
__device__ __forceinline__ void ph_attn_naive(Ctx& F, int l) {
    const int gw = F.bid * NWAVES + F.wave, NGW = F.G * NWAVES;
    const int Mq = (l == 0) ? MA : ML;
    LAS float* pbuf = (LAS float*)(F.lds) + F.wave * 640;
    for (int u = gw; u < Mq * 8; u += NGW) {
        const int m = u >> 3, hq = u & 7, kvh = hq >> 2;
        const bool isc = m >= ML; const int b = row_b(m), t = row_t(m);
        float q[64];
        { const bf16* qp = F.P() + (size_t)m * INW + C_Q + hq * 64;
#pragma unroll
          for (int i = 0; i < 8; ++i) { const u32x4 w = *(const u32x4*)(qp + 8 * i);
              q[8 * i + 0] = __uint_as_float(w.x << 16); q[8 * i + 1] = __uint_as_float(w.x & 0xffff0000u); q[8 * i + 2] = __uint_as_float(w.y << 16); q[8 * i + 3] = __uint_as_float(w.y & 0xffff0000u);
              q[8 * i + 4] = __uint_as_float(w.z << 16); q[8 * i + 5] = __uint_as_float(w.z & 0xffff0000u); q[8 * i + 6] = __uint_as_float(w.w << 16); q[8 * i + 7] = __uint_as_float(w.w & 0xffff0000u); } }
        const int lo = isc ? 0 : (t - 128 < 0 ? 0 : t - 128), hi = isc ? -1 : (t + 128 > SEQ - 1 ? SEQ - 1 : t + 128);
        const int nloc = hi - lo + 1, nk = nloc + CTXL;
        const float sink2 = F.inp(I_SINK)[l * 8 + hq] * LOG2E;
        float s[9]; float mx = sink2;
#pragma unroll
        for (int i = 0; i < 9; ++i) { const int kk = F.lane + 64 * i; s[i] = -3.0e38f;
            if (kk < nk) { const int krow = kk < nloc ? b * SEQ + lo + kk : ML + b * CTXL + (kk - nloc);
                s[i] = dot64(q, F.P() + (size_t)krow * INW + C_K + kvh * 64); mx = fmaxf(mx, s[i]); } }
        mx = wave_max(mx, F.lane);
        float lsum = 0.f;
#pragma unroll
        for (int i = 0; i < 9; ++i) { const int kk = F.lane + 64 * i; const float p = (kk < nk) ? exp2f(s[i] - mx) : 0.f; lsum += p; pbuf[kk] = p; }
        lsum = wave_sum(lsum, F.lane) + exp2f(sink2 - mx);
        asm volatile("s_waitcnt lgkmcnt(0)" ::: "memory");
        float o = 0.f;
        for (int kk = 0; kk < nk; ++kk) { const int krow = kk < nloc ? b * SEQ + lo + kk : ML + b * CTXL + (kk - nloc);
            o += pbuf[kk] * bf2f(F.P()[(size_t)krow * INW + C_V + kvh * 64 + F.lane]); }
        F.MIX()[(size_t)m * D + hq * 64 + F.lane] = (bf16)f2bf(o / lsum);
        asm volatile("s_waitcnt lgkmcnt(0)" ::: "memory");
    }
}
__device__ __forceinline__ void ph_lru_gates_naive(Ctx& F, int l) {
    const size_t gt = (size_t)F.bid * NTHR + F.tid, NGT = (size_t)F.G * NTHR;
    for (size_t i = gt; i < (size_t)MA * 512; i += NGT) {
        const int m = (int)(i >> 9), d = (int)(i >> 8) & 1, c = (int)i & 255, n = c >> 6, cc0 = c & 63;
        const int t = row_t(m), T = m < ML ? SEQ : CTXL, rb = m - t;
        const float* wr = F.inp(I_WR) + (((size_t)l * 2 + d) * 4 + n) * 4096;
        const float* wi = F.inp(I_WI) + (((size_t)l * 2 + d) * 4 + n) * 4096;
        float rp = F.inp(I_BR)[(l * 2 + d) * 256 + c], ip = F.inp(I_BI)[(l * 2 + d) * 256 + c], us = 0.f;
        for (int cc = 0; cc < 64; ++cc) {
            const int ch = n * 64 + cc; float u = F.inp(I_CONVB)[l * 256 + ch];
#pragma unroll
            for (int j = 0; j < 4; ++j) { const int tt = t - 2 + j; if (tt >= 0 && tt < T) u += F.inp(I_CONVW)[(l * 4 + j) * 256 + ch] * bf2f(F.P()[(size_t)(rb + tt) * INW + C_LX + ch]); }
            rp += u * wr[cc * 64 + cc0]; ip += u * wi[cc * 64 + cc0];
            if (cc == cc0) us = u;
        }
        const float r = sigmoidf_(rp), ig = sigmoidf_(ip);
        const float lam = F.inp(I_LAM)[(l * 2 + d) * 256 + c];
        const float la = -8.0f * r * log1pf(expf(-lam));
        const float a = expf(la), mult = sqrtf(fmaxf(-expm1f(2.0f * la), 1e-12f));
        F.GA()[i] = a; F.GB()[i] = mult * ig * us;
    }
}
__device__ __forceinline__ void ph_lru_scan_naive(Ctx& F) {
    const int gt = F.bid * NTHR + F.tid;
    if (gt >= NB * 512) return;
    const int b = gt >> 9, d = (gt >> 8) & 1, c = gt & 255;
    float h = 0.f;
    for (int s = 0; s < CTXL + SEQ; ++s) {
        int m;
        if (s < CTXL) m = ML + b * CTXL + (d ? CTXL - 1 - s : s); else { const int t = s - CTXL; m = b * SEQ + (d ? SEQ - 1 - t : t); }
        const size_t i = (size_t)m * 512 + d * 256 + c;
        h = F.GA()[i] * h + F.GB()[i];
        F.HD()[i] = h;
    }
}
__device__ __forceinline__ void ph_lru_out_naive(Ctx& F, int l) {
    const size_t gt = (size_t)F.bid * NTHR + F.tid, NGT = (size_t)F.G * NTHR;
    const int Mq = (l == 0) ? MA : ML;
    for (size_t i = gt; i < (size_t)Mq * 256; i += NGT) {
        const int m = (int)(i >> 8), c = (int)i & 255;
        const float y = (F.HD()[(size_t)m * 512 + c] + F.HD()[(size_t)m * 512 + 256 + c]) * gelu_tanh(bf2f(F.P()[(size_t)m * INW + C_LG + c]));
        F.MIX()[(size_t)m * D + 512 + c] = (bf16)f2bf(y);
    }
}
__device__ __forceinline__ float hg_lb(const Ctx& F, int l, int d, int hk) {
    if (l == 0) return 0.f;
    const float l0 = F.inp(I_LBL)[(0 * 2 + d) * 256 + hk], l1 = F.inp(I_LBL)[(1 * 2 + d) * 256 + hk];
    return 1.0f / (1.0f + expf(l0 - l1));
}
__device__ __forceinline__ void ph_hgrn_scan_naive(Ctx& F, int l) {
    if (F.bid >= NB * 2 * 4) return;
    const int b = F.bid >> 3, d = (F.bid >> 2) & 1, hh = F.bid & 3;
    const int v = F.tid & 63, kq = F.tid >> 6;
    LAS float* part = (LAS float*)F.lds;
    float lb[8], S[8];
#pragma unroll
    for (int i = 0; i < 8; ++i) { lb[i] = hg_lb(F, l, d, hh * 64 + kq * 8 + i); S[i] = 0.f; }
    int buf = 0;
    for (int s = 0; s < CTXL + SEQ; ++s) {
        int m;
        if (s < CTXL) m = ML + b * CTXL + (d ? CTXL - 1 - s : s); else { const int t = s - CTXL; m = b * SEQ + (d ? SEQ - 1 - t : t); }
        const bf16* pr = F.P() + (size_t)m * INW;
        const u32x4 zw = *(const u32x4*)(pr + (d ? C_HB : C_HF) + hh * 64 + kq * 8), qw = *(const u32x4*)(pr + C_HQ + hh * 64 + kq * 8);
        const float vv = bf2f(pr[C_HV + hh * 64 + v]);
        float z[8], q[8];
        z[0] = __uint_as_float(zw.x << 16); z[1] = __uint_as_float(zw.x & 0xffff0000u); z[2] = __uint_as_float(zw.y << 16); z[3] = __uint_as_float(zw.y & 0xffff0000u);
        z[4] = __uint_as_float(zw.z << 16); z[5] = __uint_as_float(zw.z & 0xffff0000u); z[6] = __uint_as_float(zw.w << 16); z[7] = __uint_as_float(zw.w & 0xffff0000u);
        q[0] = __uint_as_float(qw.x << 16); q[1] = __uint_as_float(qw.x & 0xffff0000u); q[2] = __uint_as_float(qw.y << 16); q[3] = __uint_as_float(qw.y & 0xffff0000u);
        q[4] = __uint_as_float(qw.z << 16); q[5] = __uint_as_float(qw.z & 0xffff0000u); q[6] = __uint_as_float(qw.w << 16); q[7] = __uint_as_float(qw.w & 0xffff0000u);
        float pa = 0.f;
#pragma unroll
        for (int i = 0; i < 8; ++i) { const float sg = sigmoidf_(z[i]); const float f = lb[i] + (1.0f - lb[i]) * sg, kk = (1.0f - lb[i]) * (1.0f - sg);
            S[i] = f * S[i] + kk * vv; pa += S[i] * q[i]; }
        part[(buf * 8 + kq) * 64 + v] = pa;
        __syncthreads();
        if (kq == 0) { float o = 0.f;
#pragma unroll
            for (int i = 0; i < 8; ++i) o += part[(buf * 8 + i) * 64 + v];
            F.OHG()[(size_t)m * 512 + d * 256 + hh * 64 + v] = o; }
        buf ^= 1;
    }
}
__device__ __forceinline__ void ph_hgrn_out_naive(Ctx& F, int l) {
    const int gw = F.bid * NWAVES + F.wave, NGW = F.G * NWAVES;
    const int Mq = (l == 0) ? MA : ML;
    for (int m = gw; m < Mq; m += NGW) {
        const int col = 4 * F.lane;
        const f32x4 a = *(const f32x4*)(F.OHG() + (size_t)m * 512 + col), bb = *(const f32x4*)(F.OHG() + (size_t)m * 512 + 256 + col);
        const f32x4 o = a + bb;
        float ss = (o.x * o.x + o.y * o.y) + (o.z * o.z + o.w * o.w);
        ss += shx(ss, 1, F.lane); ss += shx(ss, 2, F.lane); ss += shx(ss, 4, F.lane); ss += shx(ss, 8, F.lane);
        const float rstd = 1.0f / sqrtf(ss * (1.0f / 64.0f) + EPS);
        const f32x4 g = *(const f32x4*)(F.inp(I_HNG) + l * 256 + col);
        const u32x2 ow = *(const u32x2*)(F.P() + (size_t)m * INW + C_HO + col);
        const float g0 = siluf_(__uint_as_float(ow.x << 16)), g1 = siluf_(__uint_as_float(ow.x & 0xffff0000u)), g2 = siluf_(__uint_as_float(ow.y << 16)), g3 = siluf_(__uint_as_float(ow.y & 0xffff0000u));
        u32x2 w; w.x = pk2(o.x * rstd * g.x * g0, o.y * rstd * g.y * g1); w.y = pk2(o.z * rstd * g.z * g2, o.w * rstd * g.w * g3);
        *(u32x2*)(F.MIX() + (size_t)m * D + 768 + col) = w;
    }
}

constexpr int MIX_NUB = 136, MIX_NU = 272;
constexpr int LRU_NU = MIX_NU;
struct MixUnit { int b, j, rowbase, t0, ntok, T, ub; bool isc; };
__device__ __forceinline__ MixUnit mix_unit(int g) {
    MixUnit m;
    if (g < 256) { m.b = g >> 7; m.j = g & 127; m.isc = false; m.rowbase = m.b * SEQ; m.t0 = m.j * 128; m.ntok = 128; m.T = SEQ; }
    else { const int c = g - 256; m.b = c >> 3; m.j = 128 + (c & 7); m.isc = true; m.rowbase = ML + m.b * CTXL; m.t0 = (c & 7) * 32; m.ntok = 32; m.T = CTXL; }
    m.ub = m.b * MIX_NUB + m.j; return m;
}
constexpr size_t AG_LRU_A = 0, AG_LRU_B = (size_t)LRU_NU * 512, AG_LRU_H = 2 * (size_t)LRU_NU * 512;
constexpr int U_PITCH = 528;
template <bool FULL, int DIR>
__device__ __forceinline__ void lru_wave(Ctx& F, int l, int u, int n, int rowbase, int t0, int nmt) {
    int ln_ = F.lane; asm volatile("" : "+v"(ln_));
    const int r32 = ln_ & 31, h = ln_ >> 5;
    LAS unsigned char* U = F.lds;
    const bf16* wb = F.lruw() + ((((size_t)l * 2 + DIR) * 2) * 4 + n) * 4096;
    float br[2], bi[2], c8[2], hc[2], At[2], Bt[2];
#pragma unroll
    for (int ct = 0; ct < 2; ++ct) { const int c = 64 * n + 32 * ct + r32, ix = (l * 2 + DIR) * 256 + c;
        br[ct] = FULL ? 0.f : F.inp(I_BR)[ix]; bi[ct] = FULL ? 0.f : F.inp(I_BI)[ix]; c8[ct] = FULL ? 0.f : 8.0f * log1pf(expf(-F.inp(I_LAM)[ix]));
        hc[ct] = FULL ? F.AGG()[AG_LRU_H + (size_t)u * 512 + DIR * 256 + c] : 0.f; At[ct] = 1.f; Bt[ct] = 0.f; }
#pragma unroll
    for (int ct = 0; ct < 2; ++ct) {
        const int c = 64 * n + 32 * ct + r32;
        bf16x8 Bg[2][4];
        if (!FULL) {
#pragma unroll
            for (int g = 0; g < 2; ++g) { const bf16* p = wb + (size_t)g * 4 * 4096 + (32 * ct + r32) * 64 + 8 * h;
#pragma unroll
                for (int ks = 0; ks < 4; ++ks) Bg[g][ks] = *(const bf16x8*)(p + 16 * ks); } }
#pragma unroll 1
        for (int mi = 0; mi < nmt; ++mi) {
            const int mt = DIR ? nmt - 1 - mi : mi;
            float a[16], bb[16];
            const size_t gix0 = (size_t)(rowbase + t0 + 32 * mt + 4 * h) * 512 + DIR * 256 + c;
            if (FULL) {
#pragma unroll
                for (int q = 0; q < 16; ++q) { const size_t ix = gix0 + (size_t)((q & 3) + 8 * (q >> 2)) * 512; a[q] = F.GA()[ix]; bb[q] = F.GB()[ix]; }
            } else {
                f32x16 acc[2];
#pragma unroll
                for (int g = 0; g < 2; ++g)
#pragma unroll
                    for (int q = 0; q < 16; ++q) acc[g][q] = 0.f;
#pragma unroll
                for (int ks = 0; ks < 4; ++ks) { const bf16x8 af = *(const LAS bf16x8*)(U + (32 * mt + r32) * U_PITCH + (64 * n + 16 * ks + 8 * h) * 2);
                    acc[0] = __builtin_amdgcn_mfma_f32_32x32x16_bf16(af, Bg[0][ks], acc[0], 0, 0, 0); acc[1] = __builtin_amdgcn_mfma_f32_32x32x16_bf16(af, Bg[1][ks], acc[1], 0, 0, 0); }
#pragma unroll
                for (int q = 0; q < 16; ++q) { const int t = 32 * mt + crow(q, h);
                    const float uu = bf2f(*(const LAS bf16*)(U + t * U_PITCH + c * 2));
                    const float r = sigmoidf_(acc[0][q] + br[ct]), ig = sigmoidf_(acc[1][q] + bi[ct]);
                    a[q] = __expf(-c8[ct] * r); bb[q] = __builtin_amdgcn_sqrtf(fmaxf(1.0f - a[q] * a[q], 1e-12f)) * ig * uu;
                    const size_t ix = gix0 + (size_t)((q & 3) + 8 * (q >> 2)) * 512; F.GA()[ix] = a[q]; F.GB()[ix] = bb[q]; }
            }
            float gA[4], gB[4], oA[4], oB[4];
#pragma unroll
            for (int g = 0; g < 4; ++g) { float A = 1.f, B = 0.f;
#pragma unroll
                for (int jj = 0; jj < 4; ++jj) { const int q = 4 * g + (DIR ? 3 - jj : jj); B = a[q] * B + bb[q]; A *= a[q]; }
                gA[g] = A; gB[g] = B; }
#pragma unroll
            for (int g = 0; g < 4; ++g) { oA[g] = shx(gA[g], 32, ln_); oB[g] = shx(gB[g], 32, ln_); }
            float st[4] = {0.f, 0.f, 0.f, 0.f}; float hs = hc[ct];
#pragma unroll
            for (int kk = 0; kk < 8; ++kk) { const int k = DIR ? 7 - kk : kk, g = k >> 1; const bool mine = ((k & 1) == h);
                const float Ak = mine ? gA[g] : oA[g], Bk = mine ? gB[g] : oB[g];
                if (FULL) { st[g] = mine ? hs : st[g]; hs = Ak * hs + Bk; }
                else { Bt[ct] = Ak * Bt[ct] + Bk; At[ct] *= Ak; } }
            if (FULL) {
                hc[ct] = hs;
#pragma unroll
                for (int g = 0; g < 4; ++g) { float hh = st[g];
#pragma unroll
                    for (int jj = 0; jj < 4; ++jj) { const int q = 4 * g + (DIR ? 3 - jj : jj); hh = a[q] * hh + bb[q];
                        F.HD()[(size_t)(rowbase + t0 + 32 * mt + crow(q, h)) * 512 + DIR * 256 + c] = hh; } }
            }
        }
        __builtin_amdgcn_sched_barrier(0);
    }
    if (!FULL && h == 0) {
#pragma unroll
        for (int ct = 0; ct < 2; ++ct) { const int c = 64 * n + 32 * ct + r32;
            F.AGG()[AG_LRU_A + (size_t)u * 512 + DIR * 256 + c] = At[ct]; F.AGG()[AG_LRU_B + (size_t)u * 512 + DIR * 256 + c] = Bt[ct]; }
    }
}
template <bool FULL>
__device__ __forceinline__ void ph_lru_fast(Ctx& F, int l) {
    LAS unsigned char* U = F.lds;
    for (int it = 0; it < 2; ++it) {
        const int u = it == 0 ? F.bid : 256 + (F.bid - 16);
        if (it == 0 ? (u >= 256) : (F.bid < 16 || F.bid >= 32 || F.G < 256)) continue;
        const MixUnit mu = mix_unit(u); const bool isc = mu.isc;
        if (FULL && isc && l == NL - 1) continue;
        const int rowbase = mu.rowbase, T = mu.T, t0 = mu.t0, ntok = mu.ntok;
        __syncthreads();
        if (!FULL) { const int c8 = (F.tid & 31) * 8, tr = F.tid >> 5;
          float w[4][8], cb[8];
#pragma unroll
          for (int jj = 0; jj < 4; ++jj) { const f32x4 w0 = *(const f32x4*)(F.inp(I_CONVW) + (l * 4 + jj) * 256 + c8), w1 = *(const f32x4*)(F.inp(I_CONVW) + (l * 4 + jj) * 256 + c8 + 4);
              w[jj][0] = w0.x; w[jj][1] = w0.y; w[jj][2] = w0.z; w[jj][3] = w0.w; w[jj][4] = w1.x; w[jj][5] = w1.y; w[jj][6] = w1.z; w[jj][7] = w1.w; }
          { const f32x4 b0 = *(const f32x4*)(F.inp(I_CONVB) + l * 256 + c8), b1 = *(const f32x4*)(F.inp(I_CONVB) + l * 256 + c8 + 4);
            cb[0] = b0.x; cb[1] = b0.y; cb[2] = b0.z; cb[3] = b0.w; cb[4] = b1.x; cb[5] = b1.y; cb[6] = b1.z; cb[7] = b1.w; }
#pragma unroll 4
          for (int i = 0; i < 8; ++i) { const int t = tr + 16 * i, tt = t0 + t;
              if (t >= ntok) break;
              float o[8];
#pragma unroll
              for (int e = 0; e < 8; ++e) o[e] = cb[e];
#pragma unroll
              for (int jj = 0; jj < 4; ++jj) { const int ts = tt - 2 + jj;
                  if (ts >= 0 && ts < T) { const u32x4 xw = *(const u32x4*)(F.P() + (size_t)(rowbase + ts) * INW + C_LX + c8);
                      o[0] += w[jj][0] * __uint_as_float(xw.x << 16); o[1] += w[jj][1] * __uint_as_float(xw.x & 0xffff0000u); o[2] += w[jj][2] * __uint_as_float(xw.y << 16); o[3] += w[jj][3] * __uint_as_float(xw.y & 0xffff0000u);
                      o[4] += w[jj][4] * __uint_as_float(xw.z << 16); o[5] += w[jj][5] * __uint_as_float(xw.z & 0xffff0000u); o[6] += w[jj][6] * __uint_as_float(xw.w << 16); o[7] += w[jj][7] * __uint_as_float(xw.w & 0xffff0000u); } }
              u32x4 ow; ow.x = pk2(o[0], o[1]); ow.y = pk2(o[2], o[3]); ow.z = pk2(o[4], o[5]); ow.w = pk2(o[6], o[7]);
              *(LAS u32x4*)(U + t * U_PITCH + c8 * 2) = ow; } }
        __syncthreads();
        { const int n = F.wave & 3;
          if (F.wave < 4) lru_wave<FULL, 0>(F, l, mu.ub, n, rowbase, t0, ntok >> 5); else lru_wave<FULL, 1>(F, l, mu.ub, n, rowbase, t0, ntok >> 5); }
        if (FULL) {
            __syncthreads();
#pragma unroll 4
            for (int i = F.tid; i < ntok * 64; i += NTHR) { const int t = i >> 6, c4 = (i & 63) * 4; const size_t row = (size_t)rowbase + t0 + t;
                const f32x4 hf = *(const f32x4*)(F.HD() + row * 512 + c4), hb = *(const f32x4*)(F.HD() + row * 512 + 256 + c4);
                const u32x2 gw = *(const u32x2*)(F.P() + row * INW + C_LG + c4);
                u32x2 w; w.x = pk2((hf.x + hb.x) * gelu_tanh(__uint_as_float(gw.x << 16)), (hf.y + hb.y) * gelu_tanh(__uint_as_float(gw.x & 0xffff0000u)));
                w.y = pk2((hf.z + hb.z) * gelu_tanh(__uint_as_float(gw.y << 16)), (hf.w + hb.w) * gelu_tanh(__uint_as_float(gw.y & 0xffff0000u)));
                *(u32x2*)(F.MIX() + row * D + 512 + c4) = w; }
        }
    }
}
__device__ __forceinline__ int mix_order(int d, int s) { return d ? 135 - s : (s < 8 ? 128 + s : s - 8); }
__device__ __forceinline__ void ph_lru_carry(Ctx& F) {
    const int gt = F.bid * NTHR + F.tid;
    if (gt >= NB * 512) return;
    const int b = gt >> 9, dc = gt & 511, d = dc >> 8;
    float h = 0.f;
#pragma unroll 1
    for (int s0 = 0; s0 < 136; s0 += 34) {
        float av[34], bv[34];
#pragma unroll
        for (int q = 0; q < 34; ++q) { const size_t ix = (size_t)(b * MIX_NUB + mix_order(d, s0 + q)) * 512 + dc; av[q] = F.AGG()[AG_LRU_A + ix]; bv[q] = F.AGG()[AG_LRU_B + ix]; }
#pragma unroll
        for (int q = 0; q < 34; ++q) { F.AGG()[AG_LRU_H + (size_t)(b * MIX_NUB + mix_order(d, s0 + q)) * 512 + dc] = h; h = av[q] * h + bv[q]; }
    }
}

constexpr int HG_NU = MIX_NU;
constexpr int HGW_LDS = 17152;
constexpr int KT_P = 36;
constexpr size_t AG_HG_D = 1048576, AG_HG_EBR = AG_HG_D + (size_t)HG_NU * 8 * 64;
__device__ __forceinline__ void hg_stage_v(const Ctx& F, LAS bf16* Vt, int rowbase, int c0, int hh, int r32, int h, int DIR) {
    const int t = c0 + (DIR ? 31 - r32 : r32); const bf16* vp = F.P() + (size_t)(rowbase + t) * INW + C_HV + hh * 64 + 32 * h;
#pragma unroll
    for (int c = 0; c < 4; ++c) { const u32x4 w = *(const u32x4*)(vp + 8 * c); const int v0 = 32 * h + 8 * c;
        Vt[(v0 + 0) * 32 + r32] = (bf16)(w.x & 0xffffu); Vt[(v0 + 1) * 32 + r32] = (bf16)(w.x >> 16); Vt[(v0 + 2) * 32 + r32] = (bf16)(w.y & 0xffffu); Vt[(v0 + 3) * 32 + r32] = (bf16)(w.y >> 16);
        Vt[(v0 + 4) * 32 + r32] = (bf16)(w.z & 0xffffu); Vt[(v0 + 5) * 32 + r32] = (bf16)(w.z >> 16); Vt[(v0 + 6) * 32 + r32] = (bf16)(w.w & 0xffffu); Vt[(v0 + 7) * 32 + r32] = (bf16)(w.w >> 16); }
}
__device__ __forceinline__ void hg_update_s(f32x16 (&S)[2][2], const LAS bf16* KiT, const LAS bf16* Vt, const LAS float* ebr, int r32, int h) {
#pragma unroll
    for (int kt = 0; kt < 2; ++kt) {
        float e1[16];
#pragma unroll
        for (int q = 0; q < 16; ++q) e1[q] = ebr[4 * h + (32 * kt + (q & 3) + 8 * (q >> 2))];
#pragma unroll
        for (int vt = 0; vt < 2; ++vt) { f32x16 tmp;
#pragma unroll
            for (int q = 0; q < 16; ++q) tmp[q] = 0.f;
#pragma unroll
            for (int ks = 0; ks < 2; ++ks) { const LAS bf16* kp = KiT + (32 * kt + r32) * KT_P + 16 * ks + 8 * h; const u32x2 klo = *(const LAS u32x2*)kp, khi = *(const LAS u32x2*)(kp + 4);
                u32x4 fau; fau.x = klo.x; fau.y = klo.y; fau.z = khi.x; fau.w = khi.y; const bf16x8 fa = __builtin_bit_cast(bf16x8, fau), fb = *(const LAS bf16x8*)(Vt + (32 * vt + r32) * 32 + 16 * ks + 8 * h);
                tmp = __builtin_amdgcn_mfma_f32_32x32x16_bf16(fa, fb, tmp, 0, 0, 0); }
#pragma unroll
            for (int q = 0; q < 16; ++q) S[kt][vt][q] = e1[q] * (e1[q] * S[kt][vt][q] + tmp[q]); }
    }
}
template <int DIR>
__device__ __forceinline__ void hg_wave_a(Ctx& F, int l, int u, int hh, int rowbase, int nch) {
    int ln_ = F.lane; asm volatile("" : "+v"(ln_));
    const int r32 = ln_ & 31, h = ln_ >> 5, k = ln_;
    LAS unsigned char* W = F.lds + F.wave * HGW_LDS;
    LAS bf16* Qi = (LAS bf16*)W; LAS bf16* Ki = (LAS bf16*)(W + 4096); LAS bf16* KiT = (LAS bf16*)(W + 8192); LAS bf16* Vt = (LAS bf16*)(W + 12800); LAS float* ebr = (LAS float*)(W + 16896);
    const int hd = DIR * 4 + hh;
    const float lb = hg_lb(F, l, DIR, hh * 64 + k);
    const unsigned lane_s = 4 * h * 64 + r32;
    f32x16 S[2][2];
#pragma unroll
    for (int kt = 0; kt < 2; ++kt)
#pragma unroll
        for (int vt = 0; vt < 2; ++vt)
#pragma unroll
            for (int q = 0; q < 16; ++q) S[kt][vt][q] = 0.f;
    float dsum = 0.f;
#pragma unroll 1
    for (int ci = 0; ci < nch; ++ci) {
        const int cph = DIR ? nch - 1 - ci : ci, c0 = 32 * cph;
        const int si = ln_ >> 1, sh = ln_ & 1; const int ts = c0 + (DIR ? 31 - si : si);
        { const bf16* zp = F.P() + (size_t)(rowbase + ts) * INW + (DIR ? C_HB : C_HF) + hh * 64 + 32 * sh;
          const bf16* qp = F.P() + (size_t)(rowbase + ts) * INW + C_HQ + hh * 64 + 32 * sh;
          u32x4 zz[4], qq[4];
#pragma unroll
          for (int c = 0; c < 4; ++c) { zz[c] = *(const u32x4*)(zp + 8 * c); qq[c] = *(const u32x4*)(qp + 8 * c); }
#pragma unroll
          for (int c = 0; c < 4; ++c) { *(LAS u32x4*)(Qi + si * 64 + 32 * sh + 8 * c) = zz[c]; *(LAS u32x4*)(Ki + si * 64 + 32 * sh + 8 * c) = qq[c]; } }
        hg_stage_v(F, Vt, rowbase, c0, hh, r32, h, DIR);
        asm volatile("s_waitcnt lgkmcnt(0)" ::: "memory");
        {
            float lf[32]; float run = 0.f;
#pragma unroll
            for (int i = 0; i < 32; ++i) { const float z = bf2f(Qi[i * 64 + k]); lf[i] = __logf(lb + (1.0f - lb) * sigmoidf_(z)); run += lf[i]; }
            const float bref = 0.5f * run; dsum += run;
            const float eb = __expf(bref);
            ebr[k] = eb; F.AGG()[AG_HG_EBR + (((size_t)u * 4 + cph) * 8 + hd) * 64 + k] = eb;
            float cum = 0.f;
#pragma unroll
            for (int i = 0; i < 32; ++i) {
                const float qq = bf2f(Ki[i * 64 + k]);
                cum += lf[i];
                const float e = __expf(cum - bref), ei = __expf(bref - cum);
                const unsigned kv = f2bf((1.0f - __expf(lf[i])) * ei);
                Ki[i * 64 + k] = (bf16)kv; KiT[k * KT_P + i] = (bf16)kv; Qi[i * 64 + k] = (bf16)f2bf(qq * e); }
        }
        asm volatile("s_waitcnt lgkmcnt(0)" ::: "memory");
        { bf16* qo = F.ws_bf16(WS_QI) + (size_t)(rowbase + ts) * 512 + DIR * 256 + hh * 64 + 32 * sh; bf16* ko = F.ws_bf16(WS_KI) + (size_t)(rowbase + ts) * 512 + DIR * 256 + hh * 64 + 32 * sh;
#pragma unroll
          for (int c = 0; c < 4; ++c) { *(u32x4*)(qo + 8 * c) = *(const LAS u32x4*)(Qi + si * 64 + 32 * sh + 8 * c); *(u32x4*)(ko + 8 * c) = *(const LAS u32x4*)(Ki + si * 64 + 32 * sh + 8 * c); } }
        hg_update_s(S, KiT, Vt, ebr, r32, h);
        asm volatile("s_waitcnt lgkmcnt(0)" ::: "memory");
    }
    float* sa = (float*)(F.ws + WS_SAGG) + ((size_t)u * 8 + hd) * 4096;
#pragma unroll
    for (int kt = 0; kt < 2; ++kt)
#pragma unroll
        for (int vt = 0; vt < 2; ++vt)
#pragma unroll
            for (int q = 0; q < 16; ++q) sa[lane_s + (unsigned)((32 * kt + (q & 3) + 8 * (q >> 2)) * 64 + 32 * vt)] = S[kt][vt][q];
    F.AGG()[AG_HG_D + ((size_t)u * 8 + hd) * 64 + k] = __expf(dsum);
}
template <int DIR>
__device__ __forceinline__ void hg_wave_c(Ctx& F, int l, int u, int hh, int rowbase, int nch) {
    int ln_ = F.lane; asm volatile("" : "+v"(ln_));
    const int r32 = ln_ & 31, h = ln_ >> 5, k = ln_;
    LAS unsigned char* W = F.lds + F.wave * HGW_LDS;
    LAS bf16* Qi = (LAS bf16*)W; LAS bf16* Ki = (LAS bf16*)(W + 4096); LAS bf16* KiT = (LAS bf16*)(W + 8192); LAS bf16* Vt = (LAS bf16*)(W + 12800); LAS float* ebr = (LAS float*)(W + 16896);
    const int hd = DIR * 4 + hh;
    const unsigned lane_s = 4 * h * 64 + r32;
    f32x16 S[2][2];
    { const float* sin = (const float*)(F.ws + WS_SIN) + ((size_t)u * 8 + hd) * 4096;
#pragma unroll
      for (int kt = 0; kt < 2; ++kt)
#pragma unroll
          for (int vt = 0; vt < 2; ++vt)
#pragma unroll
              for (int q = 0; q < 16; ++q) S[kt][vt][q] = sin[lane_s + (unsigned)((32 * kt + (q & 3) + 8 * (q >> 2)) * 64 + 32 * vt)]; }
#pragma unroll 1
    for (int ci = 0; ci < nch; ++ci) {
        const int cph = DIR ? nch - 1 - ci : ci, c0 = 32 * cph;
        { const int si = ln_ >> 1, sh = ln_ & 1; const int ts = c0 + (DIR ? 31 - si : si);
          const bf16* qo = F.ws_bf16(WS_QI) + (size_t)(rowbase + ts) * 512 + DIR * 256 + hh * 64 + 32 * sh; const bf16* ko = F.ws_bf16(WS_KI) + (size_t)(rowbase + ts) * 512 + DIR * 256 + hh * 64 + 32 * sh;
          u32x4 qq[4], kk[4];
#pragma unroll
          for (int c = 0; c < 4; ++c) { qq[c] = *(const u32x4*)(qo + 8 * c); kk[c] = *(const u32x4*)(ko + 8 * c); }
          ebr[k] = F.AGG()[AG_HG_EBR + (((size_t)u * 4 + cph) * 8 + hd) * 64 + k];
#pragma unroll
          for (int c = 0; c < 4; ++c) { *(LAS u32x4*)(Qi + si * 64 + 32 * sh + 8 * c) = qq[c]; *(LAS u32x4*)(Ki + si * 64 + 32 * sh + 8 * c) = kk[c];
              const int k0 = 32 * sh + 8 * c;
              KiT[(k0 + 0) * KT_P + si] = (bf16)(kk[c].x & 0xffffu); KiT[(k0 + 1) * KT_P + si] = (bf16)(kk[c].x >> 16); KiT[(k0 + 2) * KT_P + si] = (bf16)(kk[c].y & 0xffffu); KiT[(k0 + 3) * KT_P + si] = (bf16)(kk[c].y >> 16);
              KiT[(k0 + 4) * KT_P + si] = (bf16)(kk[c].z & 0xffffu); KiT[(k0 + 5) * KT_P + si] = (bf16)(kk[c].z >> 16); KiT[(k0 + 6) * KT_P + si] = (bf16)(kk[c].w & 0xffffu); KiT[(k0 + 7) * KT_P + si] = (bf16)(kk[c].w >> 16); } }
        hg_stage_v(F, Vt, rowbase, c0, hh, r32, h, DIR);
        asm volatile("s_waitcnt lgkmcnt(0)" ::: "memory");
        f32x16 att;
#pragma unroll
        for (int q = 0; q < 16; ++q) att[q] = 0.f;
#pragma unroll
        for (int ks = 0; ks < 4; ++ks) { const bf16x8 fa = *(const LAS bf16x8*)(Ki + r32 * 64 + 16 * ks + 8 * h), fb = *(const LAS bf16x8*)(Qi + r32 * 64 + 16 * ks + 8 * h);
            att = __builtin_amdgcn_mfma_f32_32x32x16_bf16(fa, fb, att, 0, 0, 0); }
#pragma unroll
        for (int q = 0; q < 16; ++q) att[q] = (crow(q, h) <= r32) ? att[q] : 0.f;
        f32x16 o[2];
#pragma unroll
        for (int vt = 0; vt < 2; ++vt)
#pragma unroll
            for (int q = 0; q < 16; ++q) o[vt][q] = 0.f;
#pragma unroll
        for (int ks = 0; ks < 2; ++ks) {
            u32x4 pa; pa.x = pk2(att[8 * ks + 0], att[8 * ks + 1]); pa.y = pk2(att[8 * ks + 2], att[8 * ks + 3]); pa.z = pk2(att[8 * ks + 4], att[8 * ks + 5]); pa.w = pk2(att[8 * ks + 6], att[8 * ks + 7]);
#pragma unroll
            for (int vt = 0; vt < 2; ++vt) { const LAS bf16* vp = Vt + (32 * vt + r32) * 32 + 16 * ks + 4 * h;
                const u32x2 lo = *(const LAS u32x2*)vp, hi2 = *(const LAS u32x2*)(vp + 8);
                u32x4 fb; fb.x = lo.x; fb.y = lo.y; fb.z = hi2.x; fb.w = hi2.y;
                o[vt] = __builtin_amdgcn_mfma_f32_32x32x16_bf16(__builtin_bit_cast(bf16x8, pa), __builtin_bit_cast(bf16x8, fb), o[vt], 0, 0, 0); } }
#pragma unroll
        for (int kt = 0; kt < 2; ++kt) {
            float e1[16];
#pragma unroll
            for (int q = 0; q < 16; ++q) e1[q] = ebr[4 * h + (32 * kt + (q & 3) + 8 * (q >> 2))];
#pragma unroll
            for (int ks = 0; ks < 2; ++ks) { const LAS bf16* qp = Qi + r32 * 64 + 32 * kt + 16 * ks + 4 * h;
                const u32x2 lo = *(const LAS u32x2*)qp, hi2 = *(const LAS u32x2*)(qp + 8);
                u32x4 fa; fa.x = lo.x; fa.y = lo.y; fa.z = hi2.x; fa.w = hi2.y;
#pragma unroll
                for (int vt = 0; vt < 2; ++vt) { u32x4 sb;
                    sb.x = pk2(S[kt][vt][8 * ks + 0] * e1[8 * ks + 0], S[kt][vt][8 * ks + 1] * e1[8 * ks + 1]); sb.y = pk2(S[kt][vt][8 * ks + 2] * e1[8 * ks + 2], S[kt][vt][8 * ks + 3] * e1[8 * ks + 3]);
                    sb.z = pk2(S[kt][vt][8 * ks + 4] * e1[8 * ks + 4], S[kt][vt][8 * ks + 5] * e1[8 * ks + 5]); sb.w = pk2(S[kt][vt][8 * ks + 6] * e1[8 * ks + 6], S[kt][vt][8 * ks + 7] * e1[8 * ks + 7]);
                    o[vt] = __builtin_amdgcn_mfma_f32_32x32x16_bf16(__builtin_bit_cast(bf16x8, fa), __builtin_bit_cast(bf16x8, sb), o[vt], 0, 0, 0); } }
        }
        { float* ob = F.OHG() + (size_t)(rowbase + c0) * 512 + DIR * 256 + hh * 64;
          const unsigned lane_o = (unsigned)((DIR ? 4 - 4 * h : 4 * h) * 512 + r32);
#pragma unroll
          for (int q = 0; q < 16; ++q) { const int iq = (q & 3) + 8 * (q >> 2); const unsigned cq = (unsigned)((DIR ? 27 - iq : iq) * 512);
              ob[lane_o + cq] = o[0][q]; ob[lane_o + cq + 32u] = o[1][q]; } }
        if (ci < nch - 1) hg_update_s(S, KiT, Vt, ebr, r32, h);
        asm volatile("s_waitcnt lgkmcnt(0)" ::: "memory");
    }
}
template <bool FULL>
__device__ __forceinline__ void ph_hgrn_fast(Ctx& F, int l) {
    for (int it = 0; it < 2; ++it) {
        const int u = it == 0 ? F.bid : 256 + (F.bid - 32);
        if (it == 0 ? (u >= 256) : (F.bid < 32 || F.bid >= 48 || F.G < 256)) continue;
        const MixUnit mu = mix_unit(u); const bool isc = mu.isc;
        if (FULL && isc && l == NL - 1) continue;
        const int rowbase = mu.rowbase + mu.t0, ntok = mu.ntok;
        __syncthreads();
        { const int hh = F.wave & 3;
          if (FULL) { if (F.wave < 4) hg_wave_c<0>(F, l, mu.ub, hh, rowbase, ntok >> 5); else hg_wave_c<1>(F, l, mu.ub, hh, rowbase, ntok >> 5); }
          else { if (F.wave < 4) hg_wave_a<0>(F, l, mu.ub, hh, rowbase, ntok >> 5); else hg_wave_a<1>(F, l, mu.ub, hh, rowbase, ntok >> 5); } }
        if (FULL) {
            __syncthreads();
#pragma unroll 4
            for (int rr = F.wave; rr < ntok; rr += NWAVES) { const size_t m = (size_t)rowbase + rr; const int col = 4 * F.lane;
                const f32x4 a = *(const f32x4*)(F.OHG() + m * 512 + col), bb = *(const f32x4*)(F.OHG() + m * 512 + 256 + col);
                const f32x4 o = a + bb;
                float ss = (o.x * o.x + o.y * o.y) + (o.z * o.z + o.w * o.w);
                ss += shx(ss, 1, F.lane); ss += shx(ss, 2, F.lane); ss += shx(ss, 4, F.lane); ss += shx(ss, 8, F.lane);
                const float rstd = 1.0f / sqrtf(ss * (1.0f / 64.0f) + EPS);
                const f32x4 g = *(const f32x4*)(F.inp(I_HNG) + l * 256 + col);
                const u32x2 ow = *(const u32x2*)(F.P() + m * INW + C_HO + col);
                const float g0 = siluf_(__uint_as_float(ow.x << 16)), g1 = siluf_(__uint_as_float(ow.x & 0xffff0000u)), g2 = siluf_(__uint_as_float(ow.y << 16)), g3 = siluf_(__uint_as_float(ow.y & 0xffff0000u));
                u32x2 w; w.x = pk2(o.x * rstd * g.x * g0, o.y * rstd * g.y * g1); w.y = pk2(o.z * rstd * g.z * g2, o.w * rstd * g.w * g3);
                *(u32x2*)(F.MIX() + m * D + 768 + col) = w; }
        }
    }
}
__device__ __forceinline__ void ph_hgrn_carry(Ctx& F) {
    const int gt = F.bid * NTHR + F.tid;
    if (gt >= 16 * 4096) return;
    const int seq = gt >> 12, e = gt & 4095, b = seq >> 3, hd = seq & 7, d = hd >> 2, kk = e >> 6;
    const float* SA = (const float*)(F.ws + WS_SAGG); float* SI = (float*)(F.ws + WS_SIN);
    float S = 0.f;
#pragma unroll 1
    for (int s0 = 0; s0 < 136; s0 += 34) {
        float dv[34], sv[34];
#pragma unroll
        for (int q = 0; q < 34; ++q) { const size_t ub = (size_t)(b * MIX_NUB + mix_order(d, s0 + q)) * 8 + hd; dv[q] = F.AGG()[AG_HG_D + ub * 64 + kk]; sv[q] = SA[ub * 4096 + e]; }
#pragma unroll
        for (int q = 0; q < 34; ++q) { const size_t ub = (size_t)(b * MIX_NUB + mix_order(d, s0 + q)) * 8 + hd; SI[ub * 4096 + e] = S; S = dv[q] * S + sv[q]; }
    }
}

constexpr int CV_GU = NE * 16 * 64, CV_DN = NE * 16 * 32, CV_ITEMS = CV_GU + CV_DN, CV_PER_WAVE = CV_ITEMS / 2048;
constexpr int PROG_OFF = 147456 - 256 + 24 * 4;
constexpr int AT_CVSCR = 2 * 2 * 64 * 144;
#ifndef ATTN_RIDE
#define ATTN_RIDE 0
#endif
constexpr int AT_KP = 144;
constexpr int AT_BUF = 2 * 64 * AT_KP;
__device__ __forceinline__ void ph_attn_fast(Ctx& F, int l) {
    int ln_ = F.lane; asm volatile("" : "+v"(ln_));
    const int r32 = ln_ & 31, h = ln_ >> 5, g = F.wave >> 1, ph = F.wave & 1;
    const int lrow = F.tid >> 3, lch = F.tid & 7;
    const int NU = (l == 0) ? 1040 : 1024;
    for (int it = 0; it < 5; ++it) {
        const int u = it < 4 ? F.bid + 256 * it : 1024 + (F.bid - 240);
        if (it == 4 && (F.bid < 240 || NU <= 1024)) continue;
        const bool isc = u >= 1024;
        int b, kvh, jb;
        if (!isc) { b = u >> 9; kvh = (u >> 8) & 1; jb = u & 255; } else { const int v = u - 1024; b = v >> 3; kvh = (v >> 2) & 1; jb = v & 3; }
        const int q0 = jb * 64, qrowbase = isc ? ML + b * CTXL : b * SEQ, hq = kvh * 4 + g;
        int i_lo = 0, nloc = 0;
        if (!isc) { i_lo = q0 < 128 ? (128 - q0) >> 6 : 0; const int i_hi = (q0 + 192 <= SEQ) ? 4 : ((q0 + 128 <= SEQ) ? 3 : 2); nloc = i_hi - i_lo + 1; }
        const int NT = nloc + 4;
        bf16x8 qf[4];
        { const bf16* qp = F.P() + (size_t)(qrowbase + q0 + 32 * ph + r32) * INW + C_Q + hq * 64 + 8 * h;
#pragma unroll
          for (int ks = 0; ks < 4; ++ks) qf[ks] = *(const bf16x8*)(qp + 16 * ks); }
        float m_run = F.inp(I_SINK)[l * 8 + hq] * LOG2E, l_run = (h == 0) ? 1.0f : 0.0f;
        f32x16 ot[2];
#pragma unroll
        for (int dt = 0; dt < 2; ++dt)
#pragma unroll
            for (int q = 0; q < 16; ++q) ot[dt][q] = 0.f;
        u32x4 kreg, vreg;
#define AT_LOAD(ti) do { const int ti_ = (ti); const bool loc_ = ti_ < nloc; const int kst_ = loc_ ? q0 - 128 + 64 * (i_lo + ti_) : 64 * (ti_ - nloc); \
        const size_t krow_ = loc_ ? (size_t)b * SEQ + kst_ : (size_t)ML + b * CTXL + kst_; \
        kreg = *(const u32x4*)(F.P() + (krow_ + lrow) * INW + C_K + kvh * 64 + lch * 8); \
        const size_t vo_ = loc_ ? ((size_t)((b * 2 + kvh) * 64 + lrow)) * SEQ + kst_ : VT_CTX_OFF + ((size_t)((b * 2 + kvh) * 64 + lrow)) * CTXL + kst_; \
        vreg = *(const u32x4*)(F.Vt() + vo_ + lch * 8); } while (0)
#define AT_STORE(slot) do { LAS unsigned char* d_ = F.lds + (slot) * AT_BUF + lrow * AT_KP + lch * 16; *(LAS u32x4*)d_ = kreg; *(LAS u32x4*)(d_ + 64 * AT_KP) = vreg; } while (0)
#define AT_QK(P0, P1, slot) do { const LAS unsigned char* Kb_ = F.lds + (slot) * AT_BUF; \
        _Pragma("unroll") for (int q = 0; q < 16; ++q) { P0[q] = 0.f; P1[q] = 0.f; } \
        _Pragma("unroll") for (int ks = 0; ks < 4; ++ks) { \
            const bf16x8 a0 = *(const LAS bf16x8*)(Kb_ + r32 * AT_KP + (16 * ks + 8 * h) * 2), a1 = *(const LAS bf16x8*)(Kb_ + (32 + r32) * AT_KP + (16 * ks + 8 * h) * 2); \
            P0 = __builtin_amdgcn_mfma_f32_32x32x16_bf16(a0, qf[ks], P0, 0, 0, 0); P1 = __builtin_amdgcn_mfma_f32_32x32x16_bf16(a1, qf[ks], P1, 0, 0, 0); } } while (0)
        __syncthreads();
        AT_LOAD(0); AT_STORE(0); AT_LOAD(1); AT_STORE(1);
        __syncthreads();
        f32x16 p0, p1;
        AT_QK(p0, p1, 0);
        int sc_ = 0, sn_ = 1, sw_ = 2;
#pragma unroll 1
        for (int ti = 0; ti < NT; ++ti) {
            if (ti + 2 < NT) AT_LOAD(ti + 2);
            f32x16 n0, n1;
            if (ti + 1 < NT) AT_QK(n0, n1, sn_);
            else {
#pragma unroll
                for (int q = 0; q < 16; ++q) { n0[q] = 0.f; n1[q] = 0.f; } }
            const LAS unsigned char* Vb = F.lds + sc_ * AT_BUF + 64 * AT_KP;
            const int itile = (ti < nloc) ? i_lo + ti : 2;
            if (itile == 0 || itile == 4) {
                int ql = 32 * ph + r32; asm volatile("" : "+v"(ql));
#pragma unroll
                for (int q = 0; q < 16; ++q) { const int k0 = crow(q, h), k1 = 32 + crow(q, h);
                    const bool v0 = (itile == 0) ? (k0 >= ql) : (k0 <= ql), v1 = (itile == 0) ? (k1 >= ql) : (k1 <= ql);
                    p0[q] = v0 ? p0[q] : -1.0e30f; p1[q] = v1 ? p1[q] : -1.0e30f; }
            }
            float tm = fmaxf(fmaxf(p0[0], p1[0]), fmaxf(p0[1], p1[1]));
#pragma unroll
            for (int q = 2; q < 16; q += 2) tm = fmaxf(fmaxf(tm, fmaxf(p0[q], p1[q])), fmaxf(p0[q + 1], p1[q + 1]));
            tm = fmaxf(tm, shx(tm, 32, ln_));
            const float mn = fmaxf(m_run, tm);
            if (__builtin_amdgcn_ballot_w64(mn != m_run) != 0ull) {
                const float sc = __builtin_amdgcn_exp2f(m_run - mn);
                l_run *= sc;
#pragma unroll
                for (int dt = 0; dt < 2; ++dt)
#pragma unroll
                    for (int q = 0; q < 16; ++q) ot[dt][q] *= sc;
            }
            m_run = mn;
            float ls = 0.f;
#pragma unroll
            for (int q = 0; q < 16; ++q) { p0[q] = __builtin_amdgcn_exp2f(p0[q] - mn); p1[q] = __builtin_amdgcn_exp2f(p1[q] - mn); ls += p0[q] + p1[q]; }
            l_run += ls;
#pragma unroll
            for (int hk = 0; hk < 2; ++hk)
#pragma unroll
                for (int s = 0; s < 2; ++s) {
                    u32x4 pb;
                    if (hk == 0) { pb.x = pk2(p0[8 * s + 0], p0[8 * s + 1]); pb.y = pk2(p0[8 * s + 2], p0[8 * s + 3]); pb.z = pk2(p0[8 * s + 4], p0[8 * s + 5]); pb.w = pk2(p0[8 * s + 6], p0[8 * s + 7]); }
                    else { pb.x = pk2(p1[8 * s + 0], p1[8 * s + 1]); pb.y = pk2(p1[8 * s + 2], p1[8 * s + 3]); pb.z = pk2(p1[8 * s + 4], p1[8 * s + 5]); pb.w = pk2(p1[8 * s + 6], p1[8 * s + 7]); }
#pragma unroll
                    for (int dt = 0; dt < 2; ++dt) { const LAS unsigned char* vp = Vb + (32 * dt + r32) * AT_KP + (32 * hk + 16 * s + 4 * h) * 2;
                        const u32x2 lo = *(const LAS u32x2*)vp, hi2 = *(const LAS u32x2*)(vp + 16);
                        u32x4 fa; fa.x = lo.x; fa.y = lo.y; fa.z = hi2.x; fa.w = hi2.y;
                        ot[dt] = __builtin_amdgcn_mfma_f32_32x32x16_bf16(__builtin_bit_cast(bf16x8, fa), __builtin_bit_cast(bf16x8, pb), ot[dt], 0, 0, 0); } }
            if (ti + 2 < NT) AT_STORE(sw_);
            __syncthreads();
            p0 = n0; p1 = n1;
            { const int t_ = sc_; sc_ = sn_; sn_ = sw_; sw_ = t_; }
        }
#undef AT_LOAD
#undef AT_STORE
#undef AT_QK
        const float linv = 1.0f / (l_run + shx(l_run, 32, ln_));
        { bf16* op = F.MIX() + (size_t)(qrowbase + q0 + 32 * ph + r32) * D + hq * 64 + 4 * h;
#pragma unroll
          for (int dt = 0; dt < 2; ++dt)
#pragma unroll
              for (int gq = 0; gq < 4; ++gq) { u32x2 w; w.x = pk2(ot[dt][4 * gq + 0] * linv, ot[dt][4 * gq + 1] * linv); w.y = pk2(ot[dt][4 * gq + 2] * linv, ot[dt][4 * gq + 3] * linv);
                  *(u32x2*)(op + 32 * dt + 8 * gq) = w; } }
    }
}

__device__ __forceinline__ void ph_outproj_naive(Ctx& F, int l) {
    const int gw = F.bid * NWAVES + F.wave, NGW = F.G * NWAVES, r = F.lane & 31, h = F.lane >> 5;
    const int Mq = (l == 0) ? MA : ML;
    const bf16* Bt = F.WoutT() + (size_t)l * D * D;
    for (int ti = gw; ti < (Mq / 64) * (D / 64); ti += NGW) {
        const int rt = ti / (D / 64), ct = ti % (D / 64), m0 = rt * 64, c0 = ct * 64;
        f32x16 acc[2][2];
        sg_kloop(acc, F.MIX() + (size_t)(m0 + r) * D + 8 * h, F.MIX() + (size_t)(m0 + 32 + r) * D + 8 * h, Bt + (size_t)(c0 + r) * D + 8 * h, Bt + (size_t)(c0 + 32 + r) * D + 8 * h, D);
#pragma unroll
        for (int mt = 0; mt < 2; ++mt)
#pragma unroll
            for (int nt = 0; nt < 2; ++nt)
#pragma unroll
                for (int q = 0; q < 16; ++q) {
                    const int m = m0 + 32 * mt + crow(q, h), c = c0 + 32 * nt + r;
                    const float g2 = F.mods()[((size_t)l * 3 + mod_row(m)) * 6 * D + 2 * D + c];
                    F.P()[(size_t)m * D + c] = (bf16)f2bf(g2 * acc[mt][nt][q]);
                }
    }
}

__device__ __forceinline__ void ph_norm2_router(Ctx& F, int l, bool shadow = false) {
    const int Mq = (l == 0) ? MA : ML;
    LAS float* hs = (LAS float*)F.lds;
    LAS float* part = (LAS float*)(F.lds + 32768);
    LAS float* AC = (LAS float*)(F.lds + 49152);
    LAS float* BC = (LAS float*)(F.lds + 61440);
    LAS float* lg = (LAS float*)(F.lds + 73728);
    LAS float* tvi = (LAS float*)(F.lds + 74752);
    LAS int* lcnt = (LAS int*)(F.lds + 75776);
    LAS int* lbase = (LAS int*)(F.lds + 75776 + 128);
    LAS int* se = (LAS int*)(F.lds + 75776 + 256);
    LAS float* sg = (LAS float*)(F.lds + 75776 + 256 + 4096);
    const int e = F.tid & 31, ds = F.tid >> 5;
    f32x2 wreg[32];
#pragma unroll
    for (int i = 0; i < 32; ++i) { wreg[i].x = F.inp(I_RW)[((size_t)l * D + ds * 64 + 2 * i) * NE + e]; wreg[i].y = F.inp(I_RW)[((size_t)l * D + ds * 64 + 2 * i + 1) * NE + e]; }
    unsigned* cnt = (unsigned*)(F.ctl() + CW_CNT + l * 64 + (shadow ? 512 : 0));
    int* ltok = shadow ? (int*)(F.ws + WS_HMOE) : F.list_tok(); int* ldst = ltok + (size_t)NE * CAP; float* lgate = (float*)(ldst + (size_t)NE * CAP);
    __syncthreads();
    if (F.tid < 32) lcnt[F.tid] = 0;
    for (int i = F.tid; i < 3 * D; i += NTHR) { const int r = i >> 10, c = i & (D - 1); const float* mo = F.mods() + ((size_t)l * 3 + r) * 6 * D;
        AC[i] = F.inp(I_N2G)[l * D + c] * (1.0f + mo[4 * D + c]); BC[i] = mo[3 * D + c]; }
    f32x4 v[4]; u32x2 tv[4];
#define RT_LOAD(mm) do { const int m_ = (mm); \
        if (l == 0) { const float* s_ = m_ < ML ? F.inp(I_X) + (size_t)m_ * D : F.inp(I_CTX) + (size_t)(m_ - ML) * D; \
            _Pragma("unroll") for (int j = 0; j < 4; ++j) v[j] = *(const f32x4*)(s_ + 4 * F.lane + 256 * j); } \
        else { _Pragma("unroll") for (int j = 0; j < 4; ++j) { const u32x2 w_ = *(const u32x2*)(F.XL() + (size_t)m_ * D + 4 * F.lane + 256 * j); \
            v[j] = (f32x4){__uint_as_float(w_.x << 16), __uint_as_float(w_.x & 0xffff0000u), __uint_as_float(w_.y << 16), __uint_as_float(w_.y & 0xffff0000u)}; } } \
        _Pragma("unroll") for (int j = 0; j < 4; ++j) tv[j] = *(const u32x2*)(F.P() + (size_t)m_ * D + 4 * F.lane + 256 * j); } while (0)
    { const int m = F.bid * 8 + F.wave; if (m < Mq) RT_LOAD(m); }
    __syncthreads();
    int ti = 0;
    for (int base = F.bid * 8; base < Mq; base += F.G * 8, ++ti) {
        { const int m = base + F.wave;
          const int mr = mod_row(m);
          float ss = 0.f;
#pragma unroll
          for (int j = 0; j < 4; ++j) { v[j].x += __uint_as_float(tv[j].x << 16); v[j].y += __uint_as_float(tv[j].x & 0xffff0000u); v[j].z += __uint_as_float(tv[j].y << 16); v[j].w += __uint_as_float(tv[j].y & 0xffff0000u);
              { u32x2 xw; xw.x = pk2(v[j].x, v[j].y); xw.y = pk2(v[j].z, v[j].w); *(u32x2*)(F.XL() + (size_t)m * D + 4 * F.lane + 256 * j) = xw; }
              ss += (v[j].x * v[j].x + v[j].y * v[j].y) + (v[j].z * v[j].z + v[j].w * v[j].w); }
          const float rstd = __builtin_amdgcn_rsqf(wave_sum(ss, F.lane) * (1.0f / D) + EPS);
#pragma unroll
          for (int j = 0; j < 4; ++j) { const int col = 4 * F.lane + 256 * j;
              const f32x4 ga = *(const LAS f32x4*)(AC + mr * D + col), sh = *(const LAS f32x4*)(BC + mr * D + col);
              const f32x4 h = v[j] * rstd * ga + sh;
              if (MOE_FP8) *(unsigned*)((unsigned char*)F.H1() + (size_t)m * D + col) = pk_fp8x4(h.x, h.y, h.z, h.w);
              else { u32x2 w; w.x = pk2(h.x, h.y); w.y = pk2(h.z, h.w); *(u32x2*)(F.H1() + (size_t)m * D + col) = w; }
              *(LAS f32x4*)(hs + F.wave * D + col) = h; }
          const int mn = m + F.G * 8;
          if (mn < Mq) RT_LOAD(mn); }
        __syncthreads();
#pragma unroll
        for (int rr = 0; rr < 8; ++rr) { f32x2 a2 = {0.f, 0.f};
#pragma unroll
            for (int i = 0; i < 16; ++i) { const f32x4 hv = *(const LAS f32x4*)(hs + rr * D + ds * 64 + 4 * i);
                a2 += (f32x2){hv.x, hv.y} * wreg[2 * i]; a2 += (f32x2){hv.z, hv.w} * wreg[2 * i + 1]; }
            part[(rr * 16 + ds) * 32 + e] = a2.x + a2.y; }
        __syncthreads();
        if (F.tid < 256) {
            const int rr = F.tid >> 5; float s = F.inp(I_RB)[l * NE + e];
#pragma unroll
            for (int q = 0; q < 16; ++q) s += part[(rr * 16 + q) * 32 + e];
            lg[rr * 32 + e] = s;
            asm volatile("s_waitcnt lgkmcnt(0)" ::: "memory");
            int rank = 0;
#pragma unroll
            for (int q = 0; q < 8; ++q) { const f32x4 x = *(const LAS f32x4*)(lg + rr * 32 + 4 * q);
                rank += (x.x > s || (x.x == s && 4 * q + 0 < e)) ? 1 : 0; rank += (x.y > s || (x.y == s && 4 * q + 1 < e)) ? 1 : 0;
                rank += (x.z > s || (x.z == s && 4 * q + 2 < e)) ? 1 : 0; rank += (x.w > s || (x.w == s && 4 * q + 3 < e)) ? 1 : 0; }
            if (rank < 4) { tvi[(rr * 4 + rank) * 2] = s; tvi[(rr * 4 + rank) * 2 + 1] = __int_as_float(e); }
            asm volatile("s_waitcnt lgkmcnt(0)" ::: "memory");
            const f32x4 c01 = *(const LAS f32x4*)(tvi + rr * 8), c23 = *(const LAS f32x4*)(tvi + rr * 8 + 4);
            const float p1 = __expf(c01.z - c01.x), p2 = __expf(c23.x - c01.x), p3 = __expf(c23.z - c01.x), den = 1.0f + p1 + p2 + p3;
            if (e < 4) { const float myv = e == 0 ? 1.0f : (e == 1 ? p1 : (e == 2 ? p2 : p3)); const int mye = __float_as_int(e == 0 ? c01.y : (e == 1 ? c01.w : (e == 2 ? c23.y : c23.w)));
                const int lp = __hip_atomic_fetch_add(lcnt + mye, 1, __ATOMIC_RELAXED, __HIP_MEMORY_SCOPE_WORKGROUP);
                se[ti * 32 + rr * 4 + e] = mye | (lp << 8); sg[ti * 32 + rr * 4 + e] = myv * frcp(den); }
        }
        __syncthreads();
    }
    if (F.tid < 32) lbase[F.tid] = (int)atomicAdd(cnt + F.tid, (unsigned)lcnt[F.tid]);
    __syncthreads();
    for (int i = F.tid; i < ti * 32; i += NTHR) {
        const int w = se[i], ee = w & 255, lp = w >> 8, m = F.bid * 8 + (i >> 5) * (F.G * 8) + ((i & 31) >> 2), j = i & 3;
        const size_t pos = (size_t)ee * CAP + lbase[ee] + lp;
        ltok[pos] = m; ldst[pos] = m * 4 + j; lgate[pos] = sg[i];
    }
}

#undef RT_LOAD
__device__ __forceinline__ void ph_moe_gu_naive(Ctx& F, int l) {
    const int gw = F.bid * NWAVES + F.wave, NGW = F.G * NWAVES, r = F.lane & 31, h = F.lane >> 5;
    const unsigned* cnt = (const unsigned*)(F.ctl() + CW_CNT + l * 64);
    int id0 = 0, ts256 = 0;
    for (int e = 0; e < NE; ++e) {
        const int ce = (int)__hip_atomic_load(cnt + e, __ATOMIC_RELAXED, __HIP_MEMORY_SCOPE_AGENT);
        const int nrt = (ce + 63) / 64, n = nrt * 32;
        const bf16* Bt = F.WguT() + ((size_t)l * NE + e) * 2 * FF * D;
        const float* bg = F.inp(I_BGU) + ((size_t)l * NE + e) * 2 * FF;
        int id = id0 + ((gw - id0 % NGW) + NGW) % NGW;
        for (; id < id0 + n; id += NGW) {
            const int rt = (id - id0) / 32, ft = (id - id0) % 32, pos0 = rt * 64, ff0 = ft * 32;
            const int p0 = pos0 + r, p1 = pos0 + 32 + r;
            const int t0 = p0 < ce ? F.list_tok()[(size_t)e * CAP + p0] : 0, t1 = p1 < ce ? F.list_tok()[(size_t)e * CAP + p1] : 0;
            const int ng = (ff0 >> 7) * 256 + (ff0 & 127) + r;
            f32x16 acc[2][2];
            sg_kloop(acc, F.H1() + (size_t)t0 * D + 8 * h, F.H1() + (size_t)t1 * D + 8 * h, Bt + (size_t)ng * D + 8 * h, Bt + (size_t)(ng + 128) * D + 8 * h, D);
            const float bgate = bg[ff0 + r], bup = bg[FF + ff0 + r];
#pragma unroll
            for (int mt = 0; mt < 2; ++mt)
#pragma unroll
                for (int q = 0; q < 16; ++q) {
                    const int pos = pos0 + 32 * mt + crow(q, h);
                    if (pos < ce) {
                        const float gate = fminf(acc[mt][0][q] + bgate, 7.0f), up = fminf(fmaxf(acc[mt][1][q] + bup, -7.0f), 7.0f);
                        const float glu = gate * sigmoidf_(1.702f * gate);
                        F.HMOE()[((size_t)ts256 * 256 + pos) * FF + ff0 + r] = (bf16)f2bf((up + 1.0f) * glu);
                    }
                }
        }
        id0 += n; ts256 += (ce + 255) / 256;
    }
}
__device__ __forceinline__ void ph_moe_down_naive(Ctx& F, int l) {
    const int gw = F.bid * NWAVES + F.wave, NGW = F.G * NWAVES, r = F.lane & 31, h = F.lane >> 5;
    const unsigned* cnt = (const unsigned*)(F.ctl() + CW_CNT + l * 64);
    int id0 = 0, ts256 = 0;
    for (int e = 0; e < NE; ++e) {
        const int ce = (int)__hip_atomic_load(cnt + e, __ATOMIC_RELAXED, __HIP_MEMORY_SCOPE_AGENT);
        const int nrt = (ce + 63) / 64, n = nrt * 16;
        const bf16* Bt = F.WdT() + ((size_t)l * NE + e) * D * FF;
        const float* bd = F.inp(I_BD) + ((size_t)l * NE + e) * D;
        int id = id0 + ((gw - id0 % NGW) + NGW) % NGW;
        for (; id < id0 + n; id += NGW) {
            const int rt = (id - id0) / 16, ct = (id - id0) % 16, pos0 = rt * 64, c0 = ct * 64;
            const bf16* A = F.HMOE() + ((size_t)ts256 * 256 + pos0) * FF;
            f32x16 acc[2][2];
            sg_kloop(acc, A + (size_t)r * FF + 8 * h, A + (size_t)(32 + r) * FF + 8 * h, Bt + (size_t)(c0 + r) * FF + 8 * h, Bt + (size_t)(c0 + 32 + r) * FF + 8 * h, FF);
#pragma unroll
            for (int mt = 0; mt < 2; ++mt)
#pragma unroll
                for (int q = 0; q < 16; ++q) {
                    const int pos = pos0 + 32 * mt + crow(q, h);
                    if (pos < ce) {
                        const int dst = F.list_dst()[(size_t)e * CAP + pos]; const float g = F.list_gate()[(size_t)e * CAP + pos];
#pragma unroll
                        for (int nt = 0; nt < 2; ++nt) { const int c = c0 + 32 * nt + r;
                            F.Y2()[(size_t)dst * D + c] = (bf16)f2bf(g * (acc[mt][nt][q] + bd[c])); }
                    }
                }
        }
        id0 += n; ts256 += (ce + 255) / 256;
    }
}

namespace pg8 {
constexpr int BM = 256, BK = 64, HALF = 128, HTB = HALF * BK * 2, STAGE_BYTES = 8 * HTB, NXCD = 8, WGM = 8;
__device__ __forceinline__ int lds_byte(int r, int c) { const int st = (r >> 4) * 2 + (c >> 5), rr = r & 15, cc = c & 31, ob = rr * 64 + cc * 2; return st * 1024 + (ob ^ (((ob >> 9) & 1) << 5)); }
__device__ __forceinline__ void stage_rc(int b, int& R, int& C) { const int st = b / 1024, sb = b % 1024, swz = sb ^ (((sb >> 9) & 1) << 5); R = (st >> 1) * 16 + swz / 64; C = (st & 1) * 32 + (swz % 64) / 2; }
__device__ __forceinline__ int perm32(int rho) { const int n = rho >> 4, i = rho & 15; return 8 * (i >> 2) + 4 * n + (i & 3); }
struct Unit { int pm, pn, e, pos0, ce; };
struct StaticOrder {
    int nM, nN, nwg, G, c;
    __device__ __forceinline__ void init(int M, int N, int G_, int c_) { nM = M / BM; nN = N / BM; nwg = nM * nN; G = G_; c = c_; }
    __device__ __forceinline__ bool next(int i, Unit& u) const {
        const long L = (long)i * G + c; if (L >= nwg) return false;
        int wgid = (int)L; { const int q = nwg / NXCD, r = nwg % NXCD, xcd = wgid % NXCD, off = wgid / NXCD; wgid = (xcd < r ? xcd * (q + 1) : r * (q + 1) + (xcd - r) * q) + off; }
        const int nig = WGM * nN, gid = wgid / nig, fm = gid * WGM, gsz = (nM - fm) < WGM ? (nM - fm) : WGM;
        u.pm = fm + ((wgid % nig) % gsz); u.pn = (wgid % nig) / gsz; u.e = 0; u.pos0 = 0; u.ce = 0; return true;
    }
};
__device__ __forceinline__ unsigned cvt_pk_bf16(float lo, float hi) { unsigned r; asm volatile("v_cvt_pk_bf16_f32 %0, %1, %2" : "=v"(r) : "v"(lo), "v"(hi)); return r; }
typedef f32x4 AccT[2][2][4][2];
template <class PB>
__device__ __forceinline__ void gemm_phase(LAS unsigned char* lds, const PB& pb, const int tid) {
    const int wid = __builtin_amdgcn_readfirstlane(tid >> 6), lane = tid & 63, wr = wid >> 2, wc = wid & 3, fr = lane & 15, fq = lane >> 4;
    constexpr int K = PB::K, nt = K / BK;
    unsigned voffB[2];
#pragma unroll
    for (int i = 0; i < 2; ++i) { int R, C; stage_rc(tid * 16 + i * 8192, R, C); const int Rb = PB::PERM ? ((R & ~31) + perm32(R & 31)) : R; voffB[i] = (unsigned)(Rb * K + C) * 2u; }
    constexpr size_t kstep = (size_t)(BK * 2);
    constexpr size_t hstep = (size_t)HALF * K * 2;
    const unsigned ldsw = (unsigned)wid * 1024u;
    const int aoff = lds_byte(wr * 64 + fr, fq * 8), boff = lds_byte(wc * 32 + fr, fq * 8);
#define PG8_SA(b, h) (((b) * 2 + (h)) * HTB)
#define PG8_SB(b, h) ((4 + (b) * 2 + (h)) * HTB)
#define PG8_STAGE(bufoff, gbase, voff) do { _Pragma("unroll") for (int _i = 0; _i < 2; ++_i) \
        __builtin_amdgcn_global_load_lds((const unsigned*)((const char*)(gbase) + (voff)[_i]), (LAS unsigned*)(lds + (bufoff) + ldsw + _i * 8192), 16, 0, 0); } while (0)
#define PG8_LDA(dst, b, h) do { _Pragma("unroll") for (int m = 0; m < 4; ++m) _Pragma("unroll") for (int k = 0; k < 2; ++k) dst[m][k] = *(const LAS bf16x8*)(lds + PG8_SA(b, h) + aoff + m * 2048 + k * 1024); } while (0)
#define PG8_LDB(dst, b, h) do { _Pragma("unroll") for (int n = 0; n < 2; ++n) _Pragma("unroll") for (int k = 0; k < 2; ++k) dst[n][k] = *(const LAS bf16x8*)(lds + PG8_SB(b, h) + boff + n * 2048 + k * 1024); } while (0)
#define PG8_MMA(ai, bj, At, Bt) do { __builtin_amdgcn_s_setprio(1); _Pragma("unroll") for (int m = 0; m < 4; ++m) _Pragma("unroll") for (int n = 0; n < 2; ++n) _Pragma("unroll") for (int k = 0; k < 2; ++k) \
        acc[ai][bj][m][n] = __builtin_amdgcn_mfma_f32_16x16x32_bf16(Bt[n][k], At[m][k], acc[ai][bj][m][n], 0, 0, 0); __builtin_amdgcn_s_setprio(0); } while (0)
#define PG8_WAIT_V(n) asm volatile("s_waitcnt vmcnt(" #n ")" ::: "memory")
#define PG8_WAIT_L(n) asm volatile("s_waitcnt lgkmcnt(" #n ")" ::: "memory")
#define PG8_BAR __builtin_amdgcn_s_barrier()
#define PG8_SCHED __builtin_amdgcn_sched_barrier(0)
    Unit cur, nxt; int ui = 0;
    if (!pb.next(0, cur)) return;
    f32x4 acc[2][2][4][2];
#pragma unroll
    for (int a = 0; a < 2; ++a)
#pragma unroll
        for (int b = 0; b < 2; ++b)
#pragma unroll
            for (int m = 0; m < 4; ++m)
#pragma unroll
                for (int n = 0; n < 2; ++n) acc[a][b][m][n] = (f32x4){0.f, 0.f, 0.f, 0.f};
    bf16x8 At[4][2], B0[2][2], B1[2][2];
    unsigned cv[2][2];
    pb.a_voff(cur, cv, tid);
    const char* cA = pb.a_base(cur); const char* cB = pb.b_base(cur);
    PG8_STAGE(PG8_SB(0, 0), cB, voffB); PG8_STAGE(PG8_SB(0, 1), cB + hstep, voffB); PG8_STAGE(PG8_SA(0, 0), cA, cv[0]); PG8_STAGE(PG8_SA(0, 1), cA, cv[1]);
    if (wr == 1) PG8_BAR;
    PG8_WAIT_V(2); PG8_BAR;
    PG8_STAGE(PG8_SB(1, 0), cB + kstep, voffB); PG8_STAGE(PG8_SA(1, 0), cA + kstep, cv[0]); PG8_STAGE(PG8_SB(1, 1), cB + hstep + kstep, voffB);
    PG8_WAIT_V(6); PG8_BAR;
    for (;;) {
        const bool has_next = pb.next(ui + 1, nxt);
        const char* nA = has_next ? pb.a_base(nxt) : cA; const char* nB = has_next ? pb.b_base(nxt) : cB;
        for (int t = 0; t < nt; t += 2) {
            const bool last = (t == nt - 2);
            const char* a1 = cA + (size_t)(t + 1) * kstep;
            const char* a2 = last ? nA : cA + (size_t)(t + 2) * kstep; const char* b2 = last ? nB : cB + (size_t)(t + 2) * kstep;
            const char* a3 = a2 + kstep; const char* b3 = b2 + kstep;
            if (PB::GATHER && t == nt - 4 && has_next) pb.tok_prefetch(nxt, lds, tid, wid);
            if (PB::GATHER && last && has_next) pb.a_voff_half_lds(cv[0], lds, tid, wid, 0);
            PG8_LDB(B0, 0, 0); PG8_LDB(B1, 0, 1); PG8_SCHED; PG8_LDA(At, 0, 0); PG8_STAGE(PG8_SA(1, 1), a1, cv[1]);
            if (PB::GATHER && last && has_next) pb.a_voff_half_lds(cv[1], lds, tid, wid, 1);
            PG8_WAIT_V(8); PG8_WAIT_L(0); PG8_BAR; PG8_MMA(0, 0, At, B0); PG8_MMA(0, 1, At, B1); PG8_BAR; PG8_SCHED;
            PG8_LDA(At, 0, 1); PG8_STAGE(PG8_SB(0, 0), b2, voffB); PG8_STAGE(PG8_SB(0, 1), b2 + hstep, voffB); PG8_STAGE(PG8_SA(0, 0), a2, cv[0]);
            PG8_WAIT_V(8); PG8_WAIT_L(0); PG8_BAR; PG8_MMA(1, 0, At, B0); PG8_MMA(1, 1, At, B1); PG8_BAR; PG8_SCHED;
            PG8_LDB(B0, 1, 0); PG8_LDB(B1, 1, 1); PG8_SCHED; PG8_LDA(At, 1, 0); PG8_STAGE(PG8_SA(0, 1), a2, cv[1]);
            PG8_WAIT_V(8); PG8_WAIT_L(0); PG8_BAR; PG8_MMA(0, 0, At, B0); PG8_MMA(0, 1, At, B1); PG8_BAR; PG8_SCHED;
            PG8_LDA(At, 1, 1); PG8_STAGE(PG8_SB(1, 0), b3, voffB); PG8_STAGE(PG8_SB(1, 1), b3 + hstep, voffB); PG8_STAGE(PG8_SA(1, 0), a3, cv[0]);
            PG8_WAIT_V(8); PG8_WAIT_L(0); PG8_BAR; PG8_MMA(1, 0, At, B0); PG8_MMA(1, 1, At, B1); PG8_BAR; PG8_SCHED;
        }
        if (wr == 0) PG8_BAR;
        pb.epi(acc, cur, wr, wc, fr, fq);
        if (!has_next) break;
#pragma unroll
        for (int a = 0; a < 2; ++a)
#pragma unroll
            for (int b = 0; b < 2; ++b)
#pragma unroll
                for (int m = 0; m < 4; ++m)
#pragma unroll
                    for (int n = 0; n < 2; ++n) acc[a][b][m][n] = (f32x4){0.f, 0.f, 0.f, 0.f};
        cur = nxt; cA = nA; cB = nB; ++ui;
        if (wr == 1) PG8_BAR;
    }
    PG8_WAIT_V(0);
    PG8_BAR;
#undef PG8_SA
#undef PG8_SB
#undef PG8_STAGE
#undef PG8_LDA
#undef PG8_LDB
#undef PG8_MMA
#undef PG8_WAIT_V
#undef PG8_WAIT_L
#undef PG8_BAR
#undef PG8_SCHED
}
typedef int v4i_t __attribute__((ext_vector_type(4)));
typedef int v8i_t __attribute__((ext_vector_type(8)));
template <class PB>
__device__ __forceinline__ void gemm_phase8(LAS unsigned char* lds, const PB& pb, const int tid) {
    const int wid = __builtin_amdgcn_readfirstlane(tid >> 6), lane = tid & 63, wr = wid >> 2, wc = wid & 3, fr = lane & 15, fq = lane >> 4;
    constexpr int K = PB::K  , nt = K / 128;
    unsigned vb0, va0;
    { int R, C; stage_rc(tid * 16, R, C); const int Rb = PB::PERM ? ((R & ~31) + perm32(R & 31)) : R; vb0 = (unsigned)(Rb * K + C * 2); va0 = (unsigned)(R * K + C * 2); }
    constexpr size_t kstep = (size_t)(BK * 2);
    constexpr size_t hstep = (size_t)HALF * K;
    const unsigned ldsw = (unsigned)wid * 1024u;
    const int aoff = lds_byte(wr * 64 + fr, fq * 8), boff = lds_byte(wc * 32 + fr, fq * 8);
#define PG8_SA(b, h) (((b) * 2 + (h)) * HTB)
#define PG8_SB(b, h) ((4 + (b) * 2 + (h)) * HTB)
#define PG8_STAGE_B(bufoff, gbase) do { _Pragma("unroll") for (int _i = 0; _i < 2; ++_i) \
        __builtin_amdgcn_global_load_lds((const unsigned*)((const char*)(gbase) + (size_t)(_i * 64) * K + vb0), (LAS unsigned*)(lds + (bufoff) + ldsw + _i * 8192), 16, 0, 0); } while (0)
#define PG8_STAGE_A(bufoff, gbase, h) do { _Pragma("unroll") for (int _i = 0; _i < 2; ++_i) { \
        const char* p_ = PB::GATHER ? (const char*)(gbase) + cv[h][_i] : (const char*)(gbase) + (size_t)((h) * 128 + _i * 64) * K + va0; \
        __builtin_amdgcn_global_load_lds((const unsigned*)p_, (LAS unsigned*)(lds + (bufoff) + ldsw + _i * 8192), 16, 0, 0); } } while (0)
#define PG8_LDA(dst, b, h) do { _Pragma("unroll") for (int m = 0; m < 4; ++m) { const v4i_t lo_ = *(const LAS v4i_t*)(lds + PG8_SA(b, h) + aoff + m * 2048), hi_ = *(const LAS v4i_t*)(lds + PG8_SA(b, h) + aoff + m * 2048 + 1024); dst[m] = __builtin_shufflevector(lo_, hi_, 0, 1, 2, 3, 4, 5, 6, 7); } } while (0)
#define PG8_LDB(dst, b, h) do { _Pragma("unroll") for (int n = 0; n < 2; ++n) { const v4i_t lo_ = *(const LAS v4i_t*)(lds + PG8_SB(b, h) + boff + n * 2048), hi_ = *(const LAS v4i_t*)(lds + PG8_SB(b, h) + boff + n * 2048 + 1024); dst[n] = __builtin_shufflevector(lo_, hi_, 0, 1, 2, 3, 4, 5, 6, 7); } } while (0)
#define PG8_MMA(ai, bj, At, Bt) do { __builtin_amdgcn_s_setprio(1); _Pragma("unroll") for (int m = 0; m < 4; ++m) _Pragma("unroll") for (int n = 0; n < 2; ++n) \
        asm volatile("v_mfma_scale_f32_16x16x128_f8f6f4 %0, %1, %2, %0, %3, %3 op_sel_hi:[0,0,0]" : "+v"(acc[ai][bj][m][n]) : "v"(Bt[n]), "v"(At[m]), "v"(sc1)); \
        __builtin_amdgcn_s_setprio(0); } while (0)
#define PG8_WAIT_V(n) asm volatile("s_waitcnt vmcnt(" #n ")" ::: "memory")
#define PG8_WAIT_L(n) asm volatile("s_waitcnt lgkmcnt(" #n ")" ::: "memory")
#define PG8_BAR __builtin_amdgcn_s_barrier()
#define PG8_SCHED __builtin_amdgcn_sched_barrier(0)
    Unit cur, nxt; int ui = 0;
    if (!pb.next(0, cur)) return;
    f32x4 acc[2][2][4][2];
#pragma unroll
    for (int a = 0; a < 2; ++a)
#pragma unroll
        for (int b = 0; b < 2; ++b)
#pragma unroll
            for (int m = 0; m < 4; ++m)
#pragma unroll
                for (int n = 0; n < 2; ++n) acc[a][b][m][n] = (f32x4){0.f, 0.f, 0.f, 0.f};
    v8i_t At[4], B0[2], B1[2];
    int sc1 = 0x7f7f7f7f; asm volatile("" : "+v"(sc1));
    unsigned cv[2][2];
    if (PB::GATHER) pb.a_voff(cur, cv, tid); else { cv[0][0] = cv[0][1] = cv[1][0] = cv[1][1] = 0u; }
    const char* cA = pb.a_base(cur); const char* cB = pb.b_base(cur);
    PG8_STAGE_B(PG8_SB(0, 0), cB); PG8_STAGE_B(PG8_SB(0, 1), cB + hstep); PG8_STAGE_A(PG8_SA(0, 0), cA, 0); PG8_STAGE_A(PG8_SA(0, 1), cA, 1);
    if (wr == 1) PG8_BAR;
    PG8_WAIT_V(2); PG8_BAR;
    PG8_STAGE_B(PG8_SB(1, 0), cB + kstep); PG8_STAGE_A(PG8_SA(1, 0), cA + kstep, 0); PG8_STAGE_B(PG8_SB(1, 1), cB + hstep + kstep);
    PG8_WAIT_V(6); PG8_BAR;
    for (;;) {
        const bool has_next = pb.next(ui + 1, nxt);
        const char* nA = has_next ? pb.a_base(nxt) : cA; const char* nB = has_next ? pb.b_base(nxt) : cB;
#pragma unroll 1
        for (int t = 0; t < nt; t += 2) {
            const bool last = (t == nt - 2);
            const char* a1 = cA + (size_t)(t + 1) * kstep;
            const char* a2 = last ? nA : cA + (size_t)(t + 2) * kstep; const char* b2 = last ? nB : cB + (size_t)(t + 2) * kstep;
            const char* a3 = a2 + kstep; const char* b3 = b2 + kstep;
            if (PB::GATHER && t == nt - 4 && has_next) pb.tok_prefetch(nxt, lds, tid, wid);
            if (PB::GATHER && last && has_next) pb.a_voff_half_lds(cv[0], lds, tid, wid, 0);
            PG8_LDB(B0, 0, 0); PG8_LDB(B1, 0, 1); PG8_SCHED; PG8_LDA(At, 0, 0); PG8_STAGE_A(PG8_SA(1, 1), a1, 1);
            if (PB::GATHER && last && has_next) pb.a_voff_half_lds(cv[1], lds, tid, wid, 1);
            PG8_WAIT_V(8); PG8_WAIT_L(0); PG8_BAR; PG8_MMA(0, 0, At, B0); PG8_MMA(0, 1, At, B1); PG8_BAR; PG8_SCHED;
            PG8_LDA(At, 0, 1); PG8_STAGE_B(PG8_SB(0, 0), b2); PG8_STAGE_B(PG8_SB(0, 1), b2 + hstep); PG8_STAGE_A(PG8_SA(0, 0), a2, 0);
            PG8_WAIT_V(8); PG8_WAIT_L(0); PG8_BAR; PG8_MMA(1, 0, At, B0); PG8_MMA(1, 1, At, B1); PG8_BAR; PG8_SCHED;
            PG8_LDB(B0, 1, 0); PG8_LDB(B1, 1, 1); PG8_SCHED; PG8_LDA(At, 1, 0); PG8_STAGE_A(PG8_SA(0, 1), a2, 1);
            PG8_WAIT_V(8); PG8_WAIT_L(0); PG8_BAR; PG8_MMA(0, 0, At, B0); PG8_MMA(0, 1, At, B1); PG8_BAR; PG8_SCHED;
            PG8_LDA(At, 1, 1); PG8_STAGE_B(PG8_SB(1, 0), b3); PG8_STAGE_B(PG8_SB(1, 1), b3 + hstep); PG8_STAGE_A(PG8_SA(1, 0), a3, 0);
            PG8_WAIT_V(8); PG8_WAIT_L(0); PG8_BAR; PG8_MMA(1, 0, At, B0); PG8_MMA(1, 1, At, B1); PG8_BAR; PG8_SCHED;
        }
        if (wr == 0) PG8_BAR;
        asm volatile("s_nop 15\n\ts_nop 15" ::: "memory");
        { int fr_ = fr, fq_ = fq; asm volatile("" : "+v"(fr_), "+v"(fq_));
          pb.epi(acc, cur, wr, wc, fr_, fq_); }
        if (!has_next) break;
#pragma unroll
        for (int a = 0; a < 2; ++a)
#pragma unroll
            for (int b = 0; b < 2; ++b)
#pragma unroll
                for (int m = 0; m < 4; ++m)
#pragma unroll
                    for (int n = 0; n < 2; ++n) acc[a][b][m][n] = (f32x4){0.f, 0.f, 0.f, 0.f};
        cur = nxt; cA = nA; cB = nB; ++ui;
        if (wr == 1) PG8_BAR;
    }
    PG8_WAIT_V(0);
    PG8_BAR;
#undef PG8_SA
#undef PG8_SB
#undef PG8_STAGE_A
#undef PG8_STAGE_B
#undef PG8_LDA
#undef PG8_LDB
#undef PG8_MMA
#undef PG8_WAIT_V
#undef PG8_WAIT_L
#undef PG8_BAR
#undef PG8_SCHED
}
__device__ __forceinline__ void voff_contig8(unsigned (&v)[2][2], int tid, int KB) {
#pragma unroll
    for (int i = 0; i < 2; ++i) { int R, C; stage_rc(tid * 16 + i * 8192, R, C); v[0][i] = (unsigned)(R * KB + C * 2); v[1][i] = (unsigned)((R + HALF) * KB + C * 2); }
}
__device__ __forceinline__ void voff_contig(unsigned (&v)[2][2], int tid, int K) {
#pragma unroll
    for (int i = 0; i < 2; ++i) { int R, C; stage_rc(tid * 16 + i * 8192, R, C); v[0][i] = (unsigned)(R * K + C) * 2u; v[1][i] = (unsigned)((R + HALF) * K + C) * 2u; }
}
}

struct PbInproj {
    static constexpr int K = D; static constexpr bool PERM = true, GATHER = false;
    const bf16* A; const bf16* Bt; bf16* P; bf16* Vt; const f32x2* rope; pg8::StaticOrder S;
    __device__ __forceinline__ bool next(int i, pg8::Unit& u) const { return S.next(i, u); }
    __device__ __forceinline__ const char* a_base(const pg8::Unit& u) const { return (const char*)A + (size_t)u.pm * 256 * K * 2; }
    __device__ __forceinline__ const char* b_base(const pg8::Unit& u) const { return (const char*)Bt + (size_t)u.pn * 256 * K * 2; }
    __device__ __forceinline__ void a_voff(const pg8::Unit&, unsigned (&v)[2][2], int tid) const { pg8::voff_contig(v, tid, K); }
    __device__ __forceinline__ void tok_prefetch(const pg8::Unit&, LAS unsigned char*, int, int) const {}
    __device__ __forceinline__ void a_voff_half_lds(unsigned (&)[2], LAS unsigned char*, int, int, int) const {}
    __device__ __forceinline__ void epi(const pg8::AccT& acc, const pg8::Unit& u, int wr, int wc, int fr, int fq) const {
        const int row0 = u.pm * 256 + wr * 64 + fr; const bool lat = row0 < ML;
#pragma unroll
        for (int ai = 0; ai < 2; ++ai)
#pragma unroll
            for (int m = 0; m < 4; ++m) {
                const int row = row0 + ai * 128 + m * 16; const int t = row & (SEQ - 1);
#pragma unroll
                for (int bj = 0; bj < 2; ++bj) {
                    const int c0 = u.pn * 256 + bj * 128 + wc * 32 + 8 * fq;
                    f32x4 v0 = acc[ai][bj][m][0], v1 = acc[ai][bj][m][1];
                    if (c0 < C_V) {
                        if (lat) {
                            const int pr0 = (c0 & 63) >> 1, p = pr0 >> 4, f0 = pr0 & 15, pos = p ? (t & 63) : (t >> 6);
                            const f32x4 ca = *(const f32x4*)(rope + pos * 16 + f0), cb = *(const f32x4*)(rope + pos * 16 + f0 + 2);
                            const f32x4 w0 = {v0.x * ca.x - v0.y * ca.y, v0.x * ca.y + v0.y * ca.x, v0.z * ca.z - v0.w * ca.w, v0.z * ca.w + v0.w * ca.z};
                            const f32x4 w1 = {v1.x * cb.x - v1.y * cb.y, v1.x * cb.y + v1.y * cb.x, v1.z * cb.z - v1.w * cb.w, v1.z * cb.w + v1.w * cb.z};
                            v0 = w0; v1 = w1;
                        }
                        if (c0 < C_K) { v0 *= QSCALE; v1 *= QSCALE; }
                    }
                    u32x4 w; w.x = pg8::cvt_pk_bf16(v0.x, v0.y); w.y = pg8::cvt_pk_bf16(v0.z, v0.w); w.z = pg8::cvt_pk_bf16(v1.x, v1.y); w.w = pg8::cvt_pk_bf16(v1.z, v1.w);
                    *(u32x4*)(P + (size_t)row * INW + c0) = w;
                    if (c0 >= C_V && c0 < C_LX) {
                        const size_t vi = vt_index(row, c0 - C_V); const size_t st = row < ML ? SEQ : CTXL;
                        Vt[vi] = (bf16)(w.x & 0xffffu); Vt[vi + st] = (bf16)(w.x >> 16); Vt[vi + 2 * st] = (bf16)(w.y & 0xffffu); Vt[vi + 3 * st] = (bf16)(w.y >> 16);
                        Vt[vi + 4 * st] = (bf16)(w.z & 0xffffu); Vt[vi + 5 * st] = (bf16)(w.z >> 16); Vt[vi + 6 * st] = (bf16)(w.w & 0xffffu); Vt[vi + 7 * st] = (bf16)(w.w >> 16);
                    }
                }
            }
    }
};
struct PbOutproj {
    static constexpr int K = D; static constexpr bool PERM = true, GATHER = false;
    const bf16* A; const bf16* Bt; bf16* TMP; const float* mods_l; pg8::StaticOrder S;
    __device__ __forceinline__ bool next(int i, pg8::Unit& u) const { return S.next(i, u); }
    __device__ __forceinline__ const char* a_base(const pg8::Unit& u) const { return (const char*)A + (size_t)u.pm * 256 * K * 2; }
    __device__ __forceinline__ const char* b_base(const pg8::Unit& u) const { return (const char*)Bt + (size_t)u.pn * 256 * K * 2; }
    __device__ __forceinline__ void a_voff(const pg8::Unit&, unsigned (&v)[2][2], int tid) const { pg8::voff_contig(v, tid, K); }
    __device__ __forceinline__ void tok_prefetch(const pg8::Unit&, LAS unsigned char*, int, int) const {}
    __device__ __forceinline__ void a_voff_half_lds(unsigned (&)[2], LAS unsigned char*, int, int, int) const {}
    __device__ __forceinline__ void epi(const pg8::AccT& acc, const pg8::Unit& u, int wr, int wc, int fr, int fq) const {
        const int row0 = u.pm * 256 + wr * 64 + fr;
        const float* g2 = mods_l + (size_t)mod_row(u.pm * 256) * 6 * D + 2 * D;
        f32x4 gv[2][2];
#pragma unroll
        for (int bj = 0; bj < 2; ++bj) { const int c0 = u.pn * 256 + bj * 128 + wc * 32 + 8 * fq; gv[bj][0] = *(const f32x4*)(g2 + c0); gv[bj][1] = *(const f32x4*)(g2 + c0 + 4); }
#pragma unroll
        for (int ai = 0; ai < 2; ++ai)
#pragma unroll
            for (int m = 0; m < 4; ++m) { bf16* rowp = TMP + (size_t)(row0 + ai * 128 + m * 16) * D;
#pragma unroll
                for (int bj = 0; bj < 2; ++bj) { const int c0 = u.pn * 256 + bj * 128 + wc * 32 + 8 * fq;
                    const f32x4 v0 = gv[bj][0] * acc[ai][bj][m][0], v1 = gv[bj][1] * acc[ai][bj][m][1];
                    u32x4 w; w.x = pg8::cvt_pk_bf16(v0.x, v0.y); w.y = pg8::cvt_pk_bf16(v0.z, v0.w); w.z = pg8::cvt_pk_bf16(v1.x, v1.y); w.w = pg8::cvt_pk_bf16(v1.z, v1.w);
                    *(u32x4*)(rowp + c0) = w; } }
    }
};
constexpr int TOK_LDS = 131072 + 4096;
constexpr int MOE_LDS = 131072;
__device__ __forceinline__ int moe_setup(Ctx& F, int l) {
    LAS int* cntL = (LAS int*)(F.lds + MOE_LDS); LAS int* tst = (LAS int*)(F.lds + MOE_LDS + 256); LAS unsigned short* te = (LAS unsigned short*)(F.lds + MOE_LDS + 512);
    const unsigned* cnt = (const unsigned*)(F.ctl() + CW_CNT + l * 64);
    __syncthreads();
    if (F.tid < NE) cntL[F.tid] = (int)__hip_atomic_load(cnt + F.tid, __ATOMIC_RELAXED, __HIP_MEMORY_SCOPE_AGENT);
    __syncthreads();
    if (F.tid == 0) { int s = 0; for (int e = 0; e < NE; ++e) { tst[e] = s; s += (cntL[e] + 255) >> 8; } tst[NE] = s; }
    __syncthreads();
    const int T = tst[NE];
    for (int i = F.tid; i < T; i += NTHR) { int e = 0; for (int q = 1; q < NE; ++q) e = (tst[q] <= i) ? q : e; te[i] = (unsigned short)e; }
    __syncthreads();
    return T;
}
struct MoeOrder {
    int t0, nun, rank, nper, npn; const LAS unsigned short* te; const LAS int* tst; const LAS int* cntl;
    __device__ __forceinline__ void init(const Ctx& F, int T, int npn_) {
        const int x = F.bid & 7; nper = F.G >> 3; rank = F.bid >> 3; npn = npn_;
        t0 = (x * T) >> 3; const int t1 = ((x + 1) * T) >> 3; nun = (t1 - t0) * npn;
        te = (const LAS unsigned short*)(F.lds + MOE_LDS + 512); tst = (const LAS int*)(F.lds + MOE_LDS + 256); cntl = (const LAS int*)(F.lds + MOE_LDS);
    }
    __device__ __forceinline__ bool next(int i, pg8::Unit& u) const {
        const int x = rank + i * nper; if (x >= nun) return false;
        const int rt = t0 + x / npn; u.pm = rt; u.pn = x % npn; u.e = __builtin_amdgcn_readfirstlane((int)te[rt]); u.pos0 = (rt - __builtin_amdgcn_readfirstlane(tst[u.e])) * 256; u.ce = __builtin_amdgcn_readfirstlane(cntl[u.e]); return true;
    }
};
struct PbGu {
    static constexpr int K = D; static constexpr bool PERM = true, GATHER = true;
    const bf16* A; const bf16* Bt_l; bf16* H; const float* bgu_l; const int* list_tok; MoeOrder S; const LAS int* cntL;
    __device__ __forceinline__ bool next(int i, pg8::Unit& u) const { return S.next(i, u); }
    __device__ __forceinline__ const char* a_base(const pg8::Unit&) const { return (const char*)A; }
    __device__ __forceinline__ const char* b_base(const pg8::Unit& u) const { return (const char*)Bt_l + ((size_t)u.e * 2 * FF + (size_t)u.pn * 256) * K * 2; }
    __device__ __forceinline__ void a_voff_half(const pg8::Unit& u, unsigned (&v)[2], int tid, int h) const {
        const int ce = u.ce;
#pragma unroll
        for (int i = 0; i < 2; ++i) { int R, C; pg8::stage_rc(tid * 16 + i * 8192, R, C);
            const int pos = u.pos0 + h * 128 + R; const int tok = pos < ce ? list_tok[(size_t)u.e * CAP + pos] : 0; v[i] = (unsigned)(tok * K + C) * 2u; }
    }
    __device__ __forceinline__ void a_voff(const pg8::Unit& u, unsigned (&v)[2][2], int tid) const { a_voff_half(u, v[0], tid, 0); a_voff_half(u, v[1], tid, 1); }
    __device__ __forceinline__ void tok_prefetch(const pg8::Unit& u, LAS unsigned char* lds, int tid, int wid) const {
        const int ce = u.ce;
#pragma unroll
        for (int h = 0; h < 2; ++h)
#pragma unroll
            for (int i = 0; i < 2; ++i) { int R, C; pg8::stage_rc(tid * 16 + i * 8192, R, C);
                const int pos = u.pos0 + h * 128 + R; const int* src = list_tok + (size_t)u.e * CAP + (pos < ce ? pos : 0);
                __builtin_amdgcn_global_load_lds((const unsigned*)src, (LAS unsigned*)(lds + TOK_LDS + ((h * 2 + i) * 8 + wid) * 256), 4, 0, 0); }
    }
    __device__ __forceinline__ void a_voff_half_lds(unsigned (&v)[2], LAS unsigned char* lds, int tid, int wid, int h) const {
#pragma unroll
        for (int i = 0; i < 2; ++i) { int R, C; pg8::stage_rc(tid * 16 + i * 8192, R, C);
            const int tok = *(const LAS int*)(lds + TOK_LDS + ((h * 2 + i) * 8 + wid) * 256 + (tid & 63) * 4); v[i] = (unsigned)(tok * K + C) * 2u; }
    }
    __device__ __forceinline__ void epi(const pg8::AccT& acc, const pg8::Unit& u, int wr, int wc, int fr, int fq) const {
        const int row0 = u.pm * 256 + wr * 64 + fr, ff0 = u.pn * 128 + wc * 32 + 8 * fq;
        const float* bg = bgu_l + (size_t)u.e * 2 * FF;
        const f32x4 bg0 = *(const f32x4*)(bg + ff0), bg1 = *(const f32x4*)(bg + ff0 + 4), bu0 = *(const f32x4*)(bg + FF + ff0), bu1 = *(const f32x4*)(bg + FF + ff0 + 4);
#pragma unroll
        for (int ai = 0; ai < 2; ++ai)
#pragma unroll
            for (int m = 0; m < 4; ++m) {
                float o[8];
#pragma unroll
                for (int n = 0; n < 2; ++n) { const f32x4 g = acc[ai][0][m][n] + (n ? bg1 : bg0), up = acc[ai][1][m][n] + (n ? bu1 : bu0);
#pragma unroll
                    for (int j = 0; j < 4; ++j) { const float gate = fminf(g[j], 7.0f), upc = fminf(fmaxf(up[j], -7.0f), 7.0f); o[4 * n + j] = (upc + 1.0f) * gate * sigmoidf_(1.702f * gate); } }
                u32x4 w; w.x = pg8::cvt_pk_bf16(o[0], o[1]); w.y = pg8::cvt_pk_bf16(o[2], o[3]); w.z = pg8::cvt_pk_bf16(o[4], o[5]); w.w = pg8::cvt_pk_bf16(o[6], o[7]);
                *(u32x4*)(H + (size_t)(row0 + ai * 128 + m * 16) * FF + ff0) = w;
            }
    }
};
struct PbDown {
    static constexpr int K = FF; static constexpr bool PERM = true, GATHER = false;
    const bf16* A; const bf16* Bt_l; bf16* Y2; const float* bd_l; const int* list_dst; const float* list_gate; MoeOrder S; const LAS int* cntL;
    __device__ __forceinline__ bool next(int i, pg8::Unit& u) const { return S.next(i, u); }
    __device__ __forceinline__ const char* a_base(const pg8::Unit& u) const { return (const char*)A + (size_t)u.pm * 256 * K * 2; }
    __device__ __forceinline__ const char* b_base(const pg8::Unit& u) const { return (const char*)Bt_l + ((size_t)u.e * D + (size_t)u.pn * 256) * K * 2; }
    __device__ __forceinline__ void a_voff(const pg8::Unit&, unsigned (&v)[2][2], int tid) const { pg8::voff_contig(v, tid, K); }
    __device__ __forceinline__ void tok_prefetch(const pg8::Unit&, LAS unsigned char*, int, int) const {}
    __device__ __forceinline__ void a_voff_half_lds(unsigned (&)[2], LAS unsigned char*, int, int, int) const {}
    __device__ __forceinline__ void epi(const pg8::AccT& acc, const pg8::Unit& u, int wr, int wc, int fr, int fq) const {
        const int ce = u.ce; const int p0 = u.pos0 + wr * 64 + fr; const float* bd = bd_l + (size_t)u.e * D;
        int dsts[2][4]; float gs[2][4];
#pragma unroll
        for (int ai = 0; ai < 2; ++ai)
#pragma unroll
            for (int m = 0; m < 4; ++m) { const int pos = p0 + ai * 128 + m * 16; const size_t ix = (size_t)u.e * CAP + (pos < ce ? pos : 0); dsts[ai][m] = list_dst[ix]; gs[ai][m] = list_gate[ix]; }
        f32x4 bb[2][2];
#pragma unroll
        for (int bj = 0; bj < 2; ++bj) { const int c0 = u.pn * 256 + bj * 128 + wc * 32 + 8 * fq; bb[bj][0] = *(const f32x4*)(bd + c0); bb[bj][1] = *(const f32x4*)(bd + c0 + 4); }
#pragma unroll
        for (int ai = 0; ai < 2; ++ai)
#pragma unroll
            for (int m = 0; m < 4; ++m) {
                const int pos = p0 + ai * 128 + m * 16;
                {
                    const float g = gs[ai][m]; const size_t drow = pos < ce ? (size_t)dsts[ai][m] : (size_t)(Y2_DUMMY_ROW + (pos & 255));
#pragma unroll
                    for (int bj = 0; bj < 2; ++bj) { const int c0 = u.pn * 256 + bj * 128 + wc * 32 + 8 * fq;
                        const f32x4 v0 = (acc[ai][bj][m][0] + bb[bj][0]) * g, v1 = (acc[ai][bj][m][1] + bb[bj][1]) * g;
                        u32x4 w; w.x = pg8::cvt_pk_bf16(v0.x, v0.y); w.y = pg8::cvt_pk_bf16(v0.z, v0.w); w.z = pg8::cvt_pk_bf16(v1.x, v1.y); w.w = pg8::cvt_pk_bf16(v1.z, v1.w);
                        *(u32x4*)(Y2 + drow * D + c0) = w; }
                }
            }
    }
};
struct PbGu8 {
    static constexpr int K = D; static constexpr bool PERM = true, GATHER = true;
    const unsigned char* A; const unsigned char* Bt_l; unsigned char* H; const float* bgu_l; const int* list_tok; MoeOrder S; const LAS int* cntL;
    __device__ __forceinline__ bool next(int i, pg8::Unit& u) const { return S.next(i, u); }
    __device__ __forceinline__ const char* a_base(const pg8::Unit&) const { return (const char*)A; }
    __device__ __forceinline__ const char* b_base(const pg8::Unit& u) const { return (const char*)Bt_l + ((size_t)u.e * 2 * FF + (size_t)u.pn * 256) * K; }
    __device__ __forceinline__ void a_voff_half(const pg8::Unit& u, unsigned (&v)[2], int tid, int h) const {
        const int ce = u.ce;
#pragma unroll
        for (int i = 0; i < 2; ++i) { int R, C; pg8::stage_rc(tid * 16 + i * 8192, R, C);
            const int pos = u.pos0 + h * 128 + R; const int tok = pos < ce ? list_tok[(size_t)u.e * CAP + pos] : 0; v[i] = (unsigned)(tok * K + C * 2); }
    }
    __device__ __forceinline__ void a_voff(const pg8::Unit& u, unsigned (&v)[2][2], int tid) const { a_voff_half(u, v[0], tid, 0); a_voff_half(u, v[1], tid, 1); }
    __device__ __forceinline__ void tok_prefetch(const pg8::Unit& u, LAS unsigned char* lds, int tid, int wid) const {
        const int ce = u.ce;
#pragma unroll
        for (int h = 0; h < 2; ++h)
#pragma unroll
            for (int i = 0; i < 2; ++i) { int R, C; pg8::stage_rc(tid * 16 + i * 8192, R, C);
                const int pos = u.pos0 + h * 128 + R; const int* src = list_tok + (size_t)u.e * CAP + (pos < ce ? pos : 0);
                __builtin_amdgcn_global_load_lds((const unsigned*)src, (LAS unsigned*)(lds + TOK_LDS + ((h * 2 + i) * 8 + wid) * 256), 4, 0, 0); }
    }
    __device__ __forceinline__ void a_voff_half_lds(unsigned (&v)[2], LAS unsigned char* lds, int tid, int wid, int h) const {
#pragma unroll
        for (int i = 0; i < 2; ++i) { int R, C; pg8::stage_rc(tid * 16 + i * 8192, R, C);
            const int tok = *(const LAS int*)(lds + TOK_LDS + ((h * 2 + i) * 8 + wid) * 256 + (tid & 63) * 4); v[i] = (unsigned)(tok * K + C * 2); }
    }
    __device__ __forceinline__ void epi(const pg8::AccT& acc, const pg8::Unit& u, int wr, int wc, int fr, int fq) const {
        const int row0 = u.pm * 256 + wr * 64 + fr, ff0 = u.pn * 128 + wc * 32 + 8 * fq;
        const float* bg = bgu_l + (size_t)u.e * 2 * FF;
        const f32x4 bg0 = *(const f32x4*)(bg + ff0), bg1 = *(const f32x4*)(bg + ff0 + 4), bu0 = *(const f32x4*)(bg + FF + ff0), bu1 = *(const f32x4*)(bg + FF + ff0 + 4);
#pragma unroll
        for (int ai = 0; ai < 2; ++ai)
#pragma unroll
            for (int m = 0; m < 4; ++m) {
                float o[8];
#pragma unroll
                for (int n = 0; n < 2; ++n) { const f32x4 g = acc[ai][0][m][n] * (1.0f / W8_SCALE) + (n ? bg1 : bg0), up = acc[ai][1][m][n] * (1.0f / W8_SCALE) + (n ? bu1 : bu0);
#pragma unroll
                    for (int j = 0; j < 4; ++j) { const float gate = fminf(g[j], 7.0f), upc = fminf(fmaxf(up[j], -7.0f), 7.0f); o[4 * n + j] = (upc + 1.0f) * gate * sigmoidf_(1.702f * gate); } }
                u32x2 w; w.x = pk_fp8x4(o[0], o[1], o[2], o[3]); w.y = pk_fp8x4(o[4], o[5], o[6], o[7]);
                *(u32x2*)(H + (size_t)(row0 + ai * 128 + m * 16) * FF + ff0) = w;
            }
    }
};
struct PbDown8 {
    static constexpr int K = FF; static constexpr bool PERM = true, GATHER = false;
    const unsigned char* A; const unsigned char* Bt_l; bf16* Y2; const float* bd_l; const int* list_dst; const float* list_gate; MoeOrder S; const LAS int* cntL;
    __device__ __forceinline__ bool next(int i, pg8::Unit& u) const { return S.next(i, u); }
    __device__ __forceinline__ const char* a_base(const pg8::Unit& u) const { return (const char*)A + (size_t)u.pm * 256 * K; }
    __device__ __forceinline__ const char* b_base(const pg8::Unit& u) const { return (const char*)Bt_l + ((size_t)u.e * D + (size_t)u.pn * 256) * K; }
    __device__ __forceinline__ void a_voff(const pg8::Unit&, unsigned (&v)[2][2], int tid) const { pg8::voff_contig8(v, tid, K); }
    __device__ __forceinline__ void tok_prefetch(const pg8::Unit&, LAS unsigned char*, int, int) const {}
    __device__ __forceinline__ void a_voff_half_lds(unsigned (&)[2], LAS unsigned char*, int, int, int) const {}
    __device__ __forceinline__ void epi(const pg8::AccT& acc, const pg8::Unit& u, int wr, int wc, int fr, int fq) const {
        const int ce = u.ce; const int p0 = u.pos0 + wr * 64 + fr; const float* bd = bd_l + (size_t)u.e * D;
        int dsts[2][4]; float gs[2][4];
#pragma unroll
        for (int ai = 0; ai < 2; ++ai)
#pragma unroll
            for (int m = 0; m < 4; ++m) { const int pos = p0 + ai * 128 + m * 16; const size_t ix = (size_t)u.e * CAP + (pos < ce ? pos : 0); dsts[ai][m] = list_dst[ix]; gs[ai][m] = list_gate[ix]; }
        f32x4 bb[2][2];
#pragma unroll
        for (int bj = 0; bj < 2; ++bj) { const int c0 = u.pn * 256 + bj * 128 + wc * 32 + 8 * fq; bb[bj][0] = *(const f32x4*)(bd + c0); bb[bj][1] = *(const f32x4*)(bd + c0 + 4); }
#pragma unroll
        for (int ai = 0; ai < 2; ++ai)
#pragma unroll
            for (int m = 0; m < 4; ++m) {
                const int pos = p0 + ai * 128 + m * 16;
                {
                    const float g = gs[ai][m]; const size_t drow = pos < ce ? (size_t)dsts[ai][m] : (size_t)(Y2_DUMMY_ROW + (pos & 255));
#pragma unroll
                    for (int bj = 0; bj < 2; ++bj) { const int c0 = u.pn * 256 + bj * 128 + wc * 32 + 8 * fq;
                        const f32x4 v0 = (acc[ai][bj][m][0] * (1.0f / W8_SCALE) + bb[bj][0]) * g, v1 = (acc[ai][bj][m][1] * (1.0f / W8_SCALE) + bb[bj][1]) * g;
                        if (Y2_FP8) { u32x2 w; w.x = pk_fp8x4(v0.x * Y2_SCALE, v0.y * Y2_SCALE, v0.z * Y2_SCALE, v0.w * Y2_SCALE); w.y = pk_fp8x4(v1.x * Y2_SCALE, v1.y * Y2_SCALE, v1.z * Y2_SCALE, v1.w * Y2_SCALE);
                            *(u32x2*)((unsigned char*)Y2 + drow * D + c0) = w; }
                        else { u32x4 w; w.x = pg8::cvt_pk_bf16(v0.x, v0.y); w.y = pg8::cvt_pk_bf16(v0.z, v0.w); w.z = pg8::cvt_pk_bf16(v1.x, v1.y); w.w = pg8::cvt_pk_bf16(v1.z, v1.w);
                            *(u32x4*)(Y2 + drow * D + c0) = w; } }
                }
            }
    }
};
__device__ __forceinline__ void ph_inproj_fast(Ctx& F, int l) {
    PbInproj pb; pb.A = F.H1(); pb.Bt = F.WinT() + (size_t)l * INW * D; pb.P = F.P(); pb.Vt = F.Vt(); pb.rope = F.rope(); pb.S.init(MA, INW, F.G, F.bid);
    pg8::gemm_phase(F.lds, pb, F.tid);
}
__device__ __forceinline__ void ph_outproj_fast(Ctx& F, int l) {
    PbOutproj pb; pb.A = F.MIX(); pb.Bt = F.WoutT() + (size_t)l * D * D; pb.TMP = F.P(); pb.mods_l = F.mods() + (size_t)l * 3 * 6 * D; pb.S.init(l == 0 ? MA : ML, D, F.G, F.bid);
    pg8::gemm_phase(F.lds, pb, F.tid);
}
__device__ __forceinline__ void ph_moe_gu_fast(Ctx& F, int l) {
    const int T = moe_setup(F, l);
    if (MOE_FP8) {
        PbGu8 pb; pb.A = (const unsigned char*)F.H1(); pb.Bt_l = (const unsigned char*)F.WguT() + (size_t)l * NE * 2 * FF * D; pb.H = (unsigned char*)F.HMOE(); pb.bgu_l = F.inp(I_BGU) + (size_t)l * NE * 2 * FF; pb.list_tok = F.list_tok();
        pb.S.init(F, T, 8); pb.cntL = (const LAS int*)(F.lds + MOE_LDS);
        pg8::gemm_phase8(F.lds, pb, F.tid);
    } else {
        PbGu pb; pb.A = F.H1(); pb.Bt_l = F.WguT() + (size_t)l * NE * 2 * FF * D; pb.H = F.HMOE(); pb.bgu_l = F.inp(I_BGU) + (size_t)l * NE * 2 * FF; pb.list_tok = F.list_tok();
        pb.S.init(F, T, 8); pb.cntL = (const LAS int*)(F.lds + MOE_LDS);
        pg8::gemm_phase(F.lds, pb, F.tid);
    }
}
__device__ __forceinline__ void ph_moe_down_fast(Ctx& F, int l) {
    const int T = moe_setup(F, l);
    if (MOE_FP8) {
        PbDown8 pb; pb.A = (const unsigned char*)F.HMOE(); pb.Bt_l = (const unsigned char*)F.WdT() + (size_t)l * NE * D * FF; pb.Y2 = F.Y2(); pb.bd_l = F.inp(I_BD) + (size_t)l * NE * D; pb.list_dst = F.list_dst(); pb.list_gate = F.list_gate();
        pb.S.init(F, T, 4); pb.cntL = (const LAS int*)(F.lds + MOE_LDS);
        pg8::gemm_phase8(F.lds, pb, F.tid);
    } else {
        PbDown pb; pb.A = F.HMOE(); pb.Bt_l = F.WdT() + (size_t)l * NE * D * FF; pb.Y2 = F.Y2(); pb.bd_l = F.inp(I_BD) + (size_t)l * NE * D; pb.list_dst = F.list_dst(); pb.list_gate = F.list_gate();
        pb.S.init(F, T, 4); pb.cntL = (const LAS int*)(F.lds + MOE_LDS);
        pg8::gemm_phase(F.lds, pb, F.tid);
    }
}

#define XB_TMO      128
#define XB_XCNT(j)  (256  + 64 * (j))
#define XB_XSUB(j)  (1280 + 64 * (j))
#define XB_XGEN(j)  (2304 + 64 * (j))
#define XB_TOP      3328
#define XB_TOPGEN   3392
#define XCD_BAR_WORDS 3456
#define XB_SPIN_CAP (1u << 22)
__device__ __forceinline__ unsigned xb_ld(unsigned* p)              { return __hip_atomic_load(p, __ATOMIC_RELAXED, __HIP_MEMORY_SCOPE_AGENT); }
__device__ __forceinline__ unsigned xb_add(unsigned* p, unsigned v) { return __hip_atomic_fetch_add(p, v, __ATOMIC_RELAXED, __HIP_MEMORY_SCOPE_AGENT); }
__device__ __forceinline__ unsigned xb_xcc_id() { return (unsigned)__builtin_amdgcn_s_getreg((3 << 11) | 20) & 0xFu; }
#define XB_SPIN(cond, bar) do { unsigned _sp = 0; while (cond) { __builtin_amdgcn_s_sleep(1); \
    if ((++_sp & 255u) == 0u) { if (xb_ld(&(bar)[XB_TMO])) break; if (_sp > XB_SPIN_CAP) { atomicAdd(&(bar)[XB_TMO], 1u); break; } } } } while (0)
struct XcdBarrier { unsigned* bar; unsigned x; volatile LAS unsigned* st; };
__device__ __forceinline__ XcdBarrier xcd_barrier_post(unsigned* bar, volatile LAS unsigned* st) {
    XcdBarrier b; b.bar = bar; b.x = xb_xcc_id(); b.st = st;
    if (threadIdx.x == 0) (void)xb_add(&bar[XB_XCNT(b.x)], 1u);
    return b;
}
__device__ __forceinline__ void xcd_barrier_complete(unsigned* bar, unsigned x, unsigned& nloc, unsigned& nx) {
    const unsigned G = gridDim.x * gridDim.y * gridDim.z;
    unsigned sum, cnt, mine, sp = 0u;
    for (;;) {
        sum = 0u; cnt = 0u; mine = 0u;
#pragma unroll
        for (unsigned j = 0; j < 16; ++j) { const unsigned c = xb_ld(&bar[XB_XCNT(j)]); sum += c; cnt += (c > 0u) ? 1u : 0u; mine = (j == x) ? c : mine; }
        if (sum == G) break;
        __builtin_amdgcn_s_sleep(1);
        if ((++sp & 255u) == 0u) { if (xb_ld(&bar[XB_TMO])) break; if (sp > XB_SPIN_CAP) { atomicAdd(&bar[XB_TMO], 1u); break; } }
    }
    nloc = mine > 0u ? mine : 1u; nx = cnt > 0u ? cnt : 1u;
}
__device__ __forceinline__ void xcd_barrier(const XcdBarrier& b0) {
    asm volatile("s_waitcnt vmcnt(0)" ::: "memory");
    __syncthreads();
    XcdBarrier b = b0;
    { unsigned long long p = (unsigned long long)b0.bar; unsigned xx = b0.x; asm volatile("" : "+s"(p), "+s"(xx)); b.bar = (unsigned*)p; b.x = xx; }
    if (threadIdx.x == 0) {
        unsigned* bar = b.bar;
        __builtin_amdgcn_s_waitcnt(0);
        unsigned nloc = b.st[0], nx = b.st[1];
        if (nloc == 0u) { xcd_barrier_complete(bar, b.x, nloc, nx); b.st[0] = nloc; b.st[1] = nx; }
        const unsigned old = xb_add(&bar[XB_XSUB(b.x)], 1u);
        const unsigned gen = old / nloc;
        if (old + 1u == (gen + 1u) * nloc) {
            __builtin_amdgcn_fence(__ATOMIC_RELEASE, "agent");
            asm volatile("s_waitcnt vmcnt(0)" ::: "memory");
            const unsigned og = xb_add(&bar[XB_TOP], 1u);
            const unsigned tg = og / nx;
            if (og + 1u == (tg + 1u) * nx) xb_add(&bar[XB_TOPGEN], 1u);
            else XB_SPIN(xb_ld(&bar[XB_TOPGEN]) == tg, bar);
            __builtin_amdgcn_fence(__ATOMIC_ACQUIRE, "agent");
            xb_add(&bar[XB_XGEN(b.x)], 1u);
            asm volatile("s_waitcnt vmcnt(0)" ::: "memory");
        } else {
            XB_SPIN(xb_ld(&bar[XB_XGEN(b.x)]) == gen, bar);
            __builtin_amdgcn_fence(__ATOMIC_ACQUIRE, "agent");
            asm volatile("s_waitcnt vmcnt(0)" ::: "memory");
        }
    }
    __syncthreads();
}

__device__ __forceinline__ void convert_item(Ctx& F, int l, int wi) {
    LAS float* scr = (LAS float*)(F.lds + F.wave * 8704);
    if (MOE_FP8) {
        if (wi < CV_GU) { const int le = l * NE + (wi >> 10); tr_item8<2>(F.inp(I_WGU) + (size_t)le * D * 2 * FF, D, 2 * FF, (unsigned char*)F.WguT() + (size_t)le * 2 * FF * D, scr, wi & 1023, F.lane); }
        else { const int r = wi - CV_GU; const int le = l * NE + (r >> 9); tr_item8<0>(F.inp(I_WD) + (size_t)le * FF * D, FF, D, (unsigned char*)F.WdT() + (size_t)le * D * FF, scr, r & 511, F.lane); }
        return;
    }
    if (wi < CV_GU) { const int le = l * NE + (wi >> 10); tr_item<2>(F.inp(I_WGU) + (size_t)le * D * 2 * FF, D, 2 * FF, F.WguT() + (size_t)le * 2 * FF * D, scr, wi & 1023, F.lane); }
    else { const int r = wi - CV_GU; const int le = l * NE + (r >> 9); tr_item<0>(F.inp(I_WD) + (size_t)le * FF * D, FF, D, F.WdT() + (size_t)le * D * FF, scr, r & 511, F.lane); }
}
__device__ __forceinline__ bool convert_next(Ctx& F, volatile LAS unsigned* prog, int pmax) {
    const int p = (int)prog[F.wave];
    if (p >= pmax) return false;
    convert_item(F, p / CV_PER_WAVE, (F.bid * NWAVES + F.wave) + 2048 * (p % CV_PER_WAVE));
    if (F.lane == 0) prog[F.wave] = (unsigned)(p + 1);
    return true;
}
__device__ __forceinline__ void drain_convert(Ctx& F, int l, volatile LAS unsigned* prog) {
    while (convert_next(F, prog, CV_PER_WAVE * (l + 1))) {}
}
__device__ __forceinline__ void xcd_barrier_steal(const XcdBarrier& b0, Ctx& F, volatile LAS unsigned* fl, volatile LAS unsigned* prog) {
    asm volatile("s_waitcnt vmcnt(0)" ::: "memory");
    __syncthreads();
    XcdBarrier b = b0;
    { unsigned long long p = (unsigned long long)b0.bar; unsigned xx = b0.x; asm volatile("" : "+s"(p), "+s"(xx)); b.bar = (unsigned*)p; b.x = xx; }
    unsigned* bar = b.bar;
    if (threadIdx.x == 0) {
        __builtin_amdgcn_s_waitcnt(0);
        unsigned nloc = b.st[0], nx = b.st[1];
        if (nloc == 0u) { xcd_barrier_complete(bar, b.x, nloc, nx); b.st[0] = nloc; b.st[1] = nx; }
        const unsigned old = xb_add(&bar[XB_XSUB(b.x)], 1u);
        const unsigned gen = old / nloc;
        if (old + 1u == (gen + 1u) * nloc) {
            __builtin_amdgcn_fence(__ATOMIC_RELEASE, "agent");
            asm volatile("s_waitcnt vmcnt(0)" ::: "memory");
            const unsigned og = xb_add(&bar[XB_TOP], 1u);
            const unsigned tg = og / nx;
            if (og + 1u == (tg + 1u) * nx) xb_add(&bar[XB_TOPGEN], 1u);
            else XB_SPIN(xb_ld(&bar[XB_TOPGEN]) == tg, bar);
            __builtin_amdgcn_fence(__ATOMIC_ACQUIRE, "agent");
            xb_add(&bar[XB_XGEN(b.x)], 1u);
            asm volatile("s_waitcnt vmcnt(0)" ::: "memory");
            fl[0] = 1u;
        } else { fl[0] = 0u; fl[1] = gen; }
    }
    __syncthreads();
    if (fl[0] == 0u) {
        const unsigned gen = fl[1];
        unsigned sp = 0u;
        for (;;) {
            unsigned rel = 0u;
            if (F.lane == 0) { rel = (xb_ld(&bar[XB_XGEN(b.x)]) != gen) ? 1u : 0u;
                if (!rel && (++sp & 63u) == 0u) { if (xb_ld(&bar[XB_TMO])) rel = 1u; else if (sp > XB_SPIN_CAP) { atomicAdd(&bar[XB_TMO], 1u); rel = 1u; } } }
            rel = (unsigned)__builtin_amdgcn_readfirstlane((int)rel);
            if (rel) break;
            if (!convert_next(F, prog, CV_PER_WAVE * NL)) __builtin_amdgcn_s_sleep(2);
        }
        asm volatile("s_waitcnt vmcnt(0)" ::: "memory");
        __syncthreads();
        if (threadIdx.x == 0) { __builtin_amdgcn_fence(__ATOMIC_ACQUIRE, "agent"); asm volatile("s_waitcnt vmcnt(0)" ::: "memory"); }
    }
    __syncthreads();
}

constexpr int LDS_BYTES = 147456;
constexpr int MISC_OFF = 147456 - 256;

__global__ void __launch_bounds__(NTHR, 2) fwd(Args args) {
    extern __shared__ __attribute__((aligned(16))) unsigned char lds[];
    Ctx F0;
    F0.lds = (LAS unsigned char*)lds;
    F0.tid = threadIdx.x; F0.lane = F0.tid & 63; F0.wave = __builtin_amdgcn_readfirstlane(F0.tid >> 6); F0.G = gridDim.x; F0.bid = blockIdx.x;
    F0.in = args.in; F0.out = args.out; F0.ws = args.ws;
    volatile LAS unsigned* MISC = (volatile LAS unsigned*)(F0.lds + MISC_OFF);
    if (F0.tid < 64) MISC[F0.tid] = 0u;
    __syncthreads();
    XcdBarrier bar; bar.bar = (unsigned*)(F0.ctl() + CW_BAR); bar.x = 0; bar.st = nullptr;
    if (MK_N_LAUNCHES == 1) bar = xcd_barrier_post((unsigned*)(F0.ctl() + CW_BAR), MISC + 8);
    const int lo = args.ph_lo, hi = args.ph_hi;
#define IN(k) (lo <= (k) && (k) < hi)
#define SEAM(k) do { if (IN(k) && IN((k) + 1)) { Ctx F = fresh(F0); xcd_barrier_steal(bar, F, MISC + 16, MISC + 24); } } while (0)
#define SEAM_S(k) SEAM(k)
#define PH(k, ...) do { if (IN(k)) { Ctx F = fresh(F0); __VA_ARGS__; } } while (0)

    PH(0, REPEAT(REP_PRO, ph_prologue(F))); SEAM(0);
    for (int l = 0; l < NL; ++l) {
        const int pb = 1 + 9 * l;
        PH(pb + 0, ph_norm1(F, l); if (REP_N10 > 1 && l == 0) ph_norm1(F, l)); SEAM(pb + 0);
        PH(pb + 1, REPEAT(REP_INP, if (FAST_GEMM) ph_inproj_fast(F, l); else ph_inproj_naive(F, l))); SEAM_S(pb + 1);
        if (FAST_ATTN) PH(pb + 2, REPEAT(REP_ATT, ph_attn_fast(F, l))); else PH(pb + 2, ph_attn_naive(F, l));
        if (FAST_LRU) PH(pb + 2, REPEAT(REP_LA, ph_lru_fast<false>(F, l))); else PH(pb + 2, ph_lru_gates_naive(F, l));
        if (FAST_HG) PH(pb + 2, REPEAT(REP_HA, ph_hgrn_fast<false>(F, l)));
        SEAM(pb + 2);
        if (FAST_LRU) PH(pb + 3, REPEAT(REP_CAR, ph_lru_carry(F))); else PH(pb + 3, ph_lru_scan_naive(F));
        if (FAST_HG) PH(pb + 3, REPEAT(REP_CAR, ph_hgrn_carry(F))); else PH(pb + 3, ph_hgrn_scan_naive(F, l));
        SEAM_S(pb + 3);
        if (FAST_LRU) PH(pb + 4, REPEAT(REP_LC, ph_lru_fast<true>(F, l))); else PH(pb + 4, ph_lru_out_naive(F, l));
        if (FAST_HG) PH(pb + 4, REPEAT(REP_HC, ph_hgrn_fast<true>(F, l))); else PH(pb + 4, ph_hgrn_out_naive(F, l));
        SEAM(pb + 4);
        PH(pb + 5, if (FAST_GEMM) ph_outproj_fast(F, l); else ph_outproj_naive(F, l); if (REP_OP0 > 1) ph_outproj_fast(F, l)); SEAM_S(pb + 5);
        PH(pb + 6, ph_norm2_router(F, l); __syncthreads(); drain_convert(F, l, MISC + 24)); SEAM(pb + 6);
        PH(pb + 7, REPEAT(REP_GU, if (FAST_GEMM) ph_moe_gu_fast(F, l); else ph_moe_gu_naive(F, l))); SEAM_S(pb + 7);
        PH(pb + 8, REPEAT(REP_DN, if (FAST_GEMM) ph_moe_down_fast(F, l); else ph_moe_down_naive(F, l))); SEAM_S(pb + 8);
    }
    PH(19, REPEAT(REP_FIN, ph_norm1(F, 2)));
#undef PH
#undef IN
#undef SEAM_S
#undef SEAM
}

extern "C" void kernel_launch(void* const* d_in, const int* in_sizes, int n_in, void* d_out, int out_size, void* d_ws, size_t ws_size, hipStream_t stream) {
    static int grid = 0;
    if (grid == 0) {
        if (n_in != 27 || out_size != ML * D || ws_size < WS_END) { fprintf(stderr, "kernel_launch: unexpected shapes (n_in %d out %d ws %zu)\n", n_in, out_size, ws_size); grid = -1; return; }
        int dev = 0, cus = 0, per_cu = 0;
        if (hipGetDevice(&dev) != hipSuccess || hipDeviceGetAttribute(&cus, hipDeviceAttributeMultiprocessorCount, dev) != hipSuccess) { grid = -1; return; }
        if (hipFuncSetAttribute((const void*)fwd, hipFuncAttributeMaxDynamicSharedMemorySize, LDS_BYTES) != hipSuccess) { fprintf(stderr, "kernel_launch: hipFuncSetAttribute failed\n"); grid = -1; return; }
        if (hipOccupancyMaxActiveBlocksPerMultiprocessor(&per_cu, (const void*)fwd, NTHR, LDS_BYTES) != hipSuccess || per_cu < 1) { fprintf(stderr, "kernel_launch: occupancy query says %d\n", per_cu); }
        (void)hipGetLastError();
        grid = cus;
        if (grid != 256) { fprintf(stderr, "kernel_launch: built for a 256-CU device (got %d)\n", cus); grid = -1; return; }
    }
    if (grid < 0) return;
    (void)hipMemsetAsync((char*)d_ws + WS_CTL, 0, CTL_ZERO_BYTES, stream);
    Args a{};
    for (int i = 0; i < 27; ++i) a.in[i] = (const float*)d_in[i];
    a.out = (float*)d_out; a.ws = (unsigned char*)d_ws;
    if (MK_N_LAUNCHES == 1) { a.ph_lo = 0; a.ph_hi = N_PH; hipLaunchKernelGGL(fwd, dim3(grid), dim3(NTHR), LDS_BYTES, stream, a); }
    else for (int p = 0; p < N_PH; ++p) { a.ph_lo = p; a.ph_hi = p + 1; hipLaunchKernelGGL(fwd, dim3(grid), dim3(NTHR), LDS_BYTES, stream, a); }
}
```

```cpp
#include <hip/hip_runtime.h>
#include <stdint.h>
#include <stdio.h>

#ifndef MK_N_LAUNCHES
#define MK_N_LAUNCHES 1
#endif

#ifndef MOE_FP8
#define MOE_FP8 1
#endif
#ifndef Y2_FP8
#define Y2_FP8 1
#endif
#ifndef FAST_GEMM
#define FAST_GEMM 1
#endif
#ifndef REP_PRO
#define REP_PRO 1
#endif
#ifndef REP_INP
#define REP_INP 1
#endif
#ifndef REP_ATT
#define REP_ATT 1
#endif
#ifndef REP_LA
#define REP_LA 1
#endif
#ifndef REP_HA
#define REP_HA 1
#endif
#ifndef REP_LC
#define REP_LC 1
#endif
#ifndef REP_HC
#define REP_HC 1
#endif
#ifndef REP_N10
#define REP_N10 1
#endif
#ifndef REP_FIN
#define REP_FIN 1
#endif
#ifndef REP_OP0
#define REP_OP0 1
#endif
#ifndef REP_RT
#define REP_RT 1
#endif
#ifndef REP_CAR
#define REP_CAR 1
#endif
#ifndef REP_GU
#define REP_GU 1
#endif
#ifndef REP_DN
#define REP_DN 1
#endif
#define REPEAT(n, ...) do { _Pragma("unroll 1") for (int rep_ = 0; rep_ < (n); ++rep_) { __VA_ARGS__; } } while (0)
#ifndef FAST_ATTN
#define FAST_ATTN 1
#endif
#ifndef FAST_LRU
#define FAST_LRU 1
#endif
#ifndef FAST_HG
#define FAST_HG 1
#endif
#define GAS __attribute__((address_space(1)))
#define LAS __attribute__((address_space(3)))
typedef unsigned short bf16;
typedef short bf16x8 __attribute__((ext_vector_type(8)));
typedef float f32x4 __attribute__((ext_vector_type(4)));
typedef float f32x2 __attribute__((ext_vector_type(2)));
typedef float f32x16 __attribute__((ext_vector_type(16)));
typedef unsigned u32x4 __attribute__((ext_vector_type(4)));
typedef unsigned u32x2 __attribute__((ext_vector_type(2)));
typedef GAS unsigned gu32;

constexpr int D = 1024, NB = 2, SEQ = 16384, CTXL = 256, NL = 2;
constexpr int ML = NB * SEQ, MC = NB * CTXL, MA = ML + MC;
constexpr int INW = 2560;
constexpr int C_Q = 0, C_K = 512, C_V = 640, C_LX = 768, C_LG = 1024, C_HQ = 1280, C_HF = 1536, C_HB = 1792, C_HV = 2048, C_HO = 2304;
constexpr int NE = 32, FF = 1024, CAP = MA;
constexpr float EPS = 1e-6f;
constexpr float LOG2E = 1.4426950408889634f;
constexpr float QSCALE = 0.125f * LOG2E;
constexpr int NWAVES = 8, NTHR = 512;
constexpr int N_PH = 20;

constexpr size_t MiB = 1u << 20;
constexpr size_t WS_CTL = 0, CTL_ZERO_BYTES = 65536;
constexpr size_t WS_MODS = 1 * MiB;
constexpr size_t WS_ROPE = 2 * MiB;
constexpr size_t WS_LRUW = 3 * MiB;
constexpr size_t WS_WIN = 4 * MiB;
constexpr size_t WS_WOUT = 16 * MiB;
constexpr size_t WS_WGU = 20 * MiB;
constexpr size_t WS_WD = 276 * MiB;
constexpr size_t WS_XL = 404 * MiB;
constexpr size_t WS_H1 = 534 * MiB;
constexpr size_t WS_P = 599 * MiB;
constexpr size_t WS_VT = 762 * MiB;
constexpr size_t WS_MIX = 771 * MiB;
constexpr size_t WS_HD = 836 * MiB;
constexpr size_t WS_OHG = 901 * MiB;
constexpr size_t WS_GA = 966 * MiB;
constexpr size_t WS_GB = 1031 * MiB;
constexpr size_t WS_AGG = 1096 * MiB;
constexpr size_t WS_LIST = 1136 * MiB;
constexpr size_t WS_HMOE = 1152 * MiB;
constexpr size_t WS_Y2 = 1428 * MiB;
constexpr size_t WS_QI = 1688 * MiB;
constexpr size_t WS_KI = 1721 * MiB;
constexpr size_t WS_SAGG = 1754 * MiB;
constexpr size_t WS_SIN = 1788 * MiB;
constexpr size_t WS_DUMMY = 1823 * MiB;
constexpr size_t WS_END = 1824 * MiB;
constexpr size_t Y2_DUMMY_ROW = (WS_DUMMY - WS_Y2) / (D * ((Y2_FP8 && MOE_FP8) ? 1 : 2));
constexpr size_t VT_CTX_OFF = (size_t)NB * 2 * 64 * SEQ;
constexpr int CW_CNT = 64;
constexpr int CW_BAR = 4096;

__device__ __forceinline__ float bf2f(bf16 x) { return __uint_as_float(((unsigned)x) << 16); }
__device__ __forceinline__ unsigned pk2(float lo, float hi) { unsigned r; asm("v_cvt_pk_bf16_f32 %0, %1, %2" : "=v"(r) : "v"(lo), "v"(hi)); return r; }
__device__ __forceinline__ unsigned f2bf(float f) { return pk2(f, f) & 0xffffu; }
__device__ __forceinline__ float shx(float v, int mask, int lane) { return __int_as_float(__builtin_amdgcn_ds_bpermute((lane ^ mask) << 2, __float_as_int(v))); }
__device__ __forceinline__ float wave_sum(float v, int lane) {
#pragma unroll
    for (int o = 1; o < 64; o <<= 1) v += shx(v, o, lane);
    return v;
}
__device__ __forceinline__ float wave_max(float v, int lane) {
#pragma unroll
    for (int o = 1; o < 64; o <<= 1) v = fmaxf(v, shx(v, o, lane));
    return v;
}
__device__ __forceinline__ float frcp(float x) { return __builtin_amdgcn_rcpf(x); }
__device__ __forceinline__ float sigmoidf_(float x) { return frcp(1.0f + __expf(-x)); }
__device__ __forceinline__ float siluf_(float x) { return x * frcp(1.0f + __expf(-x)); }
__device__ __forceinline__ float gelu_tanh(float x) { const float u = 0.7978845608028654f * (x + 0.044715f * x * x * x); const float t = 1.0f - 2.0f * frcp(__expf(2.0f * u) + 1.0f); return 0.5f * x * (1.0f + t); }
__device__ __forceinline__ unsigned pk_fp8x4(float a, float b, float c, float d) { int w = 0; w = __builtin_amdgcn_cvt_pk_fp8_f32(a, b, w, false); w = __builtin_amdgcn_cvt_pk_fp8_f32(c, d, w, true); return (unsigned)w; }
constexpr float Y2_SCALE = 16.0f;
constexpr float W8_SCALE = 64.0f;
__device__ __forceinline__ int crow(int r, int hi) { return (r & 3) + 8 * (r >> 2) + 4 * hi; }

struct Args { const float* in[27]; float* out; unsigned char* ws; int ph_lo, ph_hi; };
struct Ctx {
    LAS unsigned char* lds;
    int tid, lane, wave, G, bid;
    const float* const* in;
    float* out; unsigned char* ws;
#define WSACC(T, name, off) __device__ __forceinline__ T* name() const { return (T*)(ws + (off)); }
    WSACC(gu32, ctl, WS_CTL) WSACC(float, mods, WS_MODS) WSACC(f32x2, rope, WS_ROPE) WSACC(bf16, lruw, WS_LRUW) WSACC(bf16, WinT, WS_WIN) WSACC(bf16, WoutT, WS_WOUT)
    WSACC(bf16, WguT, WS_WGU) WSACC(bf16, WdT, WS_WD) WSACC(bf16, XL, WS_XL) WSACC(bf16, H1, WS_H1) WSACC(bf16, P, WS_P) WSACC(bf16, Vt, WS_VT) WSACC(bf16, MIX, WS_MIX)
    WSACC(float, HD, WS_HD) WSACC(float, OHG, WS_OHG) WSACC(float, GA, WS_GA) WSACC(float, GB, WS_GB) WSACC(float, AGG, WS_AGG)
    WSACC(int, list_tok, WS_LIST) WSACC(int, list_dst, WS_LIST + (size_t)NE * CAP * 4) WSACC(float, list_gate, WS_LIST + (size_t)NE * CAP * 8)
    WSACC(bf16, HMOE, WS_HMOE) WSACC(bf16, Y2, WS_Y2)
    __device__ __forceinline__ bf16* ws_bf16(size_t off) const { return (bf16*)(ws + off); }
    __device__ __forceinline__ const float* inp(int i) const { return (const float*)(const GAS float*)in[i]; }
    __device__ __forceinline__ float* outp() const { return (float*)(GAS float*)out; }
#undef WSACC
};
__device__ __forceinline__ Ctx fresh(const Ctx& F0) {
    Ctx F = F0; int wv = F0.wave, g = F0.G, bi = F0.bid; asm volatile("" : "+s"(wv), "+s"(g), "+s"(bi));
    int ln; asm volatile("v_mbcnt_lo_u32_b32 %0, -1, 0\n\tv_mbcnt_hi_u32_b32 %0, -1, %0" : "=v"(ln));
    F.wave = wv; F.lane = ln; F.tid = wv * 64 + ln; F.G = g; F.bid = bi;
    unsigned long long w = (unsigned long long)F0.ws;
    asm volatile("" : "+s"(w)); F.ws = (unsigned char*)(GAS unsigned char*)w;
    return F;
}
enum { I_X = 0, I_C, I_CTX, I_CCTX, I_ADAW, I_ADAB, I_N1G, I_WIN, I_SINK, I_CONVW, I_CONVB, I_WR, I_BR, I_WI, I_BI, I_LAM, I_LBL, I_HNG, I_WOUT, I_N2G, I_RW, I_RB, I_WGU, I_BGU, I_WD, I_BD, I_FG };

__device__ __forceinline__ int row_b(int m) { return m < ML ? m / SEQ : (m - ML) / CTXL; }
__device__ __forceinline__ int row_t(int m) { return m < ML ? m % SEQ : (m - ML) % CTXL; }
__device__ __forceinline__ int mod_row(int m) { return m < ML ? m / SEQ : 2; }

__device__ __forceinline__ int dest_win(int n) {
    if (n >= C_V) return n;
    const int d = n & 63, p = d >> 5, half = (d >> 4) & 1, f = d & 15;
    return (n & ~63) + 2 * (p * 16 + f) + half;
}
__device__ __forceinline__ int dest_gu(int n) {
    const int up = n >= FF ? 1 : 0, ff = n & (FF - 1);
    return (ff >> 7) * 256 + up * 128 + (ff & 127);
}
template <int MAP>
__device__ __forceinline__ void tr_item(const float* W, int K, int N, bf16* WT, LAS float* scr, int item, int lane) {
    const int nblk = N / 32, kb = item / nblk, nb = item % nblk, k0 = 64 * kb, n0 = 32 * nb;
#pragma unroll 8
    for (int i = 0; i < 32; ++i) { const int kk = 2 * i + (lane >> 5); scr[kk * 33 + (lane & 31)] = W[(size_t)(k0 + kk) * N + n0 + (lane & 31)]; }
    asm volatile("s_waitcnt lgkmcnt(0)" ::: "memory");
    const int c = lane & 7;
#pragma unroll
    for (int j = 0; j < 4; ++j) {
        const int n = (lane >> 3) + 8 * j; const LAS float* s = scr + (8 * c) * 33 + n;
        u32x4 o; o.x = pk2(s[0 * 33], s[1 * 33]); o.y = pk2(s[2 * 33], s[3 * 33]); o.z = pk2(s[4 * 33], s[5 * 33]); o.w = pk2(s[6 * 33], s[7 * 33]);
        const int nn = n0 + n; const int dr = MAP == 1 ? dest_win(nn) : (MAP == 2 ? dest_gu(nn) : nn);
        *(u32x4*)(WT + (size_t)dr * K + k0 + 8 * c) = o;
    }
    asm volatile("s_waitcnt lgkmcnt(0)" ::: "memory");
}
template <int MAP>
__device__ __forceinline__ void tr_item8(const float* W, int K, int N, unsigned char* WT, LAS float* scr, int item, int lane) {
    const int nblk = N / 32, kb = item / nblk, nb = item % nblk, k0 = 64 * kb, n0 = 32 * nb;
#pragma unroll 8
    for (int i = 0; i < 32; ++i) { const int kk = 2 * i + (lane >> 5); scr[kk * 33 + (lane & 31)] = W[(size_t)(k0 + kk) * N + n0 + (lane & 31)]; }
    asm volatile("s_waitcnt lgkmcnt(0)" ::: "memory");
    const int c = lane & 7;
#pragma unroll
    for (int j = 0; j < 4; ++j) {
        const int n = (lane >> 3) + 8 * j; const LAS float* s = scr + (8 * c) * 33 + n;
        u32x2 o; o.x = pk_fp8x4(s[0 * 33] * W8_SCALE, s[1 * 33] * W8_SCALE, s[2 * 33] * W8_SCALE, s[3 * 33] * W8_SCALE); o.y = pk_fp8x4(s[4 * 33] * W8_SCALE, s[5 * 33] * W8_SCALE, s[6 * 33] * W8_SCALE, s[7 * 33] * W8_SCALE);
        const int nn = n0 + n; const int dr = MAP == 2 ? dest_gu(nn) : nn;
        *(u32x2*)(WT + (size_t)dr * K + k0 + 8 * c) = o;
    }
    asm volatile("s_waitcnt lgkmcnt(0)" ::: "memory");
}
__device__ __forceinline__ void tr_load(const float* W, int N, int item, int lane, float (&r)[32]) {
    const int nblk = N / 32, kb = item / nblk, nb = item % nblk, k0 = 64 * kb, n0 = 32 * nb;
    const float* p = W + (size_t)(k0 + (lane >> 5)) * N + n0 + (lane & 31);
#pragma unroll
    for (int i = 0; i < 32; ++i) r[i] = p[(size_t)(2 * i) * N];
}
template <int MAP>
__device__ __forceinline__ void tr_finish(int K, int N, bf16* WT, LAS float* scr, int item, int lane, const float (&r)[32]) {
    const int nblk = N / 32, kb = item / nblk, nb = item % nblk, k0 = 64 * kb, n0 = 32 * nb;
#pragma unroll
    for (int i = 0; i < 32; ++i) scr[(2 * i + (lane >> 5)) * 33 + (lane & 31)] = r[i];
    asm volatile("s_waitcnt lgkmcnt(0)" ::: "memory");
    const int c = lane & 7;
#pragma unroll
    for (int j = 0; j < 4; ++j) {
        const int n = (lane >> 3) + 8 * j; const LAS float* s = scr + (8 * c) * 33 + n;
        u32x4 o; o.x = pk2(s[0 * 33], s[1 * 33]); o.y = pk2(s[2 * 33], s[3 * 33]); o.z = pk2(s[4 * 33], s[5 * 33]); o.w = pk2(s[6 * 33], s[7 * 33]);
        const int nn = n0 + n; const int dr = MAP == 1 ? dest_win(nn) : (MAP == 2 ? dest_gu(nn) : nn);
        *(u32x4*)(WT + (size_t)dr * K + k0 + 8 * c) = o;
    }
    asm volatile("s_waitcnt lgkmcnt(0)" ::: "memory");
}
__device__ __forceinline__ void ph_prologue(Ctx& F) {
    LAS float* scr = (LAS float*)(F.lds + F.wave * 8704);
    const int gw = F.bid * NWAVES + F.wave, NGW = F.G * NWAVES;
    constexpr int I_IN = 16 * 80, I_OUT = 16 * 32;
    constexpr int N_IN = NL * I_IN, N_OUT = NL * I_OUT;
    for (int it = gw; it < N_IN + N_OUT; it += NGW) {
        int r = it;
        if (r < N_IN) { const int l = r / I_IN; tr_item<1>(F.inp(I_WIN) + (size_t)l * D * INW, D, INW, F.WinT() + (size_t)l * INW * D, scr, r % I_IN, F.lane); continue; } r -= N_IN;
        { const int l = r / I_OUT; tr_item<0>(F.inp(I_WOUT) + (size_t)l * D * D, D, D, F.WoutT() + (size_t)l * D * D, scr, r % I_OUT, F.lane); }
    }
    const int gt = F.bid * NTHR + F.tid, NGT = F.G * NTHR;
    for (int i = gt; i < NL * 2 * 2 * 4 * 4096; i += NGT) {
        const int c = i & 63, dd = (i >> 6) & 63, n = (i >> 12) & 3, g = (i >> 14) & 1, d = (i >> 15) & 1, l = i >> 16;
        const float* src = g ? F.inp(I_WI) : F.inp(I_WR);
        F.lruw()[i] = (bf16)f2bf(src[((((size_t)l * 2 + d) * 4 + n) * 64 + c) * 64 + dd]);
    }
    for (int i = gt; i < 256 * 16; i += NGT) {
        const int pos = i >> 4, f = i & 15;
        const float invf[16] = {1.000000000e+00f, 5.623413324e-01f, 3.162277639e-01f, 1.778279394e-01f, 1.000000015e-01f, 5.623413250e-02f, 3.162277490e-02f, 1.778279431e-02f,
                                9.999999776e-03f, 5.623413250e-03f, 3.162277630e-03f, 1.778279431e-03f, 1.000000047e-03f, 5.623413017e-04f, 3.162277571e-04f, 1.778279402e-04f};
        float fr = 1.0f;
#pragma unroll
        for (int q = 0; q < 16; ++q) fr = (f == q) ? invf[q] : fr;
        const float ang = (float)pos * fr;
        double rev = (double)ang * 0.15915494309189535; rev -= floor(rev);
        F.rope()[i] = (f32x2){__builtin_amdgcn_cosf((float)rev), __builtin_amdgcn_sinf((float)rev)};
    }
    LAS float* cond = (LAS float*)(F.lds + 72 * 1024);
    LAS float* red = (LAS float*)(F.lds + 88 * 1024);
    __syncthreads();
    for (int i = F.tid; i < 3 * D; i += NTHR) { const int r = i / D, k = i % D; const float v = r < 2 ? F.inp(I_C)[r * D + k] : F.inp(I_CCTX)[k]; cond[i] = siluf_(v); }
    __syncthreads();
    for (int unit = F.bid; unit < NL * 192; unit += F.G) {
        const int l = unit / 192, col0 = (unit % 192) * 32, cl = F.tid & 31, ks = F.tid >> 5;
        const float* W = F.inp(I_ADAW) + (size_t)l * D * 6 * D + col0 + cl;
        float a0 = 0.f, a1 = 0.f, a2 = 0.f;
#pragma unroll 8
        for (int k = ks * 64; k < ks * 64 + 64; ++k) { const float w = W[(size_t)k * 6 * D]; a0 += cond[k] * w; a1 += cond[D + k] * w; a2 += cond[2 * D + k] * w; }
        red[(ks * 3 + 0) * 32 + cl] = a0; red[(ks * 3 + 1) * 32 + cl] = a1; red[(ks * 3 + 2) * 32 + cl] = a2;
        __syncthreads();
        if (F.tid < 96) { const int i = F.tid >> 5; float s = F.inp(I_ADAB)[l * 6 * D + col0 + cl];
            for (int q = 0; q < 16; ++q) s += red[(q * 3 + i) * 32 + cl];
            F.mods()[((size_t)l * 3 + i) * 6 * D + col0 + cl] = s; }
        __syncthreads();
    }
}

__device__ __forceinline__ void ph_norm1(Ctx& F, int l) {
    const int gw = F.bid * NWAVES + F.wave, NGW = F.G * NWAVES;
    const int M = (l == 2) ? ML : MA;
    for (int m = gw; m < M; m += NGW) {
        const int mr = mod_row(m);
        f32x4 v[4];
        if (l == 0) { const float* src = m < ML ? F.inp(I_X) + (size_t)m * D : F.inp(I_CTX) + (size_t)(m - ML) * D;
#pragma unroll
            for (int j = 0; j < 4; ++j) v[j] = *(const f32x4*)(src + 4 * F.lane + 256 * j); }
        else {
#pragma unroll
            for (int j = 0; j < 4; ++j) { const u32x2 w = *(const u32x2*)(F.XL() + (size_t)m * D + 4 * F.lane + 256 * j);
                v[j] = (f32x4){__uint_as_float(w.x << 16), __uint_as_float(w.x & 0xffff0000u), __uint_as_float(w.y << 16), __uint_as_float(w.y & 0xffff0000u)}; } }
        if (l > 0) {
            const float* g5 = F.mods() + ((size_t)(l - 1) * 3 + mr) * 6 * D + 5 * D;
#pragma unroll
            for (int j = 0; j < 4; ++j) {
                const int col = 4 * F.lane + 256 * j; f32x4 s = {0.f, 0.f, 0.f, 0.f};
#pragma unroll
                for (int q = 0; q < 4; ++q) {
                    if (Y2_FP8 && MOE_FP8) { const unsigned w = *(const unsigned*)((const unsigned char*)F.Y2() + ((size_t)m * 4 + q) * D + col);
                        const f32x2 lo = __builtin_amdgcn_cvt_pk_f32_fp8((int)w, false), hi = __builtin_amdgcn_cvt_pk_f32_fp8((int)w, true);
                        s.x += lo.x; s.y += lo.y; s.z += hi.x; s.w += hi.y; }
                    else { const u32x2 w = *(const u32x2*)(F.Y2() + ((size_t)m * 4 + q) * D + col);
                        s.x += __uint_as_float(w.x << 16); s.y += __uint_as_float(w.x & 0xffff0000u); s.z += __uint_as_float(w.y << 16); s.w += __uint_as_float(w.y & 0xffff0000u); } }
                const f32x4 g = *(const f32x4*)(g5 + col) * ((Y2_FP8 && MOE_FP8) ? (1.0f / Y2_SCALE) : 1.0f);
                v[j] += g * s;
            }
        }
        if (l == 1) {
#pragma unroll
            for (int j = 0; j < 4; ++j) { u32x2 w; w.x = pk2(v[j].x, v[j].y); w.y = pk2(v[j].z, v[j].w); *(u32x2*)(F.XL() + (size_t)m * D + 4 * F.lane + 256 * j) = w; }
        }
        float ss = 0.f;
#pragma unroll
        for (int j = 0; j < 4; ++j) ss += (v[j].x * v[j].x + v[j].y * v[j].y) + (v[j].z * v[j].z + v[j].w * v[j].w);
        const float rstd = 1.0f / sqrtf(wave_sum(ss, F.lane) * (1.0f / D) + EPS);
        if (l == 2) {
#pragma unroll
            for (int j = 0; j < 4; ++j) { const int col = 4 * F.lane + 256 * j; const f32x4 g = *(const f32x4*)(F.inp(I_FG) + col); *(f32x4*)(F.outp() + (size_t)m * D + col) = v[j] * rstd * g; }
        } else {
            const float* mo = F.mods() + ((size_t)l * 3 + mr) * 6 * D;
            const float* g1 = F.inp(I_N1G) + l * D;
#pragma unroll
            for (int j = 0; j < 4; ++j) { const int col = 4 * F.lane + 256 * j;
                const f32x4 g = *(const f32x4*)(g1 + col), sh = *(const f32x4*)(mo + col), sc = *(const f32x4*)(mo + D + col);
                const f32x4 h = v[j] * rstd * g * (sc + 1.0f) + sh;
                u32x2 w; w.x = pk2(h.x, h.y); w.y = pk2(h.z, h.w);
                *(u32x2*)(F.H1() + (size_t)m * D + col) = w; }
        }
    }
}

__device__ __forceinline__ void sg_kloop(f32x16 (&acc)[2][2], const bf16* a0, const bf16* a1, const bf16* b0, const bf16* b1, int K) {
#pragma unroll
    for (int i = 0; i < 2; ++i)
#pragma unroll
        for (int j = 0; j < 2; ++j)
#pragma unroll
            for (int r = 0; r < 16; ++r) acc[i][j][r] = 0.f;
#pragma unroll 4
    for (int k = 0; k < K; k += 16) {
        const bf16x8 fa0 = *(const bf16x8*)(a0 + k), fa1 = *(const bf16x8*)(a1 + k), fb0 = *(const bf16x8*)(b0 + k), fb1 = *(const bf16x8*)(b1 + k);
        acc[0][0] = __builtin_amdgcn_mfma_f32_32x32x16_bf16(fa0, fb0, acc[0][0], 0, 0, 0);
        acc[0][1] = __builtin_amdgcn_mfma_f32_32x32x16_bf16(fa0, fb1, acc[0][1], 0, 0, 0);
        acc[1][0] = __builtin_amdgcn_mfma_f32_32x32x16_bf16(fa1, fb0, acc[1][0], 0, 0, 0);
        acc[1][1] = __builtin_amdgcn_mfma_f32_32x32x16_bf16(fa1, fb1, acc[1][1], 0, 0, 0);
    }
}

__device__ __forceinline__ float inproj_fix(const Ctx& F, int m, int c, float v, float partner) {
    float o = v;
    if (c < C_V) {
        if (m < ML) {
            const int t = m % SEQ, dp = c & 63, pr = dp >> 1, p = pr >> 4, f = pr & 15, pos = p ? (t & 63) : (t >> 6);
            const f32x2 cs = F.rope()[pos * 16 + f];
            o = (dp & 1) ? (partner * cs.y + v * cs.x) : (v * cs.x - partner * cs.y);
        }
        if (c < C_K) o *= QSCALE;
    }
    return o;
}
__device__ __forceinline__ size_t vt_index(int m, int cv  ) {
    const int kvh = cv >> 6, d = cv & 63;
    if (m < ML) { const int b = m / SEQ, t = m % SEQ; return ((size_t)((b * 2 + kvh) * 64 + d)) * SEQ + t; }
    const int b = (m - ML) / CTXL, t = (m - ML) % CTXL; return VT_CTX_OFF + ((size_t)((b * 2 + kvh) * 64 + d)) * CTXL + t;
}
__device__ __forceinline__ void ph_inproj_naive(Ctx& F, int l) {
    const int gw = F.bid * NWAVES + F.wave, NGW = F.G * NWAVES, r = F.lane & 31, h = F.lane >> 5;
    const bf16* Bt = F.WinT() + (size_t)l * INW * D;
    for (int ti = gw; ti < (MA / 64) * (INW / 64); ti += NGW) {
        const int rt = ti / (INW / 64), ct = ti % (INW / 64), m0 = rt * 64, c0 = ct * 64;
        f32x16 acc[2][2];
        sg_kloop(acc, F.H1() + (size_t)(m0 + r) * D + 8 * h, F.H1() + (size_t)(m0 + 32 + r) * D + 8 * h, Bt + (size_t)(c0 + r) * D + 8 * h, Bt + (size_t)(c0 + 32 + r) * D + 8 * h, D);
#pragma unroll
        for (int mt = 0; mt < 2; ++mt)
#pragma unroll
            for (int nt = 0; nt < 2; ++nt)
#pragma unroll
                for (int q = 0; q < 16; ++q) {
                    const int m = m0 + 32 * mt + crow(q, h), c = c0 + 32 * nt + r;
                    const float v = acc[mt][nt][q], pa = shx(v, 1, F.lane);
                    const float o = inproj_fix(F, m, c, v, pa);
                    F.P()[(size_t)m * INW + c] = (bf16)f2bf(o);
                    if (c >= C_V && c < C_LX) F.Vt()[vt_index(m, c - C_V)] = (bf16)f2bf(o);
                }
    }
}

__device__ __forceinline__ float dot64(const float (&q)[64], const bf16* kp) {
    float s = 0.f;
#pragma unroll
    for (int i = 0; i < 8; ++i) { const u32x4 w = *(const u32x4*)(kp + 8 * i);
        s += q[8 * i + 0] * __uint_as_float(w.x << 16) + q[8 * i + 1] * __uint_as_float(w.x & 0xffff0000u) + q[8 * i + 2] * __uint_as_float(w.y << 16) + q[8 * i + 3] * __uint_as_float(w.y & 0xffff0000u)
           + q[8 * i + 4] * __uint_as_float(w.z << 16) + q[8 * i + 5] * __uint_as_float(w.z & 0xffff0000u) + q[8 * i + 6] * __uint_as_float(w.w << 16) + q[8 * i + 7] * __uint_as_float(w.w & 0xffff0000u); }
    return s;
}
__device__ __forceinline__ void ph_attn_naive(Ctx& F, int l) {
    const int gw = F.bid * NWAVES + F.wave, NGW = F.G * NWAVES;
    const int Mq = (l == 0) ? MA : ML;
    LAS float* pbuf = (LAS float*)(F.lds) + F.wave * 640;
    for (int u = gw; u < Mq * 8; u += NGW) {
        const int m = u >> 3, hq = u & 7, kvh = hq >> 2;
        const bool isc = m >= ML; const int b = row_b(m), t = row_t(m);
        float q[64];
        { const bf16* qp = F.P() + (size_t)m * INW + C_Q + hq * 64;
#pragma unroll
          for (int i = 0; i < 8; ++i) { const u32x4 w = *(const u32x4*)(qp + 8 * i);
              q[8 * i + 0] = __uint_as_float(w.x << 16); q[8 * i + 1] = __uint_as_float(w.x & 0xffff0000u); q[8 * i + 2] = __uint_as_float(w.y << 16); q[8 * i + 3] = __uint_as_float(w.y & 0xffff0000u);
              q[8 * i + 4] = __uint_as_float(w.z << 16); q[8 * i + 5] = __uint_as_float(w.z & 0xffff0000u); q[8 * i + 6] = __uint_as_float(w.w << 16); q[8 * i + 7] = __uint_as_float(w.w & 0xffff0000u); } }
        const int lo = isc ? 0 : (t - 128 < 0 ? 0 : t - 128), hi = isc ? -1 : (t + 128 > SEQ - 1 ? SEQ - 1 : t + 128);
        const int nloc = hi - lo + 1, nk = nloc + CTXL;
        const float sink2 = F.inp(I_SINK)[l * 8 + hq] * LOG2E;
        float s[9]; float mx = sink2;
#pragma unroll
        for (int i = 0; i < 9; ++i) { const int kk = F.lane + 64 * i; s[i] = -3.0e38f;
            if (kk < nk) { const int krow = kk < nloc ? b * SEQ + lo + kk : ML + b * CTXL + (kk - nloc);
                s[i] = dot64(q, F.P() + (size_t)krow * INW + C_K + kvh * 64); mx = fmaxf(mx, s[i]); } }
        mx = wave_max(mx, F.lane);
        float lsum = 0.f;
#pragma unroll
        for (int i = 0; i < 9; ++i) { const int kk = F.lane + 64 * i; const float p = (kk < nk) ? exp2f(s[i] - mx) : 0.f; lsum += p; pbuf[kk] = p; }
        lsum = wave_sum(lsum, F.lane) + exp2f(sink2 - mx);
        asm volatile("s_waitcnt lgkmcnt(0)" ::: "memory");
        float o = 0.f;
        for (int kk = 0; kk < nk; ++kk) { const int krow = kk < nloc ? b * SEQ + lo + kk : ML + b * CTXL + (kk - nloc);
            o += pbuf[kk] * bf2f(F.P()[(size_t)krow * INW + C_V + kvh * 64 + F.lane]); }
        F.MIX()[(size_t)m * D + hq * 64 + F.lane] = (bf16)f2bf(o / lsum);
        asm volatile("s_waitcnt lgkmcnt(0)" ::: "memory");
    }
}
__device__ __forceinline__ void ph_lru_gates_naive(Ctx& F, int l) {
    const size_t gt = (size_t)F.bid * NTHR + F.tid, NGT = (size_t)F.G * NTHR;
    for (size_t i = gt; i < (size_t)MA * 512; i += NGT) {
        const int m = (int)(i >> 9), d = (int)(i >> 8) & 1, c = (int)i & 255, n = c >> 6, cc0 = c & 63;
        const int t = row_t(m), T = m < ML ? SEQ : CTXL, rb = m - t;
        const float* wr = F.inp(I_WR) + (((size_t)l * 2 + d) * 4 + n) * 4096;
        const float* wi = F.inp(I_WI) + (((size_t)l * 2 + d) * 4 + n) * 4096;
        float rp = F.inp(I_BR)[(l * 2 + d) * 256 + c], ip = F.inp(I_BI)[(l * 2 + d) * 256 + c], us = 0.f;
        for (int cc = 0; cc < 64; ++cc) {
            const int ch = n * 64 + cc; float u = F.inp(I_CONVB)[l * 256 + ch];
#pragma unroll
            for (int j = 0; j < 4; ++j) { const int tt = t - 2 + j; if (tt >= 0 && tt < T) u += F.inp(I_CONVW)[(l * 4 + j) * 256 + ch] * bf2f(F.P()[(size_t)(rb + tt) * INW + C_LX + ch]); }
            rp += u * wr[cc * 64 + cc0]; ip += u * wi[cc * 64 + cc0];
            if (cc == cc0) us = u;
        }
        const float r = sigmoidf_(rp), ig = sigmoidf_(ip);
        const float lam = F.inp(I_LAM)[(l * 2 + d) * 256 + c];
        const float la = -8.0f * r * log1pf(expf(-lam));
        const float a = expf(la), mult = sqrtf(fmaxf(-expm1f(2.0f * la), 1e-12f));
        F.GA()[i] = a; F.GB()[i] = mult * ig * us;
    }
}
__device__ __forceinline__ void ph_lru_scan_naive(Ctx& F) {
    const int gt = F.bid * NTHR + F.tid;
    if (gt >= NB * 512) return;
    const int b = gt >> 9, d = (gt >> 8) & 1, c = gt & 255;
    float h = 0.f;
    for (int s = 0; s < CTXL + SEQ; ++s) {
        int m;
        if (s < CTXL) m = ML + b * CTXL + (d ? CTXL - 1 - s : s); else { const int t = s - CTXL; m = b * SEQ + (d ? SEQ - 1 - t : t); }
        const size_t i = (size_t)m * 512 + d * 256 + c;
        h = F.GA()[i] * h + F.GB()[i];
        F.HD()[i] = h;
    }
}
__device__ __forceinline__ void ph_lru_out_naive(Ctx& F, int l) {
    const size_t gt = (size_t)F.bid * NTHR + F.tid, NGT = (size_t)F.G * NTHR;
    const int Mq = (l == 0) ? MA : ML;
    for (size_t i = gt; i < (size_t)Mq * 256; i += NGT) {
        const int m = (int)(i >> 8), c = (int)i & 255;
        const float y = (F.HD()[(size_t)m * 512 + c] + F.HD()[(size_t)m * 512 + 256 + c]) * gelu_tanh(bf2f(F.P()[(size_t)m * INW + C_LG + c]));
        F.MIX()[(size_t)m * D + 512 + c] = (bf16)f2bf(y);
    }
}
__device__ __forceinline__ float hg_lb(const Ctx& F, int l, int d, int hk) {
    if (l == 0) return 0.f;
    const float l0 = F.inp(I_LBL)[(0 * 2 + d) * 256 + hk], l1 = F.inp(I_LBL)[(1 * 2 + d) * 256 + hk];
    return 1.0f / (1.0f + expf(l0 - l1));
}
__device__ __forceinline__ void ph_hgrn_scan_naive(Ctx& F, int l) {
    if (F.bid >= NB * 2 * 4) return;
    const int b = F.bid >> 3, d = (F.bid >> 2) & 1, hh = F.bid & 3;
    const int v = F.tid & 63, kq = F.tid >> 6;
    LAS float* part = (LAS float*)F.lds;
    float lb[8], S[8];
#pragma unroll
    for (int i = 0; i < 8; ++i) { lb[i] = hg_lb(F, l, d, hh * 64 + kq * 8 + i); S[i] = 0.f; }
    int buf = 0;
    for (int s = 0; s < CTXL + SEQ; ++s) {
        int m;
        if (s < CTXL) m = ML + b * CTXL + (d ? CTXL - 1 - s : s); else { const int t = s - CTXL; m = b * SEQ + (d ? SEQ - 1 - t : t); }
        const bf16* pr = F.P() + (size_t)m * INW;
        const u32x4 zw = *(const u32x4*)(pr + (d ? C_HB : C_HF) + hh * 64 + kq * 8), qw = *(const u32x4*)(pr + C_HQ + hh * 64 + kq * 8);
        const float vv = bf2f(pr[C_HV + hh * 64 + v]);
        float z[8], q[8];
        z[0] = __uint_as_float(zw.x << 16); z[1] = __uint_as_float(zw.x & 0xffff0000u); z[2] = __uint_as_float(zw.y << 16); z[3] = __uint_as_float(zw.y & 0xffff0000u);
        z[4] = __uint_as_float(zw.z << 16); z[5] = __uint_as_float(zw.z & 0xffff0000u); z[6] = __uint_as_float(zw.w << 16); z[7] = __uint_as_float(zw.w & 0xffff0000u);
        q[0] = __uint_as_float(qw.x << 16); q[1] = __uint_as_float(qw.x & 0xffff0000u); q[2] = __uint_as_float(qw.y << 16); q[3] = __uint_as_float(qw.y & 0xffff0000u);
        q[4] = __uint_as_float(qw.z << 16); q[5] = __uint_as_float(qw.z & 0xffff0000u); q[6] = __uint_as_float(qw.w << 16); q[7] = __uint_as_float(qw.w & 0xffff0000u);
        float pa = 0.f;
#pragma unroll
        for (int i = 0; i < 8; ++i) { const float sg = sigmoidf_(z[i]); const float f = lb[i] + (1.0f - lb[i]) * sg, kk = (1.0f - lb[i]) * (1.0f - sg);
            S[i] = f * S[i] + kk * vv; pa += S[i] * q[i]; }
        part[(buf * 8 + kq) * 64 + v] = pa;
        __syncthreads();
        if (kq == 0) { float o = 0.f;
#pragma unroll
            for (int i = 0; i < 8; ++i) o += part[(buf * 8 + i) * 64 + v];
            F.OHG()[(size_t)m * 512 + d * 256 + hh * 64 + v] = o; }
        buf ^= 1;
    }
}
__device__ __forceinline__ void ph_hgrn_out_naive(Ctx& F, int l) {
    const int gw = F.bid * NWAVES + F.wave, NGW = F.G * NWAVES;
    const int Mq = (l == 0) ? MA : ML;
    for (int m = gw; m < Mq; m += NGW) {
        const int col = 4 * F.lane;
        const f32x4 a = *(const f32x4*)(F.OHG() + (size_t)m * 512 + col), bb = *(const f32x4*)(F.OHG() + (size_t)m * 512 + 256 + col);
        const f32x4 o = a + bb;
        float ss = (o.x * o.x + o.y * o.y) + (o.z * o.z + o.w * o.w);
        ss += shx(ss, 1, F.lane); ss += shx(ss, 2, F.lane); ss += shx(ss, 4, F.lane); ss += shx(ss, 8, F.lane);
        const float rstd = 1.0f / sqrtf(ss * (1.0f / 64.0f) + EPS);
        const f32x4 g = *(const f32x4*)(F.inp(I_HNG) + l * 256 + col);
        const u32x2 ow = *(const u32x2*)(F.P() + (size_t)m * INW + C_HO + col);
        const float g0 = siluf_(__uint_as_float(ow.x << 16)), g1 = siluf_(__uint_as_float(ow.x & 0xffff0000u)), g2 = siluf_(__uint_as_float(ow.y << 16)), g3 = siluf_(__uint_as_float(ow.y & 0xffff0000u));
        u32x2 w; w.x = pk2(o.x * rstd * g.x * g0, o.y * rstd * g.y * g1); w.y = pk2(o.z * rstd * g.z * g2, o.w * rstd * g.w * g3);
        *(u32x2*)(F.MIX() + (size_t)m * D + 768 + col) = w;
    }
}

constexpr int MIX_NUB = 136, MIX_NU = 272;
constexpr int LRU_NU = MIX_NU;
struct MixUnit { int b, j, rowbase, t0, ntok, T, ub; bool isc; };
__device__ __forceinline__ MixUnit mix_unit(int g) {
    MixUnit m;
    if (g < 256) { m.b = g >> 7; m.j = g & 127; m.isc = false; m.rowbase = m.b * SEQ; m.t0 = m.j * 128; m.ntok = 128; m.T = SEQ; }
    else { const int c = g - 256; m.b = c >> 3; m.j = 128 + (c & 7); m.isc = true; m.rowbase = ML + m.b * CTXL; m.t0 = (c & 7) * 32; m.ntok = 32; m.T = CTXL; }
    m.ub = m.b * MIX_NUB + m.j; return m;
}
constexpr size_t AG_LRU_A = 0, AG_LRU_B = (size_t)LRU_NU * 512, AG_LRU_H = 2 * (size_t)LRU_NU * 512;
constexpr int U_PITCH = 528;
template <bool FULL, int DIR>
__device__ __forceinline__ void lru_wave(Ctx& F, int l, int u, int n, int rowbase, int t0, int nmt) {
    int ln_ = F.lane; asm volatile("" : "+v"(ln_));
    const int r32 = ln_ & 31, h = ln_ >> 5;
    LAS unsigned char* U = F.lds;
    const bf16* wb = F.lruw() + ((((size_t)l * 2 + DIR) * 2) * 4 + n) * 4096;
    float br[2], bi[2], c8[2], hc[2], At[2], Bt[2];
#pragma unroll
    for (int ct = 0; ct < 2; ++ct) { const int c = 64 * n + 32 * ct + r32, ix = (l * 2 + DIR) * 256 + c;
        br[ct] = FULL ? 0.f : F.inp(I_BR)[ix]; bi[ct] = FULL ? 0.f : F.inp(I_BI)[ix]; c8[ct] = FULL ? 0.f : 8.0f * log1pf(expf(-F.inp(I_LAM)[ix]));
        hc[ct] = FULL ? F.AGG()[AG_LRU_H + (size_t)u * 512 + DIR * 256 + c] : 0.f; At[ct] = 1.f; Bt[ct] = 0.f; }
#pragma unroll
    for (int ct = 0; ct < 2; ++ct) {
        const int c = 64 * n + 32 * ct + r32;
        bf16x8 Bg[2][4];
        if (!FULL) {
#pragma unroll
            for (int g = 0; g < 2; ++g) { const bf16* p = wb + (size_t)g * 4 * 4096 + (32 * ct + r32) * 64 + 8 * h;
#pragma unroll
                for (int ks = 0; ks < 4; ++ks) Bg[g][ks] = *(const bf16x8*)(p + 16 * ks); } }
#pragma unroll 1
        for (int mi = 0; mi < nmt; ++mi) {
            const int mt = DIR ? nmt - 1 - mi : mi;
            float a[16], bb[16];
            const size_t gix0 = (size_t)(rowbase + t0 + 32 * mt + 4 * h) * 512 + DIR * 256 + c;
            if (FULL) {
#pragma unroll
                for (int q = 0; q < 16; ++q) { const size_t ix = gix0 + (size_t)((q & 3) + 8 * (q >> 2)) * 512; a[q] = F.GA()[ix]; bb[q] = F.GB()[ix]; }
            } else {
                f32x16 acc[2];
#pragma unroll
                for (int g = 0; g < 2; ++g)
#pragma unroll
                    for (int q = 0; q < 16; ++q) acc[g][q] = 0.f;
#pragma unroll
                for (int ks = 0; ks < 4; ++ks) { const bf16x8 af = *(const LAS bf16x8*)(U + (32 * mt + r32) * U_PITCH + (64 * n + 16 * ks + 8 * h) * 2);
                    acc[0] = __builtin_amdgcn_mfma_f32_32x32x16_bf16(af, Bg[0][ks], acc[0], 0, 0, 0); acc[1] = __builtin_amdgcn_mfma_f32_32x32x16_bf16(af, Bg[1][ks], acc[1], 0, 0, 0); }
#pragma unroll
                for (int q = 0; q < 16; ++q) { const int t = 32 * mt + crow(q, h);
                    const float uu = bf2f(*(const LAS bf16*)(U + t * U_PITCH + c * 2));
                    const float r = sigmoidf_(acc[0][q] + br[ct]), ig = sigmoidf_(acc[1][q] + bi[ct]);
                    a[q] = __expf(-c8[ct] * r); bb[q] = __builtin_amdgcn_sqrtf(fmaxf(1.0f - a[q] * a[q], 1e-12f)) * ig * uu;
                    const size_t ix = gix0 + (size_t)((q & 3) + 8 * (q >> 2)) * 512; F.GA()[ix] = a[q]; F.GB()[ix] = bb[q]; }
            }
            float gA[4], gB[4], oA[4], oB[4];
#pragma unroll
            for (int g = 0; g < 4; ++g) { float A = 1.f, B = 0.f;
#pragma unroll
                for (int jj = 0; jj < 4; ++jj) { const int q = 4 * g + (DIR ? 3 - jj : jj); B = a[q] * B + bb[q]; A *= a[q]; }
                gA[g] = A; gB[g] = B; }
#pragma unroll
            for (int g = 0; g < 4; ++g) { oA[g] = shx(gA[g], 32, ln_); oB[g] = shx(gB[g], 32, ln_); }
            float st[4] = {0.f, 0.f, 0.f, 0.f}; float hs = hc[ct];
#pragma unroll
            for (int kk = 0; kk < 8; ++kk) { const int k = DIR ? 7 - kk : kk, g = k >> 1; const bool mine = ((k & 1) == h);
                const float Ak = mine ? gA[g] : oA[g], Bk = mine ? gB[g] : oB[g];
                if (FULL) { st[g] = mine ? hs : st[g]; hs = Ak * hs + Bk; }
                else { Bt[ct] = Ak * Bt[ct] + Bk; At[ct] *= Ak; } }
            if (FULL) {
                hc[ct] = hs;
#pragma unroll
                for (int g = 0; g < 4; ++g) { float hh = st[g];
#pragma unroll
                    for (int jj = 0; jj < 4; ++jj) { const int q = 4 * g + (DIR ? 3 - jj : jj); hh = a[q] * hh + bb[q];
                        F.HD()[(size_t)(rowbase + t0 + 32 * mt + crow(q, h)) * 512 + DIR * 256 + c] = hh; } }
            }
        }
        __builtin_amdgcn_sched_barrier(0);
    }
    if (!FULL && h == 0) {
#pragma unroll
        for (int ct = 0; ct < 2; ++ct) { const int c = 64 * n + 32 * ct + r32;
            F.AGG()[AG_LRU_A + (size_t)u * 512 + DIR * 256 + c] = At[ct]; F.AGG()[AG_LRU_B + (size_t)u * 512 + DIR * 256 + c] = Bt[ct]; }
    }
}
template <bool FULL>
__device__ __forceinline__ void ph_lru_fast(Ctx& F, int l) {
    LAS unsigned char* U = F.lds;
    for (int it = 0; it < 2; ++it) {
        const int u = it == 0 ? F.bid : 256 + (F.bid - 16);
        if (it == 0 ? (u >= 256) : (F.bid < 16 || F.bid >= 32 || F.G < 256)) continue;
        const MixUnit mu = mix_unit(u); const bool isc = mu.isc;
        if (FULL && isc && l == NL - 1) continue;
        const int rowbase = mu.rowbase, T = mu.T, t0 = mu.t0, ntok = mu.ntok;
        __syncthreads();
        if (!FULL) { const int c8 = (F.tid & 31) * 8, tr = F.tid >> 5;
          float w[4][8], cb[8];
#pragma unroll
          for (int jj = 0; jj < 4; ++jj) { const f32x4 w0 = *(const f32x4*)(F.inp(I_CONVW) + (l * 4 + jj) * 256 + c8), w1 = *(const f32x4*)(F.inp(I_CONVW) + (l * 4 + jj) * 256 + c8 + 4);
              w[jj][0] = w0.x; w[jj][1] = w0.y; w[jj][2] = w0.z; w[jj][3] = w0.w; w[jj][4] = w1.x; w[jj][5] = w1.y; w[jj][6] = w1.z; w[jj][7] = w1.w; }
          { const f32x4 b0 = *(const f32x4*)(F.inp(I_CONVB) + l * 256 + c8), b1 = *(const f32x4*)(F.inp(I_CONVB) + l * 256 + c8 + 4);
            cb[0] = b0.x; cb[1] = b0.y; cb[2] = b0.z; cb[3] = b0.w; cb[4] = b1.x; cb[5] = b1.y; cb[6] = b1.z; cb[7] = b1.w; }
#pragma unroll 4
          for (int i = 0; i < 8; ++i) { const int t = tr + 16 * i, tt = t0 + t;
              if (t >= ntok) break;
              float o[8];
#pragma unroll
              for (int e = 0; e < 8; ++e) o[e] = cb[e];
#pragma unroll
              for (int jj = 0; jj < 4; ++jj) { const int ts = tt - 2 + jj;
                  if (ts >= 0 && ts < T) { const u32x4 xw = *(const u32x4*)(F.P() + (size_t)(rowbase + ts) * INW + C_LX + c8);
                      o[0] += w[jj][0] * __uint_as_float(xw.x << 16); o[1] += w[jj][1] * __uint_as_float(xw.x & 0xffff0000u); o[2] += w[jj][2] * __uint_as_float(xw.y << 16); o[3] += w[jj][3] * __uint_as_float(xw.y & 0xffff0000u);
                      o[4] += w[jj][4] * __uint_as_float(xw.z << 16); o[5] += w[jj][5] * __uint_as_float(xw.z & 0xffff0000u); o[6] += w[jj][6] * __uint_as_float(xw.w << 16); o[7] += w[jj][7] * __uint_as_float(xw.w & 0xffff0000u); } }
              u32x4 ow; ow.x = pk2(o[0], o[1]); ow.y = pk2(o[2], o[3]); ow.z = pk2(o[4], o[5]); ow.w = pk2(o[6], o[7]);
              *(LAS u32x4*)(U + t * U_PITCH + c8 * 2) = ow; } }
        __syncthreads();
        { const int n = F.wave & 3;
          if (F.wave < 4) lru_wave<FULL, 0>(F, l, mu.ub, n, rowbase, t0, ntok >> 5); else lru_wave<FULL, 1>(F, l, mu.ub, n, rowbase, t0, ntok >> 5); }
        if (FULL) {
            __syncthreads();
#pragma unroll 4
            for (int i = F.tid; i < ntok * 64; i += NTHR) { const int t = i >> 6, c4 = (i & 63) * 4; const size_t row = (size_t)rowbase + t0 + t;
                const f32x4 hf = *(const f32x4*)(F.HD() + row * 512 + c4), hb = *(const f32x4*)(F.HD() + row * 512 + 256 + c4);
                const u32x2 gw = *(const u32x2*)(F.P() + row * INW + C_LG + c4);
                u32x2 w; w.x = pk2((hf.x + hb.x) * gelu_tanh(__uint_as_float(gw.x << 16)), (hf.y + hb.y) * gelu_tanh(__uint_as_float(gw.x & 0xffff0000u)));
                w.y = pk2((hf.z + hb.z) * gelu_tanh(__uint_as_float(gw.y << 16)), (hf.w + hb.w) * gelu_tanh(__uint_as_float(gw.y & 0xffff0000u)));
                *(u32x2*)(F.MIX() + row * D + 512 + c4) = w; }
        }
    }
}
__device__ __forceinline__ int mix_order(int d, int s) { return d ? 135 - s : (s < 8 ? 128 + s : s - 8); }
__device__ __forceinline__ void ph_lru_carry(Ctx& F) {
    const int gt = F.bid * NTHR + F.tid;
    if (gt >= NB * 512) return;
    const int b = gt >> 9, dc = gt & 511, d = dc >> 8;
    float h = 0.f;
#pragma unroll 1
    for (int s0 = 0; s0 < 136; s0 += 34) {
        float av[34], bv[34];
#pragma unroll
        for (int q = 0; q < 34; ++q) { const size_t ix = (size_t)(b * MIX_NUB + mix_order(d, s0 + q)) * 512 + dc; av[q] = F.AGG()[AG_LRU_A + ix]; bv[q] = F.AGG()[AG_LRU_B + ix]; }
#pragma unroll
        for (int q = 0; q < 34; ++q) { F.AGG()[AG_LRU_H + (size_t)(b * MIX_NUB + mix_order(d, s0 + q)) * 512 + dc] = h; h = av[q] * h + bv[q]; }
    }
}

constexpr int HG_NU = MIX_NU;
constexpr int HGW_LDS = 17152;
constexpr int KT_P = 36;
constexpr size_t AG_HG_D = 1048576, AG_HG_EBR = AG_HG_D + (size_t)HG_NU * 8 * 64;
__device__ __forceinline__ void hg_stage_v(const Ctx& F, LAS bf16* Vt, int rowbase, int c0, int hh, int r32, int h, int DIR) {
    const int t = c0 + (DIR ? 31 - r32 : r32); const bf16* vp = F.P() + (size_t)(rowbase + t) * INW + C_HV + hh * 64 + 32 * h;
#pragma unroll
    for (int c = 0; c < 4; ++c) { const u32x4 w = *(const u32x4*)(vp + 8 * c); const int v0 = 32 * h + 8 * c;
        Vt[(v0 + 0) * 32 + r32] = (bf16)(w.x & 0xffffu); Vt[(v0 + 1) * 32 + r32] = (bf16)(w.x >> 16); Vt[(v0 + 2) * 32 + r32] = (bf16)(w.y & 0xffffu); Vt[(v0 + 3) * 32 + r32] = (bf16)(w.y >> 16);
        Vt[(v0 + 4) * 32 + r32] = (bf16)(w.z & 0xffffu); Vt[(v0 + 5) * 32 + r32] = (bf16)(w.z >> 16); Vt[(v0 + 6) * 32 + r32] = (bf16)(w.w & 0xffffu); Vt[(v0 + 7) * 32 + r32] = (bf16)(w.w >> 16); }
}
__device__ __forceinline__ void hg_update_s(f32x16 (&S)[2][2], const LAS bf16* KiT, const LAS bf16* Vt, const LAS float* ebr, int r32, int h) {
#pragma unroll
    for (int kt = 0; kt < 2; ++kt) {
        float e1[16];
#pragma unroll
        for (int q = 0; q < 16; ++q) e1[q] = ebr[4 * h + (32 * kt + (q & 3) + 8 * (q >> 2))];
#pragma unroll
        for (int vt = 0; vt < 2; ++vt) { f32x16 tmp;
#pragma unroll
            for (int q = 0; q < 16; ++q) tmp[q] = 0.f;
#pragma unroll
            for (int ks = 0; ks < 2; ++ks) { const LAS bf16* kp = KiT + (32 * kt + r32) * KT_P + 16 * ks + 8 * h; const u32x2 klo = *(const LAS u32x2*)kp, khi = *(const LAS u32x2*)(kp + 4);
                u32x4 fau; fau.x = klo.x; fau.y = klo.y; fau.z = khi.x; fau.w = khi.y; const bf16x8 fa = __builtin_bit_cast(bf16x8, fau), fb = *(const LAS bf16x8*)(Vt + (32 * vt + r32) * 32 + 16 * ks + 8 * h);
                tmp = __builtin_amdgcn_mfma_f32_32x32x16_bf16(fa, fb, tmp, 0, 0, 0); }
#pragma unroll
            for (int q = 0; q < 16; ++q) S[kt][vt][q] = e1[q] * (e1[q] * S[kt][vt][q] + tmp[q]); }
    }
}
template <int DIR>
__device__ __forceinline__ void hg_wave_a(Ctx& F, int l, int u, int hh, int rowbase, int nch) {
    int ln_ = F.lane; asm volatile("" : "+v"(ln_));
    const int r32 = ln_ & 31, h = ln_ >> 5, k = ln_;
    LAS unsigned char* W = F.lds + F.wave * HGW_LDS;
    LAS bf16* Qi = (LAS bf16*)W; LAS bf16* Ki = (LAS bf16*)(W + 4096); LAS bf16* KiT = (LAS bf16*)(W + 8192); LAS bf16* Vt = (LAS bf16*)(W + 12800); LAS float* ebr = (LAS float*)(W + 16896);
    const int hd = DIR * 4 + hh;
    const float lb = hg_lb(F, l, DIR, hh * 64 + k);
    const unsigned lane_s = 4 * h * 64 + r32;
    f32x16 S[2][2];
#pragma unroll
    for (int kt = 0; kt < 2; ++kt)
#pragma unroll
        for (int vt = 0; vt < 2; ++vt)
#pragma unroll
            for (int q = 0; q < 16; ++q) S[kt][vt][q] = 0.f;
    float dsum = 0.f;
#pragma unroll 1
    for (int ci = 0; ci < nch; ++ci) {
        const int cph = DIR ? nch - 1 - ci : ci, c0 = 32 * cph;
        const int si = ln_ >> 1, sh = ln_ & 1; const int ts = c0 + (DIR ? 31 - si : si);
        { const bf16* zp = F.P() + (size_t)(rowbase + ts) * INW + (DIR ? C_HB : C_HF) + hh * 64 + 32 * sh;
          const bf16* qp = F.P() + (size_t)(rowbase + ts) * INW + C_HQ + hh * 64 + 32 * sh;
          u32x4 zz[4], qq[4];
#pragma unroll
          for (int c = 0; c < 4; ++c) { zz[c] = *(const u32x4*)(zp + 8 * c); qq[c] = *(const u32x4*)(qp + 8 * c); }
#pragma unroll
          for (int c = 0; c < 4; ++c) { *(LAS u32x4*)(Qi + si * 64 + 32 * sh + 8 * c) = zz[c]; *(LAS u32x4*)(Ki + si * 64 + 32 * sh + 8 * c) = qq[c]; } }
        hg_stage_v(F, Vt, rowbase, c0, hh, r32, h, DIR);
        asm volatile("s_waitcnt lgkmcnt(0)" ::: "memory");
        {
            float lf[32]; float run = 0.f;
#pragma unroll
            for (int i = 0; i < 32; ++i) { const float z = bf2f(Qi[i * 64 + k]); lf[i] = __logf(lb + (1.0f - lb) * sigmoidf_(z)); run += lf[i]; }
            const float bref = 0.5f * run; dsum += run;
            const float eb = __expf(bref);
            ebr[k] = eb; F.AGG()[AG_HG_EBR + (((size_t)u * 4 + cph) * 8 + hd) * 64 + k] = eb;
            float cum = 0.f;
#pragma unroll
            for (int i = 0; i < 32; ++i) {
                const float qq = bf2f(Ki[i * 64 + k]);
                cum += lf[i];
                const float e = __expf(cum - bref), ei = __expf(bref - cum);
                const unsigned kv = f2bf((1.0f - __expf(lf[i])) * ei);
                Ki[i * 64 + k] = (bf16)kv; KiT[k * KT_P + i] = (bf16)kv; Qi[i * 64 + k] = (bf16)f2bf(qq * e); }
        }
        asm volatile("s_waitcnt lgkmcnt(0)" ::: "memory");
        { bf16* qo = F.ws_bf16(WS_QI) + (size_t)(rowbase + ts) * 512 + DIR * 256 + hh * 64 + 32 * sh; bf16* ko = F.ws_bf16(WS_KI) + (size_t)(rowbase + ts) * 512 + DIR * 256 + hh * 64 + 32 * sh;
#pragma unroll
          for (int c = 0; c < 4; ++c) { *(u32x4*)(qo + 8 * c) = *(const LAS u32x4*)(Qi + si * 64 + 32 * sh + 8 * c); *(u32x4*)(ko + 8 * c) = *(const LAS u32x4*)(Ki + si * 64 + 32 * sh + 8 * c); } }
        hg_update_s(S, KiT, Vt, ebr, r32, h);
        asm volatile("s_waitcnt lgkmcnt(0)" ::: "memory");
    }
    float* sa = (float*)(F.ws + WS_SAGG) + ((size_t)u * 8 + hd) * 4096;
#pragma unroll
    for (int kt = 0; kt < 2; ++kt)
#pragma unroll
        for (int vt = 0; vt < 2; ++vt)
#pragma unroll
            for (int q = 0; q < 16; ++q) sa[lane_s + (unsigned)((32 * kt + (q & 3) + 8 * (q >> 2)) * 64 + 32 * vt)] = S[kt][vt][q];
    F.AGG()[AG_HG_D + ((size_t)u * 8 + hd) * 64 + k] = __expf(dsum);
}
template <int DIR>
__device__ __forceinline__ void hg_wave_c(Ctx& F, int l, int u, int hh, int rowbase, int nch) {
    int ln_ = F.lane; asm volatile("" : "+v"(ln_));
    const int r32 = ln_ & 31, h = ln_ >> 5, k = ln_;
    LAS unsigned char* W = F.lds + F.wave * HGW_LDS;
    LAS bf16* Qi = (LAS bf16*)W; LAS bf16* Ki = (LAS bf16*)(W + 4096); LAS bf16* KiT = (LAS bf16*)(W + 8192); LAS bf16* Vt = (LAS bf16*)(W + 12800); LAS float* ebr = (LAS float*)(W + 16896);
    const int hd = DIR * 4 + hh;
    const unsigned lane_s = 4 * h * 64 + r32;
    f32x16 S[2][2];
    { const float* sin = (const float*)(F.ws + WS_SIN) + ((size_t)u * 8 + hd) * 4096;
#pragma unroll
      for (int kt = 0; kt < 2; ++kt)
#pragma unroll
          for (int vt = 0; vt < 2; ++vt)
#pragma unroll
              for (int q = 0; q < 16; ++q) S[kt][vt][q] = sin[lane_s + (unsigned)((32 * kt + (q & 3) + 8 * (q >> 2)) * 64 + 32 * vt)]; }
#pragma unroll 1
    for (int ci = 0; ci < nch; ++ci) {
        const int cph = DIR ? nch - 1 - ci : ci, c0 = 32 * cph;
        { const int si = ln_ >> 1, sh = ln_ & 1; const int ts = c0 + (DIR ? 31 - si : si);
          const bf16* qo = F.ws_bf16(WS_QI) + (size_t)(rowbase + ts) * 512 + DIR * 256 + hh * 64 + 32 * sh; const bf16* ko = F.ws_bf16(WS_KI) + (size_t)(rowbase + ts) * 512 + DIR * 256 + hh * 64 + 32 * sh;
          u32x4 qq[4], kk[4];
#pragma unroll
          for (int c = 0; c < 4; ++c) { qq[c] = *(const u32x4*)(qo + 8 * c); kk[c] = *(const u32x4*)(ko + 8 * c); }
          ebr[k] = F.AGG()[AG_HG_EBR + (((size_t)u * 4 + cph) * 8 + hd) * 64 + k];
#pragma unroll
          for (int c = 0; c < 4; ++c) { *(LAS u32x4*)(Qi + si * 64 + 32 * sh + 8 * c) = qq[c]; *(LAS u32x4*)(Ki + si * 64 + 32 * sh + 8 * c) = kk[c];
              const int k0 = 32 * sh + 8 * c;
              KiT[(k0 + 0) * KT_P + si] = (bf16)(kk[c].x & 0xffffu); KiT[(k0 + 1) * KT_P + si] = (bf16)(kk[c].x >> 16); KiT[(k0 + 2) * KT_P + si] = (bf16)(kk[c].y & 0xffffu); KiT[(k0 + 3) * KT_P + si] = (bf16)(kk[c].y >> 16);
              KiT[(k0 + 4) * KT_P + si] = (bf16)(kk[c].z & 0xffffu); KiT[(k0 + 5) * KT_P + si] = (bf16)(kk[c].z >> 16); KiT[(k0 + 6) * KT_P + si] = (bf16)(kk[c].w & 0xffffu); KiT[(k0 + 7) * KT_P + si] = (bf16)(kk[c].w >> 16); } }
        hg_stage_v(F, Vt, rowbase, c0, hh, r32, h, DIR);
        asm volatile("s_waitcnt lgkmcnt(0)" ::: "memory");
        f32x16 att;
#pragma unroll
        for (int q = 0; q < 16; ++q) att[q] = 0.f;
#pragma unroll
        for (int ks = 0; ks < 4; ++ks) { const bf16x8 fa = *(const LAS bf16x8*)(Ki + r32 * 64 + 16 * ks + 8 * h), fb = *(const LAS bf16x8*)(Qi + r32 * 64 + 16 * ks + 8 * h);
            att = __builtin_amdgcn_mfma_f32_32x32x16_bf16(fa, fb, att, 0, 0, 0); }
#pragma unroll
        for (int q = 0; q < 16; ++q) att[q] = (crow(q, h) <= r32) ? att[q] : 0.f;
        f32x16 o[2];
#pragma unroll
        for (int vt = 0; vt < 2; ++vt)
#pragma unroll
            for (int q = 0; q < 16; ++q) o[vt][q] = 0.f;
#pragma unroll
        for (int ks = 0; ks < 2; ++ks) {
            u32x4 pa; pa.x = pk2(att[8 * ks + 0], att[8 * ks + 1]); pa.y = pk2(att[8 * ks + 2], att[8 * ks + 3]); pa.z = pk2(att[8 * ks + 4], att[8 * ks + 5]); pa.w = pk2(att[8 * ks + 6], att[8 * ks + 7]);
#pragma unroll
            for (int vt = 0; vt < 2; ++vt) { const LAS bf16* vp = Vt + (32 * vt + r32) * 32 + 16 * ks + 4 * h;
                const u32x2 lo = *(const LAS u32x2*)vp, hi2 = *(const LAS u32x2*)(vp + 8);
                u32x4 fb; fb.x = lo.x; fb.y = lo.y; fb.z = hi2.x; fb.w = hi2.y;
                o[vt] = __builtin_amdgcn_mfma_f32_32x32x16_bf16(__builtin_bit_cast(bf16x8, pa), __builtin_bit_cast(bf16x8, fb), o[vt], 0, 0, 0); } }
#pragma unroll
        for (int kt = 0; kt < 2; ++kt) {
            float e1[16];
#pragma unroll
            for (int q = 0; q < 16; ++q) e1[q] = ebr[4 * h + (32 * kt + (q & 3) + 8 * (q >> 2))];
#pragma unroll
            for (int ks = 0; ks < 2; ++ks) { const LAS bf16* qp = Qi + r32 * 64 + 32 * kt + 16 * ks + 4 * h;
                const u32x2 lo = *(const LAS u32x2*)qp, hi2 = *(const LAS u32x2*)(qp + 8);
                u32x4 fa; fa.x = lo.x; fa.y = lo.y; fa.z = hi2.x; fa.w = hi2.y;
#pragma unroll
                for (int vt = 0; vt < 2; ++vt) { u32x4 sb;
                    sb.x = pk2(S[kt][vt][8 * ks + 0] * e1[8 * ks + 0], S[kt][vt][8 * ks + 1] * e1[8 * ks + 1]); sb.y = pk2(S[kt][vt][8 * ks + 2] * e1[8 * ks + 2], S[kt][vt][8 * ks + 3] * e1[8 * ks + 3]);
                    sb.z = pk2(S[kt][vt][8 * ks + 4] * e1[8 * ks + 4], S[kt][vt][8 * ks + 5] * e1[8 * ks + 5]); sb.w = pk2(S[kt][vt][8 * ks + 6] * e1[8 * ks + 6], S[kt][vt][8 * ks + 7] * e1[8 * ks + 7]);
                    o[vt] = __builtin_amdgcn_mfma_f32_32x32x16_bf16(__builtin_bit_cast(bf16x8, fa), __builtin_bit_cast(bf16x8, sb), o[vt], 0, 0, 0); } }
        }
        { float* ob = F.OHG() + (size_t)(rowbase + c0) * 512 + DIR * 256 + hh * 64;
          const unsigned lane_o = (unsigned)((DIR ? 4 - 4 * h : 4 * h) * 512 + r32);
#pragma unroll
          for (int q = 0; q < 16; ++q) { const int iq = (q & 3) + 8 * (q >> 2); const unsigned cq = (unsigned)((DIR ? 27 - iq : iq) * 512);
              ob[lane_o + cq] = o[0][q]; ob[lane_o + cq + 32u] = o[1][q]; } }
        if (ci < nch - 1) hg_update_s(S, KiT, Vt, ebr, r32, h);
        asm volatile("s_waitcnt lgkmcnt(0)" ::: "memory");
    }
}
template <bool FULL>
__device__ __forceinline__ void ph_hgrn_fast(Ctx& F, int l) {
    for (int it = 0; it < 2; ++it) {
        const int u = it == 0 ? F.bid : 256 + (F.bid - 32);
        if (it == 0 ? (u >= 256) : (F.bid < 32 || F.bid >= 48 || F.G < 256)) continue;
        const MixUnit mu = mix_unit(u); const bool isc = mu.isc;
        if (FULL && isc && l == NL - 1) continue;
        const int rowbase = mu.rowbase + mu.t0, ntok = mu.ntok;
        __syncthreads();
        { const int hh = F.wave & 3;
          if (FULL) { if (F.wave < 4) hg_wave_c<0>(F, l, mu.ub, hh, rowbase, ntok >> 5); else hg_wave_c<1>(F, l, mu.ub, hh, rowbase, ntok >> 5); }
          else { if (F.wave < 4) hg_wave_a<0>(F, l, mu.ub, hh, rowbase, ntok >> 5); else hg_wave_a<1>(F, l, mu.ub, hh, rowbase, ntok >> 5); } }
        if (FULL) {
            __syncthreads();
#pragma unroll 4
            for (int rr = F.wave; rr < ntok; rr += NWAVES) { const size_t m = (size_t)rowbase + rr; const int col = 4 * F.lane;
                const f32x4 a = *(const f32x4*)(F.OHG() + m * 512 + col), bb = *(const f32x4*)(F.OHG() + m * 512 + 256 + col);
                const f32x4 o = a + bb;
                float ss = (o.x * o.x + o.y * o.y) + (o.z * o.z + o.w * o.w);
                ss += shx(ss, 1, F.lane); ss += shx(ss, 2, F.lane); ss += shx(ss, 4, F.lane); ss += shx(ss, 8, F.lane);
                const float rstd = 1.0f / sqrtf(ss * (1.0f / 64.0f) + EPS);
                const f32x4 g = *(const f32x4*)(F.inp(I_HNG) + l * 256 + col);
                const u32x2 ow = *(const u32x2*)(F.P() + m * INW + C_HO + col);
                const float g0 = siluf_(__uint_as_float(ow.x << 16)), g1 = siluf_(__uint_as_float(ow.x & 0xffff0000u)), g2 = siluf_(__uint_as_float(ow.y << 16)), g3 = siluf_(__uint_as_float(ow.y & 0xffff0000u));
                u32x2 w; w.x = pk2(o.x * rstd * g.x * g0, o.y * rstd * g.y * g1); w.y = pk2(o.z * rstd * g.z * g2, o.w * rstd * g.w * g3);
                *(u32x2*)(F.MIX() + m * D + 768 + col) = w; }
        }
    }
}
__device__ __forceinline__ void ph_hgrn_carry(Ctx& F) {
    const int gt = F.bid * NTHR + F.tid;
    if (gt >= 16 * 4096) return;
    const int seq = gt >> 12, e = gt & 4095, b = seq >> 3, hd = seq & 7, d = hd >> 2, kk = e >> 6;
    const float* SA = (const float*)(F.ws + WS_SAGG); float* SI = (float*)(F.ws + WS_SIN);
    float S = 0.f;
#pragma unroll 1
    for (int s0 = 0; s0 < 136; s0 += 34) {
        float dv[34], sv[34];
#pragma unroll
        for (int q = 0; q < 34; ++q) { const size_t ub = (size_t)(b * MIX_NUB + mix_order(d, s0 + q)) * 8 + hd; dv[q] = F.AGG()[AG_HG_D + ub * 64 + kk]; sv[q] = SA[ub * 4096 + e]; }
#pragma unroll
        for (int q = 0; q < 34; ++q) { const size_t ub = (size_t)(b * MIX_NUB + mix_order(d, s0 + q)) * 8 + hd; SI[ub * 4096 + e] = S; S = dv[q] * S + sv[q]; }
    }
}

constexpr int CV_GU = NE * 16 * 64, CV_DN = NE * 16 * 32, CV_ITEMS = CV_GU + CV_DN, CV_PER_WAVE = CV_ITEMS / 2048;
constexpr int PROG_OFF = 147456 - 256 + 24 * 4;
constexpr int AT_CVSCR = 2 * 2 * 64 * 144;
#ifndef ATTN_RIDE
#define ATTN_RIDE 0
#endif
constexpr int AT_KP = 144;
constexpr int AT_BUF = 2 * 64 * AT_KP;
__device__ __forceinline__ void ph_attn_fast(Ctx& F, int l) {
    int ln_ = F.lane; asm volatile("" : "+v"(ln_));
    const int r32 = ln_ & 31, h = ln_ >> 5, g = F.wave >> 1, ph = F.wave & 1;
    const int lrow = F.tid >> 3, lch = F.tid & 7;
    const int NU = (l == 0) ? 1040 : 1024;
    for (int it = 0; it < 5; ++it) {
        const int u = it < 4 ? F.bid + 256 * it : 1024 + (F.bid - 240);
        if (it == 4 && (F.bid < 240 || NU <= 1024)) continue;
        const bool isc = u >= 1024;
        int b, kvh, jb;
        if (!isc) { b = u >> 9; kvh = (u >> 8) & 1; jb = u & 255; } else { const int v = u - 1024; b = v >> 3; kvh = (v >> 2) & 1; jb = v & 3; }
        const int q0 = jb * 64, qrowbase = isc ? ML + b * CTXL : b * SEQ, hq = kvh * 4 + g;
        int i_lo = 0, nloc = 0;
        if (!isc) { i_lo = q0 < 128 ? (128 - q0) >> 6 : 0; const int i_hi = (q0 + 192 <= SEQ) ? 4 : ((q0 + 128 <= SEQ) ? 3 : 2); nloc = i_hi - i_lo + 1; }
        const int NT = nloc + 4;
        bf16x8 qf[4];
        { const bf16* qp = F.P() + (size_t)(qrowbase + q0 + 32 * ph + r32) * INW + C_Q + hq * 64 + 8 * h;
#pragma unroll
          for (int ks = 0; ks < 4; ++ks) qf[ks] = *(const bf16x8*)(qp + 16 * ks); }
        float m_run = F.inp(I_SINK)[l * 8 + hq] * LOG2E, l_run = (h == 0) ? 1.0f : 0.0f;
        f32x16 ot[2];
#pragma unroll
        for (int dt = 0; dt < 2; ++dt)
#pragma unroll
            for (int q = 0; q < 16; ++q) ot[dt][q] = 0.f;
        u32x4 kreg, vreg;
#define AT_LOAD(ti) do { const int ti_ = (ti); const bool loc_ = ti_ < nloc; const int kst_ = loc_ ? q0 - 128 + 64 * (i_lo + ti_) : 64 * (ti_ - nloc); \
        const size_t krow_ = loc_ ? (size_t)b * SEQ + kst_ : (size_t)ML + b * CTXL + kst_; \
        kreg = *(const u32x4*)(F.P() + (krow_ + lrow) * INW + C_K + kvh * 64 + lch * 8); \
        const size_t vo_ = loc_ ? ((size_t)((b * 2 + kvh) * 64 + lrow)) * SEQ + kst_ : VT_CTX_OFF + ((size_t)((b * 2 + kvh) * 64 + lrow)) * CTXL + kst_; \
        vreg = *(const u32x4*)(F.Vt() + vo_ + lch * 8); } while (0)
#define AT_STORE(slot) do { LAS unsigned char* d_ = F.lds + (slot) * AT_BUF + lrow * AT_KP + lch * 16; *(LAS u32x4*)d_ = kreg; *(LAS u32x4*)(d_ + 64 * AT_KP) = vreg; } while (0)
#define AT_QK(P0, P1, slot) do { const LAS unsigned char* Kb_ = F.lds + (slot) * AT_BUF; \
        _Pragma("unroll") for (int q = 0; q < 16; ++q) { P0[q] = 0.f; P1[q] = 0.f; } \
        _Pragma("unroll") for (int ks = 0; ks < 4; ++ks) { \
            const bf16x8 a0 = *(const LAS bf16x8*)(Kb_ + r32 * AT_KP + (16 * ks + 8 * h) * 2), a1 = *(const LAS bf16x8*)(Kb_ + (32 + r32) * AT_KP + (16 * ks + 8 * h) * 2); \
            P0 = __builtin_amdgcn_mfma_f32_32x32x16_bf16(a0, qf[ks], P0, 0, 0, 0); P1 = __builtin_amdgcn_mfma_f32_32x32x16_bf16(a1, qf[ks], P1, 0, 0, 0); } } while (0)
        __syncthreads();
        AT_LOAD(0); AT_STORE(0); AT_LOAD(1); AT_STORE(1);
        __syncthreads();
        f32x16 p0, p1;
        AT_QK(p0, p1, 0);
        int sc_ = 0, sn_ = 1, sw_ = 2;
#pragma unroll 1
        for (int ti = 0; ti < NT; ++ti) {
            if (ti + 2 < NT) AT_LOAD(ti + 2);
            f32x16 n0, n1;
            if (ti + 1 < NT) AT_QK(n0, n1, sn_);
            else {
#pragma unroll
                for (int q = 0; q < 16; ++q) { n0[q] = 0.f; n1[q] = 0.f; } }
            const LAS unsigned char* Vb = F.lds + sc_ * AT_BUF + 64 * AT_KP;
            const int itile = (ti < nloc) ? i_lo + ti : 2;
            if (itile == 0 || itile == 4) {
                int ql = 32 * ph + r32; asm volatile("" : "+v"(ql));
#pragma unroll
                for (int q = 0; q < 16; ++q) { const int k0 = crow(q, h), k1 = 32 + crow(q, h);
                    const bool v0 = (itile == 0) ? (k0 >= ql) : (k0 <= ql), v1 = (itile == 0) ? (k1 >= ql) : (k1 <= ql);
                    p0[q] = v0 ? p0[q] : -1.0e30f; p1[q] = v1 ? p1[q] : -1.0e30f; }
            }
            float tm = fmaxf(fmaxf(p0[0], p1[0]), fmaxf(p0[1], p1[1]));
#pragma unroll
            for (int q = 2; q < 16; q += 2) tm = fmaxf(fmaxf(tm, fmaxf(p0[q], p1[q])), fmaxf(p0[q + 1], p1[q + 1]));
            tm = fmaxf(tm, shx(tm, 32, ln_));
            const float mn = fmaxf(m_run, tm);
            if (__builtin_amdgcn_ballot_w64(mn != m_run) != 0ull) {
                const float sc = __builtin_amdgcn_exp2f(m_run - mn);
                l_run *= sc;
#pragma unroll
                for (int dt = 0; dt < 2; ++dt)
#pragma unroll
                    for (int q = 0; q < 16; ++q) ot[dt][q] *= sc;
            }
            m_run = mn;
            float ls = 0.f;
#pragma unroll
            for (int q = 0; q < 16; ++q) { p0[q] = __builtin_amdgcn_exp2f(p0[q] - mn); p1[q] = __builtin_amdgcn_exp2f(p1[q] - mn); ls += p0[q] + p1[q]; }
            l_run += ls;
#pragma unroll
            for (int hk = 0; hk < 2; ++hk)
#pragma unroll
                for (int s = 0; s < 2; ++s) {
                    u32x4 pb;
                    if (hk == 0) { pb.x = pk2(p0[8 * s + 0], p0[8 * s + 1]); pb.y = pk2(p0[8 * s + 2], p0[8 * s + 3]); pb.z = pk2(p0[8 * s + 4], p0[8 * s + 5]); pb.w = pk2(p0[8 * s + 6], p0[8 * s + 7]); }
                    else { pb.x = pk2(p1[8 * s + 0], p1[8 * s + 1]); pb.y = pk2(p1[8 * s + 2], p1[8 * s + 3]); pb.z = pk2(p1[8 * s + 4], p1[8 * s + 5]); pb.w = pk2(p1[8 * s + 6], p1[8 * s + 7]); }
#pragma unroll
                    for (int dt = 0; dt < 2; ++dt) { const LAS unsigned char* vp = Vb + (32 * dt + r32) * AT_KP + (32 * hk + 16 * s + 4 * h) * 2;
                        const u32x2 lo = *(const LAS u32x2*)vp, hi2 = *(const LAS u32x2*)(vp + 16);
                        u32x4 fa; fa.x = lo.x; fa.y = lo.y; fa.z = hi2.x; fa.w = hi2.y;
                        ot[dt] = __builtin_amdgcn_mfma_f32_32x32x16_bf16(__builtin_bit_cast(bf16x8, fa), __builtin_bit_cast(bf16x8, pb), ot[dt], 0, 0, 0); } }
            if (ti + 2 < NT) AT_STORE(sw_);
            __syncthreads();
            p0 = n0; p1 = n1;
            { const int t_ = sc_; sc_ = sn_; sn_ = sw_; sw_ = t_; }
        }
#undef AT_LOAD
#undef AT_STORE
#undef AT_QK
        const float linv = 1.0f / (l_run + shx(l_run, 32, ln_));
        { bf16* op = F.MIX() + (size_t)(qrowbase + q0 + 32 * ph + r32) * D + hq * 64 + 4 * h;
#pragma unroll
          for (int dt = 0; dt < 2; ++dt)
#pragma unroll
              for (int gq = 0; gq < 4; ++gq) { u32x2 w; w.x = pk2(ot[dt][4 * gq + 0] * linv, ot[dt][4 * gq + 1] * linv); w.y = pk2(ot[dt][4 * gq + 2] * linv, ot[dt][4 * gq + 3] * linv);
                  *(u32x2*)(op + 32 * dt + 8 * gq) = w; } }
    }
}

__device__ __forceinline__ void ph_outproj_naive(Ctx& F, int l) {
    const int gw = F.bid * NWAVES + F.wave, NGW = F.G * NWAVES, r = F.lane & 31, h = F.lane >> 5;
    const int Mq = (l == 0) ? MA : ML;
    const bf16* Bt = F.WoutT() + (size_t)l * D * D;
    for (int ti = gw; ti < (Mq / 64) * (D / 64); ti += NGW) {
        const int rt = ti / (D / 64), ct = ti % (D / 64), m0 = rt * 64, c0 = ct * 64;
        f32x16 acc[2][2];
        sg_kloop(acc, F.MIX() + (size_t)(m0 + r) * D + 8 * h, F.MIX() + (size_t)(m0 + 32 + r) * D + 8 * h, Bt + (size_t)(c0 + r) * D + 8 * h, Bt + (size_t)(c0 + 32 + r) * D + 8 * h, D);
#pragma unroll
        for (int mt = 0; mt < 2; ++mt)
#pragma unroll
            for (int nt = 0; nt < 2; ++nt)
#pragma unroll
                for (int q = 0; q < 16; ++q) {
                    const int m = m0 + 32 * mt + crow(q, h), c = c0 + 32 * nt + r;
                    const float g2 = F.mods()[((size_t)l * 3 + mod_row(m)) * 6 * D + 2 * D + c];
                    F.P()[(size_t)m * D + c] = (bf16)f2bf(g2 * acc[mt][nt][q]);
                }
    }
}

__device__ __forceinline__ void ph_norm2_router(Ctx& F, int l, bool shadow = false) {
    const int Mq = (l == 0) ? MA : ML;
    LAS float* hs = (LAS float*)F.lds;
    LAS float* part = (LAS float*)(F.lds + 32768);
    LAS float* AC = (LAS float*)(F.lds + 98304);
    LAS float* BC = (LAS float*)(F.lds + 110592);
    LAS float* lg = (LAS float*)(F.lds + 122880);
    LAS float* tvi = (LAS float*)(F.lds + 123904);
    LAS int* lcnt = (LAS int*)(F.lds + 124928);
    LAS int* lbase = (LAS int*)(F.lds + 124928 + 128);
    LAS int* se = (LAS int*)(F.lds + 124928 + 256);
    LAS float* sg = (LAS float*)(F.lds + 124928 + 256 + 4096);
    const int e = F.tid & 31;
    const int eg = F.tid & 7, ks = F.tid >> 3;
    f32x4 wreg[16];
#pragma unroll
    for (int i = 0; i < 16; ++i) wreg[i] = *(const f32x4*)(F.inp(I_RW) + ((size_t)l * D + 16 * ks + i) * NE + 4 * eg);
    unsigned* cnt = (unsigned*)(F.ctl() + CW_CNT + l * 64 + (shadow ? 512 : 0));
    int* ltok = shadow ? (int*)(F.ws + WS_HMOE) : F.list_tok(); int* ldst = ltok + (size_t)NE * CAP; float* lgate = (float*)(ldst + (size_t)NE * CAP);
    __syncthreads();
    if (F.tid < 32) lcnt[F.tid] = 0;
    for (int i = F.tid; i < 3 * D; i += NTHR) { const int r = i >> 10, c = i & (D - 1); const float* mo = F.mods() + ((size_t)l * 3 + r) * 6 * D;
        AC[i] = F.inp(I_N2G)[l * D + c] * (1.0f + mo[4 * D + c]); BC[i] = mo[3 * D + c]; }
    f32x4 v[4]; u32x2 tv[4];
#define RT_LOAD(mm) do { const int m_ = (mm); \
        if (l == 0) { const float* s_ = m_ < ML ? F.inp(I_X) + (size_t)m_ * D : F.inp(I_CTX) + (size_t)(m_ - ML) * D; \
            _Pragma("unroll") for (int j = 0; j < 4; ++j) v[j] = *(const f32x4*)(s_ + 4 * F.lane + 256 * j); } \
        else { _Pragma("unroll") for (int j = 0; j < 4; ++j) { const u32x2 w_ = *(const u32x2*)(F.XL() + (size_t)m_ * D + 4 * F.lane + 256 * j); \
            v[j] = (f32x4){__uint_as_float(w_.x << 16), __uint_as_float(w_.x & 0xffff0000u), __uint_as_float(w_.y << 16), __uint_as_float(w_.y & 0xffff0000u)}; } } \
        _Pragma("unroll") for (int j = 0; j < 4; ++j) tv[j] = *(const u32x2*)(F.P() + (size_t)m_ * D + 4 * F.lane + 256 * j); } while (0)
    { const int m = F.bid * 8 + F.wave; if (m < Mq) RT_LOAD(m); }
    __syncthreads();
    int ti = 0;
    for (int base = F.bid * 8; base < Mq; base += F.G * 8, ++ti) {
        { const int m = base + F.wave;
          const int mr = mod_row(m);
          float ss = 0.f;
#pragma unroll
          for (int j = 0; j < 4; ++j) { v[j].x += __uint_as_float(tv[j].x << 16); v[j].y += __uint_as_float(tv[j].x & 0xffff0000u); v[j].z += __uint_as_float(tv[j].y << 16); v[j].w += __uint_as_float(tv[j].y & 0xffff0000u);
              { u32x2 xw; xw.x = pk2(v[j].x, v[j].y); xw.y = pk2(v[j].z, v[j].w); *(u32x2*)(F.XL() + (size_t)m * D + 4 * F.lane + 256 * j) = xw; }
              ss += (v[j].x * v[j].x + v[j].y * v[j].y) + (v[j].z * v[j].z + v[j].w * v[j].w); }
          const float rstd = __builtin_amdgcn_rsqf(wave_sum(ss, F.lane) * (1.0f / D) + EPS);
#pragma unroll
          for (int j = 0; j < 4; ++j) { const int col = 4 * F.lane + 256 * j;
              const f32x4 ga = *(const LAS f32x4*)(AC + mr * D + col), sh = *(const LAS f32x4*)(BC + mr * D + col);
              const f32x4 h = v[j] * rstd * ga + sh;
              if (MOE_FP8) *(unsigned*)((unsigned char*)F.H1() + (size_t)m * D + col) = pk_fp8x4(h.x, h.y, h.z, h.w);
              else { u32x2 w; w.x = pk2(h.x, h.y); w.y = pk2(h.z, h.w); *(u32x2*)(F.H1() + (size_t)m * D + col) = w; }
              *(LAS f32x4*)(hs + F.wave * D + col) = h; }
          const int mn = m + F.G * 8;
          if (mn < Mq) RT_LOAD(mn); }
        __syncthreads();
#pragma unroll
        for (int rr = 0; rr < 8; ++rr) { f32x4 a4 = {0.f, 0.f, 0.f, 0.f};
#pragma unroll
            for (int i = 0; i < 4; ++i) { const f32x4 hv = *(const LAS f32x4*)(hs + rr * D + ks * 16 + 4 * i);
                a4 += hv.x * wreg[4 * i]; a4 += hv.y * wreg[4 * i + 1]; a4 += hv.z * wreg[4 * i + 2]; a4 += hv.w * wreg[4 * i + 3]; }
            *(LAS f32x4*)(part + (rr * 64 + ks) * 32 + 4 * eg) = a4; }
        __syncthreads();
        if (F.tid < 256) {
            const int rr = F.tid >> 5; float s = F.inp(I_RB)[l * NE + e], s1 = 0.f, s2 = 0.f, s3 = 0.f;
#pragma unroll
            for (int q = 0; q < 64; q += 4) { s += part[(rr * 64 + q) * 32 + e]; s1 += part[(rr * 64 + q + 1) * 32 + e]; s2 += part[(rr * 64 + q + 2) * 32 + e]; s3 += part[(rr * 64 + q + 3) * 32 + e]; }
            s = (s + s1) + (s2 + s3);
            lg[rr * 32 + e] = s;
            asm volatile("s_waitcnt lgkmcnt(0)" ::: "memory");
            int rank = 0;
#pragma unroll
            for (int q = 0; q < 8; ++q) { const f32x4 x = *(const LAS f32x4*)(lg + rr * 32 + 4 * q);
                rank += (x.x > s || (x.x == s && 4 * q + 0 < e)) ? 1 : 0; rank += (x.y > s || (x.y == s && 4 * q + 1 < e)) ? 1 : 0;
                rank += (x.z > s || (x.z == s && 4 * q + 2 < e)) ? 1 : 0; rank += (x.w > s || (x.w == s && 4 * q + 3 < e)) ? 1 : 0; }
            if (rank < 4) { tvi[(rr * 4 + rank) * 2] = s; tvi[(rr * 4 + rank) * 2 + 1] = __int_as_float(e); }
            asm volatile("s_waitcnt lgkmcnt(0)" ::: "memory");
            const f32x4 c01 = *(const LAS f32x4*)(tvi + rr * 8), c23 = *(const LAS f32x4*)(tvi + rr * 8 + 4);
            const float p1 = __expf(c01.z - c01.x), p2 = __expf(c23.x - c01.x), p3 = __expf(c23.z - c01.x), den = 1.0f + p1 + p2 + p3;
            if (e < 4) { const float myv = e == 0 ? 1.0f : (e == 1 ? p1 : (e == 2 ? p2 : p3)); const int mye = __float_as_int(e == 0 ? c01.y : (e == 1 ? c01.w : (e == 2 ? c23.y : c23.w)));
                const int lp = __hip_atomic_fetch_add(lcnt + mye, 1, __ATOMIC_RELAXED, __HIP_MEMORY_SCOPE_WORKGROUP);
                se[ti * 32 + rr * 4 + e] = mye | (lp << 8); sg[ti * 32 + rr * 4 + e] = myv * frcp(den); }
        }
        __syncthreads();
    }
    if (F.tid < 32) lbase[F.tid] = (int)atomicAdd(cnt + F.tid, (unsigned)lcnt[F.tid]);
    __syncthreads();
    for (int i = F.tid; i < ti * 32; i += NTHR) {
        const int w = se[i], ee = w & 255, lp = w >> 8, m = F.bid * 8 + (i >> 5) * (F.G * 8) + ((i & 31) >> 2), j = i & 3;
        const size_t pos = (size_t)ee * CAP + lbase[ee] + lp;
        ltok[pos] = m; ldst[pos] = m * 4 + j; lgate[pos] = sg[i];
    }
}

#undef RT_LOAD
__device__ __forceinline__ void ph_moe_gu_naive(Ctx& F, int l) {
    const int gw = F.bid * NWAVES + F.wave, NGW = F.G * NWAVES, r = F.lane & 31, h = F.lane >> 5;
    const unsigned* cnt = (const unsigned*)(F.ctl() + CW_CNT + l * 64);
    int id0 = 0, ts256 = 0;
    for (int e = 0; e < NE; ++e) {
        const int ce = (int)__hip_atomic_load(cnt + e, __ATOMIC_RELAXED, __HIP_MEMORY_SCOPE_AGENT);
        const int nrt = (ce + 63) / 64, n = nrt * 32;
        const bf16* Bt = F.WguT() + ((size_t)l * NE + e) * 2 * FF * D;
        const float* bg = F.inp(I_BGU) + ((size_t)l * NE + e) * 2 * FF;
        int id = id0 + ((gw - id0 % NGW) + NGW) % NGW;
        for (; id < id0 + n; id += NGW) {
            const int rt = (id - id0) / 32, ft = (id - id0) % 32, pos0 = rt * 64, ff0 = ft * 32;
            const int p0 = pos0 + r, p1 = pos0 + 32 + r;
            const int t0 = p0 < ce ? F.list_tok()[(size_t)e * CAP + p0] : 0, t1 = p1 < ce ? F.list_tok()[(size_t)e * CAP + p1] : 0;
            const int ng = (ff0 >> 7) * 256 + (ff0 & 127) + r;
            f32x16 acc[2][2];
            sg_kloop(acc, F.H1() + (size_t)t0 * D + 8 * h, F.H1() + (size_t)t1 * D + 8 * h, Bt + (size_t)ng * D + 8 * h, Bt + (size_t)(ng + 128) * D + 8 * h, D);
            const float bgate = bg[ff0 + r], bup = bg[FF + ff0 + r];
#pragma unroll
            for (int mt = 0; mt < 2; ++mt)
#pragma unroll
                for (int q = 0; q < 16; ++q) {
                    const int pos = pos0 + 32 * mt + crow(q, h);
                    if (pos < ce) {
                        const float gate = fminf(acc[mt][0][q] + bgate, 7.0f), up = fminf(fmaxf(acc[mt][1][q] + bup, -7.0f), 7.0f);
                        const float glu = gate * sigmoidf_(1.702f * gate);
                        F.HMOE()[((size_t)ts256 * 256 + pos) * FF + ff0 + r] = (bf16)f2bf((up + 1.0f) * glu);
                    }
                }
        }
        id0 += n; ts256 += (ce + 255) / 256;
    }
}
__device__ __forceinline__ void ph_moe_down_naive(Ctx& F, int l) {
    const int gw = F.bid * NWAVES + F.wave, NGW = F.G * NWAVES, r = F.lane & 31, h = F.lane >> 5;
    const unsigned* cnt = (const unsigned*)(F.ctl() + CW_CNT + l * 64);
    int id0 = 0, ts256 = 0;
    for (int e = 0; e < NE; ++e) {
        const int ce = (int)__hip_atomic_load(cnt + e, __ATOMIC_RELAXED, __HIP_MEMORY_SCOPE_AGENT);
        const int nrt = (ce + 63) / 64, n = nrt * 16;
        const bf16* Bt = F.WdT() + ((size_t)l * NE + e) * D * FF;
        const float* bd = F.inp(I_BD) + ((size_t)l * NE + e) * D;
        int id = id0 + ((gw - id0 % NGW) + NGW) % NGW;
        for (; id < id0 + n; id += NGW) {
            const int rt = (id - id0) / 16, ct = (id - id0) % 16, pos0 = rt * 64, c0 = ct * 64;
            const bf16* A = F.HMOE() + ((size_t)ts256 * 256 + pos0) * FF;
            f32x16 acc[2][2];
            sg_kloop(acc, A + (size_t)r * FF + 8 * h, A + (size_t)(32 + r) * FF + 8 * h, Bt + (size_t)(c0 + r) * FF + 8 * h, Bt + (size_t)(c0 + 32 + r) * FF + 8 * h, FF);
#pragma unroll
            for (int mt = 0; mt < 2; ++mt)
#pragma unroll
                for (int q = 0; q < 16; ++q) {
                    const int pos = pos0 + 32 * mt + crow(q, h);
                    if (pos < ce) {
                        const int dst = F.list_dst()[(size_t)e * CAP + pos]; const float g = F.list_gate()[(size_t)e * CAP + pos];
#pragma unroll
                        for (int nt = 0; nt < 2; ++nt) { const int c = c0 + 32 * nt + r;
                            F.Y2()[(size_t)dst * D + c] = (bf16)f2bf(g * (acc[mt][nt][q] + bd[c])); }
                    }
                }
        }
        id0 += n; ts256 += (ce + 255) / 256;
    }
}

namespace pg8 {
constexpr int BM = 256, BK = 64, HALF = 128, HTB = HALF * BK * 2, STAGE_BYTES = 8 * HTB, NXCD = 8, WGM = 8;
__device__ __forceinline__ int lds_byte(int r, int c) { const int st = (r >> 4) * 2 + (c >> 5), rr = r & 15, cc = c & 31, ob = rr * 64 + cc * 2; return st * 1024 + (ob ^ (((ob >> 9) & 1) << 5)); }
__device__ __forceinline__ void stage_rc(int b, int& R, int& C) { const int st = b / 1024, sb = b % 1024, swz = sb ^ (((sb >> 9) & 1) << 5); R = (st >> 1) * 16 + swz / 64; C = (st & 1) * 32 + (swz % 64) / 2; }
__device__ __forceinline__ int perm32(int rho) { const int n = rho >> 4, i = rho & 15; return 8 * (i >> 2) + 4 * n + (i & 3); }
struct Unit { int pm, pn, e, pos0, ce; };
struct StaticOrder {
    int nM, nN, nwg, G, c;
    __device__ __forceinline__ void init(int M, int N, int G_, int c_) { nM = M / BM; nN = N / BM; nwg = nM * nN; G = G_; c = c_; }
    __device__ __forceinline__ bool next(int i, Unit& u) const {
        const long L = (long)i * G + c; if (L >= nwg) return false;
        int wgid = (int)L; { const int q = nwg / NXCD, r = nwg % NXCD, xcd = wgid % NXCD, off = wgid / NXCD; wgid = (xcd < r ? xcd * (q + 1) : r * (q + 1) + (xcd - r) * q) + off; }
        const int nig = WGM * nN, gid = wgid / nig, fm = gid * WGM, gsz = (nM - fm) < WGM ? (nM - fm) : WGM;
        u.pm = fm + ((wgid % nig) % gsz); u.pn = (wgid % nig) / gsz; u.e = 0; u.pos0 = 0; u.ce = 0; return true;
    }
};
__device__ __forceinline__ unsigned cvt_pk_bf16(float lo, float hi) { unsigned r; asm volatile("v_cvt_pk_bf16_f32 %0, %1, %2" : "=v"(r) : "v"(lo), "v"(hi)); return r; }
typedef f32x4 AccT[2][2][4][2];
template <class PB>
__device__ __forceinline__ void gemm_phase(LAS unsigned char* lds, const PB& pb, const int tid) {
    const int wid = __builtin_amdgcn_readfirstlane(tid >> 6), lane = tid & 63, wr = wid >> 2, wc = wid & 3, fr = lane & 15, fq = lane >> 4;
    constexpr int K = PB::K, nt = K / BK;
    unsigned voffB[2];
#pragma unroll
    for (int i = 0; i < 2; ++i) { int R, C; stage_rc(tid * 16 + i * 8192, R, C); const int Rb = PB::PERM ? ((R & ~31) + perm32(R & 31)) : R; voffB[i] = (unsigned)(Rb * K + C) * 2u; }
    constexpr size_t kstep = (size_t)(BK * 2);
    constexpr size_t hstep = (size_t)HALF * K * 2;
    const unsigned ldsw = (unsigned)wid * 1024u;
    const int aoff = lds_byte(wr * 64 + fr, fq * 8), boff = lds_byte(wc * 32 + fr, fq * 8);
#define PG8_SA(b, h) (((b) * 2 + (h)) * HTB)
#define PG8_SB(b, h) ((4 + (b) * 2 + (h)) * HTB)
#define PG8_STAGE(bufoff, gbase, voff) do { _Pragma("unroll") for (int _i = 0; _i < 2; ++_i) \
        __builtin_amdgcn_global_load_lds((const unsigned*)((const char*)(gbase) + (voff)[_i]), (LAS unsigned*)(lds + (bufoff) + ldsw + _i * 8192), 16, 0, 0); } while (0)
#define PG8_LDA(dst, b, h) do { _Pragma("unroll") for (int m = 0; m < 4; ++m) _Pragma("unroll") for (int k = 0; k < 2; ++k) dst[m][k] = *(const LAS bf16x8*)(lds + PG8_SA(b, h) + aoff + m * 2048 + k * 1024); } while (0)
#define PG8_LDB(dst, b, h) do { _Pragma("unroll") for (int n = 0; n < 2; ++n) _Pragma("unroll") for (int k = 0; k < 2; ++k) dst[n][k] = *(const LAS bf16x8*)(lds + PG8_SB(b, h) + boff + n * 2048 + k * 1024); } while (0)
#define PG8_MMA(ai, bj, At, Bt) do { __builtin_amdgcn_s_setprio(1); _Pragma("unroll") for (int m = 0; m < 4; ++m) _Pragma("unroll") for (int n = 0; n < 2; ++n) _Pragma("unroll") for (int k = 0; k < 2; ++k) \
        acc[ai][bj][m][n] = __builtin_amdgcn_mfma_f32_16x16x32_bf16(Bt[n][k], At[m][k], acc[ai][bj][m][n], 0, 0, 0); __builtin_amdgcn_s_setprio(0); } while (0)
#define PG8_WAIT_V(n) asm volatile("s_waitcnt vmcnt(" #n ")" ::: "memory")
#define PG8_WAIT_L(n) asm volatile("s_waitcnt lgkmcnt(" #n ")" ::: "memory")
#define PG8_BAR __builtin_amdgcn_s_barrier()
#define PG8_SCHED __builtin_amdgcn_sched_barrier(0)
    Unit cur, nxt; int ui = 0;
    if (!pb.next(0, cur)) return;
    f32x4 acc[2][2][4][2];
#pragma unroll
    for (int a = 0; a < 2; ++a)
#pragma unroll
        for (int b = 0; b < 2; ++b)
#pragma unroll
            for (int m = 0; m < 4; ++m)
#pragma unroll
                for (int n = 0; n < 2; ++n) acc[a][b][m][n] = (f32x4){0.f, 0.f, 0.f, 0.f};
    bf16x8 At[4][2], B0[2][2], B1[2][2];
    unsigned cv[2][2];
    pb.a_voff(cur, cv, tid);
    const char* cA = pb.a_base(cur); const char* cB = pb.b_base(cur);
    PG8_STAGE(PG8_SB(0, 0), cB, voffB); PG8_STAGE(PG8_SB(0, 1), cB + hstep, voffB); PG8_STAGE(PG8_SA(0, 0), cA, cv[0]); PG8_STAGE(PG8_SA(0, 1), cA, cv[1]);
    if (wr == 1) PG8_BAR;
    PG8_WAIT_V(2); PG8_BAR;
    PG8_STAGE(PG8_SB(1, 0), cB + kstep, voffB); PG8_STAGE(PG8_SA(1, 0), cA + kstep, cv[0]); PG8_STAGE(PG8_SB(1, 1), cB + hstep + kstep, voffB);
    PG8_WAIT_V(6); PG8_BAR;
    for (;;) {
        const bool has_next = pb.next(ui + 1, nxt);
        const char* nA = has_next ? pb.a_base(nxt) : cA; const char* nB = has_next ? pb.b_base(nxt) : cB;
        for (int t = 0; t < nt; t += 2) {
            const bool last = (t == nt - 2);
            const char* a1 = cA + (size_t)(t + 1) * kstep;
            const char* a2 = last ? nA : cA + (size_t)(t + 2) * kstep; const char* b2 = last ? nB : cB + (size_t)(t + 2) * kstep;
            const char* a3 = a2 + kstep; const char* b3 = b2 + kstep;
            if (PB::GATHER && t == nt - 4 && has_next) pb.tok_prefetch(nxt, lds, tid, wid);
            if (PB::GATHER && last && has_next) pb.a_voff_half_lds(cv[0], lds, tid, wid, 0);
            PG8_LDB(B0, 0, 0); PG8_LDB(B1, 0, 1); PG8_SCHED; PG8_LDA(At, 0, 0); PG8_STAGE(PG8_SA(1, 1), a1, cv[1]);
            if (PB::GATHER && last && has_next) pb.a_voff_half_lds(cv[1], lds, tid, wid, 1);
            PG8_WAIT_V(8); PG8_WAIT_L(0); PG8_BAR; PG8_MMA(0, 0, At, B0); PG8_MMA(0, 1, At, B1); PG8_BAR; PG8_SCHED;
            PG8_LDA(At, 0, 1); PG8_STAGE(PG8_SB(0, 0), b2, voffB); PG8_STAGE(PG8_SB(0, 1), b2 + hstep, voffB); PG8_STAGE(PG8_SA(0, 0), a2, cv[0]);
            PG8_WAIT_V(8); PG8_WAIT_L(0); PG8_BAR; PG8_MMA(1, 0, At, B0); PG8_MMA(1, 1, At, B1); PG8_BAR; PG8_SCHED;
            PG8_LDB(B0, 1, 0); PG8_LDB(B1, 1, 1); PG8_SCHED; PG8_LDA(At, 1, 0); PG8_STAGE(PG8_SA(0, 1), a2, cv[1]);
            PG8_WAIT_V(8); PG8_WAIT_L(0); PG8_BAR; PG8_MMA(0, 0, At, B0); PG8_MMA(0, 1, At, B1); PG8_BAR; PG8_SCHED;
            PG8_LDA(At, 1, 1); PG8_STAGE(PG8_SB(1, 0), b3, voffB); PG8_STAGE(PG8_SB(1, 1), b3 + hstep, voffB); PG8_STAGE(PG8_SA(1, 0), a3, cv[0]);
            PG8_WAIT_V(8); PG8_WAIT_L(0); PG8_BAR; PG8_MMA(1, 0, At, B0); PG8_MMA(1, 1, At, B1); PG8_BAR; PG8_SCHED;
        }
        if (wr == 0) PG8_BAR;
        pb.epi(acc, cur, wr, wc, fr, fq);
        if (!has_next) break;
#pragma unroll
        for (int a = 0; a < 2; ++a)
#pragma unroll
            for (int b = 0; b < 2; ++b)
#pragma unroll
                for (int m = 0; m < 4; ++m)
#pragma unroll
                    for (int n = 0; n < 2; ++n) acc[a][b][m][n] = (f32x4){0.f, 0.f, 0.f, 0.f};
        cur = nxt; cA = nA; cB = nB; ++ui;
        if (wr == 1) PG8_BAR;
    }
    PG8_WAIT_V(0);
    PG8_BAR;
#undef PG8_SA
#undef PG8_SB
#undef PG8_STAGE
#undef PG8_LDA
#undef PG8_LDB
#undef PG8_MMA
#undef PG8_WAIT_V
#undef PG8_WAIT_L
#undef PG8_BAR
#undef PG8_SCHED
}
typedef int v4i_t __attribute__((ext_vector_type(4)));
typedef int v8i_t __attribute__((ext_vector_type(8)));
template <class PB>
__device__ __forceinline__ void gemm_phase8(LAS unsigned char* lds, const PB& pb, const int tid) {
    const int wid = __builtin_amdgcn_readfirstlane(tid >> 6), lane = tid & 63, wr = wid >> 2, wc = wid & 3, fr = lane & 15, fq = lane >> 4;
    constexpr int K = PB::K  , nt = K / 128;
    unsigned vb0, va0;
    { int R, C; stage_rc(tid * 16, R, C); const int Rb = PB::PERM ? ((R & ~31) + perm32(R & 31)) : R; vb0 = (unsigned)(Rb * K + C * 2); va0 = (unsigned)(R * K + C * 2); }
    constexpr size_t kstep = (size_t)(BK * 2);
    constexpr size_t hstep = (size_t)HALF * K;
    const unsigned ldsw = (unsigned)wid * 1024u;
    const int aoff = lds_byte(wr * 64 + fr, fq * 8), boff = lds_byte(wc * 32 + fr, fq * 8);
#define PG8_SA(b, h) (((b) * 2 + (h)) * HTB)
#define PG8_SB(b, h) ((4 + (b) * 2 + (h)) * HTB)
#define PG8_STAGE_B(bufoff, gbase) do { _Pragma("unroll") for (int _i = 0; _i < 2; ++_i) \
        __builtin_amdgcn_global_load_lds((const unsigned*)((const char*)(gbase) + (size_t)(_i * 64) * K + vb0), (LAS unsigned*)(lds + (bufoff) + ldsw + _i * 8192), 16, 0, 0); } while (0)
#define PG8_STAGE_A(bufoff, gbase, h) do { _Pragma("unroll") for (int _i = 0; _i < 2; ++_i) { \
        const char* p_ = PB::GATHER ? (const char*)(gbase) + cv[h][_i] : (const char*)(gbase) + (size_t)((h) * 128 + _i * 64) * K + va0; \
        __builtin_amdgcn_global_load_lds((const unsigned*)p_, (LAS unsigned*)(lds + (bufoff) + ldsw + _i * 8192), 16, 0, 0); } } while (0)
#define PG8_LDA(dst, b, h) do { _Pragma("unroll") for (int m = 0; m < 4; ++m) { const v4i_t lo_ = *(const LAS v4i_t*)(lds + PG8_SA(b, h) + aoff + m * 2048), hi_ = *(const LAS v4i_t*)(lds + PG8_SA(b, h) + aoff + m * 2048 + 1024); dst[m] = __builtin_shufflevector(lo_, hi_, 0, 1, 2, 3, 4, 5, 6, 7); } } while (0)
#define PG8_LDB(dst, b, h) do { _Pragma("unroll") for (int n = 0; n < 2; ++n) { const v4i_t lo_ = *(const LAS v4i_t*)(lds + PG8_SB(b, h) + boff + n * 2048), hi_ = *(const LAS v4i_t*)(lds + PG8_SB(b, h) + boff + n * 2048 + 1024); dst[n] = __builtin_shufflevector(lo_, hi_, 0, 1, 2, 3, 4, 5, 6, 7); } } while (0)
#define PG8_MMA(ai, bj, At, Bt) do { __builtin_amdgcn_s_setprio(1); _Pragma("unroll") for (int m = 0; m < 4; ++m) _Pragma("unroll") for (int n = 0; n < 2; ++n) \
        asm volatile("v_mfma_scale_f32_16x16x128_f8f6f4 %0, %1, %2, %0, %3, %3 op_sel_hi:[0,0,0]" : "+v"(acc[ai][bj][m][n]) : "v"(Bt[n]), "v"(At[m]), "v"(sc1)); \
        __builtin_amdgcn_s_setprio(0); } while (0)
#define PG8_WAIT_V(n) asm volatile("s_waitcnt vmcnt(" #n ")" ::: "memory")
#define PG8_WAIT_L(n) asm volatile("s_waitcnt lgkmcnt(" #n ")" ::: "memory")
#define PG8_BAR __builtin_amdgcn_s_barrier()
#define PG8_SCHED __builtin_amdgcn_sched_barrier(0)
    Unit cur, nxt; int ui = 0;
    if (!pb.next(0, cur)) return;
    f32x4 acc[2][2][4][2];
#pragma unroll
    for (int a = 0; a < 2; ++a)
#pragma unroll
        for (int b = 0; b < 2; ++b)
#pragma unroll
            for (int m = 0; m < 4; ++m)
#pragma unroll
                for (int n = 0; n < 2; ++n) acc[a][b][m][n] = (f32x4){0.f, 0.f, 0.f, 0.f};
    v8i_t At[4], B0[2], B1[2];
    int sc1 = 0x7f7f7f7f; asm volatile("" : "+v"(sc1));
    unsigned cv[2][2];
    if (PB::GATHER) pb.a_voff(cur, cv, tid); else { cv[0][0] = cv[0][1] = cv[1][0] = cv[1][1] = 0u; }
    const char* cA = pb.a_base(cur); const char* cB = pb.b_base(cur);
    PG8_STAGE_B(PG8_SB(0, 0), cB); PG8_STAGE_B(PG8_SB(0, 1), cB + hstep); PG8_STAGE_A(PG8_SA(0, 0), cA, 0); PG8_STAGE_A(PG8_SA(0, 1), cA, 1);
    if (wr == 1) PG8_BAR;
    PG8_WAIT_V(2); PG8_BAR;
    PG8_STAGE_B(PG8_SB(1, 0), cB + kstep); PG8_STAGE_A(PG8_SA(1, 0), cA + kstep, 0); PG8_STAGE_B(PG8_SB(1, 1), cB + hstep + kstep);
    PG8_WAIT_V(6); PG8_BAR;
    for (;;) {
        const bool has_next = pb.next(ui + 1, nxt);
        const char* nA = has_next ? pb.a_base(nxt) : cA; const char* nB = has_next ? pb.b_base(nxt) : cB;
#pragma unroll 1
        for (int t = 0; t < nt; t += 2) {
            const bool last = (t == nt - 2);
            const char* a1 = cA + (size_t)(t + 1) * kstep;
            const char* a2 = last ? nA : cA + (size_t)(t + 2) * kstep; const char* b2 = last ? nB : cB + (size_t)(t + 2) * kstep;
            const char* a3 = a2 + kstep; const char* b3 = b2 + kstep;
            if (PB::GATHER && t == nt - 4 && has_next) pb.tok_prefetch(nxt, lds, tid, wid);
            if (PB::GATHER && last && has_next) pb.a_voff_half_lds(cv[0], lds, tid, wid, 0);
            PG8_LDB(B0, 0, 0); PG8_LDB(B1, 0, 1); PG8_SCHED; PG8_LDA(At, 0, 0); PG8_STAGE_A(PG8_SA(1, 1), a1, 1);
            if (PB::GATHER && last && has_next) pb.a_voff_half_lds(cv[1], lds, tid, wid, 1);
            PG8_WAIT_V(8); PG8_WAIT_L(0); PG8_BAR; PG8_MMA(0, 0, At, B0); PG8_MMA(0, 1, At, B1); PG8_BAR; PG8_SCHED;
            PG8_LDA(At, 0, 1); PG8_STAGE_B(PG8_SB(0, 0), b2); PG8_STAGE_B(PG8_SB(0, 1), b2 + hstep); PG8_STAGE_A(PG8_SA(0, 0), a2, 0);
            PG8_WAIT_V(8); PG8_WAIT_L(0); PG8_BAR; PG8_MMA(1, 0, At, B0); PG8_MMA(1, 1, At, B1); PG8_BAR; PG8_SCHED;
            PG8_LDB(B0, 1, 0); PG8_LDB(B1, 1, 1); PG8_SCHED; PG8_LDA(At, 1, 0); PG8_STAGE_A(PG8_SA(0, 1), a2, 1);
            PG8_WAIT_V(8); PG8_WAIT_L(0); PG8_BAR; PG8_MMA(0, 0, At, B0); PG8_MMA(0, 1, At, B1); PG8_BAR; PG8_SCHED;
            PG8_LDA(At, 1, 1); PG8_STAGE_B(PG8_SB(1, 0), b3); PG8_STAGE_B(PG8_SB(1, 1), b3 + hstep); PG8_STAGE_A(PG8_SA(1, 0), a3, 0);
            PG8_WAIT_V(8); PG8_WAIT_L(0); PG8_BAR; PG8_MMA(1, 0, At, B0); PG8_MMA(1, 1, At, B1); PG8_BAR; PG8_SCHED;
        }
        if (wr == 0) PG8_BAR;
        asm volatile("s_nop 15\n\ts_nop 15" ::: "memory");
        { int fr_ = fr, fq_ = fq; asm volatile("" : "+v"(fr_), "+v"(fq_));
          pb.epi(acc, cur, wr, wc, fr_, fq_); }
        if (!has_next) break;
#pragma unroll
        for (int a = 0; a < 2; ++a)
#pragma unroll
            for (int b = 0; b < 2; ++b)
#pragma unroll
                for (int m = 0; m < 4; ++m)
#pragma unroll
                    for (int n = 0; n < 2; ++n) acc[a][b][m][n] = (f32x4){0.f, 0.f, 0.f, 0.f};
        cur = nxt; cA = nA; cB = nB; ++ui;
        if (wr == 1) PG8_BAR;
    }
    PG8_WAIT_V(0);
    PG8_BAR;
#undef PG8_SA
#undef PG8_SB
#undef PG8_STAGE_A
#undef PG8_STAGE_B
#undef PG8_LDA
#undef PG8_LDB
#undef PG8_MMA
#undef PG8_WAIT_V
#undef PG8_WAIT_L
#undef PG8_BAR
#undef PG8_SCHED
}
__device__ __forceinline__ void voff_contig8(unsigned (&v)[2][2], int tid, int KB) {
#pragma unroll
    for (int i = 0; i < 2; ++i) { int R, C; stage_rc(tid * 16 + i * 8192, R, C); v[0][i] = (unsigned)(R * KB + C * 2); v[1][i] = (unsigned)((R + HALF) * KB + C * 2); }
}
__device__ __forceinline__ void voff_contig(unsigned (&v)[2][2], int tid, int K) {
#pragma unroll
    for (int i = 0; i < 2; ++i) { int R, C; stage_rc(tid * 16 + i * 8192, R, C); v[0][i] = (unsigned)(R * K + C) * 2u; v[1][i] = (unsigned)((R + HALF) * K + C) * 2u; }
}
}

struct PbInproj {
    static constexpr int K = D; static constexpr bool PERM = true, GATHER = false;
    const bf16* A; const bf16* Bt; bf16* P; bf16* Vt; const f32x2* rope; pg8::StaticOrder S;
    __device__ __forceinline__ bool next(int i, pg8::Unit& u) const { return S.next(i, u); }
    __device__ __forceinline__ const char* a_base(const pg8::Unit& u) const { return (const char*)A + (size_t)u.pm * 256 * K * 2; }
    __device__ __forceinline__ const char* b_base(const pg8::Unit& u) const { return (const char*)Bt + (size_t)u.pn * 256 * K * 2; }
    __device__ __forceinline__ void a_voff(const pg8::Unit&, unsigned (&v)[2][2], int tid) const { pg8::voff_contig(v, tid, K); }
    __device__ __forceinline__ void tok_prefetch(const pg8::Unit&, LAS unsigned char*, int, int) const {}
    __device__ __forceinline__ void a_voff_half_lds(unsigned (&)[2], LAS unsigned char*, int, int, int) const {}
    __device__ __forceinline__ void epi(const pg8::AccT& acc, const pg8::Unit& u, int wr, int wc, int fr, int fq) const {
        const int row0 = u.pm * 256 + wr * 64 + fr; const bool lat = row0 < ML;
#pragma unroll
        for (int ai = 0; ai < 2; ++ai)
#pragma unroll
            for (int m = 0; m < 4; ++m) {
                const int row = row0 + ai * 128 + m * 16; const int t = row & (SEQ - 1);
#pragma unroll
                for (int bj = 0; bj < 2; ++bj) {
                    const int c0 = u.pn * 256 + bj * 128 + wc * 32 + 8 * fq;
                    f32x4 v0 = acc[ai][bj][m][0], v1 = acc[ai][bj][m][1];
                    if (c0 < C_V) {
                        if (lat) {
                            const int pr0 = (c0 & 63) >> 1, p = pr0 >> 4, f0 = pr0 & 15, pos = p ? (t & 63) : (t >> 6);
                            const f32x4 ca = *(const f32x4*)(rope + pos * 16 + f0), cb = *(const f32x4*)(rope + pos * 16 + f0 + 2);
                            const f32x4 w0 = {v0.x * ca.x - v0.y * ca.y, v0.x * ca.y + v0.y * ca.x, v0.z * ca.z - v0.w * ca.w, v0.z * ca.w + v0.w * ca.z};
                            const f32x4 w1 = {v1.x * cb.x - v1.y * cb.y, v1.x * cb.y + v1.y * cb.x, v1.z * cb.z - v1.w * cb.w, v1.z * cb.w + v1.w * cb.z};
                            v0 = w0; v1 = w1;
                        }
                        if (c0 < C_K) { v0 *= QSCALE; v1 *= QSCALE; }
                    }
                    u32x4 w; w.x = pg8::cvt_pk_bf16(v0.x, v0.y); w.y = pg8::cvt_pk_bf16(v0.z, v0.w); w.z = pg8::cvt_pk_bf16(v1.x, v1.y); w.w = pg8::cvt_pk_bf16(v1.z, v1.w);
                    *(u32x4*)(P + (size_t)row * INW + c0) = w;
                    if (c0 >= C_V && c0 < C_LX) {
                        const size_t vi = vt_index(row, c0 - C_V); const size_t st = row < ML ? SEQ : CTXL;
                        Vt[vi] = (bf16)(w.x & 0xffffu); Vt[vi + st] = (bf16)(w.x >> 16); Vt[vi + 2 * st] = (bf16)(w.y & 0xffffu); Vt[vi + 3 * st] = (bf16)(w.y >> 16);
                        Vt[vi + 4 * st] = (bf16)(w.z & 0xffffu); Vt[vi + 5 * st] = (bf16)(w.z >> 16); Vt[vi + 6 * st] = (bf16)(w.w & 0xffffu); Vt[vi + 7 * st] = (bf16)(w.w >> 16);
                    }
                }
            }
    }
};
struct PbOutproj {
    static constexpr int K = D; static constexpr bool PERM = true, GATHER = false;
    const bf16* A; const bf16* Bt; bf16* TMP; const float* mods_l; pg8::StaticOrder S;
    __device__ __forceinline__ bool next(int i, pg8::Unit& u) const { return S.next(i, u); }
    __device__ __forceinline__ const char* a_base(const pg8::Unit& u) const { return (const char*)A + (size_t)u.pm * 256 * K * 2; }
    __device__ __forceinline__ const char* b_base(const pg8::Unit& u) const { return (const char*)Bt + (size_t)u.pn * 256 * K * 2; }
    __device__ __forceinline__ void a_voff(const pg8::Unit&, unsigned (&v)[2][2], int tid) const { pg8::voff_contig(v, tid, K); }
    __device__ __forceinline__ void tok_prefetch(const pg8::Unit&, LAS unsigned char*, int, int) const {}
    __device__ __forceinline__ void a_voff_half_lds(unsigned (&)[2], LAS unsigned char*, int, int, int) const {}
    __device__ __forceinline__ void epi(const pg8::AccT& acc, const pg8::Unit& u, int wr, int wc, int fr, int fq) const {
        const int row0 = u.pm * 256 + wr * 64 + fr;
        const float* g2 = mods_l + (size_t)mod_row(u.pm * 256) * 6 * D + 2 * D;
        f32x4 gv[2][2];
#pragma unroll
        for (int bj = 0; bj < 2; ++bj) { const int c0 = u.pn * 256 + bj * 128 + wc * 32 + 8 * fq; gv[bj][0] = *(const f32x4*)(g2 + c0); gv[bj][1] = *(const f32x4*)(g2 + c0 + 4); }
#pragma unroll
        for (int ai = 0; ai < 2; ++ai)
#pragma unroll
            for (int m = 0; m < 4; ++m) { bf16* rowp = TMP + (size_t)(row0 + ai * 128 + m * 16) * D;
#pragma unroll
                for (int bj = 0; bj < 2; ++bj) { const int c0 = u.pn * 256 + bj * 128 + wc * 32 + 8 * fq;
                    const f32x4 v0 = gv[bj][0] * acc[ai][bj][m][0], v1 = gv[bj][1] * acc[ai][bj][m][1];
                    u32x4 w; w.x = pg8::cvt_pk_bf16(v0.x, v0.y); w.y = pg8::cvt_pk_bf16(v0.z, v0.w); w.z = pg8::cvt_pk_bf16(v1.x, v1.y); w.w = pg8::cvt_pk_bf16(v1.z, v1.w);
                    *(u32x4*)(rowp + c0) = w; } }
    }
};
constexpr int TOK_LDS = 131072 + 4096;
constexpr int MOE_LDS = 131072;
__device__ __forceinline__ int moe_setup(Ctx& F, int l) {
    LAS int* cntL = (LAS int*)(F.lds + MOE_LDS); LAS int* tst = (LAS int*)(F.lds + MOE_LDS + 256); LAS unsigned short* te = (LAS unsigned short*)(F.lds + MOE_LDS + 512);
    const unsigned* cnt = (const unsigned*)(F.ctl() + CW_CNT + l * 64);
    __syncthreads();
    if (F.tid < NE) cntL[F.tid] = (int)__hip_atomic_load(cnt + F.tid, __ATOMIC_RELAXED, __HIP_MEMORY_SCOPE_AGENT);
    __syncthreads();
    if (F.tid == 0) { int s = 0; for (int e = 0; e < NE; ++e) { tst[e] = s; s += (cntL[e] + 255) >> 8; } tst[NE] = s; }
    __syncthreads();
    const int T = tst[NE];
    for (int i = F.tid; i < T; i += NTHR) { int e = 0; for (int q = 1; q < NE; ++q) e = (tst[q] <= i) ? q : e; te[i] = (unsigned short)e; }
    __syncthreads();
    return T;
}
struct MoeOrder {
    int t0, nun, rank, nper, npn; const LAS unsigned short* te; const LAS int* tst; const LAS int* cntl;
    __device__ __forceinline__ void init(const Ctx& F, int T, int npn_) {
        const int x = F.bid & 7; nper = F.G >> 3; rank = F.bid >> 3; npn = npn_;
        t0 = (x * T) >> 3; const int t1 = ((x + 1) * T) >> 3; nun = (t1 - t0) * npn;
        te = (const LAS unsigned short*)(F.lds + MOE_LDS + 512); tst = (const LAS int*)(F.lds + MOE_LDS + 256); cntl = (const LAS int*)(F.lds + MOE_LDS);
    }
    __device__ __forceinline__ bool next(int i, pg8::Unit& u) const {
        const int x = rank + i * nper; if (x >= nun) return false;
        const int rt = t0 + x / npn; u.pm = rt; u.pn = x % npn; u.e = __builtin_amdgcn_readfirstlane((int)te[rt]); u.pos0 = (rt - __builtin_amdgcn_readfirstlane(tst[u.e])) * 256; u.ce = __builtin_amdgcn_readfirstlane(cntl[u.e]); return true;
    }
};
struct PbGu {
    static constexpr int K = D; static constexpr bool PERM = true, GATHER = true;
    const bf16* A; const bf16* Bt_l; bf16* H; const float* bgu_l; const int* list_tok; MoeOrder S; const LAS int* cntL;
    __device__ __forceinline__ bool next(int i, pg8::Unit& u) const { return S.next(i, u); }
    __device__ __forceinline__ const char* a_base(const pg8::Unit&) const { return (const char*)A; }
    __device__ __forceinline__ const char* b_base(const pg8::Unit& u) const { return (const char*)Bt_l + ((size_t)u.e * 2 * FF + (size_t)u.pn * 256) * K * 2; }
    __device__ __forceinline__ void a_voff_half(const pg8::Unit& u, unsigned (&v)[2], int tid, int h) const {
        const int ce = u.ce;
#pragma unroll
        for (int i = 0; i < 2; ++i) { int R, C; pg8::stage_rc(tid * 16 + i * 8192, R, C);
            const int pos = u.pos0 + h * 128 + R; const int tok = pos < ce ? list_tok[(size_t)u.e * CAP + pos] : 0; v[i] = (unsigned)(tok * K + C) * 2u; }
    }
    __device__ __forceinline__ void a_voff(const pg8::Unit& u, unsigned (&v)[2][2], int tid) const { a_voff_half(u, v[0], tid, 0); a_voff_half(u, v[1], tid, 1); }
    __device__ __forceinline__ void tok_prefetch(const pg8::Unit& u, LAS unsigned char* lds, int tid, int wid) const {
        const int ce = u.ce;
#pragma unroll
        for (int h = 0; h < 2; ++h)
#pragma unroll
            for (int i = 0; i < 2; ++i) { int R, C; pg8::stage_rc(tid * 16 + i * 8192, R, C);
                const int pos = u.pos0 + h * 128 + R; const int* src = list_tok + (size_t)u.e * CAP + (pos < ce ? pos : 0);
                __builtin_amdgcn_global_load_lds((const unsigned*)src, (LAS unsigned*)(lds + TOK_LDS + ((h * 2 + i) * 8 + wid) * 256), 4, 0, 0); }
    }
    __device__ __forceinline__ void a_voff_half_lds(unsigned (&v)[2], LAS unsigned char* lds, int tid, int wid, int h) const {
#pragma unroll
        for (int i = 0; i < 2; ++i) { int R, C; pg8::stage_rc(tid * 16 + i * 8192, R, C);
            const int tok = *(const LAS int*)(lds + TOK_LDS + ((h * 2 + i) * 8 + wid) * 256 + (tid & 63) * 4); v[i] = (unsigned)(tok * K + C) * 2u; }
    }
    __device__ __forceinline__ void epi(const pg8::AccT& acc, const pg8::Unit& u, int wr, int wc, int fr, int fq) const {
        const int row0 = u.pm * 256 + wr * 64 + fr, ff0 = u.pn * 128 + wc * 32 + 8 * fq;
        const float* bg = bgu_l + (size_t)u.e * 2 * FF;
        const f32x4 bg0 = *(const f32x4*)(bg + ff0), bg1 = *(const f32x4*)(bg + ff0 + 4), bu0 = *(const f32x4*)(bg + FF + ff0), bu1 = *(const f32x4*)(bg + FF + ff0 + 4);
#pragma unroll
        for (int ai = 0; ai < 2; ++ai)
#pragma unroll
            for (int m = 0; m < 4; ++m) {
                float o[8];
#pragma unroll
                for (int n = 0; n < 2; ++n) { const f32x4 g = acc[ai][0][m][n] + (n ? bg1 : bg0), up = acc[ai][1][m][n] + (n ? bu1 : bu0);
#pragma unroll
                    for (int j = 0; j < 4; ++j) { const float gate = fminf(g[j], 7.0f), upc = fminf(fmaxf(up[j], -7.0f), 7.0f); o[4 * n + j] = (upc + 1.0f) * gate * sigmoidf_(1.702f * gate); } }
                u32x4 w; w.x = pg8::cvt_pk_bf16(o[0], o[1]); w.y = pg8::cvt_pk_bf16(o[2], o[3]); w.z = pg8::cvt_pk_bf16(o[4], o[5]); w.w = pg8::cvt_pk_bf16(o[6], o[7]);
                *(u32x4*)(H + (size_t)(row0 + ai * 128 + m * 16) * FF + ff0) = w;
            }
    }
};
struct PbDown {
    static constexpr int K = FF; static constexpr bool PERM = true, GATHER = false;
    const bf16* A; const bf16* Bt_l; bf16* Y2; const float* bd_l; const int* list_dst; const float* list_gate; MoeOrder S; const LAS int* cntL;
    __device__ __forceinline__ bool next(int i, pg8::Unit& u) const { return S.next(i, u); }
    __device__ __forceinline__ const char* a_base(const pg8::Unit& u) const { return (const char*)A + (size_t)u.pm * 256 * K * 2; }
    __device__ __forceinline__ const char* b_base(const pg8::Unit& u) const { return (const char*)Bt_l + ((size_t)u.e * D + (size_t)u.pn * 256) * K * 2; }
    __device__ __forceinline__ void a_voff(const pg8::Unit&, unsigned (&v)[2][2], int tid) const { pg8::voff_contig(v, tid, K); }
    __device__ __forceinline__ void tok_prefetch(const pg8::Unit&, LAS unsigned char*, int, int) const {}
    __device__ __forceinline__ void a_voff_half_lds(unsigned (&)[2], LAS unsigned char*, int, int, int) const {}
    __device__ __forceinline__ void epi(const pg8::AccT& acc, const pg8::Unit& u, int wr, int wc, int fr, int fq) const {
        const int ce = u.ce; const int p0 = u.pos0 + wr * 64 + fr; const float* bd = bd_l + (size_t)u.e * D;
        int dsts[2][4]; float gs[2][4];
#pragma unroll
        for (int ai = 0; ai < 2; ++ai)
#pragma unroll
            for (int m = 0; m < 4; ++m) { const int pos = p0 + ai * 128 + m * 16; const size_t ix = (size_t)u.e * CAP + (pos < ce ? pos : 0); dsts[ai][m] = list_dst[ix]; gs[ai][m] = list_gate[ix]; }
        f32x4 bb[2][2];
#pragma unroll
        for (int bj = 0; bj < 2; ++bj) { const int c0 = u.pn * 256 + bj * 128 + wc * 32 + 8 * fq; bb[bj][0] = *(const f32x4*)(bd + c0); bb[bj][1] = *(const f32x4*)(bd + c0 + 4); }
#pragma unroll
        for (int ai = 0; ai < 2; ++ai)
#pragma unroll
            for (int m = 0; m < 4; ++m) {
                const int pos = p0 + ai * 128 + m * 16;
                {
                    const float g = gs[ai][m]; const size_t drow = pos < ce ? (size_t)dsts[ai][m] : (size_t)(Y2_DUMMY_ROW + (pos & 255));
#pragma unroll
                    for (int bj = 0; bj < 2; ++bj) { const int c0 = u.pn * 256 + bj * 128 + wc * 32 + 8 * fq;
                        const f32x4 v0 = (acc[ai][bj][m][0] + bb[bj][0]) * g, v1 = (acc[ai][bj][m][1] + bb[bj][1]) * g;
                        u32x4 w; w.x = pg8::cvt_pk_bf16(v0.x, v0.y); w.y = pg8::cvt_pk_bf16(v0.z, v0.w); w.z = pg8::cvt_pk_bf16(v1.x, v1.y); w.w = pg8::cvt_pk_bf16(v1.z, v1.w);
                        *(u32x4*)(Y2 + drow * D + c0) = w; }
                }
            }
    }
};
struct PbGu8 {
    static constexpr int K = D; static constexpr bool PERM = true, GATHER = true;
    const unsigned char* A; const unsigned char* Bt_l; unsigned char* H; const float* bgu_l; const int* list_tok; MoeOrder S; const LAS int* cntL;
    __device__ __forceinline__ bool next(int i, pg8::Unit& u) const { return S.next(i, u); }
    __device__ __forceinline__ const char* a_base(const pg8::Unit&) const { return (const char*)A; }
    __device__ __forceinline__ const char* b_base(const pg8::Unit& u) const { return (const char*)Bt_l + ((size_t)u.e * 2 * FF + (size_t)u.pn * 256) * K; }
    __device__ __forceinline__ void a_voff_half(const pg8::Unit& u, unsigned (&v)[2], int tid, int h) const {
        const int ce = u.ce;
#pragma unroll
        for (int i = 0; i < 2; ++i) { int R, C; pg8::stage_rc(tid * 16 + i * 8192, R, C);
            const int pos = u.pos0 + h * 128 + R; const int tok = pos < ce ? list_tok[(size_t)u.e * CAP + pos] : 0; v[i] = (unsigned)(tok * K + C * 2); }
    }
    __device__ __forceinline__ void a_voff(const pg8::Unit& u, unsigned (&v)[2][2], int tid) const { a_voff_half(u, v[0], tid, 0); a_voff_half(u, v[1], tid, 1); }
    __device__ __forceinline__ void tok_prefetch(const pg8::Unit& u, LAS unsigned char* lds, int tid, int wid) const {
        const int ce = u.ce;
#pragma unroll
        for (int h = 0; h < 2; ++h)
#pragma unroll
            for (int i = 0; i < 2; ++i) { int R, C; pg8::stage_rc(tid * 16 + i * 8192, R, C);
                const int pos = u.pos0 + h * 128 + R; const int* src = list_tok + (size_t)u.e * CAP + (pos < ce ? pos : 0);
                __builtin_amdgcn_global_load_lds((const unsigned*)src, (LAS unsigned*)(lds + TOK_LDS + ((h * 2 + i) * 8 + wid) * 256), 4, 0, 0); }
    }
    __device__ __forceinline__ void a_voff_half_lds(unsigned (&v)[2], LAS unsigned char* lds, int tid, int wid, int h) const {
#pragma unroll
        for (int i = 0; i < 2; ++i) { int R, C; pg8::stage_rc(tid * 16 + i * 8192, R, C);
            const int tok = *(const LAS int*)(lds + TOK_LDS + ((h * 2 + i) * 8 + wid) * 256 + (tid & 63) * 4); v[i] = (unsigned)(tok * K + C * 2); }
    }
    __device__ __forceinline__ void epi(const pg8::AccT& acc, const pg8::Unit& u, int wr, int wc, int fr, int fq) const {
        const int row0 = u.pm * 256 + wr * 64 + fr, ff0 = u.pn * 128 + wc * 32 + 8 * fq;
        const float* bg = bgu_l + (size_t)u.e * 2 * FF;
        const f32x4 bg0 = *(const f32x4*)(bg + ff0), bg1 = *(const f32x4*)(bg + ff0 + 4), bu0 = *(const f32x4*)(bg + FF + ff0), bu1 = *(const f32x4*)(bg + FF + ff0 + 4);
#pragma unroll
        for (int ai = 0; ai < 2; ++ai)
#pragma unroll
            for (int m = 0; m < 4; ++m) {
                float o[8];
#pragma unroll
                for (int n = 0; n < 2; ++n) { const f32x4 g = acc[ai][0][m][n] * (1.0f / W8_SCALE) + (n ? bg1 : bg0), up = acc[ai][1][m][n] * (1.0f / W8_SCALE) + (n ? bu1 : bu0);
#pragma unroll
                    for (int j = 0; j < 4; ++j) { const float gate = fminf(g[j], 7.0f), upc = fminf(fmaxf(up[j], -7.0f), 7.0f); o[4 * n + j] = (upc + 1.0f) * gate * sigmoidf_(1.702f * gate); } }
                u32x2 w; w.x = pk_fp8x4(o[0], o[1], o[2], o[3]); w.y = pk_fp8x4(o[4], o[5], o[6], o[7]);
                *(u32x2*)(H + (size_t)(row0 + ai * 128 + m * 16) * FF + ff0) = w;
            }
    }
};
struct PbDown8 {
    static constexpr int K = FF; static constexpr bool PERM = true, GATHER = false;
    const unsigned char* A; const unsigned char* Bt_l; bf16* Y2; const float* bd_l; const int* list_dst; const float* list_gate; MoeOrder S; const LAS int* cntL;
    __device__ __forceinline__ bool next(int i, pg8::Unit& u) const { return S.next(i, u); }
    __device__ __forceinline__ const char* a_base(const pg8::Unit& u) const { return (const char*)A + (size_t)u.pm * 256 * K; }
    __device__ __forceinline__ const char* b_base(const pg8::Unit& u) const { return (const char*)Bt_l + ((size_t)u.e * D + (size_t)u.pn * 256) * K; }
    __device__ __forceinline__ void a_voff(const pg8::Unit&, unsigned (&v)[2][2], int tid) const { pg8::voff_contig8(v, tid, K); }
    __device__ __forceinline__ void tok_prefetch(const pg8::Unit&, LAS unsigned char*, int, int) const {}
    __device__ __forceinline__ void a_voff_half_lds(unsigned (&)[2], LAS unsigned char*, int, int, int) const {}
    __device__ __forceinline__ void epi(const pg8::AccT& acc, const pg8::Unit& u, int wr, int wc, int fr, int fq) const {
        const int ce = u.ce; const int p0 = u.pos0 + wr * 64 + fr; const float* bd = bd_l + (size_t)u.e * D;
        int dsts[2][4]; float gs[2][4];
#pragma unroll
        for (int ai = 0; ai < 2; ++ai)
#pragma unroll
            for (int m = 0; m < 4; ++m) { const int pos = p0 + ai * 128 + m * 16; const size_t ix = (size_t)u.e * CAP + (pos < ce ? pos : 0); dsts[ai][m] = list_dst[ix]; gs[ai][m] = list_gate[ix]; }
        f32x4 bb[2][2];
#pragma unroll
        for (int bj = 0; bj < 2; ++bj) { const int c0 = u.pn * 256 + bj * 128 + wc * 32 + 8 * fq; bb[bj][0] = *(const f32x4*)(bd + c0); bb[bj][1] = *(const f32x4*)(bd + c0 + 4); }
#pragma unroll
        for (int ai = 0; ai < 2; ++ai)
#pragma unroll
            for (int m = 0; m < 4; ++m) {
                const int pos = p0 + ai * 128 + m * 16;
                {
                    const float g = gs[ai][m]; const size_t drow = pos < ce ? (size_t)dsts[ai][m] : (size_t)(Y2_DUMMY_ROW + (pos & 255));
#pragma unroll
                    for (int bj = 0; bj < 2; ++bj) { const int c0 = u.pn * 256 + bj * 128 + wc * 32 + 8 * fq;
                        const f32x4 v0 = (acc[ai][bj][m][0] * (1.0f / W8_SCALE) + bb[bj][0]) * g, v1 = (acc[ai][bj][m][1] * (1.0f / W8_SCALE) + bb[bj][1]) * g;
                        if (Y2_FP8) { u32x2 w; w.x = pk_fp8x4(v0.x * Y2_SCALE, v0.y * Y2_SCALE, v0.z * Y2_SCALE, v0.w * Y2_SCALE); w.y = pk_fp8x4(v1.x * Y2_SCALE, v1.y * Y2_SCALE, v1.z * Y2_SCALE, v1.w * Y2_SCALE);
                            *(u32x2*)((unsigned char*)Y2 + drow * D + c0) = w; }
                        else { u32x4 w; w.x = pg8::cvt_pk_bf16(v0.x, v0.y); w.y = pg8::cvt_pk_bf16(v0.z, v0.w); w.z = pg8::cvt_pk_bf16(v1.x, v1.y); w.w = pg8::cvt_pk_bf16(v1.z, v1.w);
                            *(u32x4*)(Y2 + drow * D + c0) = w; } }
                }
            }
    }
};
__device__ __forceinline__ void ph_inproj_fast(Ctx& F, int l) {
    PbInproj pb; pb.A = F.H1(); pb.Bt = F.WinT() + (size_t)l * INW * D; pb.P = F.P(); pb.Vt = F.Vt(); pb.rope = F.rope(); pb.S.init(MA, INW, F.G, F.bid);
    pg8::gemm_phase(F.lds, pb, F.tid);
}
__device__ __forceinline__ void ph_outproj_fast(Ctx& F, int l) {
    PbOutproj pb; pb.A = F.MIX(); pb.Bt = F.WoutT() + (size_t)l * D * D; pb.TMP = F.P(); pb.mods_l = F.mods() + (size_t)l * 3 * 6 * D; pb.S.init(l == 0 ? MA : ML, D, F.G, F.bid);
    pg8::gemm_phase(F.lds, pb, F.tid);
}
__device__ __forceinline__ void ph_moe_gu_fast(Ctx& F, int l) {
    const int T = moe_setup(F, l);
    if (MOE_FP8) {
        PbGu8 pb; pb.A = (const unsigned char*)F.H1(); pb.Bt_l = (const unsigned char*)F.WguT() + (size_t)l * NE * 2 * FF * D; pb.H = (unsigned char*)F.HMOE(); pb.bgu_l = F.inp(I_BGU) + (size_t)l * NE * 2 * FF; pb.list_tok = F.list_tok();
        pb.S.init(F, T, 8); pb.cntL = (const LAS int*)(F.lds + MOE_LDS);
        pg8::gemm_phase8(F.lds, pb, F.tid);
    } else {
        PbGu pb; pb.A = F.H1(); pb.Bt_l = F.WguT() + (size_t)l * NE * 2 * FF * D; pb.H = F.HMOE(); pb.bgu_l = F.inp(I_BGU) + (size_t)l * NE * 2 * FF; pb.list_tok = F.list_tok();
        pb.S.init(F, T, 8); pb.cntL = (const LAS int*)(F.lds + MOE_LDS);
        pg8::gemm_phase(F.lds, pb, F.tid);
    }
}
__device__ __forceinline__ void ph_moe_down_fast(Ctx& F, int l) {
    const int T = moe_setup(F, l);
    if (MOE_FP8) {
        PbDown8 pb; pb.A = (const unsigned char*)F.HMOE(); pb.Bt_l = (const unsigned char*)F.WdT() + (size_t)l * NE * D * FF; pb.Y2 = F.Y2(); pb.bd_l = F.inp(I_BD) + (size_t)l * NE * D; pb.list_dst = F.list_dst(); pb.list_gate = F.list_gate();
        pb.S.init(F, T, 4); pb.cntL = (const LAS int*)(F.lds + MOE_LDS);
        pg8::gemm_phase8(F.lds, pb, F.tid);
    } else {
        PbDown pb; pb.A = F.HMOE(); pb.Bt_l = F.WdT() + (size_t)l * NE * D * FF; pb.Y2 = F.Y2(); pb.bd_l = F.inp(I_BD) + (size_t)l * NE * D; pb.list_dst = F.list_dst(); pb.list_gate = F.list_gate();
        pb.S.init(F, T, 4); pb.cntL = (const LAS int*)(F.lds + MOE_LDS);
        pg8::gemm_phase(F.lds, pb, F.tid);
    }
}

#define XB_TMO      128
#define XB_XCNT(j)  (256  + 64 * (j))
#define XB_XSUB(j)  (1280 + 64 * (j))
#define XB_XGEN(j)  (2304 + 64 * (j))
#define XB_TOP      3328
#define XB_TOPGEN   3392
#define XCD_BAR_WORDS 3456
#define XB_SPIN_CAP (1u << 22)
__device__ __forceinline__ unsigned xb_ld(unsigned* p)              { return __hip_atomic_load(p, __ATOMIC_RELAXED, __HIP_MEMORY_SCOPE_AGENT); }
__device__ __forceinline__ unsigned xb_add(unsigned* p, unsigned v) { return __hip_atomic_fetch_add(p, v, __ATOMIC_RELAXED, __HIP_MEMORY_SCOPE_AGENT); }
__device__ __forceinline__ unsigned xb_xcc_id() { return (unsigned)__builtin_amdgcn_s_getreg((3 << 11) | 20) & 0xFu; }
#define XB_SPIN(cond, bar) do { unsigned _sp = 0; while (cond) { __builtin_amdgcn_s_sleep(1); \
    if ((++_sp & 255u) == 0u) { if (xb_ld(&(bar)[XB_TMO])) break; if (_sp > XB_SPIN_CAP) { atomicAdd(&(bar)[XB_TMO], 1u); break; } } } } while (0)
struct XcdBarrier { unsigned* bar; unsigned x; volatile LAS unsigned* st; };
__device__ __forceinline__ XcdBarrier xcd_barrier_post(unsigned* bar, volatile LAS unsigned* st) {
    XcdBarrier b; b.bar = bar; b.x = xb_xcc_id(); b.st = st;
    if (threadIdx.x == 0) (void)xb_add(&bar[XB_XCNT(b.x)], 1u);
    return b;
}
__device__ __forceinline__ void xcd_barrier_complete(unsigned* bar, unsigned x, unsigned& nloc, unsigned& nx) {
    const unsigned G = gridDim.x * gridDim.y * gridDim.z;
    unsigned sum, cnt, mine, sp = 0u;
    for (;;) {
        sum = 0u; cnt = 0u; mine = 0u;
#pragma unroll
        for (unsigned j = 0; j < 16; ++j) { const unsigned c = xb_ld(&bar[XB_XCNT(j)]); sum += c; cnt += (c > 0u) ? 1u : 0u; mine = (j == x) ? c : mine; }
        if (sum == G) break;
        __builtin_amdgcn_s_sleep(1);
        if ((++sp & 255u) == 0u) { if (xb_ld(&bar[XB_TMO])) break; if (sp > XB_SPIN_CAP) { atomicAdd(&bar[XB_TMO], 1u); break; } }
    }
    nloc = mine > 0u ? mine : 1u; nx = cnt > 0u ? cnt : 1u;
}
__device__ __forceinline__ void xcd_barrier(const XcdBarrier& b0) {
    asm volatile("s_waitcnt vmcnt(0)" ::: "memory");
    __syncthreads();
    XcdBarrier b = b0;
    { unsigned long long p = (unsigned long long)b0.bar; unsigned xx = b0.x; asm volatile("" : "+s"(p), "+s"(xx)); b.bar = (unsigned*)p; b.x = xx; }
    if (threadIdx.x == 0) {
        unsigned* bar = b.bar;
        __builtin_amdgcn_s_waitcnt(0);
        unsigned nloc = b.st[0], nx = b.st[1];
        if (nloc == 0u) { xcd_barrier_complete(bar, b.x, nloc, nx); b.st[0] = nloc; b.st[1] = nx; }
        const unsigned old = xb_add(&bar[XB_XSUB(b.x)], 1u);
        const unsigned gen = old / nloc;
        if (old + 1u == (gen + 1u) * nloc) {
            __builtin_amdgcn_fence(__ATOMIC_RELEASE, "agent");
            asm volatile("s_waitcnt vmcnt(0)" ::: "memory");
            const unsigned og = xb_add(&bar[XB_TOP], 1u);
            const unsigned tg = og / nx;
            if (og + 1u == (tg + 1u) * nx) xb_add(&bar[XB_TOPGEN], 1u);
            else XB_SPIN(xb_ld(&bar[XB_TOPGEN]) == tg, bar);
            __builtin_amdgcn_fence(__ATOMIC_ACQUIRE, "agent");
            xb_add(&bar[XB_XGEN(b.x)], 1u);
            asm volatile("s_waitcnt vmcnt(0)" ::: "memory");
        } else {
            XB_SPIN(xb_ld(&bar[XB_XGEN(b.x)]) == gen, bar);
            __builtin_amdgcn_fence(__ATOMIC_ACQUIRE, "agent");
            asm volatile("s_waitcnt vmcnt(0)" ::: "memory");
        }
    }
    __syncthreads();
}

__device__ __forceinline__ void convert_item(Ctx& F, int l, int wi) {
    LAS float* scr = (LAS float*)(F.lds + F.wave * 8704);
    if (MOE_FP8) {
        if (wi < CV_GU) { const int le = l * NE + (wi >> 10); tr_item8<2>(F.inp(I_WGU) + (size_t)le * D * 2 * FF, D, 2 * FF, (unsigned char*)F.WguT() + (size_t)le * 2 * FF * D, scr, wi & 1023, F.lane); }
        else { const int r = wi - CV_GU; const int le = l * NE + (r >> 9); tr_item8<0>(F.inp(I_WD) + (size_t)le * FF * D, FF, D, (unsigned char*)F.WdT() + (size_t)le * D * FF, scr, r & 511, F.lane); }
        return;
    }
    if (wi < CV_GU) { const int le = l * NE + (wi >> 10); tr_item<2>(F.inp(I_WGU) + (size_t)le * D * 2 * FF, D, 2 * FF, F.WguT() + (size_t)le * 2 * FF * D, scr, wi & 1023, F.lane); }
    else { const int r = wi - CV_GU; const int le = l * NE + (r >> 9); tr_item<0>(F.inp(I_WD) + (size_t)le * FF * D, FF, D, F.WdT() + (size_t)le * D * FF, scr, r & 511, F.lane); }
}
__device__ __forceinline__ bool convert_next(Ctx& F, volatile LAS unsigned* prog, int pmax) {
    const int p = (int)prog[F.wave];
    if (p >= pmax) return false;
    convert_item(F, p / CV_PER_WAVE, (F.bid * NWAVES + F.wave) + 2048 * (p % CV_PER_WAVE));
    if (F.lane == 0) prog[F.wave] = (unsigned)(p + 1);
    return true;
}
__device__ __forceinline__ void drain_convert(Ctx& F, int l, volatile LAS unsigned* prog) {
    while (convert_next(F, prog, CV_PER_WAVE * (l + 1))) {}
}
__device__ __forceinline__ void xcd_barrier_steal(const XcdBarrier& b0, Ctx& F, volatile LAS unsigned* fl, volatile LAS unsigned* prog) {
    asm volatile("s_waitcnt vmcnt(0)" ::: "memory");
    __syncthreads();
    XcdBarrier b = b0;
    { unsigned long long p = (unsigned long long)b0.bar; unsigned xx = b0.x; asm volatile("" : "+s"(p), "+s"(xx)); b.bar = (unsigned*)p; b.x = xx; }
    unsigned* bar = b.bar;
    if (threadIdx.x == 0) {
        __builtin_amdgcn_s_waitcnt(0);
        unsigned nloc = b.st[0], nx = b.st[1];
        if (nloc == 0u) { xcd_barrier_complete(bar, b.x, nloc, nx); b.st[0] = nloc; b.st[1] = nx; }
        const unsigned old = xb_add(&bar[XB_XSUB(b.x)], 1u);
        const unsigned gen = old / nloc;
        if (old + 1u == (gen + 1u) * nloc) {
            __builtin_amdgcn_fence(__ATOMIC_RELEASE, "agent");
            asm volatile("s_waitcnt vmcnt(0)" ::: "memory");
            const unsigned og = xb_add(&bar[XB_TOP], 1u);
            const unsigned tg = og / nx;
            if (og + 1u == (tg + 1u) * nx) xb_add(&bar[XB_TOPGEN], 1u);
            else XB_SPIN(xb_ld(&bar[XB_TOPGEN]) == tg, bar);
            __builtin_amdgcn_fence(__ATOMIC_ACQUIRE, "agent");
            xb_add(&bar[XB_XGEN(b.x)], 1u);
            asm volatile("s_waitcnt vmcnt(0)" ::: "memory");
            fl[0] = 1u;
        } else { fl[0] = 0u; fl[1] = gen; }
    }
    __syncthreads();
    if (fl[0] == 0u) {
        const unsigned gen = fl[1];
        unsigned sp = 0u;
        for (;;) {
            unsigned rel = 0u;
            if (F.lane == 0) { rel = (xb_ld(&bar[XB_XGEN(b.x)]) != gen) ? 1u : 0u;
                if (!rel && (++sp & 63u) == 0u) { if (xb_ld(&bar[XB_TMO])) rel = 1u; else if (sp > XB_SPIN_CAP) { atomicAdd(&bar[XB_TMO], 1u); rel = 1u; } } }
            rel = (unsigned)__builtin_amdgcn_readfirstlane((int)rel);
            if (rel) break;
            if (!convert_next(F, prog, CV_PER_WAVE * NL)) __builtin_amdgcn_s_sleep(2);
        }
        asm volatile("s_waitcnt vmcnt(0)" ::: "memory");
        __syncthreads();
        if (threadIdx.x == 0) { __builtin_amdgcn_fence(__ATOMIC_ACQUIRE, "agent"); asm volatile("s_waitcnt vmcnt(0)" ::: "memory"); }
    }
    __syncthreads();
}

constexpr int LDS_BYTES = 147456;
constexpr int MISC_OFF = 147456 - 256;

__global__ void __launch_bounds__(NTHR, 2) fwd(Args args) {
    extern __shared__ __attribute__((aligned(16))) unsigned char lds[];
    Ctx F0;
    F0.lds = (LAS unsigned char*)lds;
    F0.tid = threadIdx.x; F0.lane = F0.tid & 63; F0.wave = __builtin_amdgcn_readfirstlane(F0.tid >> 6); F0.G = gridDim.x; F0.bid = blockIdx.x;
    F0.in = args.in; F0.out = args.out; F0.ws = args.ws;
    volatile LAS unsigned* MISC = (volatile LAS unsigned*)(F0.lds + MISC_OFF);
    if (F0.tid < 64) MISC[F0.tid] = 0u;
    __syncthreads();
    XcdBarrier bar; bar.bar = (unsigned*)(F0.ctl() + CW_BAR); bar.x = 0; bar.st = nullptr;
    if (MK_N_LAUNCHES == 1) bar = xcd_barrier_post((unsigned*)(F0.ctl() + CW_BAR), MISC + 8);
    const int lo = args.ph_lo, hi = args.ph_hi;
#define IN(k) (lo <= (k) && (k) < hi)
#define SEAM(k) do { if (IN(k) && IN((k) + 1)) { Ctx F = fresh(F0); xcd_barrier_steal(bar, F, MISC + 16, MISC + 24); } } while (0)
#define SEAM_S(k) SEAM(k)
#define PH(k, ...) do { if (IN(k)) { Ctx F = fresh(F0); __VA_ARGS__; } } while (0)

    PH(0, REPEAT(REP_PRO, ph_prologue(F))); SEAM(0);
    for (int l = 0; l < NL; ++l) {
        const int pb = 1 + 9 * l;
        PH(pb + 0, ph_norm1(F, l); if (REP_N10 > 1 && l == 0) ph_norm1(F, l)); SEAM(pb + 0);
        PH(pb + 1, REPEAT(REP_INP, if (FAST_GEMM) ph_inproj_fast(F, l); else ph_inproj_naive(F, l))); SEAM_S(pb + 1);
        if (FAST_ATTN) PH(pb + 2, REPEAT(REP_ATT, ph_attn_fast(F, l))); else PH(pb + 2, ph_attn_naive(F, l));
        if (FAST_LRU) PH(pb + 2, REPEAT(REP_LA, ph_lru_fast<false>(F, l))); else PH(pb + 2, ph_lru_gates_naive(F, l));
        if (FAST_HG) PH(pb + 2, REPEAT(REP_HA, ph_hgrn_fast<false>(F, l)));
        SEAM(pb + 2);
        if (FAST_LRU) PH(pb + 3, REPEAT(REP_CAR, ph_lru_carry(F))); else PH(pb + 3, ph_lru_scan_naive(F));
        if (FAST_HG) PH(pb + 3, REPEAT(REP_CAR, ph_hgrn_carry(F))); else PH(pb + 3, ph_hgrn_scan_naive(F, l));
        SEAM_S(pb + 3);
        if (FAST_LRU) PH(pb + 4, REPEAT(REP_LC, ph_lru_fast<true>(F, l))); else PH(pb + 4, ph_lru_out_naive(F, l));
        if (FAST_HG) PH(pb + 4, REPEAT(REP_HC, ph_hgrn_fast<true>(F, l))); else PH(pb + 4, ph_hgrn_out_naive(F, l));
        SEAM(pb + 4);
        PH(pb + 5, if (FAST_GEMM) ph_outproj_fast(F, l); else ph_outproj_naive(F, l); if (REP_OP0 > 1) ph_outproj_fast(F, l)); SEAM_S(pb + 5);
        PH(pb + 6, ph_norm2_router(F, l); __syncthreads(); drain_convert(F, l, MISC + 24)); SEAM(pb + 6);
        PH(pb + 7, REPEAT(REP_GU, if (FAST_GEMM) ph_moe_gu_fast(F, l); else ph_moe_gu_naive(F, l))); SEAM_S(pb + 7);
        PH(pb + 8, REPEAT(REP_DN, if (FAST_GEMM) ph_moe_down_fast(F, l); else ph_moe_down_naive(F, l))); SEAM_S(pb + 8);
    }
    PH(19, REPEAT(REP_FIN, ph_norm1(F, 2)));
#undef PH
#undef IN
#undef SEAM_S
#undef SEAM
}

extern "C" void kernel_launch(void* const* d_in, const int* in_sizes, int n_in, void* d_out, int out_size, void* d_ws, size_t ws_size, hipStream_t stream) {
    static int grid = 0;
    if (grid == 0) {
        if (n_in != 27 || out_size != ML * D || ws_size < WS_END) { fprintf(stderr, "kernel_launch: unexpected shapes (n_in %d out %d ws %zu)\n", n_in, out_size, ws_size); grid = -1; return; }
        int dev = 0, cus = 0, per_cu = 0;
        if (hipGetDevice(&dev) != hipSuccess || hipDeviceGetAttribute(&cus, hipDeviceAttributeMultiprocessorCount, dev) != hipSuccess) { grid = -1; return; }
        if (hipFuncSetAttribute((const void*)fwd, hipFuncAttributeMaxDynamicSharedMemorySize, LDS_BYTES) != hipSuccess) { fprintf(stderr, "kernel_launch: hipFuncSetAttribute failed\n"); grid = -1; return; }
        if (hipOccupancyMaxActiveBlocksPerMultiprocessor(&per_cu, (const void*)fwd, NTHR, LDS_BYTES) != hipSuccess || per_cu < 1) { fprintf(stderr, "kernel_launch: occupancy query says %d\n", per_cu); }
        (void)hipGetLastError();
        grid = cus;
        if (grid != 256) { fprintf(stderr, "kernel_launch: built for a 256-CU device (got %d)\n", cus); grid = -1; return; }
    }
    if (grid < 0) return;
    (void)hipMemsetAsync((char*)d_ws + WS_CTL, 0, CTL_ZERO_BYTES, stream);
    Args a{};
    for (int i = 0; i < 27; ++i) a.in[i] = (const float*)d_in[i];
    a.out = (float*)d_out; a.ws = (unsigned char*)d_ws;
    if (MK_N_LAUNCHES == 1) { a.ph_lo = 0; a.ph_hi = N_PH; hipLaunchKernelGGL(fwd, dim3(grid), dim3(NTHR), LDS_BYTES, stream, a); }
    else for (int p = 0; p < N_PH; ++p) { a.ph_lo = p; a.ph_hi = p + 1; hipLaunchKernelGGL(fwd, dim3(grid), dim3(NTHR), LDS_BYTES, stream, a); }
}
```

```cpp
#include <hip/hip_runtime.h>
#include <stdint.h>
#include <stdio.h>

#ifndef MK_N_LAUNCHES
#define MK_N_LAUNCHES 1
#endif

#ifndef MOE_FP8
#define MOE_FP8 1
#endif
#ifndef Y2_FP8
#define Y2_FP8 1
#endif
#ifndef FAST_GEMM
#define FAST_GEMM 1
#endif
#ifndef REP_PRO
#define REP_PRO 1
#endif
#ifndef REP_INP
#define REP_INP 1
#endif
#ifndef REP_ATT
#define REP_ATT 1
#endif
#ifndef REP_LA
#define REP_LA 1
#endif
#ifndef REP_HA
#define REP_HA 1
#endif
#ifndef REP_LC
#define REP_LC 1
#endif
#ifndef REP_HC
#define REP_HC 1
#endif
#ifndef REP_N10
#define REP_N10 1
#endif
#ifndef REP_FIN
#define REP_FIN 1
#endif
#ifndef REP_OP0
#define REP_OP0 1
#endif
#ifndef REP_RT
#define REP_RT 1
#endif
#ifndef REP_CAR
#define REP_CAR 1
#endif
#ifndef REP_GU
#define REP_GU 1
#endif
#ifndef REP_DN
#define REP_DN 1
#endif
#define REPEAT(n, ...) do { _Pragma("unroll 1") for (int rep_ = 0; rep_ < (n); ++rep_) { __VA_ARGS__; } } while (0)
#ifndef FAST_ATTN
#define FAST_ATTN 1
#endif
#ifndef FAST_LRU
#define FAST_LRU 1
#endif
#ifndef FAST_HG
#define FAST_HG 1
#endif
#define GAS __attribute__((address_space(1)))
#define LAS __attribute__((address_space(3)))
typedef unsigned short bf16;
typedef short bf16x8 __attribute__((ext_vector_type(8)));
typedef float f32x4 __attribute__((ext_vector_type(4)));
typedef float f32x2 __attribute__((ext_vector_type(2)));
typedef float f32x16 __attribute__((ext_vector_type(16)));
typedef unsigned u32x4 __attribute__((ext_vector_type(4)));
typedef unsigned u32x2 __attribute__((ext_vector_type(2)));
typedef GAS unsigned gu32;

constexpr int D = 1024, NB = 2, SEQ = 16384, CTXL = 256, NL = 2;
constexpr int ML = NB * SEQ, MC = NB * CTXL, MA = ML + MC;
constexpr int INW = 2560;
constexpr int C_Q = 0, C_K = 512, C_V = 640, C_LX = 768, C_LG = 1024, C_HQ = 1280, C_HF = 1536, C_HB = 1792, C_HV = 2048, C_HO = 2304;
constexpr int NE = 32, FF = 1024, CAP = MA;
constexpr float EPS = 1e-6f;
constexpr float LOG2E = 1.4426950408889634f;
constexpr float QSCALE = 0.125f * LOG2E;
constexpr int NWAVES = 8, NTHR = 512;
constexpr int N_PH = 20;

constexpr size_t MiB = 1u << 20;
constexpr size_t WS_CTL = 0, CTL_ZERO_BYTES = 65536;
constexpr size_t WS_MODS = 1 * MiB;
constexpr size_t WS_ROPE = 2 * MiB;
constexpr size_t WS_LRUW = 3 * MiB;
constexpr size_t WS_WIN = 4 * MiB;
constexpr size_t WS_WOUT = 16 * MiB;
constexpr size_t WS_WGU = 20 * MiB;
constexpr size_t WS_WD = 276 * MiB;
constexpr size_t WS_XL = 404 * MiB;
constexpr size_t WS_H1 = 534 * MiB;
constexpr size_t WS_P = 599 * MiB;
constexpr size_t WS_VT = 762 * MiB;
constexpr size_t WS_MIX = 771 * MiB;
constexpr size_t WS_HD = 836 * MiB;
constexpr size_t WS_OHG = 901 * MiB;
constexpr size_t WS_GA = 966 * MiB;
constexpr size_t WS_GB = 1031 * MiB;
constexpr size_t WS_AGG = 1096 * MiB;
constexpr size_t WS_LIST = 1136 * MiB;
constexpr size_t WS_HMOE = 1152 * MiB;
constexpr size_t WS_Y2 = 1428 * MiB;
constexpr size_t WS_QI = 1688 * MiB;
constexpr size_t WS_KI = 1721 * MiB;
constexpr size_t WS_SAGG = 1754 * MiB;
constexpr size_t WS_SIN = 1788 * MiB;
constexpr size_t WS_DUMMY = 1823 * MiB;
constexpr size_t WS_END = 1824 * MiB;
constexpr size_t Y2_DUMMY_ROW = (WS_DUMMY - WS_Y2) / (D * ((Y2_FP8 && MOE_FP8) ? 1 : 2));
constexpr size_t VT_CTX_OFF = (size_t)NB * 2 * 64 * SEQ;
constexpr int CW_CNT = 64;
constexpr int CW_BAR = 4096;

__device__ __forceinline__ float bf2f(bf16 x) { return __uint_as_float(((unsigned)x) << 16); }
__device__ __forceinline__ unsigned pk2(float lo, float hi) { unsigned r; asm("v_cvt_pk_bf16_f32 %0, %1, %2" : "=v"(r) : "v"(lo), "v"(hi)); return r; }
__device__ __forceinline__ unsigned f2bf(float f) { return pk2(f, f) & 0xffffu; }
__device__ __forceinline__ float shx(float v, int mask, int lane) { return __int_as_float(__builtin_amdgcn_ds_bpermute((lane ^ mask) << 2, __float_as_int(v))); }
__device__ __forceinline__ float wave_sum(float v, int lane) {
#pragma unroll
    for (int o = 1; o < 64; o <<= 1) v += shx(v, o, lane);
    return v;
}
__device__ __forceinline__ float wave_max(float v, int lane) {
#pragma unroll
    for (int o = 1; o < 64; o <<= 1) v = fmaxf(v, shx(v, o, lane));
    return v;
}
__device__ __forceinline__ float frcp(float x) { return __builtin_amdgcn_rcpf(x); }
__device__ __forceinline__ float sigmoidf_(float x) { return frcp(1.0f + __expf(-x)); }
__device__ __forceinline__ float siluf_(float x) { return x * frcp(1.0f + __expf(-x)); }
__device__ __forceinline__ float gelu_tanh(float x) { const float u = 0.7978845608028654f * (x + 0.044715f * x * x * x); const float t = 1.0f - 2.0f * frcp(__expf(2.0f * u) + 1.0f); return 0.5f * x * (1.0f + t); }
__device__ __forceinline__ unsigned pk_fp8x4(float a, float b, float c, float d) { int w = 0; w = __builtin_amdgcn_cvt_pk_fp8_f32(a, b, w, false); w = __builtin_amdgcn_cvt_pk_fp8_f32(c, d, w, true); return (unsigned)w; }
constexpr float Y2_SCALE = 16.0f;
constexpr float W8_SCALE = 64.0f;
__device__ __forceinline__ int crow(int r, int hi) { return (r & 3) + 8 * (r >> 2) + 4 * hi; }

struct Args { const float* in[27]; float* out; unsigned char* ws; int ph_lo, ph_hi; };
struct Ctx {
    LAS unsigned char* lds;
    int tid, lane, wave, G, bid;
    const float* const* in;
    float* out; unsigned char* ws;
#define WSACC(T, name, off) __device__ __forceinline__ T* name() const { return (T*)(ws + (off)); }
    WSACC(gu32, ctl, WS_CTL) WSACC(float, mods, WS_MODS) WSACC(f32x2, rope, WS_ROPE) WSACC(bf16, lruw, WS_LRUW) WSACC(bf16, WinT, WS_WIN) WSACC(bf16, WoutT, WS_WOUT)
    WSACC(bf16, WguT, WS_WGU) WSACC(bf16, WdT, WS_WD) WSACC(bf16, XL, WS_XL) WSACC(bf16, H1, WS_H1) WSACC(bf16, P, WS_P) WSACC(bf16, Vt, WS_VT) WSACC(bf16, MIX, WS_MIX)
    WSACC(float, HD, WS_HD) WSACC(float, OHG, WS_OHG) WSACC(float, GA, WS_GA) WSACC(float, GB, WS_GB) WSACC(float, AGG, WS_AGG)
    WSACC(int, list_tok, WS_LIST) WSACC(int, list_dst, WS_LIST + (size_t)NE * CAP * 4) WSACC(float, list_gate, WS_LIST + (size_t)NE * CAP * 8)
    WSACC(bf16, HMOE, WS_HMOE) WSACC(bf16, Y2, WS_Y2)
    __device__ __forceinline__ bf16* ws_bf16(size_t off) const { return (bf16*)(ws + off); }
    __device__ __forceinline__ const float* inp(int i) const { return (const float*)(const GAS float*)in[i]; }
    __device__ __forceinline__ float* outp() const { return (float*)(GAS float*)out; }
#undef WSACC
};
__device__ __forceinline__ Ctx fresh(const Ctx& F0) {
    Ctx F = F0; int wv = F0.wave, g = F0.G, bi = F0.bid; asm volatile("" : "+s"(wv), "+s"(g), "+s"(bi));
    int ln; asm volatile("v_mbcnt_lo_u32_b32 %0, -1, 0\n\tv_mbcnt_hi_u32_b32 %0, -1, %0" : "=v"(ln));
    F.wave = wv; F.lane = ln; F.tid = wv * 64 + ln; F.G = g; F.bid = bi;
    unsigned long long w = (unsigned long long)F0.ws;
    asm volatile("" : "+s"(w)); F.ws = (unsigned char*)(GAS unsigned char*)w;
    return F;
}
enum { I_X = 0, I_C, I_CTX, I_CCTX, I_ADAW, I_ADAB, I_N1G, I_WIN, I_SINK, I_CONVW, I_CONVB, I_WR, I_BR, I_WI, I_BI, I_LAM, I_LBL, I_HNG, I_WOUT, I_N2G, I_RW, I_RB, I_WGU, I_BGU, I_WD, I_BD, I_FG };

__device__ __forceinline__ int row_b(int m) { return m < ML ? m / SEQ : (m - ML) / CTXL; }
__device__ __forceinline__ int row_t(int m) { return m < ML ? m % SEQ : (m - ML) % CTXL; }
__device__ __forceinline__ int mod_row(int m) { return m < ML ? m / SEQ : 2; }

__device__ __forceinline__ int dest_win(int n) {
    if (n >= C_V) return n;
    const int d = n & 63, p = d >> 5, half = (d >> 4) & 1, f = d & 15;
    return (n & ~63) + 2 * (p * 16 + f) + half;
}
__device__ __forceinline__ int dest_gu(int n) {
    const int up = n >= FF ? 1 : 0, ff = n & (FF - 1);
    return (ff >> 7) * 256 + up * 128 + (ff & 127);
}
template <int MAP>
__device__ __forceinline__ void tr_item(const float* W, int K, int N, bf16* WT, LAS float* scr, int item, int lane) {
    const int nblk = N / 32, kb = item / nblk, nb = item % nblk, k0 = 64 * kb, n0 = 32 * nb;
#pragma unroll 8
    for (int i = 0; i < 32; ++i) { const int kk = 2 * i + (lane >> 5); scr[kk * 33 + (lane & 31)] = W[(size_t)(k0 + kk) * N + n0 + (lane & 31)]; }
    asm volatile("s_waitcnt lgkmcnt(0)" ::: "memory");
    const int c = lane & 7;
#pragma unroll
    for (int j = 0; j < 4; ++j) {
        const int n = (lane >> 3) + 8 * j; const LAS float* s = scr + (8 * c) * 33 + n;
        u32x4 o; o.x = pk2(s[0 * 33], s[1 * 33]); o.y = pk2(s[2 * 33], s[3 * 33]); o.z = pk2(s[4 * 33], s[5 * 33]); o.w = pk2(s[6 * 33], s[7 * 33]);
        const int nn = n0 + n; const int dr = MAP == 1 ? dest_win(nn) : (MAP == 2 ? dest_gu(nn) : nn);
        *(u32x4*)(WT + (size_t)dr * K + k0 + 8 * c) = o;
    }
    asm volatile("s_waitcnt lgkmcnt(0)" ::: "memory");
}
template <int MAP>
__device__ __forceinline__ void tr_item8(const float* W, int K, int N, unsigned char* WT, LAS float* scr, int item, int lane) {
    const int nblk = N / 32, kb = item / nblk, nb = item % nblk, k0 = 64 * kb, n0 = 32 * nb;
#pragma unroll 8
    for (int i = 0; i < 32; ++i) { const int kk = 2 * i + (lane >> 5); scr[kk * 33 + (lane & 31)] = W[(size_t)(k0 + kk) * N + n0 + (lane & 31)]; }
    asm volatile("s_waitcnt lgkmcnt(0)" ::: "memory");
    const int c = lane & 7;
#pragma unroll
    for (int j = 0; j < 4; ++j) {
        const int n = (lane >> 3) + 8 * j; const LAS float* s = scr + (8 * c) * 33 + n;
        u32x2 o; o.x = pk_fp8x4(s[0 * 33] * W8_SCALE, s[1 * 33] * W8_SCALE, s[2 * 33] * W8_SCALE, s[3 * 33] * W8_SCALE); o.y = pk_fp8x4(s[4 * 33] * W8_SCALE, s[5 * 33] * W8_SCALE, s[6 * 33] * W8_SCALE, s[7 * 33] * W8_SCALE);
        const int nn = n0 + n; const int dr = MAP == 2 ? dest_gu(nn) : nn;
        *(u32x2*)(WT + (size_t)dr * K + k0 + 8 * c) = o;
    }
    asm volatile("s_waitcnt lgkmcnt(0)" ::: "memory");
}
__device__ __forceinline__ void tr_load(const float* W, int N, int item, int lane, float (&r)[32]) {
    const int nblk = N / 32, kb = item / nblk, nb = item % nblk, k0 = 64 * kb, n0 = 32 * nb;
    const float* p = W + (size_t)(k0 + (lane >> 5)) * N + n0 + (lane & 31);
#pragma unroll
    for (int i = 0; i < 32; ++i) r[i] = p[(size_t)(2 * i) * N];
}
template <int MAP>
__device__ __forceinline__ void tr_finish(int K, int N, bf16* WT, LAS float* scr, int item, int lane, const float (&r)[32]) {
    const int nblk = N / 32, kb = item / nblk, nb = item % nblk, k0 = 64 * kb, n0 = 32 * nb;
#pragma unroll
    for (int i = 0; i < 32; ++i) scr[(2 * i + (lane >> 5)) * 33 + (lane & 31)] = r[i];
    asm volatile("s_waitcnt lgkmcnt(0)" ::: "memory");
    const int c = lane & 7;
#pragma unroll
    for (int j = 0; j < 4; ++j) {
        const int n = (lane >> 3) + 8 * j; const LAS float* s = scr + (8 * c) * 33 + n;
        u32x4 o; o.x = pk2(s[0 * 33], s[1 * 33]); o.y = pk2(s[2 * 33], s[3 * 33]); o.z = pk2(s[4 * 33], s[5 * 33]); o.w = pk2(s[6 * 33], s[7 * 33]);
        const int nn = n0 + n; const int dr = MAP == 1 ? dest_win(nn) : (MAP == 2 ? dest_gu(nn) : nn);
        *(u32x4*)(WT + (size_t)dr * K + k0 + 8 * c) = o;
    }
    asm volatile("s_waitcnt lgkmcnt(0)" ::: "memory");
}
__device__ __forceinline__ void ph_prologue(Ctx& F) {
    LAS float* scr = (LAS float*)(F.lds + F.wave * 8704);
    const int gw = F.bid * NWAVES + F.wave, NGW = F.G * NWAVES;
    constexpr int I_IN = 16 * 80, I_OUT = 16 * 32;
    constexpr int N_IN = NL * I_IN, N_OUT = NL * I_OUT;
    for (int it = gw; it < N_IN + N_OUT; it += NGW) {
        int r = it;
        if (r < N_IN) { const int l = r / I_IN; tr_item<1>(F.inp(I_WIN) + (size_t)l * D * INW, D, INW, F.WinT() + (size_t)l * INW * D, scr, r % I_IN, F.lane); continue; } r -= N_IN;
        { const int l = r / I_OUT; tr_item<0>(F.inp(I_WOUT) + (size_t)l * D * D, D, D, F.WoutT() + (size_t)l * D * D, scr, r % I_OUT, F.lane); }
    }
    const int gt = F.bid * NTHR + F.tid, NGT = F.G * NTHR;
    for (int i = gt; i < NL * 2 * 2 * 4 * 4096; i += NGT) {
        const int c = i & 63, dd = (i >> 6) & 63, n = (i >> 12) & 3, g = (i >> 14) & 1, d = (i >> 15) & 1, l = i >> 16;
        const float* src = g ? F.inp(I_WI) : F.inp(I_WR);
        F.lruw()[i] = (bf16)f2bf(src[((((size_t)l * 2 + d) * 4 + n) * 64 + c) * 64 + dd]);
    }
    for (int i = gt; i < 256 * 16; i += NGT) {
        const int pos = i >> 4, f = i & 15;
        const float invf[16] = {1.000000000e+00f, 5.623413324e-01f, 3.162277639e-01f, 1.778279394e-01f, 1.000000015e-01f, 5.623413250e-02f, 3.162277490e-02f, 1.778279431e-02f,
                                9.999999776e-03f, 5.623413250e-03f, 3.162277630e-03f, 1.778279431e-03f, 1.000000047e-03f, 5.623413017e-04f, 3.162277571e-04f, 1.778279402e-04f};
        float fr = 1.0f;
#pragma unroll
        for (int q = 0; q < 16; ++q) fr = (f == q) ? invf[q] : fr;
        const float ang = (float)pos * fr;
        double rev = (double)ang * 0.15915494309189535; rev -= floor(rev);
        F.rope()[i] = (f32x2){__builtin_amdgcn_cosf((float)rev), __builtin_amdgcn_sinf((float)rev)};
    }
    LAS float* cond = (LAS float*)(F.lds + 72 * 1024);
    LAS float* red = (LAS float*)(F.lds + 88 * 1024);
    __syncthreads();
    for (int i = F.tid; i < 3 * D; i += NTHR) { const int r = i / D, k = i % D; const float v = r < 2 ? F.inp(I_C)[r * D + k] : F.inp(I_CCTX)[k]; cond[i] = siluf_(v); }
    __syncthreads();
    for (int unit = F.bid; unit < NL * 192; unit += F.G) {
        const int l = unit / 192, col0 = (unit % 192) * 32, cl = F.tid & 31, ks = F.tid >> 5;
        const float* W = F.inp(I_ADAW) + (size_t)l * D * 6 * D + col0 + cl;
        float a0 = 0.f, a1 = 0.f, a2 = 0.f;
#pragma unroll 8
        for (int k = ks * 64; k < ks * 64 + 64; ++k) { const float w = W[(size_t)k * 6 * D]; a0 += cond[k] * w; a1 += cond[D + k] * w; a2 += cond[2 * D + k] * w; }
        red[(ks * 3 + 0) * 32 + cl] = a0; red[(ks * 3 + 1) * 32 + cl] = a1; red[(ks * 3 + 2) * 32 + cl] = a2;
        __syncthreads();
        if (F.tid < 96) { const int i = F.tid >> 5; float s = F.inp(I_ADAB)[l * 6 * D + col0 + cl];
            for (int q = 0; q < 16; ++q) s += red[(q * 3 + i) * 32 + cl];
            F.mods()[((size_t)l * 3 + i) * 6 * D + col0 + cl] = s; }
        __syncthreads();
    }
}

__device__ __forceinline__ void ph_norm1(Ctx& F, int l) {
    const int gw = F.bid * NWAVES + F.wave, NGW = F.G * NWAVES;
    const int M = (l == 2) ? ML : MA;
    for (int m = gw; m < M; m += NGW) {
        const int mr = mod_row(m);
        f32x4 v[4];
        if (l == 0) { const float* src = m < ML ? F.inp(I_X) + (size_t)m * D : F.inp(I_CTX) + (size_t)(m - ML) * D;
#pragma unroll
            for (int j = 0; j < 4; ++j) v[j] = *(const f32x4*)(src + 4 * F.lane + 256 * j); }
        else {
#pragma unroll
            for (int j = 0; j < 4; ++j) { const u32x2 w = *(const u32x2*)(F.XL() + (size_t)m * D + 4 * F.lane + 256 * j);
                v[j] = (f32x4){__uint_as_float(w.x << 16), __uint_as_float(w.x & 0xffff0000u), __uint_as_float(w.y << 16), __uint_as_float(w.y & 0xffff0000u)}; } }
        if (l > 0) {
            const float* g5 = F.mods() + ((size_t)(l - 1) * 3 + mr) * 6 * D + 5 * D;
#pragma unroll
            for (int j = 0; j < 4; ++j) {
                const int col = 4 * F.lane + 256 * j; f32x4 s = {0.f, 0.f, 0.f, 0.f};
#pragma unroll
                for (int q = 0; q < 4; ++q) {
                    if (Y2_FP8 && MOE_FP8) { const unsigned w = *(const unsigned*)((const unsigned char*)F.Y2() + ((size_t)m * 4 + q) * D + col);
                        const f32x2 lo = __builtin_amdgcn_cvt_pk_f32_fp8((int)w, false), hi = __builtin_amdgcn_cvt_pk_f32_fp8((int)w, true);
                        s.x += lo.x; s.y += lo.y; s.z += hi.x; s.w += hi.y; }
                    else { const u32x2 w = *(const u32x2*)(F.Y2() + ((size_t)m * 4 + q) * D + col);
                        s.x += __uint_as_float(w.x << 16); s.y += __uint_as_float(w.x & 0xffff0000u); s.z += __uint_as_float(w.y << 16); s.w += __uint_as_float(w.y & 0xffff0000u); } }
                const f32x4 g = *(const f32x4*)(g5 + col) * ((Y2_FP8 && MOE_FP8) ? (1.0f / Y2_SCALE) : 1.0f);
                v[j] += g * s;
            }
        }
        if (l == 1) {
#pragma unroll
            for (int j = 0; j < 4; ++j) { u32x2 w; w.x = pk2(v[j].x, v[j].y); w.y = pk2(v[j].z, v[j].w); *(u32x2*)(F.XL() + (size_t)m * D + 4 * F.lane + 256 * j) = w; }
        }
        float ss = 0.f;
#pragma unroll
        for (int j = 0; j < 4; ++j) ss += (v[j].x * v[j].x + v[j].y * v[j].y) + (v[j].z * v[j].z + v[j].w * v[j].w);
        const float rstd = 1.0f / sqrtf(wave_sum(ss, F.lane) * (1.0f / D) + EPS);
        if (l == 2) {
#pragma unroll
            for (int j = 0; j < 4; ++j) { const int col = 4 * F.lane + 256 * j; const f32x4 g = *(const f32x4*)(F.inp(I_FG) + col); *(f32x4*)(F.outp() + (size_t)m * D + col) = v[j] * rstd * g; }
        } else {
            const float* mo = F.mods() + ((size_t)l * 3 + mr) * 6 * D;
            const float* g1 = F.inp(I_N1G) + l * D;
#pragma unroll
            for (int j = 0; j < 4; ++j) { const int col = 4 * F.lane + 256 * j;
                const f32x4 g = *(const f32x4*)(g1 + col), sh = *(const f32x4*)(mo + col), sc = *(const f32x4*)(mo + D + col);
                const f32x4 h = v[j] * rstd * g * (sc + 1.0f) + sh;
                u32x2 w; w.x = pk2(h.x, h.y); w.y = pk2(h.z, h.w);
                *(u32x2*)(F.H1() + (size_t)m * D + col) = w; }
        }
    }
}

__device__ __forceinline__ void sg_kloop(f32x16 (&acc)[2][2], const bf16* a0, const bf16* a1, const bf16* b0, const bf16* b1, int K) {
#pragma unroll
    for (int i = 0; i < 2; ++i)
#pragma unroll
        for (int j = 0; j < 2; ++j)
#pragma unroll
            for (int r = 0; r < 16; ++r) acc[i][j][r] = 0.f;
#pragma unroll 4
    for (int k = 0; k < K; k += 16) {
        const bf16x8 fa0 = *(const bf16x8*)(a0 + k), fa1 = *(const bf16x8*)(a1 + k), fb0 = *(const bf16x8*)(b0 + k), fb1 = *(const bf16x8*)(b1 + k);
        acc[0][0] = __builtin_amdgcn_mfma_f32_32x32x16_bf16(fa0, fb0, acc[0][0], 0, 0, 0);
        acc[0][1] = __builtin_amdgcn_mfma_f32_32x32x16_bf16(fa0, fb1, acc[0][1], 0, 0, 0);
        acc[1][0] = __builtin_amdgcn_mfma_f32_32x32x16_bf16(fa1, fb0, acc[1][0], 0, 0, 0);
        acc[1][1] = __builtin_amdgcn_mfma_f32_32x32x16_bf16(fa1, fb1, acc[1][1], 0, 0, 0);
    }
}

__device__ __forceinline__ float inproj_fix(const Ctx& F, int m, int c, float v, float partner) {
    float o = v;
    if (c < C_V) {
        if (m < ML) {
            const int t = m % SEQ, dp = c & 63, pr = dp >> 1, p = pr >> 4, f = pr & 15, pos = p ? (t & 63) : (t >> 6);
            const f32x2 cs = F.rope()[pos * 16 + f];
            o = (dp & 1) ? (partner * cs.y + v * cs.x) : (v * cs.x - partner * cs.y);
        }
        if (c < C_K) o *= QSCALE;
    }
    return o;
}
__device__ __forceinline__ size_t vt_index(int m, int cv  ) {
    const int kvh = cv >> 6, d = cv & 63;
    if (m < ML) { const int b = m / SEQ, t = m % SEQ; return ((size_t)((b * 2 + kvh) * 64 + d)) * SEQ + t; }
    const int b = (m - ML) / CTXL, t = (m - ML) % CTXL; return VT_CTX_OFF + ((size_t)((b * 2 + kvh) * 64 + d)) * CTXL + t;
}
__device__ __forceinline__ void ph_inproj_naive(Ctx& F, int l) {
    const int gw = F.bid * NWAVES + F.wave, NGW = F.G * NWAVES, r = F.lane & 31, h = F.lane >> 5;
    const bf16* Bt = F.WinT() + (size_t)l * INW * D;
    for (int ti = gw; ti < (MA / 64) * (INW / 64); ti += NGW) {
        const int rt = ti / (INW / 64), ct = ti % (INW / 64), m0 = rt * 64, c0 = ct * 64;
        f32x16 acc[2][2];
        sg_kloop(acc, F.H1() + (size_t)(m0 + r) * D + 8 * h, F.H1() + (size_t)(m0 + 32 + r) * D + 8 * h, Bt + (size_t)(c0 + r) * D + 8 * h, Bt + (size_t)(c0 + 32 + r) * D + 8 * h, D);
#pragma unroll
        for (int mt = 0; mt < 2; ++mt)
#pragma unroll
            for (int nt = 0; nt < 2; ++nt)
#pragma unroll
                for (int q = 0; q < 16; ++q) {
                    const int m = m0 + 32 * mt + crow(q, h), c = c0 + 32 * nt + r;
                    const float v = acc[mt][nt][q], pa = shx(v, 1, F.lane);
                    const float o = inproj_fix(F, m, c, v, pa);
                    F.P()[(size_t)m * INW + c] = (bf16)f2bf(o);
                    if (c >= C_V && c < C_LX) F.Vt()[vt_index(m, c - C_V)] = (bf16)f2bf(o);
                }
    }
}

__device__ __forceinline__ float dot64(const float (&q)[64], const bf16* kp) {
    float s = 0.f;
#pragma unroll
    for (int i = 0; i < 8; ++i) { const u32x4 w = *(const u32x4*)(kp + 8 * i);
        s += q[8 * i + 0] * __uint_as_float(w.x << 16) + q[8 * i + 1] * __uint_as_float(w.x & 0xffff0000u) + q[8 * i + 2] * __uint_as_float(w.y << 16) + q[8 * i + 3] * __uint_as_float(w.y & 0xffff0000u)
           + q[8 * i + 4] * __uint_as_float(w.z << 16) + q[8 * i + 5] * __uint_as_float(w.z & 0xffff0000u) + q[8 * i + 6] * __uint_as_float(w.w << 16) + q[8 * i + 7] * __uint_as_float(w.w & 0xffff0000u); }
    return s;
}
__device__ __forceinline__ void ph_attn_naive(Ctx& F, int l) {
    const int gw = F.bid * NWAVES + F.wave, NGW = F.G * NWAVES;
    const int Mq = (l == 0) ? MA : ML;
    LAS float* pbuf = (LAS float*)(F.lds) + F.wave * 640;
    for (int u = gw; u < Mq * 8; u += NGW) {
        const int m = u >> 3, hq = u & 7, kvh = hq >> 2;
        const bool isc = m >= ML; const int b = row_b(m), t = row_t(m);
        float q[64];
        { const bf16* qp = F.P() + (size_t)m * INW + C_Q + hq * 64;
#pragma unroll
          for (int i = 0; i < 8; ++i) { const u32x4 w = *(const u32x4*)(qp + 8 * i);
              q[8 * i + 0] = __uint_as_float(w.x << 16); q[8 * i + 1] = __uint_as_float(w.x & 0xffff0000u); q[8 * i + 2] = __uint_as_float(w.y << 16); q[8 * i + 3] = __uint_as_float(w.y & 0xffff0000u);
              q[8 * i + 4] = __uint_as_float(w.z << 16); q[8 * i + 5] = __uint_as_float(w.z & 0xffff0000u); q[8 * i + 6] = __uint_as_float(w.w << 16); q[8 * i + 7] = __uint_as_float(w.w & 0xffff0000u); } }
        const int lo = isc ? 0 : (t - 128 < 0 ? 0 : t - 128), hi = isc ? -1 : (t + 128 > SEQ - 1 ? SEQ - 1 : t + 128);
        const int nloc = hi - lo + 1, nk = nloc + CTXL;
        const float sink2 = F.inp(I_SINK)[l * 8 + hq] * LOG2E;
        float s[9]; float mx = sink2;
#pragma unroll
        for (int i = 0; i < 9; ++i) { const int kk = F.lane + 64 * i; s[i] = -3.0e38f;
            if (kk < nk) { const int krow = kk < nloc ? b * SEQ + lo + kk : ML + b * CTXL + (kk - nloc);
                s[i] = dot64(q, F.P() + (size_t)krow * INW + C_K + kvh * 64); mx = fmaxf(mx, s[i]); } }
        mx = wave_max(mx, F.lane);
        float lsum = 0.f;
#pragma unroll
        for (int i = 0; i < 9; ++i) { const int kk = F.lane + 64 * i; const float p = (kk < nk) ? exp2f(s[i] - mx) : 0.f; lsum += p; pbuf[kk] = p; }
        lsum = wave_sum(lsum, F.lane) + exp2f(sink2 - mx);
        asm volatile("s_waitcnt lgkmcnt(0)" ::: "memory");
        float o = 0.f;
        for (int kk = 0; kk < nk; ++kk) { const int krow = kk < nloc ? b * SEQ + lo + kk : ML + b * CTXL + (kk - nloc);
            o += pbuf[kk] * bf2f(F.P()[(size_t)krow * INW + C_V + kvh * 64 + F.lane]); }
        F.MIX()[(size_t)m * D + hq * 64 + F.lane] = (bf16)f2bf(o / lsum);
        asm volatile("s_waitcnt lgkmcnt(0)" ::: "memory");
    }
}
__device__ __forceinline__ void ph_lru_gates_naive(Ctx& F, int l) {
    const size_t gt = (size_t)F.bid * NTHR + F.tid, NGT = (size_t)F.G * NTHR;
    for (size_t i = gt; i < (size_t)MA * 512; i += NGT) {
        const int m = (int)(i >> 9), d = (int)(i >> 8) & 1, c = (int)i & 255, n = c >> 6, cc0 = c & 63;
        const int t = row_t(m), T = m < ML ? SEQ : CTXL, rb = m - t;
        const float* wr = F.inp(I_WR) + (((size_t)l * 2 + d) * 4 + n) * 4096;
        const float* wi = F.inp(I_WI) + (((size_t)l * 2 + d) * 4 + n) * 4096;
        float rp = F.inp(I_BR)[(l * 2 + d) * 256 + c], ip = F.inp(I_BI)[(l * 2 + d) * 256 + c], us = 0.f;
        for (int cc = 0; cc < 64; ++cc) {
            const int ch = n * 64 + cc; float u = F.inp(I_CONVB)[l * 256 + ch];
#pragma unroll
            for (int j = 0; j < 4; ++j) { const int tt = t - 2 + j; if (tt >= 0 && tt < T) u += F.inp(I_CONVW)[(l * 4 + j) * 256 + ch] * bf2f(F.P()[(size_t)(rb + tt) * INW + C_LX + ch]); }
            rp += u * wr[cc * 64 + cc0]; ip += u * wi[cc * 64 + cc0];
            if (cc == cc0) us = u;
        }
        const float r = sigmoidf_(rp), ig = sigmoidf_(ip);
        const float lam = F.inp(I_LAM)[(l * 2 + d) * 256 + c];
        const float la = -8.0f * r * log1pf(expf(-lam));
        const float a = expf(la), mult = sqrtf(fmaxf(-expm1f(2.0f * la), 1e-12f));
        F.GA()[i] = a; F.GB()[i] = mult * ig * us;
    }
}
__device__ __forceinline__ void ph_lru_scan_naive(Ctx& F) {
    const int gt = F.bid * NTHR + F.tid;
    if (gt >= NB * 512) return;
    const int b = gt >> 9, d = (gt >> 8) & 1, c = gt & 255;
    float h = 0.f;
    for (int s = 0; s < CTXL + SEQ; ++s) {
        int m;
        if (s < CTXL) m = ML + b * CTXL + (d ? CTXL - 1 - s : s); else { const int t = s - CTXL; m = b * SEQ + (d ? SEQ - 1 - t : t); }
        const size_t i = (size_t)m * 512 + d * 256 + c;
        h = F.GA()[i] * h + F.GB()[i];
        F.HD()[i] = h;
    }
}
__device__ __forceinline__ void ph_lru_out_naive(Ctx& F, int l) {
    const size_t gt = (size_t)F.bid * NTHR + F.tid, NGT = (size_t)F.G * NTHR;
    const int Mq = (l == 0) ? MA : ML;
    for (size_t i = gt; i < (size_t)Mq * 256; i += NGT) {
        const int m = (int)(i >> 8), c = (int)i & 255;
        const float y = (F.HD()[(size_t)m * 512 + c] + F.HD()[(size_t)m * 512 + 256 + c]) * gelu_tanh(bf2f(F.P()[(size_t)m * INW + C_LG + c]));
        F.MIX()[(size_t)m * D + 512 + c] = (bf16)f2bf(y);
    }
}
__device__ __forceinline__ float hg_lb(const Ctx& F, int l, int d, int hk) {
    if (l == 0) return 0.f;
    const float l0 = F.inp(I_LBL)[(0 * 2 + d) * 256 + hk], l1 = F.inp(I_LBL)[(1 * 2 + d) * 256 + hk];
    return 1.0f / (1.0f + expf(l0 - l1));
}
__device__ __forceinline__ void ph_hgrn_scan_naive(Ctx& F, int l) {
    if (F.bid >= NB * 2 * 4) return;
    const int b = F.bid >> 3, d = (F.bid >> 2) & 1, hh = F.bid & 3;
    const int v = F.tid & 63, kq = F.tid >> 6;
    LAS float* part = (LAS float*)F.lds;
    float lb[8], S[8];
#pragma unroll
    for (int i = 0; i < 8; ++i) { lb[i] = hg_lb(F, l, d, hh * 64 + kq * 8 + i); S[i] = 0.f; }
    int buf = 0;
    for (int s = 0; s < CTXL + SEQ; ++s) {
        int m;
        if (s < CTXL) m = ML + b * CTXL + (d ? CTXL - 1 - s : s); else { const int t = s - CTXL; m = b * SEQ + (d ? SEQ - 1 - t : t); }
        const bf16* pr = F.P() + (size_t)m * INW;
        const u32x4 zw = *(const u32x4*)(pr + (d ? C_HB : C_HF) + hh * 64 + kq * 8), qw = *(const u32x4*)(pr + C_HQ + hh * 64 + kq * 8);
        const float vv = bf2f(pr[C_HV + hh * 64 + v]);
        float z[8], q[8];
        z[0] = __uint_as_float(zw.x << 16); z[1] = __uint_as_float(zw.x & 0xffff0000u); z[2] = __uint_as_float(zw.y << 16); z[3] = __uint_as_float(zw.y & 0xffff0000u);
        z[4] = __uint_as_float(zw.z << 16); z[5] = __uint_as_float(zw.z & 0xffff0000u); z[6] = __uint_as_float(zw.w << 16); z[7] = __uint_as_float(zw.w & 0xffff0000u);
        q[0] = __uint_as_float(qw.x << 16); q[1] = __uint_as_float(qw.x & 0xffff0000u); q[2] = __uint_as_float(qw.y << 16); q[3] = __uint_as_float(qw.y & 0xffff0000u);
        q[4] = __uint_as_float(qw.z << 16); q[5] = __uint_as_float(qw.z & 0xffff0000u); q[6] = __uint_as_float(qw.w << 16); q[7] = __uint_as_float(qw.w & 0xffff0000u);
        float pa = 0.f;
#pragma unroll
        for (int i = 0; i < 8; ++i) { const float sg = sigmoidf_(z[i]); const float f = lb[i] + (1.0f - lb[i]) * sg, kk = (1.0f - lb[i]) * (1.0f - sg);
            S[i] = f * S[i] + kk * vv; pa += S[i] * q[i]; }
        part[(buf * 8 + kq) * 64 + v] = pa;
        __syncthreads();
        if (kq == 0) { float o = 0.f;
#pragma unroll
            for (int i = 0; i < 8; ++i) o += part[(buf * 8 + i) * 64 + v];
            F.OHG()[(size_t)m * 512 + d * 256 + hh * 64 + v] = o; }
        buf ^= 1;
    }
}
__device__ __forceinline__ void ph_hgrn_out_naive(Ctx& F, int l) {
    const int gw = F.bid * NWAVES + F.wave, NGW = F.G * NWAVES;
    const int Mq = (l == 0) ? MA : ML;
    for (int m = gw; m < Mq; m += NGW) {
        const int col = 4 * F.lane;
        const f32x4 a = *(const f32x4*)(F.OHG() + (size_t)m * 512 + col), bb = *(const f32x4*)(F.OHG() + (size_t)m * 512 + 256 + col);
        const f32x4 o = a + bb;
        float ss = (o.x * o.x + o.y * o.y) + (o.z * o.z + o.w * o.w);
        ss += shx(ss, 1, F.lane); ss += shx(ss, 2, F.lane); ss += shx(ss, 4, F.lane); ss += shx(ss, 8, F.lane);
        const float rstd = 1.0f / sqrtf(ss * (1.0f / 64.0f) + EPS);
        const f32x4 g = *(const f32x4*)(F.inp(I_HNG) + l * 256 + col);
        const u32x2 ow = *(const u32x2*)(F.P() + (size_t)m * INW + C_HO + col);
        const float g0 = siluf_(__uint_as_float(ow.x << 16)), g1 = siluf_(__uint_as_float(ow.x & 0xffff0000u)), g2 = siluf_(__uint_as_float(ow.y << 16)), g3 = siluf_(__uint_as_float(ow.y & 0xffff0000u));
        u32x2 w; w.x = pk2(o.x * rstd * g.x * g0, o.y * rstd * g.y * g1); w.y = pk2(o.z * rstd * g.z * g2, o.w * rstd * g.w * g3);
        *(u32x2*)(F.MIX() + (size_t)m * D + 768 + col) = w;
    }
}

constexpr int MIX_NUB = 136, MIX_NU = 272;
constexpr int LRU_NU = MIX_NU;
struct MixUnit { int b, j, rowbase, t0, ntok, T, ub; bool isc; };
__device__ __forceinline__ MixUnit mix_unit(int g) {
    MixUnit m;
    if (g < 256) { m.b = g >> 7; m.j = g & 127; m.isc = false; m.rowbase = m.b * SEQ; m.t0 = m.j * 128; m.ntok = 128; m.T = SEQ; }
    else { const int c = g - 256; m.b = c >> 3; m.j = 128 + (c & 7); m.isc = true; m.rowbase = ML + m.b * CTXL; m.t0 = (c & 7) * 32; m.ntok = 32; m.T = CTXL; }
    m.ub = m.b * MIX_NUB + m.j; return m;
}
constexpr size_t AG_LRU_A = 0, AG_LRU_B = (size_t)LRU_NU * 512, AG_LRU_H = 2 * (size_t)LRU_NU * 512;
constexpr int U_PITCH = 528;
template <bool FULL, int DIR>
__device__ __forceinline__ void lru_wave(Ctx& F, int l, int u, int n, int rowbase, int t0, int nmt) {
    int ln_ = F.lane; asm volatile("" : "+v"(ln_));
    const int r32 = ln_ & 31, h = ln_ >> 5;
    LAS unsigned char* U = F.lds;
    const bf16* wb = F.lruw() + ((((size_t)l * 2 + DIR) * 2) * 4 + n) * 4096;
    float br[2], bi[2], c8[2], hc[2], At[2], Bt[2];
#pragma unroll
    for (int ct = 0; ct < 2; ++ct) { const int c = 64 * n + 32 * ct + r32, ix = (l * 2 + DIR) * 256 + c;
        br[ct] = FULL ? 0.f : F.inp(I_BR)[ix]; bi[ct] = FULL ? 0.f : F.inp(I_BI)[ix]; c8[ct] = FULL ? 0.f : 8.0f * log1pf(expf(-F.inp(I_LAM)[ix]));
        hc[ct] = FULL ? F.AGG()[AG_LRU_H + (size_t)u * 512 + DIR * 256 + c] : 0.f; At[ct] = 1.f; Bt[ct] = 0.f; }
#pragma unroll
    for (int ct = 0; ct < 2; ++ct) {
        const int c = 64 * n + 32 * ct + r32;
        bf16x8 Bg[2][4];
        if (!FULL) {
#pragma unroll
            for (int g = 0; g < 2; ++g) { const bf16* p = wb + (size_t)g * 4 * 4096 + (32 * ct + r32) * 64 + 8 * h;
#pragma unroll
                for (int ks = 0; ks < 4; ++ks) Bg[g][ks] = *(const bf16x8*)(p + 16 * ks); } }
#pragma unroll 1
        for (int mi = 0; mi < nmt; ++mi) {
            const int mt = DIR ? nmt - 1 - mi : mi;
            float a[16], bb[16];
            const size_t gix0 = (size_t)(rowbase + t0 + 32 * mt + 4 * h) * 512 + DIR * 256 + c;
            if (FULL) {
#pragma unroll
                for (int q = 0; q < 16; ++q) { const size_t ix = gix0 + (size_t)((q & 3) + 8 * (q >> 2)) * 512; a[q] = F.GA()[ix]; bb[q] = F.GB()[ix]; }
            } else {
                f32x16 acc[2];
#pragma unroll
                for (int g = 0; g < 2; ++g)
#pragma unroll
                    for (int q = 0; q < 16; ++q) acc[g][q] = 0.f;
#pragma unroll
                for (int ks = 0; ks < 4; ++ks) { const bf16x8 af = *(const LAS bf16x8*)(U + (32 * mt + r32) * U_PITCH + (64 * n + 16 * ks + 8 * h) * 2);
                    acc[0] = __builtin_amdgcn_mfma_f32_32x32x16_bf16(af, Bg[0][ks], acc[0], 0, 0, 0); acc[1] = __builtin_amdgcn_mfma_f32_32x32x16_bf16(af, Bg[1][ks], acc[1], 0, 0, 0); }
#pragma unroll
                for (int q = 0; q < 16; ++q) { const int t = 32 * mt + crow(q, h);
                    const float uu = bf2f(*(const LAS bf16*)(U + t * U_PITCH + c * 2));
                    const float r = sigmoidf_(acc[0][q] + br[ct]), ig = sigmoidf_(acc[1][q] + bi[ct]);
                    a[q] = __expf(-c8[ct] * r); bb[q] = __builtin_amdgcn_sqrtf(fmaxf(1.0f - a[q] * a[q], 1e-12f)) * ig * uu;
                    const size_t ix = gix0 + (size_t)((q & 3) + 8 * (q >> 2)) * 512; F.GA()[ix] = a[q]; F.GB()[ix] = bb[q]; }
            }
            float gA[4], gB[4], oA[4], oB[4];
#pragma unroll
            for (int g = 0; g < 4; ++g) { float A = 1.f, B = 0.f;
#pragma unroll
                for (int jj = 0; jj < 4; ++jj) { const int q = 4 * g + (DIR ? 3 - jj : jj); B = a[q] * B + bb[q]; A *= a[q]; }
                gA[g] = A; gB[g] = B; }
#pragma unroll
            for (int g = 0; g < 4; ++g) { oA[g] = shx(gA[g], 32, ln_); oB[g] = shx(gB[g], 32, ln_); }
            float st[4] = {0.f, 0.f, 0.f, 0.f}; float hs = hc[ct];
#pragma unroll
            for (int kk = 0; kk < 8; ++kk) { const int k = DIR ? 7 - kk : kk, g = k >> 1; const bool mine = ((k & 1) == h);
                const float Ak = mine ? gA[g] : oA[g], Bk = mine ? gB[g] : oB[g];
                if (FULL) { st[g] = mine ? hs : st[g]; hs = Ak * hs + Bk; }
                else { Bt[ct] = Ak * Bt[ct] + Bk; At[ct] *= Ak; } }
            if (FULL) {
                hc[ct] = hs;
#pragma unroll
                for (int g = 0; g < 4; ++g) { float hh = st[g];
#pragma unroll
                    for (int jj = 0; jj < 4; ++jj) { const int q = 4 * g + (DIR ? 3 - jj : jj); hh = a[q] * hh + bb[q];
                        F.HD()[(size_t)(rowbase + t0 + 32 * mt + crow(q, h)) * 512 + DIR * 256 + c] = hh; } }
            }
        }
        __builtin_amdgcn_sched_barrier(0);
    }
    if (!FULL && h == 0) {
#pragma unroll
        for (int ct = 0; ct < 2; ++ct) { const int c = 64 * n + 32 * ct + r32;
            F.AGG()[AG_LRU_A + (size_t)u * 512 + DIR * 256 + c] = At[ct]; F.AGG()[AG_LRU_B + (size_t)u * 512 + DIR * 256 + c] = Bt[ct]; }
    }
}
template <bool FULL>
__device__ __forceinline__ void ph_lru_fast(Ctx& F, int l) {
    LAS unsigned char* U = F.lds;
    for (int it = 0; it < 2; ++it) {
        const int u = it == 0 ? F.bid : 256 + (F.bid - 16);
        if (it == 0 ? (u >= 256) : (F.bid < 16 || F.bid >= 32 || F.G < 256)) continue;
        const MixUnit mu = mix_unit(u); const bool isc = mu.isc;
        if (FULL && isc && l == NL - 1) continue;
        const int rowbase = mu.rowbase, T = mu.T, t0 = mu.t0, ntok = mu.ntok;
        __syncthreads();
        if (!FULL) { const int c8 = (F.tid & 31) * 8, tr = F.tid >> 5;
          float w[4][8], cb[8];
#pragma unroll
          for (int jj = 0; jj < 4; ++jj) { const f32x4 w0 = *(const f32x4*)(F.inp(I_CONVW) + (l * 4 + jj) * 256 + c8), w1 = *(const f32x4*)(F.inp(I_CONVW) + (l * 4 + jj) * 256 + c8 + 4);
              w[jj][0] = w0.x; w[jj][1] = w0.y; w[jj][2] = w0.z; w[jj][3] = w0.w; w[jj][4] = w1.x; w[jj][5] = w1.y; w[jj][6] = w1.z; w[jj][7] = w1.w; }
          { const f32x4 b0 = *(const f32x4*)(F.inp(I_CONVB) + l * 256 + c8), b1 = *(const f32x4*)(F.inp(I_CONVB) + l * 256 + c8 + 4);
            cb[0] = b0.x; cb[1] = b0.y; cb[2] = b0.z; cb[3] = b0.w; cb[4] = b1.x; cb[5] = b1.y; cb[6] = b1.z; cb[7] = b1.w; }
#pragma unroll 4
          for (int i = 0; i < 8; ++i) { const int t = tr + 16 * i, tt = t0 + t;
              if (t >= ntok) break;
              float o[8];
#pragma unroll
              for (int e = 0; e < 8; ++e) o[e] = cb[e];
#pragma unroll
              for (int jj = 0; jj < 4; ++jj) { const int ts = tt - 2 + jj;
                  if (ts >= 0 && ts < T) { const u32x4 xw = *(const u32x4*)(F.P() + (size_t)(rowbase + ts) * INW + C_LX + c8);
                      o[0] += w[jj][0] * __uint_as_float(xw.x << 16); o[1] += w[jj][1] * __uint_as_float(xw.x & 0xffff0000u); o[2] += w[jj][2] * __uint_as_float(xw.y << 16); o[3] += w[jj][3] * __uint_as_float(xw.y & 0xffff0000u);
                      o[4] += w[jj][4] * __uint_as_float(xw.z << 16); o[5] += w[jj][5] * __uint_as_float(xw.z & 0xffff0000u); o[6] += w[jj][6] * __uint_as_float(xw.w << 16); o[7] += w[jj][7] * __uint_as_float(xw.w & 0xffff0000u); } }
              u32x4 ow; ow.x = pk2(o[0], o[1]); ow.y = pk2(o[2], o[3]); ow.z = pk2(o[4], o[5]); ow.w = pk2(o[6], o[7]);
              *(LAS u32x4*)(U + t * U_PITCH + c8 * 2) = ow; } }
        __syncthreads();
        { const int n = F.wave & 3;
          if (F.wave < 4) lru_wave<FULL, 0>(F, l, mu.ub, n, rowbase, t0, ntok >> 5); else lru_wave<FULL, 1>(F, l, mu.ub, n, rowbase, t0, ntok >> 5); }
        if (FULL) {
            __syncthreads();
#pragma unroll 4
            for (int i = F.tid; i < ntok * 64; i += NTHR) { const int t = i >> 6, c4 = (i & 63) * 4; const size_t row = (size_t)rowbase + t0 + t;
                const f32x4 hf = *(const f32x4*)(F.HD() + row * 512 + c4), hb = *(const f32x4*)(F.HD() + row * 512 + 256 + c4);
                const u32x2 gw = *(const u32x2*)(F.P() + row * INW + C_LG + c4);
                u32x2 w; w.x = pk2((hf.x + hb.x) * gelu_tanh(__uint_as_float(gw.x << 16)), (hf.y + hb.y) * gelu_tanh(__uint_as_float(gw.x & 0xffff0000u)));
                w.y = pk2((hf.z + hb.z) * gelu_tanh(__uint_as_float(gw.y << 16)), (hf.w + hb.w) * gelu_tanh(__uint_as_float(gw.y & 0xffff0000u)));
                *(u32x2*)(F.MIX() + row * D + 512 + c4) = w; }
        }
    }
}
__device__ __forceinline__ int mix_order(int d, int s) { return d ? 135 - s : (s < 8 ? 128 + s : s - 8); }
__device__ __forceinline__ void ph_lru_carry(Ctx& F) {
    const int gt = F.bid * NTHR + F.tid;
    if (gt >= NB * 512) return;
    const int b = gt >> 9, dc = gt & 511, d = dc >> 8;
    float h = 0.f;
#pragma unroll 1
    for (int s0 = 0; s0 < 136; s0 += 34) {
        float av[34], bv[34];
#pragma unroll
        for (int q = 0; q < 34; ++q) { const size_t ix = (size_t)(b * MIX_NUB + mix_order(d, s0 + q)) * 512 + dc; av[q] = F.AGG()[AG_LRU_A + ix]; bv[q] = F.AGG()[AG_LRU_B + ix]; }
#pragma unroll
        for (int q = 0; q < 34; ++q) { F.AGG()[AG_LRU_H + (size_t)(b * MIX_NUB + mix_order(d, s0 + q)) * 512 + dc] = h; h = av[q] * h + bv[q]; }
    }
}

constexpr int HG_NU = MIX_NU;
constexpr int HGW_LDS = 17152;
constexpr int KT_P = 36;
constexpr size_t AG_HG_D = 1048576, AG_HG_EBR = AG_HG_D + (size_t)HG_NU * 8 * 64;
__device__ __forceinline__ void hg_stage_v(const Ctx& F, LAS bf16* Vt, int rowbase, int c0, int hh, int r32, int h, int DIR) {
    const int t = c0 + (DIR ? 31 - r32 : r32); const bf16* vp = F.P() + (size_t)(rowbase + t) * INW + C_HV + hh * 64 + 32 * h;
#pragma unroll
    for (int c = 0; c < 4; ++c) { const u32x4 w = *(const u32x4*)(vp + 8 * c); const int v0 = 32 * h + 8 * c;
        Vt[(v0 + 0) * 32 + r32] = (bf16)(w.x & 0xffffu); Vt[(v0 + 1) * 32 + r32] = (bf16)(w.x >> 16); Vt[(v0 + 2) * 32 + r32] = (bf16)(w.y & 0xffffu); Vt[(v0 + 3) * 32 + r32] = (bf16)(w.y >> 16);
        Vt[(v0 + 4) * 32 + r32] = (bf16)(w.z & 0xffffu); Vt[(v0 + 5) * 32 + r32] = (bf16)(w.z >> 16); Vt[(v0 + 6) * 32 + r32] = (bf16)(w.w & 0xffffu); Vt[(v0 + 7) * 32 + r32] = (bf16)(w.w >> 16); }
}
__device__ __forceinline__ void hg_update_s(f32x16 (&S)[2][2], const LAS bf16* KiT, const LAS bf16* Vt, const LAS float* ebr, int r32, int h) {
#pragma unroll
    for (int kt = 0; kt < 2; ++kt) {
        float e1[16];
#pragma unroll
        for (int q = 0; q < 16; ++q) e1[q] = ebr[4 * h + (32 * kt + (q & 3) + 8 * (q >> 2))];
#pragma unroll
        for (int vt = 0; vt < 2; ++vt) { f32x16 tmp;
#pragma unroll
            for (int q = 0; q < 16; ++q) tmp[q] = 0.f;
#pragma unroll
            for (int ks = 0; ks < 2; ++ks) { const LAS bf16* kp = KiT + (32 * kt + r32) * KT_P + 16 * ks + 8 * h; const u32x2 klo = *(const LAS u32x2*)kp, khi = *(const LAS u32x2*)(kp + 4);
                u32x4 fau; fau.x = klo.x; fau.y = klo.y; fau.z = khi.x; fau.w = khi.y; const bf16x8 fa = __builtin_bit_cast(bf16x8, fau), fb = *(const LAS bf16x8*)(Vt + (32 * vt + r32) * 32 + 16 * ks + 8 * h);
                tmp = __builtin_amdgcn_mfma_f32_32x32x16_bf16(fa, fb, tmp, 0, 0, 0); }
#pragma unroll
            for (int q = 0; q < 16; ++q) S[kt][vt][q] = e1[q] * (e1[q] * S[kt][vt][q] + tmp[q]); }
    }
}
template <int DIR>
__device__ __forceinline__ void hg_wave_a(Ctx& F, int l, int u, int hh, int rowbase, int nch) {
    int ln_ = F.lane; asm volatile("" : "+v"(ln_));
    const int r32 = ln_ & 31, h = ln_ >> 5, k = ln_;
    LAS unsigned char* W = F.lds + F.wave * HGW_LDS;
    LAS bf16* Qi = (LAS bf16*)W; LAS bf16* Ki = (LAS bf16*)(W + 4096); LAS bf16* KiT = (LAS bf16*)(W + 8192); LAS bf16* Vt = (LAS bf16*)(W + 12800); LAS float* ebr = (LAS float*)(W + 16896);
    const int hd = DIR * 4 + hh;
    const float lb = hg_lb(F, l, DIR, hh * 64 + k);
    const unsigned lane_s = 4 * h * 64 + r32;
    f32x16 S[2][2];
#pragma unroll
    for (int kt = 0; kt < 2; ++kt)
#pragma unroll
        for (int vt = 0; vt < 2; ++vt)
#pragma unroll
            for (int q = 0; q < 16; ++q) S[kt][vt][q] = 0.f;
    float dsum = 0.f;
#pragma unroll 1
    for (int ci = 0; ci < nch; ++ci) {
        const int cph = DIR ? nch - 1 - ci : ci, c0 = 32 * cph;
        const int si = ln_ >> 1, sh = ln_ & 1; const int ts = c0 + (DIR ? 31 - si : si);
        { const bf16* zp = F.P() + (size_t)(rowbase + ts) * INW + (DIR ? C_HB : C_HF) + hh * 64 + 32 * sh;
          const bf16* qp = F.P() + (size_t)(rowbase + ts) * INW + C_HQ + hh * 64 + 32 * sh;
          u32x4 zz[4], qq[4];
#pragma unroll
          for (int c = 0; c < 4; ++c) { zz[c] = *(const u32x4*)(zp + 8 * c); qq[c] = *(const u32x4*)(qp + 8 * c); }
#pragma unroll
          for (int c = 0; c < 4; ++c) { *(LAS u32x4*)(Qi + si * 64 + 32 * sh + 8 * c) = zz[c]; *(LAS u32x4*)(Ki + si * 64 + 32 * sh + 8 * c) = qq[c]; } }
        hg_stage_v(F, Vt, rowbase, c0, hh, r32, h, DIR);
        asm volatile("s_waitcnt lgkmcnt(0)" ::: "memory");
        {
            float lf[32]; float run = 0.f;
#pragma unroll
            for (int i = 0; i < 32; ++i) { const float z = bf2f(Qi[i * 64 + k]); lf[i] = __logf(lb + (1.0f - lb) * sigmoidf_(z)); run += lf[i]; }
            const float bref = 0.5f * run; dsum += run;
            const float eb = __expf(bref);
            ebr[k] = eb; F.AGG()[AG_HG_EBR + (((size_t)u * 4 + cph) * 8 + hd) * 64 + k] = eb;
            float cum = 0.f;
#pragma unroll
            for (int i = 0; i < 32; ++i) {
                const float qq = bf2f(Ki[i * 64 + k]);
                cum += lf[i];
                const float e = __expf(cum - bref), ei = __expf(bref - cum);
                const unsigned kv = f2bf((1.0f - __expf(lf[i])) * ei);
                Ki[i * 64 + k] = (bf16)kv; KiT[k * KT_P + i] = (bf16)kv; Qi[i * 64 + k] = (bf16)f2bf(qq * e); }
        }
        asm volatile("s_waitcnt lgkmcnt(0)" ::: "memory");
        { bf16* qo = F.ws_bf16(WS_QI) + (size_t)(rowbase + ts) * 512 + DIR * 256 + hh * 64 + 32 * sh; bf16* ko = F.ws_bf16(WS_KI) + (size_t)(rowbase + ts) * 512 + DIR * 256 + hh * 64 + 32 * sh;
#pragma unroll
          for (int c = 0; c < 4; ++c) { *(u32x4*)(qo + 8 * c) = *(const LAS u32x4*)(Qi + si * 64 + 32 * sh + 8 * c); *(u32x4*)(ko + 8 * c) = *(const LAS u32x4*)(Ki + si * 64 + 32 * sh + 8 * c); } }
        hg_update_s(S, KiT, Vt, ebr, r32, h);
        asm volatile("s_waitcnt lgkmcnt(0)" ::: "memory");
    }
    float* sa = (float*)(F.ws + WS_SAGG) + ((size_t)u * 8 + hd) * 4096;
#pragma unroll
    for (int kt = 0; kt < 2; ++kt)
#pragma unroll
        for (int vt = 0; vt < 2; ++vt)
#pragma unroll
            for (int q = 0; q < 16; ++q) sa[lane_s + (unsigned)((32 * kt + (q & 3) + 8 * (q >> 2)) * 64 + 32 * vt)] = S[kt][vt][q];
    F.AGG()[AG_HG_D + ((size_t)u * 8 + hd) * 64 + k] = __expf(dsum);
}
template <int DIR>
__device__ __forceinline__ void hg_wave_c(Ctx& F, int l, int u, int hh, int rowbase, int nch) {
    int ln_ = F.lane; asm volatile("" : "+v"(ln_));
    const int r32 = ln_ & 31, h = ln_ >> 5, k = ln_;
    LAS unsigned char* W = F.lds + F.wave * HGW_LDS;
    LAS bf16* Qi = (LAS bf16*)W; LAS bf16* Ki = (LAS bf16*)(W + 4096); LAS bf16* KiT = (LAS bf16*)(W + 8192); LAS bf16* Vt = (LAS bf16*)(W + 12800); LAS float* ebr = (LAS float*)(W + 16896);
    const int hd = DIR * 4 + hh;
    const unsigned lane_s = 4 * h * 64 + r32;
    f32x16 S[2][2];
    { const float* sin = (const float*)(F.ws + WS_SIN) + ((size_t)u * 8 + hd) * 4096;
#pragma unroll
      for (int kt = 0; kt < 2; ++kt)
#pragma unroll
          for (int vt = 0; vt < 2; ++vt)
#pragma unroll
              for (int q = 0; q < 16; ++q) S[kt][vt][q] = sin[lane_s + (unsigned)((32 * kt + (q & 3) + 8 * (q >> 2)) * 64 + 32 * vt)]; }
#pragma unroll 1
    for (int ci = 0; ci < nch; ++ci) {
        const int cph = DIR ? nch - 1 - ci : ci, c0 = 32 * cph;
        { const int si = ln_ >> 1, sh = ln_ & 1; const int ts = c0 + (DIR ? 31 - si : si);
          const bf16* qo = F.ws_bf16(WS_QI) + (size_t)(rowbase + ts) * 512 + DIR * 256 + hh * 64 + 32 * sh; const bf16* ko = F.ws_bf16(WS_KI) + (size_t)(rowbase + ts) * 512 + DIR * 256 + hh * 64 + 32 * sh;
          u32x4 qq[4], kk[4];
#pragma unroll
          for (int c = 0; c < 4; ++c) { qq[c] = *(const u32x4*)(qo + 8 * c); kk[c] = *(const u32x4*)(ko + 8 * c); }
          ebr[k] = F.AGG()[AG_HG_EBR + (((size_t)u * 4 + cph) * 8 + hd) * 64 + k];
#pragma unroll
          for (int c = 0; c < 4; ++c) { *(LAS u32x4*)(Qi + si * 64 + 32 * sh + 8 * c) = qq[c]; *(LAS u32x4*)(Ki + si * 64 + 32 * sh + 8 * c) = kk[c];
              const int k0 = 32 * sh + 8 * c;
              KiT[(k0 + 0) * KT_P + si] = (bf16)(kk[c].x & 0xffffu); KiT[(k0 + 1) * KT_P + si] = (bf16)(kk[c].x >> 16); KiT[(k0 + 2) * KT_P + si] = (bf16)(kk[c].y & 0xffffu); KiT[(k0 + 3) * KT_P + si] = (bf16)(kk[c].y >> 16);
              KiT[(k0 + 4) * KT_P + si] = (bf16)(kk[c].z & 0xffffu); KiT[(k0 + 5) * KT_P + si] = (bf16)(kk[c].z >> 16); KiT[(k0 + 6) * KT_P + si] = (bf16)(kk[c].w & 0xffffu); KiT[(k0 + 7) * KT_P + si] = (bf16)(kk[c].w >> 16); } }
        hg_stage_v(F, Vt, rowbase, c0, hh, r32, h, DIR);
        asm volatile("s_waitcnt lgkmcnt(0)" ::: "memory");
        f32x16 att;
#pragma unroll
        for (int q = 0; q < 16; ++q) att[q] = 0.f;
#pragma unroll
        for (int ks = 0; ks < 4; ++ks) { const bf16x8 fa = *(const LAS bf16x8*)(Ki + r32 * 64 + 16 * ks + 8 * h), fb = *(const LAS bf16x8*)(Qi + r32 * 64 + 16 * ks + 8 * h);
            att = __builtin_amdgcn_mfma_f32_32x32x16_bf16(fa, fb, att, 0, 0, 0); }
#pragma unroll
        for (int q = 0; q < 16; ++q) att[q] = (crow(q, h) <= r32) ? att[q] : 0.f;
        f32x16 o[2];
#pragma unroll
        for (int vt = 0; vt < 2; ++vt)
#pragma unroll
            for (int q = 0; q < 16; ++q) o[vt][q] = 0.f;
#pragma unroll
        for (int ks = 0; ks < 2; ++ks) {
            u32x4 pa; pa.x = pk2(att[8 * ks + 0], att[8 * ks + 1]); pa.y = pk2(att[8 * ks + 2], att[8 * ks + 3]); pa.z = pk2(att[8 * ks + 4], att[8 * ks + 5]); pa.w = pk2(att[8 * ks + 6], att[8 * ks + 7]);
#pragma unroll
            for (int vt = 0; vt < 2; ++vt) { const LAS bf16* vp = Vt + (32 * vt + r32) * 32 + 16 * ks + 4 * h;
                const u32x2 lo = *(const LAS u32x2*)vp, hi2 = *(const LAS u32x2*)(vp + 8);
                u32x4 fb; fb.x = lo.x; fb.y = lo.y; fb.z = hi2.x; fb.w = hi2.y;
                o[vt] = __builtin_amdgcn_mfma_f32_32x32x16_bf16(__builtin_bit_cast(bf16x8, pa), __builtin_bit_cast(bf16x8, fb), o[vt], 0, 0, 0); } }
#pragma unroll
        for (int kt = 0; kt < 2; ++kt) {
            float e1[16];
#pragma unroll
            for (int q = 0; q < 16; ++q) e1[q] = ebr[4 * h + (32 * kt + (q & 3) + 8 * (q >> 2))];
#pragma unroll
            for (int ks = 0; ks < 2; ++ks) { const LAS bf16* qp = Qi + r32 * 64 + 32 * kt + 16 * ks + 4 * h;
                const u32x2 lo = *(const LAS u32x2*)qp, hi2 = *(const LAS u32x2*)(qp + 8);
                u32x4 fa; fa.x = lo.x; fa.y = lo.y; fa.z = hi2.x; fa.w = hi2.y;
#pragma unroll
                for (int vt = 0; vt < 2; ++vt) { u32x4 sb;
                    sb.x = pk2(S[kt][vt][8 * ks + 0] * e1[8 * ks + 0], S[kt][vt][8 * ks + 1] * e1[8 * ks + 1]); sb.y = pk2(S[kt][vt][8 * ks + 2] * e1[8 * ks + 2], S[kt][vt][8 * ks + 3] * e1[8 * ks + 3]);
                    sb.z = pk2(S[kt][vt][8 * ks + 4] * e1[8 * ks + 4], S[kt][vt][8 * ks + 5] * e1[8 * ks + 5]); sb.w = pk2(S[kt][vt][8 * ks + 6] * e1[8 * ks + 6], S[kt][vt][8 * ks + 7] * e1[8 * ks + 7]);
                    o[vt] = __builtin_amdgcn_mfma_f32_32x32x16_bf16(__builtin_bit_cast(bf16x8, fa), __builtin_bit_cast(bf16x8, sb), o[vt], 0, 0, 0); } }
        }
        { float* ob = F.OHG() + (size_t)(rowbase + c0) * 512 + DIR * 256 + hh * 64;
          const unsigned lane_o = (unsigned)((DIR ? 4 - 4 * h : 4 * h) * 512 + r32);
#pragma unroll
          for (int q = 0; q < 16; ++q) { const int iq = (q & 3) + 8 * (q >> 2); const unsigned cq = (unsigned)((DIR ? 27 - iq : iq) * 512);
              ob[lane_o + cq] = o[0][q]; ob[lane_o + cq + 32u] = o[1][q]; } }
        if (ci < nch - 1) hg_update_s(S, KiT, Vt, ebr, r32, h);
        asm volatile("s_waitcnt lgkmcnt(0)" ::: "memory");
    }
}
template <bool FULL>
__device__ __forceinline__ void ph_hgrn_fast(Ctx& F, int l) {
    for (int it = 0; it < 2; ++it) {
        const int u = it == 0 ? F.bid : 256 + (F.bid - 32);
        if (it == 0 ? (u >= 256) : (F.bid < 32 || F.bid >= 48 || F.G < 256)) continue;
        const MixUnit mu = mix_unit(u); const bool isc = mu.isc;
        if (FULL && isc && l == NL - 1) continue;
        const int rowbase = mu.rowbase + mu.t0, ntok = mu.ntok;
        __syncthreads();
        { const int hh = F.wave & 3;
          if (FULL) { if (F.wave < 4) hg_wave_c<0>(F, l, mu.ub, hh, rowbase, ntok >> 5); else hg_wave_c<1>(F, l, mu.ub, hh, rowbase, ntok >> 5); }
          else { if (F.wave < 4) hg_wave_a<0>(F, l, mu.ub, hh, rowbase, ntok >> 5); else hg_wave_a<1>(F, l, mu.ub, hh, rowbase, ntok >> 5); } }
        if (FULL) {
            __syncthreads();
#pragma unroll 4
            for (int rr = F.wave; rr < ntok; rr += NWAVES) { const size_t m = (size_t)rowbase + rr; const int col = 4 * F.lane;
                const f32x4 a = *(const f32x4*)(F.OHG() + m * 512 + col), bb = *(const f32x4*)(F.OHG() + m * 512 + 256 + col);
                const f32x4 o = a + bb;
                float ss = (o.x * o.x + o.y * o.y) + (o.z * o.z + o.w * o.w);
                ss += shx(ss, 1, F.lane); ss += shx(ss, 2, F.lane); ss += shx(ss, 4, F.lane); ss += shx(ss, 8, F.lane);
                const float rstd = 1.0f / sqrtf(ss * (1.0f / 64.0f) + EPS);
                const f32x4 g = *(const f32x4*)(F.inp(I_HNG) + l * 256 + col);
                const u32x2 ow = *(const u32x2*)(F.P() + m * INW + C_HO + col);
                const float g0 = siluf_(__uint_as_float(ow.x << 16)), g1 = siluf_(__uint_as_float(ow.x & 0xffff0000u)), g2 = siluf_(__uint_as_float(ow.y << 16)), g3 = siluf_(__uint_as_float(ow.y & 0xffff0000u));
                u32x2 w; w.x = pk2(o.x * rstd * g.x * g0, o.y * rstd * g.y * g1); w.y = pk2(o.z * rstd * g.z * g2, o.w * rstd * g.w * g3);
                *(u32x2*)(F.MIX() + m * D + 768 + col) = w; }
        }
    }
}
__device__ __forceinline__ void ph_hgrn_carry(Ctx& F) {
    const int gt = F.bid * NTHR + F.tid;
    if (gt >= 16 * 4096) return;
    const int seq = gt >> 12, e = gt & 4095, b = seq >> 3, hd = seq & 7, d = hd >> 2, kk = e >> 6;
    const float* SA = (const float*)(F.ws + WS_SAGG); float* SI = (float*)(F.ws + WS_SIN);
    float S = 0.f;
#pragma unroll 1
    for (int s0 = 0; s0 < 136; s0 += 34) {
        float dv[34], sv[34];
#pragma unroll
        for (int q = 0; q < 34; ++q) { const size_t ub = (size_t)(b * MIX_NUB + mix_order(d, s0 + q)) * 8 + hd; dv[q] = F.AGG()[AG_HG_D + ub * 64 + kk]; sv[q] = SA[ub * 4096 + e]; }
#pragma unroll
        for (int q = 0; q < 34; ++q) { const size_t ub = (size_t)(b * MIX_NUB + mix_order(d, s0 + q)) * 8 + hd; SI[ub * 4096 + e] = S; S = dv[q] * S + sv[q]; }
    }
}

constexpr int CV_GU = NE * 16 * 64, CV_DN = NE * 16 * 32, CV_ITEMS = CV_GU + CV_DN, CV_PER_WAVE = CV_ITEMS / 2048;
constexpr int PROG_OFF = 147456 - 256 + 24 * 4;
constexpr int AT_CVSCR = 2 * 2 * 64 * 144;
#ifndef ATTN_RIDE
#define ATTN_RIDE 0
#endif
constexpr int AT_KP = 144;
constexpr int AT_BUF = 2 * 64 * AT_KP;
__device__ __forceinline__ void ph_attn_fast(Ctx& F, int l) {
    int ln_ = F.lane; asm volatile("" : "+v"(ln_));
    const int r32 = ln_ & 31, h = ln_ >> 5, g = F.wave >> 1, ph = F.wave & 1;
    const int lrow = F.tid >> 3, lch = F.tid & 7;
    const int NU = (l == 0) ? 1040 : 1024;
    for (int it = 0; it < 5; ++it) {
        const int u = it < 4 ? F.bid + 256 * it : 1024 + (F.bid - 240);
        if (it == 4 && (F.bid < 240 || NU <= 1024)) continue;
        const bool isc = u >= 1024;
        int b, kvh, jb;
        if (!isc) { b = u >> 9; kvh = (u >> 8) & 1; jb = u & 255; } else { const int v = u - 1024; b = v >> 3; kvh = (v >> 2) & 1; jb = v & 3; }
        const int q0 = jb * 64, qrowbase = isc ? ML + b * CTXL : b * SEQ, hq = kvh * 4 + g;
        int i_lo = 0, nloc = 0;
        if (!isc) { i_lo = q0 < 128 ? (128 - q0) >> 6 : 0; const int i_hi = (q0 + 192 <= SEQ) ? 4 : ((q0 + 128 <= SEQ) ? 3 : 2); nloc = i_hi - i_lo + 1; }
        const int NT = nloc + 4;
        bf16x8 qf[4];
        { const bf16* qp = F.P() + (size_t)(qrowbase + q0 + 32 * ph + r32) * INW + C_Q + hq * 64 + 8 * h;
#pragma unroll
          for (int ks = 0; ks < 4; ++ks) qf[ks] = *(const bf16x8*)(qp + 16 * ks); }
        float m_run = F.inp(I_SINK)[l * 8 + hq] * LOG2E, l_run = (h == 0) ? 1.0f : 0.0f;
        f32x16 ot[2];
#pragma unroll
        for (int dt = 0; dt < 2; ++dt)
#pragma unroll
            for (int q = 0; q < 16; ++q) ot[dt][q] = 0.f;
        u32x4 kreg, vreg;
#define AT_LOAD(ti) do { const int ti_ = (ti); const bool loc_ = ti_ < nloc; const int kst_ = loc_ ? q0 - 128 + 64 * (i_lo + ti_) : 64 * (ti_ - nloc); \
        const size_t krow_ = loc_ ? (size_t)b * SEQ + kst_ : (size_t)ML + b * CTXL + kst_; \
        kreg = *(const u32x4*)(F.P() + (krow_ + lrow) * INW + C_K + kvh * 64 + lch * 8); \
        const size_t vo_ = loc_ ? ((size_t)((b * 2 + kvh) * 64 + lrow)) * SEQ + kst_ : VT_CTX_OFF + ((size_t)((b * 2 + kvh) * 64 + lrow)) * CTXL + kst_; \
        vreg = *(const u32x4*)(F.Vt() + vo_ + lch * 8); } while (0)
#define AT_STORE(slot) do { LAS unsigned char* d_ = F.lds + (slot) * AT_BUF + lrow * AT_KP + lch * 16; *(LAS u32x4*)d_ = kreg; *(LAS u32x4*)(d_ + 64 * AT_KP) = vreg; } while (0)
#define AT_QK(P0, P1, slot) do { const LAS unsigned char* Kb_ = F.lds + (slot) * AT_BUF; \
        _Pragma("unroll") for (int q = 0; q < 16; ++q) { P0[q] = 0.f; P1[q] = 0.f; } \
        _Pragma("unroll") for (int ks = 0; ks < 4; ++ks) { \
            const bf16x8 a0 = *(const LAS bf16x8*)(Kb_ + r32 * AT_KP + (16 * ks + 8 * h) * 2), a1 = *(const LAS bf16x8*)(Kb_ + (32 + r32) * AT_KP + (16 * ks + 8 * h) * 2); \
            P0 = __builtin_amdgcn_mfma_f32_32x32x16_bf16(a0, qf[ks], P0, 0, 0, 0); P1 = __builtin_amdgcn_mfma_f32_32x32x16_bf16(a1, qf[ks], P1, 0, 0, 0); } } while (0)
        __syncthreads();
        AT_LOAD(0); AT_STORE(0); AT_LOAD(1); AT_STORE(1);
        __syncthreads();
        f32x16 p0, p1;
        AT_QK(p0, p1, 0);
        int sc_ = 0, sn_ = 1, sw_ = 2;
#pragma unroll 1
        for (int ti = 0; ti < NT; ++ti) {
            if (ti + 2 < NT) AT_LOAD(ti + 2);
            f32x16 n0, n1;
            if (ti + 1 < NT) AT_QK(n0, n1, sn_);
            else {
#pragma unroll
                for (int q = 0; q < 16; ++q) { n0[q] = 0.f; n1[q] = 0.f; } }
            const LAS unsigned char* Vb = F.lds + sc_ * AT_BUF + 64 * AT_KP;
            const int itile = (ti < nloc) ? i_lo + ti : 2;
            if (itile == 0 || itile == 4) {
                int ql = 32 * ph + r32; asm volatile("" : "+v"(ql));
#pragma unroll
                for (int q = 0; q < 16; ++q) { const int k0 = crow(q, h), k1 = 32 + crow(q, h);
                    const bool v0 = (itile == 0) ? (k0 >= ql) : (k0 <= ql), v1 = (itile == 0) ? (k1 >= ql) : (k1 <= ql);
                    p0[q] = v0 ? p0[q] : -1.0e30f; p1[q] = v1 ? p1[q] : -1.0e30f; }
            }
            float tm = fmaxf(fmaxf(p0[0], p1[0]), fmaxf(p0[1], p1[1]));
#pragma unroll
            for (int q = 2; q < 16; q += 2) tm = fmaxf(fmaxf(tm, fmaxf(p0[q], p1[q])), fmaxf(p0[q + 1], p1[q + 1]));
            tm = fmaxf(tm, shx(tm, 32, ln_));
            const float mn = fmaxf(m_run, tm);
            if (__builtin_amdgcn_ballot_w64(mn != m_run) != 0ull) {
                const float sc = __builtin_amdgcn_exp2f(m_run - mn);
                l_run *= sc;
#pragma unroll
                for (int dt = 0; dt < 2; ++dt)
#pragma unroll
                    for (int q = 0; q < 16; ++q) ot[dt][q] *= sc;
            }
            m_run = mn;
            float ls = 0.f;
#pragma unroll
            for (int q = 0; q < 16; ++q) { p0[q] = __builtin_amdgcn_exp2f(p0[q] - mn); p1[q] = __builtin_amdgcn_exp2f(p1[q] - mn); ls += p0[q] + p1[q]; }
            l_run += ls;
#pragma unroll
            for (int hk = 0; hk < 2; ++hk)
#pragma unroll
                for (int s = 0; s < 2; ++s) {
                    u32x4 pb;
                    if (hk == 0) { pb.x = pk2(p0[8 * s + 0], p0[8 * s + 1]); pb.y = pk2(p0[8 * s + 2], p0[8 * s + 3]); pb.z = pk2(p0[8 * s + 4], p0[8 * s + 5]); pb.w = pk2(p0[8 * s + 6], p0[8 * s + 7]); }
                    else { pb.x = pk2(p1[8 * s + 0], p1[8 * s + 1]); pb.y = pk2(p1[8 * s + 2], p1[8 * s + 3]); pb.z = pk2(p1[8 * s + 4], p1[8 * s + 5]); pb.w = pk2(p1[8 * s + 6], p1[8 * s + 7]); }
#pragma unroll
                    for (int dt = 0; dt < 2; ++dt) { const LAS unsigned char* vp = Vb + (32 * dt + r32) * AT_KP + (32 * hk + 16 * s + 4 * h) * 2;
                        const u32x2 lo = *(const LAS u32x2*)vp, hi2 = *(const LAS u32x2*)(vp + 16);
                        u32x4 fa; fa.x = lo.x; fa.y = lo.y; fa.z = hi2.x; fa.w = hi2.y;
                        ot[dt] = __builtin_amdgcn_mfma_f32_32x32x16_bf16(__builtin_bit_cast(bf16x8, fa), __builtin_bit_cast(bf16x8, pb), ot[dt], 0, 0, 0); } }
            if (ti + 2 < NT) AT_STORE(sw_);
            __syncthreads();
            p0 = n0; p1 = n1;
            { const int t_ = sc_; sc_ = sn_; sn_ = sw_; sw_ = t_; }
        }
#undef AT_LOAD
#undef AT_STORE
#undef AT_QK
        const float linv = 1.0f / (l_run + shx(l_run, 32, ln_));
        { bf16* op = F.MIX() + (size_t)(qrowbase + q0 + 32 * ph + r32) * D + hq * 64 + 4 * h;
#pragma unroll
          for (int dt = 0; dt < 2; ++dt)
#pragma unroll
              for (int gq = 0; gq < 4; ++gq) { u32x2 w; w.x = pk2(ot[dt][4 * gq + 0] * linv, ot[dt][4 * gq + 1] * linv); w.y = pk2(ot[dt][4 * gq + 2] * linv, ot[dt][4 * gq + 3] * linv);
                  *(u32x2*)(op + 32 * dt + 8 * gq) = w; } }
    }
}

__device__ __forceinline__ void ph_outproj_naive(Ctx& F, int l) {
    const int gw = F.bid * NWAVES + F.wave, NGW = F.G * NWAVES, r = F.lane & 31, h = F.lane >> 5;
    const int Mq = (l == 0) ? MA : ML;
    const bf16* Bt = F.WoutT() + (size_t)l * D * D;
    for (int ti = gw; ti < (Mq / 64) * (D / 64); ti += NGW) {
        const int rt = ti / (D / 64), ct = ti % (D / 64), m0 = rt * 64, c0 = ct * 64;
        f32x16 acc[2][2];
        sg_kloop(acc, F.MIX() + (size_t)(m0 + r) * D + 8 * h, F.MIX() + (size_t)(m0 + 32 + r) * D + 8 * h, Bt + (size_t)(c0 + r) * D + 8 * h, Bt + (size_t)(c0 + 32 + r) * D + 8 * h, D);
#pragma unroll
        for (int mt = 0; mt < 2; ++mt)
#pragma unroll
            for (int nt = 0; nt < 2; ++nt)
#pragma unroll
                for (int q = 0; q < 16; ++q) {
                    const int m = m0 + 32 * mt + crow(q, h), c = c0 + 32 * nt + r;
                    const float g2 = F.mods()[((size_t)l * 3 + mod_row(m)) * 6 * D + 2 * D + c];
                    F.P()[(size_t)m * D + c] = (bf16)f2bf(g2 * acc[mt][nt][q]);
                }
    }
}

__device__ __forceinline__ void ph_norm2_router(Ctx& F, int l, bool shadow = false) {
    const int Mq = (l == 0) ? MA : ML;
    LAS unsigned char* HI = F.lds; LAS unsigned char* LO = F.lds + 16512;
    constexpr int HP = 2064;
    LAS float* part = (LAS float*)(F.lds + 36864);
    LAS float* AC = (LAS float*)(F.lds + 98304);
    LAS float* BC = (LAS float*)(F.lds + 110592);
    LAS float* lg = (LAS float*)(F.lds + 122880);
    LAS float* tvi = (LAS float*)(F.lds + 123904);
    LAS int* lcnt = (LAS int*)(F.lds + 124928);
    LAS int* lbase = (LAS int*)(F.lds + 124928 + 128);
    LAS int* se = (LAS int*)(F.lds + 124928 + 256);
    LAS float* sg = (LAS float*)(F.lds + 124928 + 256 + 4096);
    const int e = F.tid & 31;
    const int fr = F.lane & 15, fq = F.lane >> 4, kw = F.wave * 128;
    bf16x8 whi[2][4], wlo[2][4];
#pragma unroll
    for (int nt = 0; nt < 2; ++nt)
#pragma unroll
        for (int ks = 0; ks < 4; ++ks) { float wv[8];
#pragma unroll
            for (int i = 0; i < 8; ++i) wv[i] = F.inp(I_RW)[((size_t)l * D + kw + 32 * ks + 8 * fq + i) * NE + 16 * nt + fr];
            u32x4 hi, lo;
            hi.x = pk2(wv[0], wv[1]); hi.y = pk2(wv[2], wv[3]); hi.z = pk2(wv[4], wv[5]); hi.w = pk2(wv[6], wv[7]);
            lo.x = pk2(wv[0] - __uint_as_float(hi.x << 16), wv[1] - __uint_as_float(hi.x & 0xffff0000u)); lo.y = pk2(wv[2] - __uint_as_float(hi.y << 16), wv[3] - __uint_as_float(hi.y & 0xffff0000u));
            lo.z = pk2(wv[4] - __uint_as_float(hi.z << 16), wv[5] - __uint_as_float(hi.z & 0xffff0000u)); lo.w = pk2(wv[6] - __uint_as_float(hi.w << 16), wv[7] - __uint_as_float(hi.w & 0xffff0000u));
            whi[nt][ks] = __builtin_bit_cast(bf16x8, hi); wlo[nt][ks] = __builtin_bit_cast(bf16x8, lo); }
    unsigned* cnt = (unsigned*)(F.ctl() + CW_CNT + l * 64 + (shadow ? 512 : 0));
    int* ltok = shadow ? (int*)(F.ws + WS_HMOE) : F.list_tok(); int* ldst = ltok + (size_t)NE * CAP; float* lgate = (float*)(ldst + (size_t)NE * CAP);
    __syncthreads();
    if (F.tid < 32) lcnt[F.tid] = 0;
    for (int i = F.tid; i < 3 * D; i += NTHR) { const int r = i >> 10, c = i & (D - 1); const float* mo = F.mods() + ((size_t)l * 3 + r) * 6 * D;
        AC[i] = F.inp(I_N2G)[l * D + c] * (1.0f + mo[4 * D + c]); BC[i] = mo[3 * D + c]; }
    f32x4 v[4]; u32x2 tv[4];
#define RT_LOAD(mm) do { const int m_ = (mm); \
        if (l == 0) { const float* s_ = m_ < ML ? F.inp(I_X) + (size_t)m_ * D : F.inp(I_CTX) + (size_t)(m_ - ML) * D; \
            _Pragma("unroll") for (int j = 0; j < 4; ++j) v[j] = *(const f32x4*)(s_ + 4 * F.lane + 256 * j); } \
        else { _Pragma("unroll") for (int j = 0; j < 4; ++j) { const u32x2 w_ = *(const u32x2*)(F.XL() + (size_t)m_ * D + 4 * F.lane + 256 * j); \
            v[j] = (f32x4){__uint_as_float(w_.x << 16), __uint_as_float(w_.x & 0xffff0000u), __uint_as_float(w_.y << 16), __uint_as_float(w_.y & 0xffff0000u)}; } } \
        _Pragma("unroll") for (int j = 0; j < 4; ++j) tv[j] = *(const u32x2*)(F.P() + (size_t)m_ * D + 4 * F.lane + 256 * j); } while (0)
    { const int m = F.bid * 8 + F.wave; if (m < Mq) RT_LOAD(m); }
    __syncthreads();
    int ti = 0;
    for (int base = F.bid * 8; base < Mq; base += F.G * 8, ++ti) {
        { const int m = base + F.wave;
          const int mr = mod_row(m);
          float ss = 0.f;
#pragma unroll
          for (int j = 0; j < 4; ++j) { v[j].x += __uint_as_float(tv[j].x << 16); v[j].y += __uint_as_float(tv[j].x & 0xffff0000u); v[j].z += __uint_as_float(tv[j].y << 16); v[j].w += __uint_as_float(tv[j].y & 0xffff0000u);
              { u32x2 xw; xw.x = pk2(v[j].x, v[j].y); xw.y = pk2(v[j].z, v[j].w); *(u32x2*)(F.XL() + (size_t)m * D + 4 * F.lane + 256 * j) = xw; }
              ss += (v[j].x * v[j].x + v[j].y * v[j].y) + (v[j].z * v[j].z + v[j].w * v[j].w); }
          const float rstd = __builtin_amdgcn_rsqf(wave_sum(ss, F.lane) * (1.0f / D) + EPS);
#pragma unroll
          for (int j = 0; j < 4; ++j) { const int col = 4 * F.lane + 256 * j;
              const f32x4 ga = *(const LAS f32x4*)(AC + mr * D + col), sh = *(const LAS f32x4*)(BC + mr * D + col);
              const f32x4 h = v[j] * rstd * ga + sh;
              if (MOE_FP8) *(unsigned*)((unsigned char*)F.H1() + (size_t)m * D + col) = pk_fp8x4(h.x, h.y, h.z, h.w);
              else { u32x2 w; w.x = pk2(h.x, h.y); w.y = pk2(h.z, h.w); *(u32x2*)(F.H1() + (size_t)m * D + col) = w; }
              { u32x2 wh, wl; wh.x = pk2(h.x, h.y); wh.y = pk2(h.z, h.w);
                wl.x = pk2(h.x - __uint_as_float(wh.x << 16), h.y - __uint_as_float(wh.x & 0xffff0000u)); wl.y = pk2(h.z - __uint_as_float(wh.y << 16), h.w - __uint_as_float(wh.y & 0xffff0000u));
                *(LAS u32x2*)(HI + F.wave * HP + col * 2) = wh; *(LAS u32x2*)(LO + F.wave * HP + col * 2) = wl; } }
          const int mn = m + F.G * 8;
          if (mn < Mq) RT_LOAD(mn); }
        __syncthreads();
        { f32x4 acc[2] = {{0.f, 0.f, 0.f, 0.f}, {0.f, 0.f, 0.f, 0.f}};
#pragma unroll
          for (int ks = 0; ks < 4; ++ks) { const int ao = (fr & 7) * HP + (kw + 32 * ks + 8 * fq) * 2;
              const bf16x8 ah = *(const LAS bf16x8*)(HI + ao), al = *(const LAS bf16x8*)(LO + ao);
#pragma unroll
              for (int nt = 0; nt < 2; ++nt) { acc[nt] = __builtin_amdgcn_mfma_f32_16x16x32_bf16(al, whi[nt][ks], acc[nt], 0, 0, 0); acc[nt] = __builtin_amdgcn_mfma_f32_16x16x32_bf16(ah, wlo[nt][ks], acc[nt], 0, 0, 0);
                  acc[nt] = __builtin_amdgcn_mfma_f32_16x16x32_bf16(ah, whi[nt][ks], acc[nt], 0, 0, 0); } }
          if (fq < 2) {
#pragma unroll
              for (int nt = 0; nt < 2; ++nt)
#pragma unroll
                  for (int j = 0; j < 4; ++j) part[(F.wave * 8 + 4 * fq + j) * 32 + 16 * nt + fr] = acc[nt][j]; } }
        __syncthreads();
        if (F.tid < 256) {
            const int rr = F.tid >> 5; float s = F.inp(I_RB)[l * NE + e];
#pragma unroll
            for (int q = 0; q < 8; ++q) s += part[(q * 8 + rr) * 32 + e];
            lg[rr * 32 + e] = s;
            asm volatile("s_waitcnt lgkmcnt(0)" ::: "memory");
            int rank = 0;
#pragma unroll
            for (int q = 0; q < 8; ++q) { const f32x4 x = *(const LAS f32x4*)(lg + rr * 32 + 4 * q);
                rank += (x.x > s || (x.x == s && 4 * q + 0 < e)) ? 1 : 0; rank += (x.y > s || (x.y == s && 4 * q + 1 < e)) ? 1 : 0;
                rank += (x.z > s || (x.z == s && 4 * q + 2 < e)) ? 1 : 0; rank += (x.w > s || (x.w == s && 4 * q + 3 < e)) ? 1 : 0; }
            if (rank < 4) { tvi[(rr * 4 + rank) * 2] = s; tvi[(rr * 4 + rank) * 2 + 1] = __int_as_float(e); }
            asm volatile("s_waitcnt lgkmcnt(0)" ::: "memory");
            const f32x4 c01 = *(const LAS f32x4*)(tvi + rr * 8), c23 = *(const LAS f32x4*)(tvi + rr * 8 + 4);
            const float p1 = __expf(c01.z - c01.x), p2 = __expf(c23.x - c01.x), p3 = __expf(c23.z - c01.x), den = 1.0f + p1 + p2 + p3;
            if (e < 4) { const float myv = e == 0 ? 1.0f : (e == 1 ? p1 : (e == 2 ? p2 : p3)); const int mye = __float_as_int(e == 0 ? c01.y : (e == 1 ? c01.w : (e == 2 ? c23.y : c23.w)));
                const int lp = __hip_atomic_fetch_add(lcnt + mye, 1, __ATOMIC_RELAXED, __HIP_MEMORY_SCOPE_WORKGROUP);
                se[ti * 32 + rr * 4 + e] = mye | (lp << 8); sg[ti * 32 + rr * 4 + e] = myv * frcp(den); }
        }
        __syncthreads();
    }
    if (F.tid < 32) lbase[F.tid] = (int)atomicAdd(cnt + F.tid, (unsigned)lcnt[F.tid]);
    __syncthreads();
    for (int i = F.tid; i < ti * 32; i += NTHR) {
        const int w = se[i], ee = w & 255, lp = w >> 8, m = F.bid * 8 + (i >> 5) * (F.G * 8) + ((i & 31) >> 2), j = i & 3;
        const size_t pos = (size_t)ee * CAP + lbase[ee] + lp;
        ltok[pos] = m; ldst[pos] = m * 4 + j; lgate[pos] = sg[i];
    }
}

#undef RT_LOAD
__device__ __forceinline__ void ph_moe_gu_naive(Ctx& F, int l) {
    const int gw = F.bid * NWAVES + F.wave, NGW = F.G * NWAVES, r = F.lane & 31, h = F.lane >> 5;
    const unsigned* cnt = (const unsigned*)(F.ctl() + CW_CNT + l * 64);
    int id0 = 0, ts256 = 0;
    for (int e = 0; e < NE; ++e) {
        const int ce = (int)__hip_atomic_load(cnt + e, __ATOMIC_RELAXED, __HIP_MEMORY_SCOPE_AGENT);
        const int nrt = (ce + 63) / 64, n = nrt * 32;
        const bf16* Bt = F.WguT() + ((size_t)l * NE + e) * 2 * FF * D;
        const float* bg = F.inp(I_BGU) + ((size_t)l * NE + e) * 2 * FF;
        int id = id0 + ((gw - id0 % NGW) + NGW) % NGW;
        for (; id < id0 + n; id += NGW) {
            const int rt = (id - id0) / 32, ft = (id - id0) % 32, pos0 = rt * 64, ff0 = ft * 32;
            const int p0 = pos0 + r, p1 = pos0 + 32 + r;
            const int t0 = p0 < ce ? F.list_tok()[(size_t)e * CAP + p0] : 0, t1 = p1 < ce ? F.list_tok()[(size_t)e * CAP + p1] : 0;
            const int ng = (ff0 >> 7) * 256 + (ff0 & 127) + r;
            f32x16 acc[2][2];
            sg_kloop(acc, F.H1() + (size_t)t0 * D + 8 * h, F.H1() + (size_t)t1 * D + 8 * h, Bt + (size_t)ng * D + 8 * h, Bt + (size_t)(ng + 128) * D + 8 * h, D);
            const float bgate = bg[ff0 + r], bup = bg[FF + ff0 + r];
#pragma unroll
            for (int mt = 0; mt < 2; ++mt)
#pragma unroll
                for (int q = 0; q < 16; ++q) {
                    const int pos = pos0 + 32 * mt + crow(q, h);
                    if (pos < ce) {
                        const float gate = fminf(acc[mt][0][q] + bgate, 7.0f), up = fminf(fmaxf(acc[mt][1][q] + bup, -7.0f), 7.0f);
                        const float glu = gate * sigmoidf_(1.702f * gate);
                        F.HMOE()[((size_t)ts256 * 256 + pos) * FF + ff0 + r] = (bf16)f2bf((up + 1.0f) * glu);
                    }
                }
        }
        id0 += n; ts256 += (ce + 255) / 256;
    }
}
__device__ __forceinline__ void ph_moe_down_naive(Ctx& F, int l) {
    const int gw = F.bid * NWAVES + F.wave, NGW = F.G * NWAVES, r = F.lane & 31, h = F.lane >> 5;
    const unsigned* cnt = (const unsigned*)(F.ctl() + CW_CNT + l * 64);
    int id0 = 0, ts256 = 0;
    for (int e = 0; e < NE; ++e) {
        const int ce = (int)__hip_atomic_load(cnt + e, __ATOMIC_RELAXED, __HIP_MEMORY_SCOPE_AGENT);
        const int nrt = (ce + 63) / 64, n = nrt * 16;
        const bf16* Bt = F.WdT() + ((size_t)l * NE + e) * D * FF;
        const float* bd = F.inp(I_BD) + ((size_t)l * NE + e) * D;
        int id = id0 + ((gw - id0 % NGW) + NGW) % NGW;
        for (; id < id0 + n; id += NGW) {
            const int rt = (id - id0) / 16, ct = (id - id0) % 16, pos0 = rt * 64, c0 = ct * 64;
            const bf16* A = F.HMOE() + ((size_t)ts256 * 256 + pos0) * FF;
            f32x16 acc[2][2];
            sg_kloop(acc, A + (size_t)r * FF + 8 * h, A + (size_t)(32 + r) * FF + 8 * h, Bt + (size_t)(c0 + r) * FF + 8 * h, Bt + (size_t)(c0 + 32 + r) * FF + 8 * h, FF);
#pragma unroll
            for (int mt = 0; mt < 2; ++mt)
#pragma unroll
                for (int q = 0; q < 16; ++q) {
                    const int pos = pos0 + 32 * mt + crow(q, h);
                    if (pos < ce) {
                        const int dst = F.list_dst()[(size_t)e * CAP + pos]; const float g = F.list_gate()[(size_t)e * CAP + pos];
#pragma unroll
                        for (int nt = 0; nt < 2; ++nt) { const int c = c0 + 32 * nt + r;
                            F.Y2()[(size_t)dst * D + c] = (bf16)f2bf(g * (acc[mt][nt][q] + bd[c])); }
                    }
                }
        }
        id0 += n; ts256 += (ce + 255) / 256;
    }
}

namespace pg8 {
constexpr int BM = 256, BK = 64, HALF = 128, HTB = HALF * BK * 2, STAGE_BYTES = 8 * HTB, NXCD = 8, WGM = 8;
__device__ __forceinline__ int lds_byte(int r, int c) { const int st = (r >> 4) * 2 + (c >> 5), rr = r & 15, cc = c & 31, ob = rr * 64 + cc * 2; return st * 1024 + (ob ^ (((ob >> 9) & 1) << 5)); }
__device__ __forceinline__ void stage_rc(int b, int& R, int& C) { const int st = b / 1024, sb = b % 1024, swz = sb ^ (((sb >> 9) & 1) << 5); R = (st >> 1) * 16 + swz / 64; C = (st & 1) * 32 + (swz % 64) / 2; }
__device__ __forceinline__ int perm32(int rho) { const int n = rho >> 4, i = rho & 15; return 8 * (i >> 2) + 4 * n + (i & 3); }
struct Unit { int pm, pn, e, pos0, ce; };
struct StaticOrder {
    int nM, nN, nwg, G, c;
    __device__ __forceinline__ void init(int M, int N, int G_, int c_) { nM = M / BM; nN = N / BM; nwg = nM * nN; G = G_; c = c_; }
    __device__ __forceinline__ bool next(int i, Unit& u) const {
        const long L = (long)i * G + c; if (L >= nwg) return false;
        int wgid = (int)L; { const int q = nwg / NXCD, r = nwg % NXCD, xcd = wgid % NXCD, off = wgid / NXCD; wgid = (xcd < r ? xcd * (q + 1) : r * (q + 1) + (xcd - r) * q) + off; }
        const int nig = WGM * nN, gid = wgid / nig, fm = gid * WGM, gsz = (nM - fm) < WGM ? (nM - fm) : WGM;
        u.pm = fm + ((wgid % nig) % gsz); u.pn = (wgid % nig) / gsz; u.e = 0; u.pos0 = 0; u.ce = 0; return true;
    }
};
__device__ __forceinline__ unsigned cvt_pk_bf16(float lo, float hi) { unsigned r; asm volatile("v_cvt_pk_bf16_f32 %0, %1, %2" : "=v"(r) : "v"(lo), "v"(hi)); return r; }
typedef f32x4 AccT[2][2][4][2];
template <class PB>
__device__ __forceinline__ void gemm_phase(LAS unsigned char* lds, const PB& pb, const int tid) {
    const int wid = __builtin_amdgcn_readfirstlane(tid >> 6), lane = tid & 63, wr = wid >> 2, wc = wid & 3, fr = lane & 15, fq = lane >> 4;
    constexpr int K = PB::K, nt = K / BK;
    unsigned voffB[2];
#pragma unroll
    for (int i = 0; i < 2; ++i) { int R, C; stage_rc(tid * 16 + i * 8192, R, C); const int Rb = PB::PERM ? ((R & ~31) + perm32(R & 31)) : R; voffB[i] = (unsigned)(Rb * K + C) * 2u; }
    constexpr size_t kstep = (size_t)(BK * 2);
    constexpr size_t hstep = (size_t)HALF * K * 2;
    const unsigned ldsw = (unsigned)wid * 1024u;
    const int aoff = lds_byte(wr * 64 + fr, fq * 8), boff = lds_byte(wc * 32 + fr, fq * 8);
#define PG8_SA(b, h) (((b) * 2 + (h)) * HTB)
#define PG8_SB(b, h) ((4 + (b) * 2 + (h)) * HTB)
#define PG8_STAGE(bufoff, gbase, voff) do { _Pragma("unroll") for (int _i = 0; _i < 2; ++_i) \
        __builtin_amdgcn_global_load_lds((const unsigned*)((const char*)(gbase) + (voff)[_i]), (LAS unsigned*)(lds + (bufoff) + ldsw + _i * 8192), 16, 0, 0); } while (0)
#define PG8_LDA(dst, b, h) do { _Pragma("unroll") for (int m = 0; m < 4; ++m) _Pragma("unroll") for (int k = 0; k < 2; ++k) dst[m][k] = *(const LAS bf16x8*)(lds + PG8_SA(b, h) + aoff + m * 2048 + k * 1024); } while (0)
#define PG8_LDB(dst, b, h) do { _Pragma("unroll") for (int n = 0; n < 2; ++n) _Pragma("unroll") for (int k = 0; k < 2; ++k) dst[n][k] = *(const LAS bf16x8*)(lds + PG8_SB(b, h) + boff + n * 2048 + k * 1024); } while (0)
#define PG8_MMA(ai, bj, At, Bt) do { __builtin_amdgcn_s_setprio(1); _Pragma("unroll") for (int m = 0; m < 4; ++m) _Pragma("unroll") for (int n = 0; n < 2; ++n) _Pragma("unroll") for (int k = 0; k < 2; ++k) \
        acc[ai][bj][m][n] = __builtin_amdgcn_mfma_f32_16x16x32_bf16(Bt[n][k], At[m][k], acc[ai][bj][m][n], 0, 0, 0); __builtin_amdgcn_s_setprio(0); } while (0)
#define PG8_WAIT_V(n) asm volatile("s_waitcnt vmcnt(" #n ")" ::: "memory")
#define PG8_WAIT_L(n) asm volatile("s_waitcnt lgkmcnt(" #n ")" ::: "memory")
#define PG8_BAR __builtin_amdgcn_s_barrier()
#define PG8_SCHED __builtin_amdgcn_sched_barrier(0)
    Unit cur, nxt; int ui = 0;
    if (!pb.next(0, cur)) return;
    f32x4 acc[2][2][4][2];
#pragma unroll
    for (int a = 0; a < 2; ++a)
#pragma unroll
        for (int b = 0; b < 2; ++b)
#pragma unroll
            for (int m = 0; m < 4; ++m)
#pragma unroll
                for (int n = 0; n < 2; ++n) acc[a][b][m][n] = (f32x4){0.f, 0.f, 0.f, 0.f};
    bf16x8 At[4][2], B0[2][2], B1[2][2];
    unsigned cv[2][2];
    pb.a_voff(cur, cv, tid);
    const char* cA = pb.a_base(cur); const char* cB = pb.b_base(cur);
    PG8_STAGE(PG8_SB(0, 0), cB, voffB); PG8_STAGE(PG8_SB(0, 1), cB + hstep, voffB); PG8_STAGE(PG8_SA(0, 0), cA, cv[0]); PG8_STAGE(PG8_SA(0, 1), cA, cv[1]);
    if (wr == 1) PG8_BAR;
    PG8_WAIT_V(2); PG8_BAR;
    PG8_STAGE(PG8_SB(1, 0), cB + kstep, voffB); PG8_STAGE(PG8_SA(1, 0), cA + kstep, cv[0]); PG8_STAGE(PG8_SB(1, 1), cB + hstep + kstep, voffB);
    PG8_WAIT_V(6); PG8_BAR;
    for (;;) {
        const bool has_next = pb.next(ui + 1, nxt);
        const char* nA = has_next ? pb.a_base(nxt) : cA; const char* nB = has_next ? pb.b_base(nxt) : cB;
        for (int t = 0; t < nt; t += 2) {
            const bool last = (t == nt - 2);
            const char* a1 = cA + (size_t)(t + 1) * kstep;
            const char* a2 = last ? nA : cA + (size_t)(t + 2) * kstep; const char* b2 = last ? nB : cB + (size_t)(t + 2) * kstep;
            const char* a3 = a2 + kstep; const char* b3 = b2 + kstep;
            if (PB::GATHER && t == nt - 4 && has_next) pb.tok_prefetch(nxt, lds, tid, wid);
            if (PB::GATHER && last && has_next) pb.a_voff_half_lds(cv[0], lds, tid, wid, 0);
            PG8_LDB(B0, 0, 0); PG8_LDB(B1, 0, 1); PG8_SCHED; PG8_LDA(At, 0, 0); PG8_STAGE(PG8_SA(1, 1), a1, cv[1]);
            if (PB::GATHER && last && has_next) pb.a_voff_half_lds(cv[1], lds, tid, wid, 1);
            PG8_WAIT_V(8); PG8_WAIT_L(0); PG8_BAR; PG8_MMA(0, 0, At, B0); PG8_MMA(0, 1, At, B1); PG8_BAR; PG8_SCHED;
            PG8_LDA(At, 0, 1); PG8_STAGE(PG8_SB(0, 0), b2, voffB); PG8_STAGE(PG8_SB(0, 1), b2 + hstep, voffB); PG8_STAGE(PG8_SA(0, 0), a2, cv[0]);
            PG8_WAIT_V(8); PG8_WAIT_L(0); PG8_BAR; PG8_MMA(1, 0, At, B0); PG8_MMA(1, 1, At, B1); PG8_BAR; PG8_SCHED;
            PG8_LDB(B0, 1, 0); PG8_LDB(B1, 1, 1); PG8_SCHED; PG8_LDA(At, 1, 0); PG8_STAGE(PG8_SA(0, 1), a2, cv[1]);
            PG8_WAIT_V(8); PG8_WAIT_L(0); PG8_BAR; PG8_MMA(0, 0, At, B0); PG8_MMA(0, 1, At, B1); PG8_BAR; PG8_SCHED;
            PG8_LDA(At, 1, 1); PG8_STAGE(PG8_SB(1, 0), b3, voffB); PG8_STAGE(PG8_SB(1, 1), b3 + hstep, voffB); PG8_STAGE(PG8_SA(1, 0), a3, cv[0]);
            PG8_WAIT_V(8); PG8_WAIT_L(0); PG8_BAR; PG8_MMA(1, 0, At, B0); PG8_MMA(1, 1, At, B1); PG8_BAR; PG8_SCHED;
        }
        if (wr == 0) PG8_BAR;
        pb.epi(acc, cur, wr, wc, fr, fq);
        if (!has_next) break;
#pragma unroll
        for (int a = 0; a < 2; ++a)
#pragma unroll
            for (int b = 0; b < 2; ++b)
#pragma unroll
                for (int m = 0; m < 4; ++m)
#pragma unroll
                    for (int n = 0; n < 2; ++n) acc[a][b][m][n] = (f32x4){0.f, 0.f, 0.f, 0.f};
        cur = nxt; cA = nA; cB = nB; ++ui;
        if (wr == 1) PG8_BAR;
    }
    PG8_WAIT_V(0);
    PG8_BAR;
#undef PG8_SA
#undef PG8_SB
#undef PG8_STAGE
#undef PG8_LDA
#undef PG8_LDB
#undef PG8_MMA
#undef PG8_WAIT_V
#undef PG8_WAIT_L
#undef PG8_BAR
#undef PG8_SCHED
}
typedef int v4i_t __attribute__((ext_vector_type(4)));
typedef int v8i_t __attribute__((ext_vector_type(8)));
template <class PB>
__device__ __forceinline__ void gemm_phase8(LAS unsigned char* lds, const PB& pb, const int tid) {
    const int wid = __builtin_amdgcn_readfirstlane(tid >> 6), lane = tid & 63, wr = wid >> 2, wc = wid & 3, fr = lane & 15, fq = lane >> 4;
    constexpr int K = PB::K  , nt = K / 128;
    unsigned vb0, va0;
    { int R, C; stage_rc(tid * 16, R, C); const int Rb = PB::PERM ? ((R & ~31) + perm32(R & 31)) : R; vb0 = (unsigned)(Rb * K + C * 2); va0 = (unsigned)(R * K + C * 2); }
    constexpr size_t kstep = (size_t)(BK * 2);
    constexpr size_t hstep = (size_t)HALF * K;
    const unsigned ldsw = (unsigned)wid * 1024u;
    const int aoff = lds_byte(wr * 64 + fr, fq * 8), boff = lds_byte(wc * 32 + fr, fq * 8);
#define PG8_SA(b, h) (((b) * 2 + (h)) * HTB)
#define PG8_SB(b, h) ((4 + (b) * 2 + (h)) * HTB)
#define PG8_STAGE_B(bufoff, gbase) do { _Pragma("unroll") for (int _i = 0; _i < 2; ++_i) \
        __builtin_amdgcn_global_load_lds((const unsigned*)((const char*)(gbase) + (size_t)(_i * 64) * K + vb0), (LAS unsigned*)(lds + (bufoff) + ldsw + _i * 8192), 16, 0, 0); } while (0)
#define PG8_STAGE_A(bufoff, gbase, h) do { _Pragma("unroll") for (int _i = 0; _i < 2; ++_i) { \
        const char* p_ = PB::GATHER ? (const char*)(gbase) + cv[h][_i] : (const char*)(gbase) + (size_t)((h) * 128 + _i * 64) * K + va0; \
        __builtin_amdgcn_global_load_lds((const unsigned*)p_, (LAS unsigned*)(lds + (bufoff) + ldsw + _i * 8192), 16, 0, 0); } } while (0)
#define PG8_LDA(dst, b, h) do { _Pragma("unroll") for (int m = 0; m < 4; ++m) { const v4i_t lo_ = *(const LAS v4i_t*)(lds + PG8_SA(b, h) + aoff + m * 2048), hi_ = *(const LAS v4i_t*)(lds + PG8_SA(b, h) + aoff + m * 2048 + 1024); dst[m] = __builtin_shufflevector(lo_, hi_, 0, 1, 2, 3, 4, 5, 6, 7); } } while (0)
#define PG8_LDB(dst, b, h) do { _Pragma("unroll") for (int n = 0; n < 2; ++n) { const v4i_t lo_ = *(const LAS v4i_t*)(lds + PG8_SB(b, h) + boff + n * 2048), hi_ = *(const LAS v4i_t*)(lds + PG8_SB(b, h) + boff + n * 2048 + 1024); dst[n] = __builtin_shufflevector(lo_, hi_, 0, 1, 2, 3, 4, 5, 6, 7); } } while (0)
#define PG8_MMA(ai, bj, At, Bt) do { __builtin_amdgcn_s_setprio(1); _Pragma("unroll") for (int m = 0; m < 4; ++m) _Pragma("unroll") for (int n = 0; n < 2; ++n) \
        asm volatile("v_mfma_scale_f32_16x16x128_f8f6f4 %0, %1, %2, %0, %3, %3 op_sel_hi:[0,0,0]" : "+v"(acc[ai][bj][m][n]) : "v"(Bt[n]), "v"(At[m]), "v"(sc1)); \
        __builtin_amdgcn_s_setprio(0); } while (0)
#define PG8_WAIT_V(n) asm volatile("s_waitcnt vmcnt(" #n ")" ::: "memory")
#define PG8_WAIT_L(n) asm volatile("s_waitcnt lgkmcnt(" #n ")" ::: "memory")
#define PG8_BAR __builtin_amdgcn_s_barrier()
#define PG8_SCHED __builtin_amdgcn_sched_barrier(0)
    Unit cur, nxt; int ui = 0;
    if (!pb.next(0, cur)) return;
    f32x4 acc[2][2][4][2];
#pragma unroll
    for (int a = 0; a < 2; ++a)
#pragma unroll
        for (int b = 0; b < 2; ++b)
#pragma unroll
            for (int m = 0; m < 4; ++m)
#pragma unroll
                for (int n = 0; n < 2; ++n) acc[a][b][m][n] = (f32x4){0.f, 0.f, 0.f, 0.f};
    v8i_t At[4], B0[2], B1[2];
    int sc1 = 0x7f7f7f7f; asm volatile("" : "+v"(sc1));
    unsigned cv[2][2];
    if (PB::GATHER) pb.a_voff(cur, cv, tid); else { cv[0][0] = cv[0][1] = cv[1][0] = cv[1][1] = 0u; }
    const char* cA = pb.a_base(cur); const char* cB = pb.b_base(cur);
    PG8_STAGE_B(PG8_SB(0, 0), cB); PG8_STAGE_B(PG8_SB(0, 1), cB + hstep); PG8_STAGE_A(PG8_SA(0, 0), cA, 0); PG8_STAGE_A(PG8_SA(0, 1), cA, 1);
    if (wr == 1) PG8_BAR;
    PG8_WAIT_V(2); PG8_BAR;
    PG8_STAGE_B(PG8_SB(1, 0), cB + kstep); PG8_STAGE_A(PG8_SA(1, 0), cA + kstep, 0); PG8_STAGE_B(PG8_SB(1, 1), cB + hstep + kstep);
    PG8_WAIT_V(6); PG8_BAR;
    for (;;) {
        const bool has_next = pb.next(ui + 1, nxt);
        const char* nA = has_next ? pb.a_base(nxt) : cA; const char* nB = has_next ? pb.b_base(nxt) : cB;
#pragma unroll 1
        for (int t = 0; t < nt; t += 2) {
            const bool last = (t == nt - 2);
            const char* a1 = cA + (size_t)(t + 1) * kstep;
            const char* a2 = last ? nA : cA + (size_t)(t + 2) * kstep; const char* b2 = last ? nB : cB + (size_t)(t + 2) * kstep;
            const char* a3 = a2 + kstep; const char* b3 = b2 + kstep;
            if (PB::GATHER && t == nt - 4 && has_next) pb.tok_prefetch(nxt, lds, tid, wid);
            if (PB::GATHER && last && has_next) pb.a_voff_half_lds(cv[0], lds, tid, wid, 0);
            PG8_LDB(B0, 0, 0); PG8_LDB(B1, 0, 1); PG8_SCHED; PG8_LDA(At, 0, 0); PG8_STAGE_A(PG8_SA(1, 1), a1, 1);
            if (PB::GATHER && last && has_next) pb.a_voff_half_lds(cv[1], lds, tid, wid, 1);
            PG8_WAIT_V(8); PG8_WAIT_L(0); PG8_BAR; PG8_MMA(0, 0, At, B0); PG8_MMA(0, 1, At, B1); PG8_BAR; PG8_SCHED;
            PG8_LDA(At, 0, 1); PG8_STAGE_B(PG8_SB(0, 0), b2); PG8_STAGE_B(PG8_SB(0, 1), b2 + hstep); PG8_STAGE_A(PG8_SA(0, 0), a2, 0);
            PG8_WAIT_V(8); PG8_WAIT_L(0); PG8_BAR; PG8_MMA(1, 0, At, B0); PG8_MMA(1, 1, At, B1); PG8_BAR; PG8_SCHED;
            PG8_LDB(B0, 1, 0); PG8_LDB(B1, 1, 1); PG8_SCHED; PG8_LDA(At, 1, 0); PG8_STAGE_A(PG8_SA(0, 1), a2, 1);
            PG8_WAIT_V(8); PG8_WAIT_L(0); PG8_BAR; PG8_MMA(0, 0, At, B0); PG8_MMA(0, 1, At, B1); PG8_BAR; PG8_SCHED;
            PG8_LDA(At, 1, 1); PG8_STAGE_B(PG8_SB(1, 0), b3); PG8_STAGE_B(PG8_SB(1, 1), b3 + hstep); PG8_STAGE_A(PG8_SA(1, 0), a3, 0);
            PG8_WAIT_V(8); PG8_WAIT_L(0); PG8_BAR; PG8_MMA(1, 0, At, B0); PG8_MMA(1, 1, At, B1); PG8_BAR; PG8_SCHED;
        }
        if (wr == 0) PG8_BAR;
        asm volatile("s_nop 15\n\ts_nop 15" ::: "memory");
        { int fr_ = fr, fq_ = fq; asm volatile("" : "+v"(fr_), "+v"(fq_));
          pb.epi(acc, cur, wr, wc, fr_, fq_); }
        if (!has_next) break;
#pragma unroll
        for (int a = 0; a < 2; ++a)
#pragma unroll
            for (int b = 0; b < 2; ++b)
#pragma unroll
                for (int m = 0; m < 4; ++m)
#pragma unroll
                    for (int n = 0; n < 2; ++n) acc[a][b][m][n] = (f32x4){0.f, 0.f, 0.f, 0.f};
        cur = nxt; cA = nA; cB = nB; ++ui;
        if (wr == 1) PG8_BAR;
    }
    PG8_WAIT_V(0);
    PG8_BAR;
#undef PG8_SA
#undef PG8_SB
#undef PG8_STAGE_A
#undef PG8_STAGE_B
#undef PG8_LDA
#undef PG8_LDB
#undef PG8_MMA
#undef PG8_WAIT_V
#undef PG8_WAIT_L
#undef PG8_BAR
#undef PG8_SCHED
}
__device__ __forceinline__ void voff_contig8(unsigned (&v)[2][2], int tid, int KB) {
#pragma unroll
    for (int i = 0; i < 2; ++i) { int R, C; stage_rc(tid * 16 + i * 8192, R, C); v[0][i] = (unsigned)(R * KB + C * 2); v[1][i] = (unsigned)((R + HALF) * KB + C * 2); }
}
__device__ __forceinline__ void voff_contig(unsigned (&v)[2][2], int tid, int K) {
#pragma unroll
    for (int i = 0; i < 2; ++i) { int R, C; stage_rc(tid * 16 + i * 8192, R, C); v[0][i] = (unsigned)(R * K + C) * 2u; v[1][i] = (unsigned)((R + HALF) * K + C) * 2u; }
}
}

struct PbInproj {
    static constexpr int K = D; static constexpr bool PERM = true, GATHER = false;
    const bf16* A; const bf16* Bt; bf16* P; bf16* Vt; const f32x2* rope; pg8::StaticOrder S;
    __device__ __forceinline__ bool next(int i, pg8::Unit& u) const { return S.next(i, u); }
    __device__ __forceinline__ const char* a_base(const pg8::Unit& u) const { return (const char*)A + (size_t)u.pm * 256 * K * 2; }
    __device__ __forceinline__ const char* b_base(const pg8::Unit& u) const { return (const char*)Bt + (size_t)u.pn * 256 * K * 2; }
    __device__ __forceinline__ void a_voff(const pg8::Unit&, unsigned (&v)[2][2], int tid) const { pg8::voff_contig(v, tid, K); }
    __device__ __forceinline__ void tok_prefetch(const pg8::Unit&, LAS unsigned char*, int, int) const {}
    __device__ __forceinline__ void a_voff_half_lds(unsigned (&)[2], LAS unsigned char*, int, int, int) const {}
    __device__ __forceinline__ void epi(const pg8::AccT& acc, const pg8::Unit& u, int wr, int wc, int fr, int fq) const {
        const int row0 = u.pm * 256 + wr * 64 + fr; const bool lat = row0 < ML;
#pragma unroll
        for (int ai = 0; ai < 2; ++ai)
#pragma unroll
            for (int m = 0; m < 4; ++m) {
                const int row = row0 + ai * 128 + m * 16; const int t = row & (SEQ - 1);
#pragma unroll
                for (int bj = 0; bj < 2; ++bj) {
                    const int c0 = u.pn * 256 + bj * 128 + wc * 32 + 8 * fq;
                    f32x4 v0 = acc[ai][bj][m][0], v1 = acc[ai][bj][m][1];
                    if (c0 < C_V) {
                        if (lat) {
                            const int pr0 = (c0 & 63) >> 1, p = pr0 >> 4, f0 = pr0 & 15, pos = p ? (t & 63) : (t >> 6);
                            const f32x4 ca = *(const f32x4*)(rope + pos * 16 + f0), cb = *(const f32x4*)(rope + pos * 16 + f0 + 2);
                            const f32x4 w0 = {v0.x * ca.x - v0.y * ca.y, v0.x * ca.y + v0.y * ca.x, v0.z * ca.z - v0.w * ca.w, v0.z * ca.w + v0.w * ca.z};
                            const f32x4 w1 = {v1.x * cb.x - v1.y * cb.y, v1.x * cb.y + v1.y * cb.x, v1.z * cb.z - v1.w * cb.w, v1.z * cb.w + v1.w * cb.z};
                            v0 = w0; v1 = w1;
                        }
                        if (c0 < C_K) { v0 *= QSCALE; v1 *= QSCALE; }
                    }
                    u32x4 w; w.x = pg8::cvt_pk_bf16(v0.x, v0.y); w.y = pg8::cvt_pk_bf16(v0.z, v0.w); w.z = pg8::cvt_pk_bf16(v1.x, v1.y); w.w = pg8::cvt_pk_bf16(v1.z, v1.w);
                    *(u32x4*)(P + (size_t)row * INW + c0) = w;
                    if (c0 >= C_V && c0 < C_LX) {
                        const size_t vi = vt_index(row, c0 - C_V); const size_t st = row < ML ? SEQ : CTXL;
                        Vt[vi] = (bf16)(w.x & 0xffffu); Vt[vi + st] = (bf16)(w.x >> 16); Vt[vi + 2 * st] = (bf16)(w.y & 0xffffu); Vt[vi + 3 * st] = (bf16)(w.y >> 16);
                        Vt[vi + 4 * st] = (bf16)(w.z & 0xffffu); Vt[vi + 5 * st] = (bf16)(w.z >> 16); Vt[vi + 6 * st] = (bf16)(w.w & 0xffffu); Vt[vi + 7 * st] = (bf16)(w.w >> 16);
                    }
                }
            }
    }
};
struct PbOutproj {
    static constexpr int K = D; static constexpr bool PERM = true, GATHER = false;
    const bf16* A; const bf16* Bt; bf16* TMP; const float* mods_l; pg8::StaticOrder S;
    __device__ __forceinline__ bool next(int i, pg8::Unit& u) const { return S.next(i, u); }
    __device__ __forceinline__ const char* a_base(const pg8::Unit& u) const { return (const char*)A + (size_t)u.pm * 256 * K * 2; }
    __device__ __forceinline__ const char* b_base(const pg8::Unit& u) const { return (const char*)Bt + (size_t)u.pn * 256 * K * 2; }
    __device__ __forceinline__ void a_voff(const pg8::Unit&, unsigned (&v)[2][2], int tid) const { pg8::voff_contig(v, tid, K); }
    __device__ __forceinline__ void tok_prefetch(const pg8::Unit&, LAS unsigned char*, int, int) const {}
    __device__ __forceinline__ void a_voff_half_lds(unsigned (&)[2], LAS unsigned char*, int, int, int) const {}
    __device__ __forceinline__ void epi(const pg8::AccT& acc, const pg8::Unit& u, int wr, int wc, int fr, int fq) const {
        const int row0 = u.pm * 256 + wr * 64 + fr;
        const float* g2 = mods_l + (size_t)mod_row(u.pm * 256) * 6 * D + 2 * D;
        f32x4 gv[2][2];
#pragma unroll
        for (int bj = 0; bj < 2; ++bj) { const int c0 = u.pn * 256 + bj * 128 + wc * 32 + 8 * fq; gv[bj][0] = *(const f32x4*)(g2 + c0); gv[bj][1] = *(const f32x4*)(g2 + c0 + 4); }
#pragma unroll
        for (int ai = 0; ai < 2; ++ai)
#pragma unroll
            for (int m = 0; m < 4; ++m) { bf16* rowp = TMP + (size_t)(row0 + ai * 128 + m * 16) * D;
#pragma unroll
                for (int bj = 0; bj < 2; ++bj) { const int c0 = u.pn * 256 + bj * 128 + wc * 32 + 8 * fq;
                    const f32x4 v0 = gv[bj][0] * acc[ai][bj][m][0], v1 = gv[bj][1] * acc[ai][bj][m][1];
                    u32x4 w; w.x = pg8::cvt_pk_bf16(v0.x, v0.y); w.y = pg8::cvt_pk_bf16(v0.z, v0.w); w.z = pg8::cvt_pk_bf16(v1.x, v1.y); w.w = pg8::cvt_pk_bf16(v1.z, v1.w);
                    *(u32x4*)(rowp + c0) = w; } }
    }
};
constexpr int TOK_LDS = 131072 + 4096;
constexpr int MOE_LDS = 131072;
__device__ __forceinline__ int moe_setup(Ctx& F, int l) {
    LAS int* cntL = (LAS int*)(F.lds + MOE_LDS); LAS int* tst = (LAS int*)(F.lds + MOE_LDS + 256); LAS unsigned short* te = (LAS unsigned short*)(F.lds + MOE_LDS + 512);
    const unsigned* cnt = (const unsigned*)(F.ctl() + CW_CNT + l * 64);
    __syncthreads();
    if (F.tid < NE) cntL[F.tid] = (int)__hip_atomic_load(cnt + F.tid, __ATOMIC_RELAXED, __HIP_MEMORY_SCOPE_AGENT);
    __syncthreads();
    if (F.tid == 0) { int s = 0; for (int e = 0; e < NE; ++e) { tst[e] = s; s += (cntL[e] + 255) >> 8; } tst[NE] = s; }
    __syncthreads();
    const int T = tst[NE];
    for (int i = F.tid; i < T; i += NTHR) { int e = 0; for (int q = 1; q < NE; ++q) e = (tst[q] <= i) ? q : e; te[i] = (unsigned short)e; }
    __syncthreads();
    return T;
}
struct MoeOrder {
    int t0, nun, rank, nper, npn; const LAS unsigned short* te; const LAS int* tst; const LAS int* cntl;
    __device__ __forceinline__ void init(const Ctx& F, int T, int npn_) {
        const int x = F.bid & 7; nper = F.G >> 3; rank = F.bid >> 3; npn = npn_;
        t0 = (x * T) >> 3; const int t1 = ((x + 1) * T) >> 3; nun = (t1 - t0) * npn;
        te = (const LAS unsigned short*)(F.lds + MOE_LDS + 512); tst = (const LAS int*)(F.lds + MOE_LDS + 256); cntl = (const LAS int*)(F.lds + MOE_LDS);
    }
    __device__ __forceinline__ bool next(int i, pg8::Unit& u) const {
        const int x = rank + i * nper; if (x >= nun) return false;
        const int rt = t0 + x / npn; u.pm = rt; u.pn = x % npn; u.e = __builtin_amdgcn_readfirstlane((int)te[rt]); u.pos0 = (rt - __builtin_amdgcn_readfirstlane(tst[u.e])) * 256; u.ce = __builtin_amdgcn_readfirstlane(cntl[u.e]); return true;
    }
};
struct PbGu {
    static constexpr int K = D; static constexpr bool PERM = true, GATHER = true;
    const bf16* A; const bf16* Bt_l; bf16* H; const float* bgu_l; const int* list_tok; MoeOrder S; const LAS int* cntL;
    __device__ __forceinline__ bool next(int i, pg8::Unit& u) const { return S.next(i, u); }
    __device__ __forceinline__ const char* a_base(const pg8::Unit&) const { return (const char*)A; }
    __device__ __forceinline__ const char* b_base(const pg8::Unit& u) const { return (const char*)Bt_l + ((size_t)u.e * 2 * FF + (size_t)u.pn * 256) * K * 2; }
    __device__ __forceinline__ void a_voff_half(const pg8::Unit& u, unsigned (&v)[2], int tid, int h) const {
        const int ce = u.ce;
#pragma unroll
        for (int i = 0; i < 2; ++i) { int R, C; pg8::stage_rc(tid * 16 + i * 8192, R, C);
            const int pos = u.pos0 + h * 128 + R; const int tok = pos < ce ? list_tok[(size_t)u.e * CAP + pos] : 0; v[i] = (unsigned)(tok * K + C) * 2u; }
    }
    __device__ __forceinline__ void a_voff(const pg8::Unit& u, unsigned (&v)[2][2], int tid) const { a_voff_half(u, v[0], tid, 0); a_voff_half(u, v[1], tid, 1); }
    __device__ __forceinline__ void tok_prefetch(const pg8::Unit& u, LAS unsigned char* lds, int tid, int wid) const {
        const int ce = u.ce;
#pragma unroll
        for (int h = 0; h < 2; ++h)
#pragma unroll
            for (int i = 0; i < 2; ++i) { int R, C; pg8::stage_rc(tid * 16 + i * 8192, R, C);
                const int pos = u.pos0 + h * 128 + R; const int* src = list_tok + (size_t)u.e * CAP + (pos < ce ? pos : 0);
                __builtin_amdgcn_global_load_lds((const unsigned*)src, (LAS unsigned*)(lds + TOK_LDS + ((h * 2 + i) * 8 + wid) * 256), 4, 0, 0); }
    }
    __device__ __forceinline__ void a_voff_half_lds(unsigned (&v)[2], LAS unsigned char* lds, int tid, int wid, int h) const {
#pragma unroll
        for (int i = 0; i < 2; ++i) { int R, C; pg8::stage_rc(tid * 16 + i * 8192, R, C);
            const int tok = *(const LAS int*)(lds + TOK_LDS + ((h * 2 + i) * 8 + wid) * 256 + (tid & 63) * 4); v[i] = (unsigned)(tok * K + C) * 2u; }
    }
    __device__ __forceinline__ void epi(const pg8::AccT& acc, const pg8::Unit& u, int wr, int wc, int fr, int fq) const {
        const int row0 = u.pm * 256 + wr * 64 + fr, ff0 = u.pn * 128 + wc * 32 + 8 * fq;
        const float* bg = bgu_l + (size_t)u.e * 2 * FF;
        const f32x4 bg0 = *(const f32x4*)(bg + ff0), bg1 = *(const f32x4*)(bg + ff0 + 4), bu0 = *(const f32x4*)(bg + FF + ff0), bu1 = *(const f32x4*)(bg + FF + ff0 + 4);
#pragma unroll
        for (int ai = 0; ai < 2; ++ai)
#pragma unroll
            for (int m = 0; m < 4; ++m) {
                float o[8];
#pragma unroll
                for (int n = 0; n < 2; ++n) { const f32x4 g = acc[ai][0][m][n] + (n ? bg1 : bg0), up = acc[ai][1][m][n] + (n ? bu1 : bu0);
#pragma unroll
                    for (int j = 0; j < 4; ++j) { const float gate = fminf(g[j], 7.0f), upc = fminf(fmaxf(up[j], -7.0f), 7.0f); o[4 * n + j] = (upc + 1.0f) * gate * sigmoidf_(1.702f * gate); } }
                u32x4 w; w.x = pg8::cvt_pk_bf16(o[0], o[1]); w.y = pg8::cvt_pk_bf16(o[2], o[3]); w.z = pg8::cvt_pk_bf16(o[4], o[5]); w.w = pg8::cvt_pk_bf16(o[6], o[7]);
                *(u32x4*)(H + (size_t)(row0 + ai * 128 + m * 16) * FF + ff0) = w;
            }
    }
};
struct PbDown {
    static constexpr int K = FF; static constexpr bool PERM = true, GATHER = false;
    const bf16* A; const bf16* Bt_l; bf16* Y2; const float* bd_l; const int* list_dst; const float* list_gate; MoeOrder S; const LAS int* cntL;
    __device__ __forceinline__ bool next(int i, pg8::Unit& u) const { return S.next(i, u); }
    __device__ __forceinline__ const char* a_base(const pg8::Unit& u) const { return (const char*)A + (size_t)u.pm * 256 * K * 2; }
    __device__ __forceinline__ const char* b_base(const pg8::Unit& u) const { return (const char*)Bt_l + ((size_t)u.e * D + (size_t)u.pn * 256) * K * 2; }
    __device__ __forceinline__ void a_voff(const pg8::Unit&, unsigned (&v)[2][2], int tid) const { pg8::voff_contig(v, tid, K); }
    __device__ __forceinline__ void tok_prefetch(const pg8::Unit&, LAS unsigned char*, int, int) const {}
    __device__ __forceinline__ void a_voff_half_lds(unsigned (&)[2], LAS unsigned char*, int, int, int) const {}
    __device__ __forceinline__ void epi(const pg8::AccT& acc, const pg8::Unit& u, int wr, int wc, int fr, int fq) const {
        const int ce = u.ce; const int p0 = u.pos0 + wr * 64 + fr; const float* bd = bd_l + (size_t)u.e * D;
        int dsts[2][4]; float gs[2][4];
#pragma unroll
        for (int ai = 0; ai < 2; ++ai)
#pragma unroll
            for (int m = 0; m < 4; ++m) { const int pos = p0 + ai * 128 + m * 16; const size_t ix = (size_t)u.e * CAP + (pos < ce ? pos : 0); dsts[ai][m] = list_dst[ix]; gs[ai][m] = list_gate[ix]; }
        f32x4 bb[2][2];
#pragma unroll
        for (int bj = 0; bj < 2; ++bj) { const int c0 = u.pn * 256 + bj * 128 + wc * 32 + 8 * fq; bb[bj][0] = *(const f32x4*)(bd + c0); bb[bj][1] = *(const f32x4*)(bd + c0 + 4); }
#pragma unroll
        for (int ai = 0; ai < 2; ++ai)
#pragma unroll
            for (int m = 0; m < 4; ++m) {
                const int pos = p0 + ai * 128 + m * 16;
                {
                    const float g = gs[ai][m]; const size_t drow = pos < ce ? (size_t)dsts[ai][m] : (size_t)(Y2_DUMMY_ROW + (pos & 255));
#pragma unroll
                    for (int bj = 0; bj < 2; ++bj) { const int c0 = u.pn * 256 + bj * 128 + wc * 32 + 8 * fq;
                        const f32x4 v0 = (acc[ai][bj][m][0] + bb[bj][0]) * g, v1 = (acc[ai][bj][m][1] + bb[bj][1]) * g;
                        u32x4 w; w.x = pg8::cvt_pk_bf16(v0.x, v0.y); w.y = pg8::cvt_pk_bf16(v0.z, v0.w); w.z = pg8::cvt_pk_bf16(v1.x, v1.y); w.w = pg8::cvt_pk_bf16(v1.z, v1.w);
                        *(u32x4*)(Y2 + drow * D + c0) = w; }
                }
            }
    }
};
struct PbGu8 {
    static constexpr int K = D; static constexpr bool PERM = true, GATHER = true;
    const unsigned char* A; const unsigned char* Bt_l; unsigned char* H; const float* bgu_l; const int* list_tok; MoeOrder S; const LAS int* cntL;
    __device__ __forceinline__ bool next(int i, pg8::Unit& u) const { return S.next(i, u); }
    __device__ __forceinline__ const char* a_base(const pg8::Unit&) const { return (const char*)A; }
    __device__ __forceinline__ const char* b_base(const pg8::Unit& u) const { return (const char*)Bt_l + ((size_t)u.e * 2 * FF + (size_t)u.pn * 256) * K; }
    __device__ __forceinline__ void a_voff_half(const pg8::Unit& u, unsigned (&v)[2], int tid, int h) const {
        const int ce = u.ce;
#pragma unroll
        for (int i = 0; i < 2; ++i) { int R, C; pg8::stage_rc(tid * 16 + i * 8192, R, C);
            const int pos = u.pos0 + h * 128 + R; const int tok = pos < ce ? list_tok[(size_t)u.e * CAP + pos] : 0; v[i] = (unsigned)(tok * K + C * 2); }
    }
    __device__ __forceinline__ void a_voff(const pg8::Unit& u, unsigned (&v)[2][2], int tid) const { a_voff_half(u, v[0], tid, 0); a_voff_half(u, v[1], tid, 1); }
    __device__ __forceinline__ void tok_prefetch(const pg8::Unit& u, LAS unsigned char* lds, int tid, int wid) const {
        const int ce = u.ce;
#pragma unroll
        for (int h = 0; h < 2; ++h)
#pragma unroll
            for (int i = 0; i < 2; ++i) { int R, C; pg8::stage_rc(tid * 16 + i * 8192, R, C);
                const int pos = u.pos0 + h * 128 + R; const int* src = list_tok + (size_t)u.e * CAP + (pos < ce ? pos : 0);
                __builtin_amdgcn_global_load_lds((const unsigned*)src, (LAS unsigned*)(lds + TOK_LDS + ((h * 2 + i) * 8 + wid) * 256), 4, 0, 0); }
    }
    __device__ __forceinline__ void a_voff_half_lds(unsigned (&v)[2], LAS unsigned char* lds, int tid, int wid, int h) const {
#pragma unroll
        for (int i = 0; i < 2; ++i) { int R, C; pg8::stage_rc(tid * 16 + i * 8192, R, C);
            const int tok = *(const LAS int*)(lds + TOK_LDS + ((h * 2 + i) * 8 + wid) * 256 + (tid & 63) * 4); v[i] = (unsigned)(tok * K + C * 2); }
    }
    __device__ __forceinline__ void epi(const pg8::AccT& acc, const pg8::Unit& u, int wr, int wc, int fr, int fq) const {
        const int row0 = u.pm * 256 + wr * 64 + fr, ff0 = u.pn * 128 + wc * 32 + 8 * fq;
        const float* bg = bgu_l + (size_t)u.e * 2 * FF;
        const f32x4 bg0 = *(const f32x4*)(bg + ff0), bg1 = *(const f32x4*)(bg + ff0 + 4), bu0 = *(const f32x4*)(bg + FF + ff0), bu1 = *(const f32x4*)(bg + FF + ff0 + 4);
#pragma unroll
        for (int ai = 0; ai < 2; ++ai)
#pragma unroll
            for (int m = 0; m < 4; ++m) {
                float o[8];
#pragma unroll
                for (int n = 0; n < 2; ++n) { const f32x4 g = acc[ai][0][m][n] * (1.0f / W8_SCALE) + (n ? bg1 : bg0), up = acc[ai][1][m][n] * (1.0f / W8_SCALE) + (n ? bu1 : bu0);
#pragma unroll
                    for (int j = 0; j < 4; ++j) { const float gate = fminf(g[j], 7.0f), upc = fminf(fmaxf(up[j], -7.0f), 7.0f); o[4 * n + j] = (upc + 1.0f) * gate * sigmoidf_(1.702f * gate); } }
                u32x2 w; w.x = pk_fp8x4(o[0], o[1], o[2], o[3]); w.y = pk_fp8x4(o[4], o[5], o[6], o[7]);
                *(u32x2*)(H + (size_t)(row0 + ai * 128 + m * 16) * FF + ff0) = w;
            }
    }
};
struct PbDown8 {
    static constexpr int K = FF; static constexpr bool PERM = true, GATHER = false;
    const unsigned char* A; const unsigned char* Bt_l; bf16* Y2; const float* bd_l; const int* list_dst; const float* list_gate; MoeOrder S; const LAS int* cntL;
    __device__ __forceinline__ bool next(int i, pg8::Unit& u) const { return S.next(i, u); }
    __device__ __forceinline__ const char* a_base(const pg8::Unit& u) const { return (const char*)A + (size_t)u.pm * 256 * K; }
    __device__ __forceinline__ const char* b_base(const pg8::Unit& u) const { return (const char*)Bt_l + ((size_t)u.e * D + (size_t)u.pn * 256) * K; }
    __device__ __forceinline__ void a_voff(const pg8::Unit&, unsigned (&v)[2][2], int tid) const { pg8::voff_contig8(v, tid, K); }
    __device__ __forceinline__ void tok_prefetch(const pg8::Unit&, LAS unsigned char*, int, int) const {}
    __device__ __forceinline__ void a_voff_half_lds(unsigned (&)[2], LAS unsigned char*, int, int, int) const {}
    __device__ __forceinline__ void epi(const pg8::AccT& acc, const pg8::Unit& u, int wr, int wc, int fr, int fq) const {
        const int ce = u.ce; const int p0 = u.pos0 + wr * 64 + fr; const float* bd = bd_l + (size_t)u.e * D;
        int dsts[2][4]; float gs[2][4];
#pragma unroll
        for (int ai = 0; ai < 2; ++ai)
#pragma unroll
            for (int m = 0; m < 4; ++m) { const int pos = p0 + ai * 128 + m * 16; const size_t ix = (size_t)u.e * CAP + (pos < ce ? pos : 0); dsts[ai][m] = list_dst[ix]; gs[ai][m] = list_gate[ix]; }
        f32x4 bb[2][2];
#pragma unroll
        for (int bj = 0; bj < 2; ++bj) { const int c0 = u.pn * 256 + bj * 128 + wc * 32 + 8 * fq; bb[bj][0] = *(const f32x4*)(bd + c0); bb[bj][1] = *(const f32x4*)(bd + c0 + 4); }
#pragma unroll
        for (int ai = 0; ai < 2; ++ai)
#pragma unroll
            for (int m = 0; m < 4; ++m) {
                const int pos = p0 + ai * 128 + m * 16;
                {
                    const float g = gs[ai][m]; const size_t drow = pos < ce ? (size_t)dsts[ai][m] : (size_t)(Y2_DUMMY_ROW + (pos & 255));
#pragma unroll
                    for (int bj = 0; bj < 2; ++bj) { const int c0 = u.pn * 256 + bj * 128 + wc * 32 + 8 * fq;
                        const f32x4 v0 = (acc[ai][bj][m][0] * (1.0f / W8_SCALE) + bb[bj][0]) * g, v1 = (acc[ai][bj][m][1] * (1.0f / W8_SCALE) + bb[bj][1]) * g;
                        if (Y2_FP8) { u32x2 w; w.x = pk_fp8x4(v0.x * Y2_SCALE, v0.y * Y2_SCALE, v0.z * Y2_SCALE, v0.w * Y2_SCALE); w.y = pk_fp8x4(v1.x * Y2_SCALE, v1.y * Y2_SCALE, v1.z * Y2_SCALE, v1.w * Y2_SCALE);
                            *(u32x2*)((unsigned char*)Y2 + drow * D + c0) = w; }
                        else { u32x4 w; w.x = pg8::cvt_pk_bf16(v0.x, v0.y); w.y = pg8::cvt_pk_bf16(v0.z, v0.w); w.z = pg8::cvt_pk_bf16(v1.x, v1.y); w.w = pg8::cvt_pk_bf16(v1.z, v1.w);
                            *(u32x4*)(Y2 + drow * D + c0) = w; } }
                }
            }
    }
};
__device__ __forceinline__ void ph_inproj_fast(Ctx& F, int l) {
    PbInproj pb; pb.A = F.H1(); pb.Bt = F.WinT() + (size_t)l * INW * D; pb.P = F.P(); pb.Vt = F.Vt(); pb.rope = F.rope(); pb.S.init(MA, INW, F.G, F.bid);
    pg8::gemm_phase(F.lds, pb, F.tid);
}
__device__ __forceinline__ void ph_outproj_fast(Ctx& F, int l) {
    PbOutproj pb; pb.A = F.MIX(); pb.Bt = F.WoutT() + (size_t)l * D * D; pb.TMP = F.P(); pb.mods_l = F.mods() + (size_t)l * 3 * 6 * D; pb.S.init(l == 0 ? MA : ML, D, F.G, F.bid);
    pg8::gemm_phase(F.lds, pb, F.tid);
}
__device__ __forceinline__ void ph_moe_gu_fast(Ctx& F, int l) {
    const int T = moe_setup(F, l);
    if (MOE_FP8) {
        PbGu8 pb; pb.A = (const unsigned char*)F.H1(); pb.Bt_l = (const unsigned char*)F.WguT() + (size_t)l * NE * 2 * FF * D; pb.H = (unsigned char*)F.HMOE(); pb.bgu_l = F.inp(I_BGU) + (size_t)l * NE * 2 * FF; pb.list_tok = F.list_tok();
        pb.S.init(F, T, 8); pb.cntL = (const LAS int*)(F.lds + MOE_LDS);
        pg8::gemm_phase8(F.lds, pb, F.tid);
    } else {
        PbGu pb; pb.A = F.H1(); pb.Bt_l = F.WguT() + (size_t)l * NE * 2 * FF * D; pb.H = F.HMOE(); pb.bgu_l = F.inp(I_BGU) + (size_t)l * NE * 2 * FF; pb.list_tok = F.list_tok();
        pb.S.init(F, T, 8); pb.cntL = (const LAS int*)(F.lds + MOE_LDS);
        pg8::gemm_phase(F.lds, pb, F.tid);
    }
}
__device__ __forceinline__ void ph_moe_down_fast(Ctx& F, int l) {
    const int T = moe_setup(F, l);
    if (MOE_FP8) {
        PbDown8 pb; pb.A = (const unsigned char*)F.HMOE(); pb.Bt_l = (const unsigned char*)F.WdT() + (size_t)l * NE * D * FF; pb.Y2 = F.Y2(); pb.bd_l = F.inp(I_BD) + (size_t)l * NE * D; pb.list_dst = F.list_dst(); pb.list_gate = F.list_gate();
        pb.S.init(F, T, 4); pb.cntL = (const LAS int*)(F.lds + MOE_LDS);
        pg8::gemm_phase8(F.lds, pb, F.tid);
    } else {
        PbDown pb; pb.A = F.HMOE(); pb.Bt_l = F.WdT() + (size_t)l * NE * D * FF; pb.Y2 = F.Y2(); pb.bd_l = F.inp(I_BD) + (size_t)l * NE * D; pb.list_dst = F.list_dst(); pb.list_gate = F.list_gate();
        pb.S.init(F, T, 4); pb.cntL = (const LAS int*)(F.lds + MOE_LDS);
        pg8::gemm_phase(F.lds, pb, F.tid);
    }
}

#define XB_TMO      128
#define XB_XCNT(j)  (256  + 64 * (j))
#define XB_XSUB(j)  (1280 + 64 * (j))
#define XB_XGEN(j)  (2304 + 64 * (j))
#define XB_TOP      3328
#define XB_TOPGEN   3392
#define XCD_BAR_WORDS 3456
#define XB_SPIN_CAP (1u << 22)
__device__ __forceinline__ unsigned xb_ld(unsigned* p)              { return __hip_atomic_load(p, __ATOMIC_RELAXED, __HIP_MEMORY_SCOPE_AGENT); }
__device__ __forceinline__ unsigned xb_add(unsigned* p, unsigned v) { return __hip_atomic_fetch_add(p, v, __ATOMIC_RELAXED, __HIP_MEMORY_SCOPE_AGENT); }
__device__ __forceinline__ unsigned xb_xcc_id() { return (unsigned)__builtin_amdgcn_s_getreg((3 << 11) | 20) & 0xFu; }
#define XB_SPIN(cond, bar) do { unsigned _sp = 0; while (cond) { __builtin_amdgcn_s_sleep(1); \
    if ((++_sp & 255u) == 0u) { if (xb_ld(&(bar)[XB_TMO])) break; if (_sp > XB_SPIN_CAP) { atomicAdd(&(bar)[XB_TMO], 1u); break; } } } } while (0)
struct XcdBarrier { unsigned* bar; unsigned x; volatile LAS unsigned* st; };
__device__ __forceinline__ XcdBarrier xcd_barrier_post(unsigned* bar, volatile LAS unsigned* st) {
    XcdBarrier b; b.bar = bar; b.x = xb_xcc_id(); b.st = st;
    if (threadIdx.x == 0) (void)xb_add(&bar[XB_XCNT(b.x)], 1u);
    return b;
}
__device__ __forceinline__ void xcd_barrier_complete(unsigned* bar, unsigned x, unsigned& nloc, unsigned& nx) {
    const unsigned G = gridDim.x * gridDim.y * gridDim.z;
    unsigned sum, cnt, mine, sp = 0u;
    for (;;) {
        sum = 0u; cnt = 0u; mine = 0u;
#pragma unroll
        for (unsigned j = 0; j < 16; ++j) { const unsigned c = xb_ld(&bar[XB_XCNT(j)]); sum += c; cnt += (c > 0u) ? 1u : 0u; mine = (j == x) ? c : mine; }
        if (sum == G) break;
        __builtin_amdgcn_s_sleep(1);
        if ((++sp & 255u) == 0u) { if (xb_ld(&bar[XB_TMO])) break; if (sp > XB_SPIN_CAP) { atomicAdd(&bar[XB_TMO], 1u); break; } }
    }
    nloc = mine > 0u ? mine : 1u; nx = cnt > 0u ? cnt : 1u;
}
__device__ __forceinline__ void xcd_barrier(const XcdBarrier& b0) {
    asm volatile("s_waitcnt vmcnt(0)" ::: "memory");
    __syncthreads();
    XcdBarrier b = b0;
    { unsigned long long p = (unsigned long long)b0.bar; unsigned xx = b0.x; asm volatile("" : "+s"(p), "+s"(xx)); b.bar = (unsigned*)p; b.x = xx; }
    if (threadIdx.x == 0) {
        unsigned* bar = b.bar;
        __builtin_amdgcn_s_waitcnt(0);
        unsigned nloc = b.st[0], nx = b.st[1];
        if (nloc == 0u) { xcd_barrier_complete(bar, b.x, nloc, nx); b.st[0] = nloc; b.st[1] = nx; }
        const unsigned old = xb_add(&bar[XB_XSUB(b.x)], 1u);
        const unsigned gen = old / nloc;
        if (old + 1u == (gen + 1u) * nloc) {
            __builtin_amdgcn_fence(__ATOMIC_RELEASE, "agent");
            asm volatile("s_waitcnt vmcnt(0)" ::: "memory");
            const unsigned og = xb_add(&bar[XB_TOP], 1u);
            const unsigned tg = og / nx;
            if (og + 1u == (tg + 1u) * nx) xb_add(&bar[XB_TOPGEN], 1u);
            else XB_SPIN(xb_ld(&bar[XB_TOPGEN]) == tg, bar);
            __builtin_amdgcn_fence(__ATOMIC_ACQUIRE, "agent");
            xb_add(&bar[XB_XGEN(b.x)], 1u);
            asm volatile("s_waitcnt vmcnt(0)" ::: "memory");
        } else {
            XB_SPIN(xb_ld(&bar[XB_XGEN(b.x)]) == gen, bar);
            __builtin_amdgcn_fence(__ATOMIC_ACQUIRE, "agent");
            asm volatile("s_waitcnt vmcnt(0)" ::: "memory");
        }
    }
    __syncthreads();
}

__device__ __forceinline__ void convert_item(Ctx& F, int l, int wi) {
    LAS float* scr = (LAS float*)(F.lds + F.wave * 8704);
    if (MOE_FP8) {
        if (wi < CV_GU) { const int le = l * NE + (wi >> 10); tr_item8<2>(F.inp(I_WGU) + (size_t)le * D * 2 * FF, D, 2 * FF, (unsigned char*)F.WguT() + (size_t)le * 2 * FF * D, scr, wi & 1023, F.lane); }
        else { const int r = wi - CV_GU; const int le = l * NE + (r >> 9); tr_item8<0>(F.inp(I_WD) + (size_t)le * FF * D, FF, D, (unsigned char*)F.WdT() + (size_t)le * D * FF, scr, r & 511, F.lane); }
        return;
    }
    if (wi < CV_GU) { const int le = l * NE + (wi >> 10); tr_item<2>(F.inp(I_WGU) + (size_t)le * D * 2 * FF, D, 2 * FF, F.WguT() + (size_t)le * 2 * FF * D, scr, wi & 1023, F.lane); }
    else { const int r = wi - CV_GU; const int le = l * NE + (r >> 9); tr_item<0>(F.inp(I_WD) + (size_t)le * FF * D, FF, D, F.WdT() + (size_t)le * D * FF, scr, r & 511, F.lane); }
}
__device__ __forceinline__ bool convert_next(Ctx& F, volatile LAS unsigned* prog, int pmax) {
    const int p = (int)prog[F.wave];
    if (p >= pmax) return false;
    convert_item(F, p / CV_PER_WAVE, (F.bid * NWAVES + F.wave) + 2048 * (p % CV_PER_WAVE));
    if (F.lane == 0) prog[F.wave] = (unsigned)(p + 1);
    return true;
}
__device__ __forceinline__ void drain_convert(Ctx& F, int l, volatile LAS unsigned* prog) {
    while (convert_next(F, prog, CV_PER_WAVE * (l + 1))) {}
}
__device__ __forceinline__ void xcd_barrier_steal(const XcdBarrier& b0, Ctx& F, volatile LAS unsigned* fl, volatile LAS unsigned* prog) {
    asm volatile("s_waitcnt vmcnt(0)" ::: "memory");
    __syncthreads();
    XcdBarrier b = b0;
    { unsigned long long p = (unsigned long long)b0.bar; unsigned xx = b0.x; asm volatile("" : "+s"(p), "+s"(xx)); b.bar = (unsigned*)p; b.x = xx; }
    unsigned* bar = b.bar;
    if (threadIdx.x == 0) {
        __builtin_amdgcn_s_waitcnt(0);
        unsigned nloc = b.st[0], nx = b.st[1];
        if (nloc == 0u) { xcd_barrier_complete(bar, b.x, nloc, nx); b.st[0] = nloc; b.st[1] = nx; }
        const unsigned old = xb_add(&bar[XB_XSUB(b.x)], 1u);
        const unsigned gen = old / nloc;
        if (old + 1u == (gen + 1u) * nloc) {
            __builtin_amdgcn_fence(__ATOMIC_RELEASE, "agent");
            asm volatile("s_waitcnt vmcnt(0)" ::: "memory");
            const unsigned og = xb_add(&bar[XB_TOP], 1u);
            const unsigned tg = og / nx;
            if (og + 1u == (tg + 1u) * nx) xb_add(&bar[XB_TOPGEN], 1u);
            else XB_SPIN(xb_ld(&bar[XB_TOPGEN]) == tg, bar);
            __builtin_amdgcn_fence(__ATOMIC_ACQUIRE, "agent");
            xb_add(&bar[XB_XGEN(b.x)], 1u);
            asm volatile("s_waitcnt vmcnt(0)" ::: "memory");
            fl[0] = 1u;
        } else { fl[0] = 0u; fl[1] = gen; }
    }
    __syncthreads();
    if (fl[0] == 0u) {
        const unsigned gen = fl[1];
        unsigned sp = 0u;
        for (;;) {
            unsigned rel = 0u;
            if (F.lane == 0) { rel = (xb_ld(&bar[XB_XGEN(b.x)]) != gen) ? 1u : 0u;
                if (!rel && (++sp & 63u) == 0u) { if (xb_ld(&bar[XB_TMO])) rel = 1u; else if (sp > XB_SPIN_CAP) { atomicAdd(&bar[XB_TMO], 1u); rel = 1u; } } }
            rel = (unsigned)__builtin_amdgcn_readfirstlane((int)rel);
            if (rel) break;
            if (!convert_next(F, prog, CV_PER_WAVE * NL)) __builtin_amdgcn_s_sleep(2);
        }
        asm volatile("s_waitcnt vmcnt(0)" ::: "memory");
        __syncthreads();
        if (threadIdx.x == 0) { __builtin_amdgcn_fence(__ATOMIC_ACQUIRE, "agent"); asm volatile("s_waitcnt vmcnt(0)" ::: "memory"); }
    }
    __syncthreads();
}

constexpr int LDS_BYTES = 147456;
constexpr int MISC_OFF = 147456 - 256;

__global__ void __launch_bounds__(NTHR, 2) fwd(Args args) {
    extern __shared__ __attribute__((aligned(16))) unsigned char lds[];
    Ctx F0;
    F0.lds = (LAS unsigned char*)lds;
    F0.tid = threadIdx.x; F0.lane = F0.tid & 63; F0.wave = __builtin_amdgcn_readfirstlane(F0.tid >> 6); F0.G = gridDim.x; F0.bid = blockIdx.x;
    F0.in = args.in; F0.out = args.out; F0.ws = args.ws;
    volatile LAS unsigned* MISC = (volatile LAS unsigned*)(F0.lds + MISC_OFF);
    if (F0.tid < 64) MISC[F0.tid] = 0u;
    __syncthreads();
    XcdBarrier bar; bar.bar = (unsigned*)(F0.ctl() + CW_BAR); bar.x = 0; bar.st = nullptr;
    if (MK_N_LAUNCHES == 1) bar = xcd_barrier_post((unsigned*)(F0.ctl() + CW_BAR), MISC + 8);
    const int lo = args.ph_lo, hi = args.ph_hi;
#define IN(k) (lo <= (k) && (k) < hi)
#define SEAM(k) do { if (IN(k) && IN((k) + 1)) { Ctx F = fresh(F0); xcd_barrier_steal(bar, F, MISC + 16, MISC + 24); } } while (0)
#define SEAM_S(k) SEAM(k)
#define PH(k, ...) do { if (IN(k)) { Ctx F = fresh(F0); __VA_ARGS__; } } while (0)

    PH(0, REPEAT(REP_PRO, ph_prologue(F))); SEAM(0);
    for (int l = 0; l < NL; ++l) {
        const int pb = 1 + 9 * l;
        PH(pb + 0, ph_norm1(F, l); if (REP_N10 > 1 && l == 0) ph_norm1(F, l)); SEAM(pb + 0);
        PH(pb + 1, REPEAT(REP_INP, if (FAST_GEMM) ph_inproj_fast(F, l); else ph_inproj_naive(F, l))); SEAM_S(pb + 1);
        if (FAST_ATTN) PH(pb + 2, REPEAT(REP_ATT, ph_attn_fast(F, l))); else PH(pb + 2, ph_attn_naive(F, l));
        if (FAST_LRU) PH(pb + 2, REPEAT(REP_LA, ph_lru_fast<false>(F, l))); else PH(pb + 2, ph_lru_gates_naive(F, l));
        if (FAST_HG) PH(pb + 2, REPEAT(REP_HA, ph_hgrn_fast<false>(F, l)));
        SEAM(pb + 2);
        if (FAST_LRU) PH(pb + 3, REPEAT(REP_CAR, ph_lru_carry(F))); else PH(pb + 3, ph_lru_scan_naive(F));
        if (FAST_HG) PH(pb + 3, REPEAT(REP_CAR, ph_hgrn_carry(F))); else PH(pb + 3, ph_hgrn_scan_naive(F, l));
        SEAM_S(pb + 3);
        if (FAST_LRU) PH(pb + 4, REPEAT(REP_LC, ph_lru_fast<true>(F, l))); else PH(pb + 4, ph_lru_out_naive(F, l));
        if (FAST_HG) PH(pb + 4, REPEAT(REP_HC, ph_hgrn_fast<true>(F, l))); else PH(pb + 4, ph_hgrn_out_naive(F, l));
        SEAM(pb + 4);
        PH(pb + 5, if (FAST_GEMM) ph_outproj_fast(F, l); else ph_outproj_naive(F, l); if (REP_OP0 > 1) ph_outproj_fast(F, l)); SEAM_S(pb + 5);
        PH(pb + 6, ph_norm2_router(F, l); __syncthreads(); drain_convert(F, l, MISC + 24)); SEAM(pb + 6);
        PH(pb + 7, REPEAT(REP_GU, if (FAST_GEMM) ph_moe_gu_fast(F, l); else ph_moe_gu_naive(F, l))); SEAM_S(pb + 7);
        PH(pb + 8, REPEAT(REP_DN, if (FAST_GEMM) ph_moe_down_fast(F, l); else ph_moe_down_naive(F, l))); SEAM_S(pb + 8);
    }
    PH(19, REPEAT(REP_FIN, ph_norm1(F, 2)));
#undef PH
#undef IN
#undef SEAM_S
#undef SEAM
}

extern "C" void kernel_launch(void* const* d_in, const int* in_sizes, int n_in, void* d_out, int out_size, void* d_ws, size_t ws_size, hipStream_t stream) {
    static int grid = 0;
    if (grid == 0) {
        if (n_in != 27 || out_size != ML * D || ws_size < WS_END) { fprintf(stderr, "kernel_launch: unexpected shapes (n_in %d out %d ws %zu)\n", n_in, out_size, ws_size); grid = -1; return; }
        int dev = 0, cus = 0, per_cu = 0;
        if (hipGetDevice(&dev) != hipSuccess || hipDeviceGetAttribute(&cus, hipDeviceAttributeMultiprocessorCount, dev) != hipSuccess) { grid = -1; return; }
        if (hipFuncSetAttribute((const void*)fwd, hipFuncAttributeMaxDynamicSharedMemorySize, LDS_BYTES) != hipSuccess) { fprintf(stderr, "kernel_launch: hipFuncSetAttribute failed\n"); grid = -1; return; }
        if (hipOccupancyMaxActiveBlocksPerMultiprocessor(&per_cu, (const void*)fwd, NTHR, LDS_BYTES) != hipSuccess || per_cu < 1) { fprintf(stderr, "kernel_launch: occupancy query says %d\n", per_cu); }
        (void)hipGetLastError();
        grid = cus;
        if (grid != 256) { fprintf(stderr, "kernel_launch: built for a 256-CU device (got %d)\n", cus); grid = -1; return; }
    }
    if (grid < 0) return;
    (void)hipMemsetAsync((char*)d_ws + WS_CTL, 0, CTL_ZERO_BYTES, stream);
    Args a{};
    for (int i = 0; i < 27; ++i) a.in[i] = (const float*)d_in[i];
    a.out = (float*)d_out; a.ws = (unsigned char*)d_ws;
    if (MK_N_LAUNCHES == 1) { a.ph_lo = 0; a.ph_hi = N_PH; hipLaunchKernelGGL(fwd, dim3(grid), dim3(NTHR), LDS_BYTES, stream, a); }
    else for (int p = 0; p < N_PH; ++p) { a.ph_lo = p; a.ph_hi = p + 1; hipLaunchKernelGGL(fwd, dim3(grid), dim3(NTHR), LDS_BYTES, stream, a); }
}
```

```cpp
#include <hip/hip_runtime.h>
#include <stdint.h>
#include <stdio.h>

#ifndef MK_N_LAUNCHES
#define MK_N_LAUNCHES 1
#endif

#ifndef MOE_FP8
#define MOE_FP8 1
#endif
#ifndef Y2_FP8
#define Y2_FP8 1
#endif
#ifndef FAST_GEMM
#define FAST_GEMM 1
#endif
#ifndef REP_PRO
#define REP_PRO 1
#endif
#ifndef REP_INP
#define REP_INP 1
#endif
#ifndef REP_ATT
#define REP_ATT 1
#endif
#ifndef REP_LA
#define REP_LA 1
#endif
#ifndef REP_HA
#define REP_HA 1
#endif
#ifndef REP_LC
#define REP_LC 1
#endif
#ifndef REP_HC
#define REP_HC 1
#endif
#ifndef REP_N10
#define REP_N10 1
#endif
#ifndef REP_FIN
#define REP_FIN 1
#endif
#ifndef REP_OP0
#define REP_OP0 1
#endif
#ifndef REP_RT
#define REP_RT 1
#endif
#ifndef REP_CAR
#define REP_CAR 1
#endif
#ifndef REP_GU
#define REP_GU 1
#endif
#ifndef REP_DN
#define REP_DN 1
#endif
#define REPEAT(n, ...) do { _Pragma("unroll 1") for (int rep_ = 0; rep_ < (n); ++rep_) { __VA_ARGS__; } } while (0)
#ifndef FAST_ATTN
#define FAST_ATTN 1
#endif
#ifndef FAST_LRU
#define FAST_LRU 1
#endif
#ifndef FAST_HG
#define FAST_HG 1
#endif
#define GAS __attribute__((address_space(1)))
#define LAS __attribute__((address_space(3)))
typedef unsigned short bf16;
typedef short bf16x8 __attribute__((ext_vector_type(8)));
typedef float f32x4 __attribute__((ext_vector_type(4)));
typedef float f32x2 __attribute__((ext_vector_type(2)));
typedef float f32x16 __attribute__((ext_vector_type(16)));
typedef unsigned u32x4 __attribute__((ext_vector_type(4)));
typedef unsigned u32x2 __attribute__((ext_vector_type(2)));
typedef GAS unsigned gu32;

constexpr int D = 1024, NB = 2, SEQ = 16384, CTXL = 256, NL = 2;
constexpr int ML = NB * SEQ, MC = NB * CTXL, MA = ML + MC;
constexpr int INW = 2560;
constexpr int C_Q = 0, C_K = 512, C_V = 640, C_LX = 768, C_LG = 1024, C_HQ = 1280, C_HF = 1536, C_HB = 1792, C_HV = 2048, C_HO = 2304;
constexpr int NE = 32, FF = 1024, CAP = MA;
constexpr float EPS = 1e-6f;
constexpr float LOG2E = 1.4426950408889634f;
constexpr float QSCALE = 0.125f * LOG2E;
constexpr int NWAVES = 8, NTHR = 512;
constexpr int N_PH = 20;

constexpr size_t MiB = 1u << 20;
constexpr size_t WS_CTL = 0, CTL_ZERO_BYTES = 65536;
constexpr size_t WS_MODS = 1 * MiB;
constexpr size_t WS_ROPE = 2 * MiB;
constexpr size_t WS_LRUW = 3 * MiB;
constexpr size_t WS_WIN = 4 * MiB;
constexpr size_t WS_WOUT = 16 * MiB;
constexpr size_t WS_WGU = 20 * MiB;
constexpr size_t WS_WD = 276 * MiB;
constexpr size_t WS_XL = 404 * MiB;
constexpr size_t WS_H1 = 534 * MiB;
constexpr size_t WS_P = 599 * MiB;
constexpr size_t WS_VT = 762 * MiB;
constexpr size_t WS_MIX = 771 * MiB;
constexpr size_t WS_HD = 836 * MiB;
constexpr size_t WS_OHG = 901 * MiB;
constexpr size_t WS_GA = 966 * MiB;
constexpr size_t WS_GB = 1031 * MiB;
constexpr size_t WS_AGG = 1096 * MiB;
constexpr size_t WS_LIST = 1136 * MiB;
constexpr size_t WS_HMOE = 1152 * MiB;
constexpr size_t WS_Y2 = 1428 * MiB;
constexpr size_t WS_QI = 1688 * MiB;
constexpr size_t WS_KI = 1721 * MiB;
constexpr size_t WS_SAGG = 1754 * MiB;
constexpr size_t WS_SIN = 1788 * MiB;
constexpr size_t WS_DUMMY = 1823 * MiB;
constexpr size_t WS_END = 1824 * MiB;
constexpr size_t Y2_DUMMY_ROW = (WS_DUMMY - WS_Y2) / (D * ((Y2_FP8 && MOE_FP8) ? 1 : 2));
constexpr size_t VT_CTX_OFF = (size_t)NB * 2 * 64 * SEQ;
constexpr int CW_CNT = 64;
constexpr int CW_BAR = 4096;

__device__ __forceinline__ float bf2f(bf16 x) { return __uint_as_float(((unsigned)x) << 16); }
__device__ __forceinline__ unsigned pk2(float lo, float hi) { unsigned r; asm("v_cvt_pk_bf16_f32 %0, %1, %2" : "=v"(r) : "v"(lo), "v"(hi)); return r; }
__device__ __forceinline__ unsigned f2bf(float f) { return pk2(f, f) & 0xffffu; }
__device__ __forceinline__ float shx(float v, int mask, int lane) { return __int_as_float(__builtin_amdgcn_ds_bpermute((lane ^ mask) << 2, __float_as_int(v))); }
__device__ __forceinline__ float wave_sum(float v, int lane) {
#pragma unroll
    for (int o = 1; o < 64; o <<= 1) v += shx(v, o, lane);
    return v;
}
__device__ __forceinline__ float wave_max(float v, int lane) {
#pragma unroll
    for (int o = 1; o < 64; o <<= 1) v = fmaxf(v, shx(v, o, lane));
    return v;
}
__device__ __forceinline__ float frcp(float x) { return __builtin_amdgcn_rcpf(x); }
__device__ __forceinline__ float sigmoidf_(float x) { return frcp(1.0f + __expf(-x)); }
__device__ __forceinline__ float siluf_(float x) { return x * frcp(1.0f + __expf(-x)); }
__device__ __forceinline__ float gelu_tanh(float x) { const float u = 0.7978845608028654f * (x + 0.044715f * x * x * x); const float t = 1.0f - 2.0f * frcp(__expf(2.0f * u) + 1.0f); return 0.5f * x * (1.0f + t); }
__device__ __forceinline__ unsigned pk_fp8x4(float a, float b, float c, float d) { int w = 0; w = __builtin_amdgcn_cvt_pk_fp8_f32(a, b, w, false); w = __builtin_amdgcn_cvt_pk_fp8_f32(c, d, w, true); return (unsigned)w; }
constexpr float Y2_SCALE = 16.0f;
constexpr float W8_SCALE = 64.0f;
__device__ __forceinline__ int crow(int r, int hi) { return (r & 3) + 8 * (r >> 2) + 4 * hi; }

struct Args { const float* in[27]; float* out; unsigned char* ws; int ph_lo, ph_hi; };
struct Ctx {
    LAS unsigned char* lds;
    int tid, lane, wave, G, bid;
    const float* const* in;
    float* out; unsigned char* ws;
#define WSACC(T, name, off) __device__ __forceinline__ T* name() const { return (T*)(ws + (off)); }
    WSACC(gu32, ctl, WS_CTL) WSACC(float, mods, WS_MODS) WSACC(f32x2, rope, WS_ROPE) WSACC(bf16, lruw, WS_LRUW) WSACC(bf16, WinT, WS_WIN) WSACC(bf16, WoutT, WS_WOUT)
    WSACC(bf16, WguT, WS_WGU) WSACC(bf16, WdT, WS_WD) WSACC(bf16, XL, WS_XL) WSACC(bf16, H1, WS_H1) WSACC(bf16, P, WS_P) WSACC(bf16, Vt, WS_VT) WSACC(bf16, MIX, WS_MIX)
    WSACC(float, HD, WS_HD) WSACC(float, OHG, WS_OHG) WSACC(float, GA, WS_GA) WSACC(float, GB, WS_GB) WSACC(float, AGG, WS_AGG)
    WSACC(int, list_tok, WS_LIST) WSACC(int, list_dst, WS_LIST + (size_t)NE * CAP * 4) WSACC(float, list_gate, WS_LIST + (size_t)NE * CAP * 8)
    WSACC(bf16, HMOE, WS_HMOE) WSACC(bf16, Y2, WS_Y2)
    __device__ __forceinline__ bf16* ws_bf16(size_t off) const { return (bf16*)(ws + off); }
    __device__ __forceinline__ const float* inp(int i) const { return (const float*)(const GAS float*)in[i]; }
    __device__ __forceinline__ float* outp() const { return (float*)(GAS float*)out; }
#undef WSACC
};
__device__ __forceinline__ Ctx fresh(const Ctx& F0) {
    Ctx F = F0; int wv = F0.wave, g = F0.G, bi = F0.bid; asm volatile("" : "+s"(wv), "+s"(g), "+s"(bi));
    int ln; asm volatile("v_mbcnt_lo_u32_b32 %0, -1, 0\n\tv_mbcnt_hi_u32_b32 %0, -1, %0" : "=v"(ln));
    F.wave = wv; F.lane = ln; F.tid = wv * 64 + ln; F.G = g; F.bid = bi;
    unsigned long long w = (unsigned long long)F0.ws;
    asm volatile("" : "+s"(w)); F.ws = (unsigned char*)(GAS unsigned char*)w;
    return F;
}
enum { I_X = 0, I_C, I_CTX, I_CCTX, I_ADAW, I_ADAB, I_N1G, I_WIN, I_SINK, I_CONVW, I_CONVB, I_WR, I_BR, I_WI, I_BI, I_LAM, I_LBL, I_HNG, I_WOUT, I_N2G, I_RW, I_RB, I_WGU, I_BGU, I_WD, I_BD, I_FG };

__device__ __forceinline__ int row_b(int m) { return m < ML ? m / SEQ : (m - ML) / CTXL; }
__device__ __forceinline__ int row_t(int m) { return m < ML ? m % SEQ : (m - ML) % CTXL; }
__device__ __forceinline__ int mod_row(int m) { return m < ML ? m / SEQ : 2; }

__device__ __forceinline__ int dest_win(int n) {
    if (n >= C_V) return n;
    const int d = n & 63, p = d >> 5, half = (d >> 4) & 1, f = d & 15;
    return (n & ~63) + 2 * (p * 16 + f) + half;
}
__device__ __forceinline__ int dest_gu(int n) {
    const int up = n >= FF ? 1 : 0, ff = n & (FF - 1);
    return (ff >> 7) * 256 + up * 128 + (ff & 127);
}
template <int MAP>
__device__ __forceinline__ void tr_item(const float* W, int K, int N, bf16* WT, LAS float* scr, int item, int lane) {
    const int nblk = N / 32, kb = item / nblk, nb = item % nblk, k0 = 64 * kb, n0 = 32 * nb;
#pragma unroll 8
    for (int i = 0; i < 32; ++i) { const int kk = 2 * i + (lane >> 5); scr[kk * 33 + (lane & 31)] = W[(size_t)(k0 + kk) * N + n0 + (lane & 31)]; }
    asm volatile("s_waitcnt lgkmcnt(0)" ::: "memory");
    const int c = lane & 7;
#pragma unroll
    for (int j = 0; j < 4; ++j) {
        const int n = (lane >> 3) + 8 * j; const LAS float* s = scr + (8 * c) * 33 + n;
        u32x4 o; o.x = pk2(s[0 * 33], s[1 * 33]); o.y = pk2(s[2 * 33], s[3 * 33]); o.z = pk2(s[4 * 33], s[5 * 33]); o.w = pk2(s[6 * 33], s[7 * 33]);
        const int nn = n0 + n; const int dr = MAP == 1 ? dest_win(nn) : (MAP == 2 ? dest_gu(nn) : nn);
        *(u32x4*)(WT + (size_t)dr * K + k0 + 8 * c) = o;
    }
    asm volatile("s_waitcnt lgkmcnt(0)" ::: "memory");
}
template <int MAP>
__device__ __forceinline__ void tr_item8(const float* W, int K, int N, unsigned char* WT, LAS float* scr, int item, int lane) {
    const int nblk = N / 32, kb = item / nblk, nb = item % nblk, k0 = 64 * kb, n0 = 32 * nb;
#pragma unroll 8
    for (int i = 0; i < 32; ++i) { const int kk = 2 * i + (lane >> 5); scr[kk * 33 + (lane & 31)] = W[(size_t)(k0 + kk) * N + n0 + (lane & 31)]; }
    asm volatile("s_waitcnt lgkmcnt(0)" ::: "memory");
    const int c = lane & 7;
#pragma unroll
    for (int j = 0; j < 4; ++j) {
        const int n = (lane >> 3) + 8 * j; const LAS float* s = scr + (8 * c) * 33 + n;
        u32x2 o; o.x = pk_fp8x4(s[0 * 33] * W8_SCALE, s[1 * 33] * W8_SCALE, s[2 * 33] * W8_SCALE, s[3 * 33] * W8_SCALE); o.y = pk_fp8x4(s[4 * 33] * W8_SCALE, s[5 * 33] * W8_SCALE, s[6 * 33] * W8_SCALE, s[7 * 33] * W8_SCALE);
        const int nn = n0 + n; const int dr = MAP == 2 ? dest_gu(nn) : nn;
        *(u32x2*)(WT + (size_t)dr * K + k0 + 8 * c) = o;
    }
    asm volatile("s_waitcnt lgkmcnt(0)" ::: "memory");
}
__device__ __forceinline__ void tr_load(const float* W, int N, int item, int lane, float (&r)[32]) {
    const int nblk = N / 32, kb = item / nblk, nb = item % nblk, k0 = 64 * kb, n0 = 32 * nb;
    const float* p = W + (size_t)(k0 + (lane >> 5)) * N + n0 + (lane & 31);
#pragma unroll
    for (int i = 0; i < 32; ++i) r[i] = p[(size_t)(2 * i) * N];
}
template <int MAP>
__device__ __forceinline__ void tr_finish(int K, int N, bf16* WT, LAS float* scr, int item, int lane, const float (&r)[32]) {
    const int nblk = N / 32, kb = item / nblk, nb = item % nblk, k0 = 64 * kb, n0 = 32 * nb;
#pragma unroll
    for (int i = 0; i < 32; ++i) scr[(2 * i + (lane >> 5)) * 33 + (lane & 31)] = r[i];
    asm volatile("s_waitcnt lgkmcnt(0)" ::: "memory");
    const int c = lane & 7;
#pragma unroll
    for (int j = 0; j < 4; ++j) {
        const int n = (lane >> 3) + 8 * j; const LAS float* s = scr + (8 * c) * 33 + n;
        u32x4 o; o.x = pk2(s[0 * 33], s[1 * 33]); o.y = pk2(s[2 * 33], s[3 * 33]); o.z = pk2(s[4 * 33], s[5 * 33]); o.w = pk2(s[6 * 33], s[7 * 33]);
        const int nn = n0 + n; const int dr = MAP == 1 ? dest_win(nn) : (MAP == 2 ? dest_gu(nn) : nn);
        *(u32x4*)(WT + (size_t)dr * K + k0 + 8 * c) = o;
    }
    asm volatile("s_waitcnt lgkmcnt(0)" ::: "memory");
}
__device__ __forceinline__ void ph_prologue(Ctx& F) {
    LAS float* scr = (LAS float*)(F.lds + F.wave * 8704);
    const int gw = F.bid * NWAVES + F.wave, NGW = F.G * NWAVES;
    constexpr int I_IN = 16 * 80, I_OUT = 16 * 32;
    constexpr int N_IN = NL * I_IN, N_OUT = NL * I_OUT;
    for (int it = gw; it < N_IN + N_OUT; it += NGW) {
        int r = it;
        if (r < N_IN) { const int l = r / I_IN; tr_item<1>(F.inp(I_WIN) + (size_t)l * D * INW, D, INW, F.WinT() + (size_t)l * INW * D, scr, r % I_IN, F.lane); continue; } r -= N_IN;
        { const int l = r / I_OUT; tr_item<0>(F.inp(I_WOUT) + (size_t)l * D * D, D, D, F.WoutT() + (size_t)l * D * D, scr, r % I_OUT, F.lane); }
    }
    const int gt = F.bid * NTHR + F.tid, NGT = F.G * NTHR;
    for (int i = gt; i < NL * 2 * 2 * 4 * 4096; i += NGT) {
        const int c = i & 63, dd = (i >> 6) & 63, n = (i >> 12) & 3, g = (i >> 14) & 1, d = (i >> 15) & 1, l = i >> 16;
        const float* src = g ? F.inp(I_WI) : F.inp(I_WR);
        F.lruw()[i] = (bf16)f2bf(src[((((size_t)l * 2 + d) * 4 + n) * 64 + c) * 64 + dd]);
    }
    for (int i = gt; i < 256 * 16; i += NGT) {
        const int pos = i >> 4, f = i & 15;
        const float invf[16] = {1.000000000e+00f, 5.623413324e-01f, 3.162277639e-01f, 1.778279394e-01f, 1.000000015e-01f, 5.623413250e-02f, 3.162277490e-02f, 1.778279431e-02f,
                                9.999999776e-03f, 5.623413250e-03f, 3.162277630e-03f, 1.778279431e-03f, 1.000000047e-03f, 5.623413017e-04f, 3.162277571e-04f, 1.778279402e-04f};
        float fr = 1.0f;
#pragma unroll
        for (int q = 0; q < 16; ++q) fr = (f == q) ? invf[q] : fr;
        const float ang = (float)pos * fr;
        double rev = (double)ang * 0.15915494309189535; rev -= floor(rev);
        F.rope()[i] = (f32x2){__builtin_amdgcn_cosf((float)rev), __builtin_amdgcn_sinf((float)rev)};
    }
    LAS float* cond = (LAS float*)(F.lds + 72 * 1024);
    LAS float* red = (LAS float*)(F.lds + 88 * 1024);
    __syncthreads();
    for (int i = F.tid; i < 3 * D; i += NTHR) { const int r = i / D, k = i % D; const float v = r < 2 ? F.inp(I_C)[r * D + k] : F.inp(I_CCTX)[k]; cond[i] = siluf_(v); }
    __syncthreads();
    for (int unit = F.bid; unit < NL * 192; unit += F.G) {
        const int l = unit / 192, col0 = (unit % 192) * 32, cl = F.tid & 31, ks = F.tid >> 5;
        const float* W = F.inp(I_ADAW) + (size_t)l * D * 6 * D + col0 + cl;
        float a0 = 0.f, a1 = 0.f, a2 = 0.f;
#pragma unroll 8
        for (int k = ks * 64; k < ks * 64 + 64; ++k) { const float w = W[(size_t)k * 6 * D]; a0 += cond[k] * w; a1 += cond[D + k] * w; a2 += cond[2 * D + k] * w; }
        red[(ks * 3 + 0) * 32 + cl] = a0; red[(ks * 3 + 1) * 32 + cl] = a1; red[(ks * 3 + 2) * 32 + cl] = a2;
        __syncthreads();
        if (F.tid < 96) { const int i = F.tid >> 5; float s = F.inp(I_ADAB)[l * 6 * D + col0 + cl];
            for (int q = 0; q < 16; ++q) s += red[(q * 3 + i) * 32 + cl];
            F.mods()[((size_t)l * 3 + i) * 6 * D + col0 + cl] = s; }
        __syncthreads();
    }
}

__device__ __forceinline__ void ph_norm1(Ctx& F, int l) {
    const int gw = F.bid * NWAVES + F.wave, NGW = F.G * NWAVES;
    const int M = (l == 2) ? ML : MA;
    for (int m = gw; m < M; m += NGW) {
        const int mr = mod_row(m);
        f32x4 v[4];
        if (l == 0) { const float* src = m < ML ? F.inp(I_X) + (size_t)m * D : F.inp(I_CTX) + (size_t)(m - ML) * D;
#pragma unroll
            for (int j = 0; j < 4; ++j) v[j] = *(const f32x4*)(src + 4 * F.lane + 256 * j); }
        else {
#pragma unroll
            for (int j = 0; j < 4; ++j) { const u32x2 w = *(const u32x2*)(F.XL() + (size_t)m * D + 4 * F.lane + 256 * j);
                v[j] = (f32x4){__uint_as_float(w.x << 16), __uint_as_float(w.x & 0xffff0000u), __uint_as_float(w.y << 16), __uint_as_float(w.y & 0xffff0000u)}; } }
        if (l > 0) {
            const float* g5 = F.mods() + ((size_t)(l - 1) * 3 + mr) * 6 * D + 5 * D;
#pragma unroll
            for (int j = 0; j < 4; ++j) {
                const int col = 4 * F.lane + 256 * j; f32x4 s = {0.f, 0.f, 0.f, 0.f};
#pragma unroll
                for (int q = 0; q < 4; ++q) {
                    if (Y2_FP8 && MOE_FP8) { const unsigned w = *(const unsigned*)((const unsigned char*)F.Y2() + ((size_t)m * 4 + q) * D + col);
                        const f32x2 lo = __builtin_amdgcn_cvt_pk_f32_fp8((int)w, false), hi = __builtin_amdgcn_cvt_pk_f32_fp8((int)w, true);
                        s.x += lo.x; s.y += lo.y; s.z += hi.x; s.w += hi.y; }
                    else { const u32x2 w = *(const u32x2*)(F.Y2() + ((size_t)m * 4 + q) * D + col);
                        s.x += __uint_as_float(w.x << 16); s.y += __uint_as_float(w.x & 0xffff0000u); s.z += __uint_as_float(w.y << 16); s.w += __uint_as_float(w.y & 0xffff0000u); } }
                const f32x4 g = *(const f32x4*)(g5 + col) * ((Y2_FP8 && MOE_FP8) ? (1.0f / Y2_SCALE) : 1.0f);
                v[j] += g * s;
            }
        }
        if (l == 1) {
#pragma unroll
            for (int j = 0; j < 4; ++j) { u32x2 w; w.x = pk2(v[j].x, v[j].y); w.y = pk2(v[j].z, v[j].w); *(u32x2*)(F.XL() + (size_t)m * D + 4 * F.lane + 256 * j) = w; }
        }
        float ss = 0.f;
#pragma unroll
        for (int j = 0; j < 4; ++j) ss += (v[j].x * v[j].x + v[j].y * v[j].y) + (v[j].z * v[j].z + v[j].w * v[j].w);
        const float rstd = 1.0f / sqrtf(wave_sum(ss, F.lane) * (1.0f / D) + EPS);
        if (l == 2) {
#pragma unroll
            for (int j = 0; j < 4; ++j) { const int col = 4 * F.lane + 256 * j; const f32x4 g = *(const f32x4*)(F.inp(I_FG) + col); *(f32x4*)(F.outp() + (size_t)m * D + col) = v[j] * rstd * g; }
        } else {
            const float* mo = F.mods() + ((size_t)l * 3 + mr) * 6 * D;
            const float* g1 = F.inp(I_N1G) + l * D;
#pragma unroll
            for (int j = 0; j < 4; ++j) { const int col = 4 * F.lane + 256 * j;
                const f32x4 g = *(const f32x4*)(g1 + col), sh = *(const f32x4*)(mo + col), sc = *(const f32x4*)(mo + D + col);
                const f32x4 h = v[j] * rstd * g * (sc + 1.0f) + sh;
                u32x2 w; w.x = pk2(h.x, h.y); w.y = pk2(h.z, h.w);
                *(u32x2*)(F.H1() + (size_t)m * D + col) = w; }
        }
    }
}

__device__ __forceinline__ void sg_kloop(f32x16 (&acc)[2][2], const bf16* a0, const bf16* a1, const bf16* b0, const bf16* b1, int K) {
#pragma unroll
    for (int i = 0; i < 2; ++i)
#pragma unroll
        for (int j = 0; j < 2; ++j)
#pragma unroll
            for (int r = 0; r < 16; ++r) acc[i][j][r] = 0.f;
#pragma unroll 4
    for (int k = 0; k < K; k += 16) {
        const bf16x8 fa0 = *(const bf16x8*)(a0 + k), fa1 = *(const bf16x8*)(a1 + k), fb0 = *(const bf16x8*)(b0 + k), fb1 = *(const bf16x8*)(b1 + k);
        acc[0][0] = __builtin_amdgcn_mfma_f32_32x32x16_bf16(fa0, fb0, acc[0][0], 0, 0, 0);
        acc[0][1] = __builtin_amdgcn_mfma_f32_32x32x16_bf16(fa0, fb1, acc[0][1], 0, 0, 0);
        acc[1][0] = __builtin_amdgcn_mfma_f32_32x32x16_bf16(fa1, fb0, acc[1][0], 0, 0, 0);
        acc[1][1] = __builtin_amdgcn_mfma_f32_32x32x16_bf16(fa1, fb1, acc[1][1], 0, 0, 0);
    }
}

__device__ __forceinline__ float inproj_fix(const Ctx& F, int m, int c, float v, float partner) {
    float o = v;
    if (c < C_V) {
        if (m < ML) {
            const int t = m % SEQ, dp = c & 63, pr = dp >> 1, p = pr >> 4, f = pr & 15, pos = p ? (t & 63) : (t >> 6);
            const f32x2 cs = F.rope()[pos * 16 + f];
            o = (dp & 1) ? (partner * cs.y + v * cs.x) : (v * cs.x - partner * cs.y);
        }
        if (c < C_K) o *= QSCALE;
    }
    return o;
}
__device__ __forceinline__ size_t vt_index(int m, int cv  ) {
    const int kvh = cv >> 6, d = cv & 63;
    if (m < ML) { const int b = m / SEQ, t = m % SEQ; return ((size_t)((b * 2 + kvh) * 64 + d)) * SEQ + t; }
    const int b = (m - ML) / CTXL, t = (m - ML) % CTXL; return VT_CTX_OFF + ((size_t)((b * 2 + kvh) * 64 + d)) * CTXL + t;
}
__device__ __forceinline__ void ph_inproj_naive(Ctx& F, int l) {
    const int gw = F.bid * NWAVES + F.wave, NGW = F.G * NWAVES, r = F.lane & 31, h = F.lane >> 5;
    const bf16* Bt = F.WinT() + (size_t)l * INW * D;
    for (int ti = gw; ti < (MA / 64) * (INW / 64); ti += NGW) {
        const int rt = ti / (INW / 64), ct = ti % (INW / 64), m0 = rt * 64, c0 = ct * 64;
        f32x16 acc[2][2];
        sg_kloop(acc, F.H1() + (size_t)(m0 + r) * D + 8 * h, F.H1() + (size_t)(m0 + 32 + r) * D + 8 * h, Bt + (size_t)(c0 + r) * D + 8 * h, Bt + (size_t)(c0 + 32 + r) * D + 8 * h, D);
#pragma unroll
        for (int mt = 0; mt < 2; ++mt)
#pragma unroll
            for (int nt = 0; nt < 2; ++nt)
#pragma unroll
                for (int q = 0; q < 16; ++q) {
                    const int m = m0 + 32 * mt + crow(q, h), c = c0 + 32 * nt + r;
                    const float v = acc[mt][nt][q], pa = shx(v, 1, F.lane);
                    const float o = inproj_fix(F, m, c, v, pa);
                    F.P()[(size_t)m * INW + c] = (bf16)f2bf(o);
                    if (c >= C_V && c < C_LX) F.Vt()[vt_index(m, c - C_V)] = (bf16)f2bf(o);
                }
    }
}

__device__ __forceinline__ float dot64(const float (&q)[64], const bf16* kp) {
    float s = 0.f;
#pragma unroll
    for (int i = 0; i < 8; ++i) { const u32x4 w = *(const u32x4*)(kp + 8 * i);
        s += q[8 * i + 0] * __uint_as_float(w.x << 16) + q[8 * i + 1] * __uint_as_float(w.x & 0xffff0000u) + q[8 * i + 2] * __uint_as_float(w.y << 16) + q[8 * i + 3] * __uint_as_float(w.y & 0xffff0000u)
           + q[8 * i + 4] * __uint_as_float(w.z << 16) + q[8 * i + 5] * __uint_as_float(w.z & 0xffff0000u) + q[8 * i + 6] * __uint_as_float(w.w << 16) + q[8 * i + 7] * __uint_as_float(w.w & 0xffff0000u); }
    return s;
}
__device__ __forceinline__ void ph_attn_naive(Ctx& F, int l) {
    const int gw = F.bid * NWAVES + F.wave, NGW = F.G * NWAVES;
    const int Mq = (l == 0) ? MA : ML;
    LAS float* pbuf = (LAS float*)(F.lds) + F.wave * 640;
    for (int u = gw; u < Mq * 8; u += NGW) {
        const int m = u >> 3, hq = u & 7, kvh = hq >> 2;
        const bool isc = m >= ML; const int b = row_b(m), t = row_t(m);
        float q[64];
        { const bf16* qp = F.P() + (size_t)m * INW + C_Q + hq * 64;
#pragma unroll
          for (int i = 0; i < 8; ++i) { const u32x4 w = *(const u32x4*)(qp + 8 * i);
              q[8 * i + 0] = __uint_as_float(w.x << 16); q[8 * i + 1] = __uint_as_float(w.x & 0xffff0000u); q[8 * i + 2] = __uint_as_float(w.y << 16); q[8 * i + 3] = __uint_as_float(w.y & 0xffff0000u);
              q[8 * i + 4] = __uint_as_float(w.z << 16); q[8 * i + 5] = __uint_as_float(w.z & 0xffff0000u); q[8 * i + 6] = __uint_as_float(w.w << 16); q[8 * i + 7] = __uint_as_float(w.w & 0xffff0000u); } }
        const int lo = isc ? 0 : (t - 128 < 0 ? 0 : t - 128), hi = isc ? -1 : (t + 128 > SEQ - 1 ? SEQ - 1 : t + 128);
        const int nloc = hi - lo + 1, nk = nloc + CTXL;
        const float sink2 = F.inp(I_SINK)[l * 8 + hq] * LOG2E;
        float s[9]; float mx = sink2;
#pragma unroll
        for (int i = 0; i < 9; ++i) { const int kk = F.lane + 64 * i; s[i] = -3.0e38f;
            if (kk < nk) { const int krow = kk < nloc ? b * SEQ + lo + kk : ML + b * CTXL + (kk - nloc);
                s[i] = dot64(q, F.P() + (size_t)krow * INW + C_K + kvh * 64); mx = fmaxf(mx, s[i]); } }
        mx = wave_max(mx, F.lane);
        float lsum = 0.f;
#pragma unroll
        for (int i = 0; i < 9; ++i) { const int kk = F.lane + 64 * i; const float p = (kk < nk) ? exp2f(s[i] - mx) : 0.f; lsum += p; pbuf[kk] = p; }
        lsum = wave_sum(lsum, F.lane) + exp2f(sink2 - mx);
        asm volatile("s_waitcnt lgkmcnt(0)" ::: "memory");
        float o = 0.f;
        for (int kk = 0; kk < nk; ++kk) { const int krow = kk < nloc ? b * SEQ + lo + kk : ML + b * CTXL + (kk - nloc);
            o += pbuf[kk] * bf2f(F.P()[(size_t)krow * INW + C_V + kvh * 64 + F.lane]); }
        F.MIX()[(size_t)m * D + hq * 64 + F.lane] = (bf16)f2bf(o / lsum);
        asm volatile("s_waitcnt lgkmcnt(0)" ::: "memory");
    }
}
__device__ __forceinline__ void ph_lru_gates_naive(Ctx& F, int l) {
    const size_t gt = (size_t)F.bid * NTHR + F.tid, NGT = (size_t)F.G * NTHR;
    for (size_t i = gt; i < (size_t)MA * 512; i += NGT) {
        const int m = (int)(i >> 9), d = (int)(i >> 8) & 1, c = (int)i & 255, n = c >> 6, cc0 = c & 63;
        const int t = row_t(m), T = m < ML ? SEQ : CTXL, rb = m - t;
        const float* wr = F.inp(I_WR) + (((size_t)l * 2 + d) * 4 + n) * 4096;
        const float* wi = F.inp(I_WI) + (((size_t)l * 2 + d) * 4 + n) * 4096;
        float rp = F.inp(I_BR)[(l * 2 + d) * 256 + c], ip = F.inp(I_BI)[(l * 2 + d) * 256 + c], us = 0.f;
        for (int cc = 0; cc < 64; ++cc) {
            const int ch = n * 64 + cc; float u = F.inp(I_CONVB)[l * 256 + ch];
#pragma unroll
            for (int j = 0; j < 4; ++j) { const int tt = t - 2 + j; if (tt >= 0 && tt < T) u += F.inp(I_CONVW)[(l * 4 + j) * 256 + ch] * bf2f(F.P()[(size_t)(rb + tt) * INW + C_LX + ch]); }
            rp += u * wr[cc * 64 + cc0]; ip += u * wi[cc * 64 + cc0];
            if (cc == cc0) us = u;
        }
        const float r = sigmoidf_(rp), ig = sigmoidf_(ip);
        const float lam = F.inp(I_LAM)[(l * 2 + d) * 256 + c];
        const float la = -8.0f * r * log1pf(expf(-lam));
        const float a = expf(la), mult = sqrtf(fmaxf(-expm1f(2.0f * la), 1e-12f));
        F.GA()[i] = a; F.GB()[i] = mult * ig * us;
    }
}
__device__ __forceinline__ void ph_lru_scan_naive(Ctx& F) {
    const int gt = F.bid * NTHR + F.tid;
    if (gt >= NB * 512) return;
    const int b = gt >> 9, d = (gt >> 8) & 1, c = gt & 255;
    float h = 0.f;
    for (int s = 0; s < CTXL + SEQ; ++s) {
        int m;
        if (s < CTXL) m = ML + b * CTXL + (d ? CTXL - 1 - s : s); else { const int t = s - CTXL; m = b * SEQ + (d ? SEQ - 1 - t : t); }
        const size_t i = (size_t)m * 512 + d * 256 + c;
        h = F.GA()[i] * h + F.GB()[i];
        F.HD()[i] = h;
    }
}
__device__ __forceinline__ void ph_lru_out_naive(Ctx& F, int l) {
    const size_t gt = (size_t)F.bid * NTHR + F.tid, NGT = (size_t)F.G * NTHR;
    const int Mq = (l == 0) ? MA : ML;
    for (size_t i = gt; i < (size_t)Mq * 256; i += NGT) {
        const int m = (int)(i >> 8), c = (int)i & 255;
        const float y = (F.HD()[(size_t)m * 512 + c] + F.HD()[(size_t)m * 512 + 256 + c]) * gelu_tanh(bf2f(F.P()[(size_t)m * INW + C_LG + c]));
        F.MIX()[(size_t)m * D + 512 + c] = (bf16)f2bf(y);
    }
}
__device__ __forceinline__ float hg_lb(const Ctx& F, int l, int d, int hk) {
    if (l == 0) return 0.f;
    const float l0 = F.inp(I_LBL)[(0 * 2 + d) * 256 + hk], l1 = F.inp(I_LBL)[(1 * 2 + d) * 256 + hk];
    return 1.0f / (1.0f + expf(l0 - l1));
}
__device__ __forceinline__ void ph_hgrn_scan_naive(Ctx& F, int l) {
    if (F.bid >= NB * 2 * 4) return;
    const int b = F.bid >> 3, d = (F.bid >> 2) & 1, hh = F.bid & 3;
    const int v = F.tid & 63, kq = F.tid >> 6;
    LAS float* part = (LAS float*)F.lds;
    float lb[8], S[8];
#pragma unroll
    for (int i = 0; i < 8; ++i) { lb[i] = hg_lb(F, l, d, hh * 64 + kq * 8 + i); S[i] = 0.f; }
    int buf = 0;
    for (int s = 0; s < CTXL + SEQ; ++s) {
        int m;
        if (s < CTXL) m = ML + b * CTXL + (d ? CTXL - 1 - s : s); else { const int t = s - CTXL; m = b * SEQ + (d ? SEQ - 1 - t : t); }
        const bf16* pr = F.P() + (size_t)m * INW;
        const u32x4 zw = *(const u32x4*)(pr + (d ? C_HB : C_HF) + hh * 64 + kq * 8), qw = *(const u32x4*)(pr + C_HQ + hh * 64 + kq * 8);
        const float vv = bf2f(pr[C_HV + hh * 64 + v]);
        float z[8], q[8];
        z[0] = __uint_as_float(zw.x << 16); z[1] = __uint_as_float(zw.x & 0xffff0000u); z[2] = __uint_as_float(zw.y << 16); z[3] = __uint_as_float(zw.y & 0xffff0000u);
        z[4] = __uint_as_float(zw.z << 16); z[5] = __uint_as_float(zw.z & 0xffff0000u); z[6] = __uint_as_float(zw.w << 16); z[7] = __uint_as_float(zw.w & 0xffff0000u);
        q[0] = __uint_as_float(qw.x << 16); q[1] = __uint_as_float(qw.x & 0xffff0000u); q[2] = __uint_as_float(qw.y << 16); q[3] = __uint_as_float(qw.y & 0xffff0000u);
        q[4] = __uint_as_float(qw.z << 16); q[5] = __uint_as_float(qw.z & 0xffff0000u); q[6] = __uint_as_float(qw.w << 16); q[7] = __uint_as_float(qw.w & 0xffff0000u);
        float pa = 0.f;
#pragma unroll
        for (int i = 0; i < 8; ++i) { const float sg = sigmoidf_(z[i]); const float f = lb[i] + (1.0f - lb[i]) * sg, kk = (1.0f - lb[i]) * (1.0f - sg);
            S[i] = f * S[i] + kk * vv; pa += S[i] * q[i]; }
        part[(buf * 8 + kq) * 64 + v] = pa;
        __syncthreads();
        if (kq == 0) { float o = 0.f;
#pragma unroll
            for (int i = 0; i < 8; ++i) o += part[(buf * 8 + i) * 64 + v];
            F.OHG()[(size_t)m * 512 + d * 256 + hh * 64 + v] = o; }
        buf ^= 1;
    }
}
__device__ __forceinline__ void ph_hgrn_out_naive(Ctx& F, int l) {
    const int gw = F.bid * NWAVES + F.wave, NGW = F.G * NWAVES;
    const int Mq = (l == 0) ? MA : ML;
    for (int m = gw; m < Mq; m += NGW) {
        const int col = 4 * F.lane;
        const f32x4 a = *(const f32x4*)(F.OHG() + (size_t)m * 512 + col), bb = *(const f32x4*)(F.OHG() + (size_t)m * 512 + 256 + col);
        const f32x4 o = a + bb;
        float ss = (o.x * o.x + o.y * o.y) + (o.z * o.z + o.w * o.w);
        ss += shx(ss, 1, F.lane); ss += shx(ss, 2, F.lane); ss += shx(ss, 4, F.lane); ss += shx(ss, 8, F.lane);
        const float rstd = 1.0f / sqrtf(ss * (1.0f / 64.0f) + EPS);
        const f32x4 g = *(const f32x4*)(F.inp(I_HNG) + l * 256 + col);
        const u32x2 ow = *(const u32x2*)(F.P() + (size_t)m * INW + C_HO + col);
        const float g0 = siluf_(__uint_as_float(ow.x << 16)), g1 = siluf_(__uint_as_float(ow.x & 0xffff0000u)), g2 = siluf_(__uint_as_float(ow.y << 16)), g3 = siluf_(__uint_as_float(ow.y & 0xffff0000u));
        u32x2 w; w.x = pk2(o.x * rstd * g.x * g0, o.y * rstd * g.y * g1); w.y = pk2(o.z * rstd * g.z * g2, o.w * rstd * g.w * g3);
        *(u32x2*)(F.MIX() + (size_t)m * D + 768 + col) = w;
    }
}

constexpr int MIX_NUB = 136, MIX_NU = 272;
constexpr int LRU_NU = MIX_NU;
struct MixUnit { int b, j, rowbase, t0, ntok, T, ub; bool isc; };
__device__ __forceinline__ MixUnit mix_unit(int g) {
    MixUnit m;
    if (g < 256) { m.b = g >> 7; m.j = g & 127; m.isc = false; m.rowbase = m.b * SEQ; m.t0 = m.j * 128; m.ntok = 128; m.T = SEQ; }
    else { const int c = g - 256; m.b = c >> 3; m.j = 128 + (c & 7); m.isc = true; m.rowbase = ML + m.b * CTXL; m.t0 = (c & 7) * 32; m.ntok = 32; m.T = CTXL; }
    m.ub = m.b * MIX_NUB + m.j; return m;
}
constexpr size_t AG_LRU_A = 0, AG_LRU_B = (size_t)LRU_NU * 512, AG_LRU_H = 2 * (size_t)LRU_NU * 512;
constexpr int U_PITCH = 528;
template <bool FULL, int DIR>
__device__ __forceinline__ void lru_wave(Ctx& F, int l, int u, int n, int rowbase, int t0, int nmt) {
    int ln_ = F.lane; asm volatile("" : "+v"(ln_));
    const int r32 = ln_ & 31, h = ln_ >> 5;
    LAS unsigned char* U = F.lds;
    const bf16* wb = F.lruw() + ((((size_t)l * 2 + DIR) * 2) * 4 + n) * 4096;
    float br[2], bi[2], c8[2], hc[2], At[2], Bt[2];
#pragma unroll
    for (int ct = 0; ct < 2; ++ct) { const int c = 64 * n + 32 * ct + r32, ix = (l * 2 + DIR) * 256 + c;
        br[ct] = FULL ? 0.f : F.inp(I_BR)[ix]; bi[ct] = FULL ? 0.f : F.inp(I_BI)[ix]; c8[ct] = FULL ? 0.f : 8.0f * log1pf(expf(-F.inp(I_LAM)[ix]));
        hc[ct] = FULL ? F.AGG()[AG_LRU_H + (size_t)u * 512 + DIR * 256 + c] : 0.f; At[ct] = 1.f; Bt[ct] = 0.f; }
#pragma unroll
    for (int ct = 0; ct < 2; ++ct) {
        const int c = 64 * n + 32 * ct + r32;
        bf16x8 Bg[2][4];
        if (!FULL) {
#pragma unroll
            for (int g = 0; g < 2; ++g) { const bf16* p = wb + (size_t)g * 4 * 4096 + (32 * ct + r32) * 64 + 8 * h;
#pragma unroll
                for (int ks = 0; ks < 4; ++ks) Bg[g][ks] = *(const bf16x8*)(p + 16 * ks); } }
#pragma unroll 1
        for (int mi = 0; mi < nmt; ++mi) {
            const int mt = DIR ? nmt - 1 - mi : mi;
            float a[16], bb[16];
            const size_t gix0 = (size_t)(rowbase + t0 + 32 * mt + 4 * h) * 512 + DIR * 256 + c;
            if (FULL) {
#pragma unroll
                for (int q = 0; q < 16; ++q) { const size_t ix = gix0 + (size_t)((q & 3) + 8 * (q >> 2)) * 512; a[q] = F.GA()[ix]; bb[q] = F.GB()[ix]; }
            } else {
                f32x16 acc[2];
#pragma unroll
                for (int g = 0; g < 2; ++g)
#pragma unroll
                    for (int q = 0; q < 16; ++q) acc[g][q] = 0.f;
#pragma unroll
                for (int ks = 0; ks < 4; ++ks) { const bf16x8 af = *(const LAS bf16x8*)(U + (32 * mt + r32) * U_PITCH + (64 * n + 16 * ks + 8 * h) * 2);
                    acc[0] = __builtin_amdgcn_mfma_f32_32x32x16_bf16(af, Bg[0][ks], acc[0], 0, 0, 0); acc[1] = __builtin_amdgcn_mfma_f32_32x32x16_bf16(af, Bg[1][ks], acc[1], 0, 0, 0); }
#pragma unroll
                for (int q = 0; q < 16; ++q) { const int t = 32 * mt + crow(q, h);
                    const float uu = bf2f(*(const LAS bf16*)(U + t * U_PITCH + c * 2));
                    const float r = sigmoidf_(acc[0][q] + br[ct]), ig = sigmoidf_(acc[1][q] + bi[ct]);
                    a[q] = __expf(-c8[ct] * r); bb[q] = __builtin_amdgcn_sqrtf(fmaxf(1.0f - a[q] * a[q], 1e-12f)) * ig * uu;
                    const size_t ix = gix0 + (size_t)((q & 3) + 8 * (q >> 2)) * 512; F.GA()[ix] = a[q]; F.GB()[ix] = bb[q]; }
            }
            float gA[4], gB[4], oA[4], oB[4];
#pragma unroll
            for (int g = 0; g < 4; ++g) { float A = 1.f, B = 0.f;
#pragma unroll
                for (int jj = 0; jj < 4; ++jj) { const int q = 4 * g + (DIR ? 3 - jj : jj); B = a[q] * B + bb[q]; A *= a[q]; }
                gA[g] = A; gB[g] = B; }
#pragma unroll
            for (int g = 0; g < 4; ++g) { oA[g] = shx(gA[g], 32, ln_); oB[g] = shx(gB[g], 32, ln_); }
            float st[4] = {0.f, 0.f, 0.f, 0.f}; float hs = hc[ct];
#pragma unroll
            for (int kk = 0; kk < 8; ++kk) { const int k = DIR ? 7 - kk : kk, g = k >> 1; const bool mine = ((k & 1) == h);
                const float Ak = mine ? gA[g] : oA[g], Bk = mine ? gB[g] : oB[g];
                if (FULL) { st[g] = mine ? hs : st[g]; hs = Ak * hs + Bk; }
                else { Bt[ct] = Ak * Bt[ct] + Bk; At[ct] *= Ak; } }
            if (FULL) {
                hc[ct] = hs;
#pragma unroll
                for (int g = 0; g < 4; ++g) { float hh = st[g];
#pragma unroll
                    for (int jj = 0; jj < 4; ++jj) { const int q = 4 * g + (DIR ? 3 - jj : jj); hh = a[q] * hh + bb[q];
                        F.HD()[(size_t)(rowbase + t0 + 32 * mt + crow(q, h)) * 512 + DIR * 256 + c] = hh; } }
            }
        }
        __builtin_amdgcn_sched_barrier(0);
    }
    if (!FULL && h == 0) {
#pragma unroll
        for (int ct = 0; ct < 2; ++ct) { const int c = 64 * n + 32 * ct + r32;
            F.AGG()[AG_LRU_A + (size_t)u * 512 + DIR * 256 + c] = At[ct]; F.AGG()[AG_LRU_B + (size_t)u * 512 + DIR * 256 + c] = Bt[ct]; }
    }
}
template <bool FULL>
__device__ __forceinline__ void ph_lru_fast(Ctx& F, int l) {
    LAS unsigned char* U = F.lds;
    for (int it = 0; it < 2; ++it) {
        const int u = it == 0 ? F.bid : 256 + (F.bid - 16);
        if (it == 0 ? (u >= 256) : (F.bid < 16 || F.bid >= 32 || F.G < 256)) continue;
        const MixUnit mu = mix_unit(u); const bool isc = mu.isc;
        if (FULL && isc && l == NL - 1) continue;
        const int rowbase = mu.rowbase, T = mu.T, t0 = mu.t0, ntok = mu.ntok;
        __syncthreads();
        if (!FULL) { const int c8 = (F.tid & 31) * 8, tr = F.tid >> 5;
          float w[4][8], cb[8];
#pragma unroll
          for (int jj = 0; jj < 4; ++jj) { const f32x4 w0 = *(const f32x4*)(F.inp(I_CONVW) + (l * 4 + jj) * 256 + c8), w1 = *(const f32x4*)(F.inp(I_CONVW) + (l * 4 + jj) * 256 + c8 + 4);
              w[jj][0] = w0.x; w[jj][1] = w0.y; w[jj][2] = w0.z; w[jj][3] = w0.w; w[jj][4] = w1.x; w[jj][5] = w1.y; w[jj][6] = w1.z; w[jj][7] = w1.w; }
          { const f32x4 b0 = *(const f32x4*)(F.inp(I_CONVB) + l * 256 + c8), b1 = *(const f32x4*)(F.inp(I_CONVB) + l * 256 + c8 + 4);
            cb[0] = b0.x; cb[1] = b0.y; cb[2] = b0.z; cb[3] = b0.w; cb[4] = b1.x; cb[5] = b1.y; cb[6] = b1.z; cb[7] = b1.w; }
#pragma unroll 4
          for (int i = 0; i < 8; ++i) { const int t = tr + 16 * i, tt = t0 + t;
              if (t >= ntok) break;
              float o[8];
#pragma unroll
              for (int e = 0; e < 8; ++e) o[e] = cb[e];
#pragma unroll
              for (int jj = 0; jj < 4; ++jj) { const int ts = tt - 2 + jj;
                  if (ts >= 0 && ts < T) { const u32x4 xw = *(const u32x4*)(F.P() + (size_t)(rowbase + ts) * INW + C_LX + c8);
                      o[0] += w[jj][0] * __uint_as_float(xw.x << 16); o[1] += w[jj][1] * __uint_as_float(xw.x & 0xffff0000u); o[2] += w[jj][2] * __uint_as_float(xw.y << 16); o[3] += w[jj][3] * __uint_as_float(xw.y & 0xffff0000u);
                      o[4] += w[jj][4] * __uint_as_float(xw.z << 16); o[5] += w[jj][5] * __uint_as_float(xw.z & 0xffff0000u); o[6] += w[jj][6] * __uint_as_float(xw.w << 16); o[7] += w[jj][7] * __uint_as_float(xw.w & 0xffff0000u); } }
              u32x4 ow; ow.x = pk2(o[0], o[1]); ow.y = pk2(o[2], o[3]); ow.z = pk2(o[4], o[5]); ow.w = pk2(o[6], o[7]);
              *(LAS u32x4*)(U + t * U_PITCH + c8 * 2) = ow; } }
        __syncthreads();
        { const int n = F.wave & 3;
          if (F.wave < 4) lru_wave<FULL, 0>(F, l, mu.ub, n, rowbase, t0, ntok >> 5); else lru_wave<FULL, 1>(F, l, mu.ub, n, rowbase, t0, ntok >> 5); }
        if (FULL) {
            __syncthreads();
#pragma unroll 4
            for (int i = F.tid; i < ntok * 64; i += NTHR) { const int t = i >> 6, c4 = (i & 63) * 4; const size_t row = (size_t)rowbase + t0 + t;
                const f32x4 hf = *(const f32x4*)(F.HD() + row * 512 + c4), hb = *(const f32x4*)(F.HD() + row * 512 + 256 + c4);
                const u32x2 gw = *(const u32x2*)(F.P() + row * INW + C_LG + c4);
                u32x2 w; w.x = pk2((hf.x + hb.x) * gelu_tanh(__uint_as_float(gw.x << 16)), (hf.y + hb.y) * gelu_tanh(__uint_as_float(gw.x & 0xffff0000u)));
                w.y = pk2((hf.z + hb.z) * gelu_tanh(__uint_as_float(gw.y << 16)), (hf.w + hb.w) * gelu_tanh(__uint_as_float(gw.y & 0xffff0000u)));
                *(u32x2*)(F.MIX() + row * D + 512 + c4) = w; }
        }
    }
}
__device__ __forceinline__ int mix_order(int d, int s) { return d ? 135 - s : (s < 8 ? 128 + s : s - 8); }
__device__ __forceinline__ void ph_lru_carry(Ctx& F) {
    const int gt = F.bid * NTHR + F.tid;
    if (gt >= NB * 512) return;
    const int b = gt >> 9, dc = gt & 511, d = dc >> 8;
    float h = 0.f;
#pragma unroll 1
    for (int s0 = 0; s0 < 136; s0 += 34) {
        float av[34], bv[34];
#pragma unroll
        for (int q = 0; q < 34; ++q) { const size_t ix = (size_t)(b * MIX_NUB + mix_order(d, s0 + q)) * 512 + dc; av[q] = F.AGG()[AG_LRU_A + ix]; bv[q] = F.AGG()[AG_LRU_B + ix]; }
#pragma unroll
        for (int q = 0; q < 34; ++q) { F.AGG()[AG_LRU_H + (size_t)(b * MIX_NUB + mix_order(d, s0 + q)) * 512 + dc] = h; h = av[q] * h + bv[q]; }
    }
}

constexpr int HG_NU = MIX_NU;
constexpr int HGW_LDS = 17152;
constexpr int KT_P = 36;
constexpr size_t AG_HG_D = 1048576, AG_HG_EBR = AG_HG_D + (size_t)HG_NU * 8 * 64;
__device__ __forceinline__ void hg_stage_v(const Ctx& F, LAS bf16* Vt, int rowbase, int c0, int hh, int r32, int h, int DIR) {
    const int t = c0 + (DIR ? 31 - r32 : r32); const bf16* vp = F.P() + (size_t)(rowbase + t) * INW + C_HV + hh * 64 + 32 * h;
#pragma unroll
    for (int c = 0; c < 4; ++c) { const u32x4 w = *(const u32x4*)(vp + 8 * c); const int v0 = 32 * h + 8 * c;
        Vt[(v0 + 0) * 32 + r32] = (bf16)(w.x & 0xffffu); Vt[(v0 + 1) * 32 + r32] = (bf16)(w.x >> 16); Vt[(v0 + 2) * 32 + r32] = (bf16)(w.y & 0xffffu); Vt[(v0 + 3) * 32 + r32] = (bf16)(w.y >> 16);
        Vt[(v0 + 4) * 32 + r32] = (bf16)(w.z & 0xffffu); Vt[(v0 + 5) * 32 + r32] = (bf16)(w.z >> 16); Vt[(v0 + 6) * 32 + r32] = (bf16)(w.w & 0xffffu); Vt[(v0 + 7) * 32 + r32] = (bf16)(w.w >> 16); }
}
__device__ __forceinline__ void hg_update_s(f32x16 (&S)[2][2], const LAS bf16* KiT, const LAS bf16* Vt, const LAS float* ebr, int r32, int h) {
#pragma unroll
    for (int kt = 0; kt < 2; ++kt) {
        float e1[16];
#pragma unroll
        for (int q = 0; q < 16; ++q) e1[q] = ebr[4 * h + (32 * kt + (q & 3) + 8 * (q >> 2))];
#pragma unroll
        for (int vt = 0; vt < 2; ++vt) { f32x16 tmp;
#pragma unroll
            for (int q = 0; q < 16; ++q) tmp[q] = 0.f;
#pragma unroll
            for (int ks = 0; ks < 2; ++ks) { const LAS bf16* kp = KiT + (32 * kt + r32) * KT_P + 16 * ks + 8 * h; const u32x2 klo = *(const LAS u32x2*)kp, khi = *(const LAS u32x2*)(kp + 4);
                u32x4 fau; fau.x = klo.x; fau.y = klo.y; fau.z = khi.x; fau.w = khi.y; const bf16x8 fa = __builtin_bit_cast(bf16x8, fau), fb = *(const LAS bf16x8*)(Vt + (32 * vt + r32) * 32 + 16 * ks + 8 * h);
                tmp = __builtin_amdgcn_mfma_f32_32x32x16_bf16(fa, fb, tmp, 0, 0, 0); }
#pragma unroll
            for (int q = 0; q < 16; ++q) S[kt][vt][q] = e1[q] * (e1[q] * S[kt][vt][q] + tmp[q]); }
    }
}
template <int DIR>
__device__ __forceinline__ void hg_wave_a(Ctx& F, int l, int u, int hh, int rowbase, int nch) {
    int ln_ = F.lane; asm volatile("" : "+v"(ln_));
    const int r32 = ln_ & 31, h = ln_ >> 5, k = ln_;
    LAS unsigned char* W = F.lds + F.wave * HGW_LDS;
    LAS bf16* Qi = (LAS bf16*)W; LAS bf16* Ki = (LAS bf16*)(W + 4096); LAS bf16* KiT = (LAS bf16*)(W + 8192); LAS bf16* Vt = (LAS bf16*)(W + 12800); LAS float* ebr = (LAS float*)(W + 16896);
    const int hd = DIR * 4 + hh;
    const float lb = hg_lb(F, l, DIR, hh * 64 + k);
    const unsigned lane_s = 4 * h * 64 + r32;
    f32x16 S[2][2];
#pragma unroll
    for (int kt = 0; kt < 2; ++kt)
#pragma unroll
        for (int vt = 0; vt < 2; ++vt)
#pragma unroll
            for (int q = 0; q < 16; ++q) S[kt][vt][q] = 0.f;
    float dsum = 0.f;
#pragma unroll 1
    for (int ci = 0; ci < nch; ++ci) {
        const int cph = DIR ? nch - 1 - ci : ci, c0 = 32 * cph;
        const int si = ln_ >> 1, sh = ln_ & 1; const int ts = c0 + (DIR ? 31 - si : si);
        { const bf16* zp = F.P() + (size_t)(rowbase + ts) * INW + (DIR ? C_HB : C_HF) + hh * 64 + 32 * sh;
          const bf16* qp = F.P() + (size_t)(rowbase + ts) * INW + C_HQ + hh * 64 + 32 * sh;
          u32x4 zz[4], qq[4];
#pragma unroll
          for (int c = 0; c < 4; ++c) { zz[c] = *(const u32x4*)(zp + 8 * c); qq[c] = *(const u32x4*)(qp + 8 * c); }
#pragma unroll
          for (int c = 0; c < 4; ++c) { *(LAS u32x4*)(Qi + si * 64 + 32 * sh + 8 * c) = zz[c]; *(LAS u32x4*)(Ki + si * 64 + 32 * sh + 8 * c) = qq[c]; } }
        hg_stage_v(F, Vt, rowbase, c0, hh, r32, h, DIR);
        asm volatile("s_waitcnt lgkmcnt(0)" ::: "memory");
        {
            float lf[32]; float run = 0.f;
#pragma unroll
            for (int i = 0; i < 32; ++i) { const float z = bf2f(Qi[i * 64 + k]); lf[i] = __logf(lb + (1.0f - lb) * sigmoidf_(z)); run += lf[i]; }
            const float bref = 0.5f * run; dsum += run;
            const float eb = __expf(bref);
            ebr[k] = eb; F.AGG()[AG_HG_EBR + (((size_t)u * 4 + cph) * 8 + hd) * 64 + k] = eb;
            float cum = 0.f;
#pragma unroll
            for (int i = 0; i < 32; ++i) {
                const float qq = bf2f(Ki[i * 64 + k]);
                cum += lf[i];
                const float e = __expf(cum - bref), ei = __expf(bref - cum);
                const unsigned kv = f2bf((1.0f - __expf(lf[i])) * ei);
                Ki[i * 64 + k] = (bf16)kv; KiT[k * KT_P + i] = (bf16)kv; Qi[i * 64 + k] = (bf16)f2bf(qq * e); }
        }
        asm volatile("s_waitcnt lgkmcnt(0)" ::: "memory");
        { bf16* qo = F.ws_bf16(WS_QI) + (size_t)(rowbase + ts) * 512 + DIR * 256 + hh * 64 + 32 * sh; bf16* ko = F.ws_bf16(WS_KI) + (size_t)(rowbase + ts) * 512 + DIR * 256 + hh * 64 + 32 * sh;
#pragma unroll
          for (int c = 0; c < 4; ++c) { *(u32x4*)(qo + 8 * c) = *(const LAS u32x4*)(Qi + si * 64 + 32 * sh + 8 * c); *(u32x4*)(ko + 8 * c) = *(const LAS u32x4*)(Ki + si * 64 + 32 * sh + 8 * c); } }
        hg_update_s(S, KiT, Vt, ebr, r32, h);
        asm volatile("s_waitcnt lgkmcnt(0)" ::: "memory");
    }
    float* sa = (float*)(F.ws + WS_SAGG) + ((size_t)u * 8 + hd) * 4096;
#pragma unroll
    for (int kt = 0; kt < 2; ++kt)
#pragma unroll
        for (int vt = 0; vt < 2; ++vt)
#pragma unroll
            for (int q = 0; q < 16; ++q) sa[lane_s + (unsigned)((32 * kt + (q & 3) + 8 * (q >> 2)) * 64 + 32 * vt)] = S[kt][vt][q];
    F.AGG()[AG_HG_D + ((size_t)u * 8 + hd) * 64 + k] = __expf(dsum);
}
template <int DIR>
__device__ __forceinline__ void hg_wave_c(Ctx& F, int l, int u, int hh, int rowbase, int nch) {
    int ln_ = F.lane; asm volatile("" : "+v"(ln_));
    const int r32 = ln_ & 31, h = ln_ >> 5, k = ln_;
    LAS unsigned char* W = F.lds + F.wave * HGW_LDS;
    LAS bf16* Qi = (LAS bf16*)W; LAS bf16* Ki = (LAS bf16*)(W + 4096); LAS bf16* KiT = (LAS bf16*)(W + 8192); LAS bf16* Vt = (LAS bf16*)(W + 12800); LAS float* ebr = (LAS float*)(W + 16896);
    const int hd = DIR * 4 + hh;
    const unsigned lane_s = 4 * h * 64 + r32;
    f32x16 S[2][2];
    { const float* sin = (const float*)(F.ws + WS_SIN) + ((size_t)u * 8 + hd) * 4096;
#pragma unroll
      for (int kt = 0; kt < 2; ++kt)
#pragma unroll
          for (int vt = 0; vt < 2; ++vt)
#pragma unroll
              for (int q = 0; q < 16; ++q) S[kt][vt][q] = sin[lane_s + (unsigned)((32 * kt + (q & 3) + 8 * (q >> 2)) * 64 + 32 * vt)]; }
#pragma unroll 1
    for (int ci = 0; ci < nch; ++ci) {
        const int cph = DIR ? nch - 1 - ci : ci, c0 = 32 * cph;
        { const int si = ln_ >> 1, sh = ln_ & 1; const int ts = c0 + (DIR ? 31 - si : si);
          const bf16* qo = F.ws_bf16(WS_QI) + (size_t)(rowbase + ts) * 512 + DIR * 256 + hh * 64 + 32 * sh; const bf16* ko = F.ws_bf16(WS_KI) + (size_t)(rowbase + ts) * 512 + DIR * 256 + hh * 64 + 32 * sh;
          u32x4 qq[4], kk[4];
#pragma unroll
          for (int c = 0; c < 4; ++c) { qq[c] = *(const u32x4*)(qo + 8 * c); kk[c] = *(const u32x4*)(ko + 8 * c); }
          ebr[k] = F.AGG()[AG_HG_EBR + (((size_t)u * 4 + cph) * 8 + hd) * 64 + k];
#pragma unroll
          for (int c = 0; c < 4; ++c) { *(LAS u32x4*)(Qi + si * 64 + 32 * sh + 8 * c) = qq[c]; *(LAS u32x4*)(Ki + si * 64 + 32 * sh + 8 * c) = kk[c];
              const int k0 = 32 * sh + 8 * c;
              KiT[(k0 + 0) * KT_P + si] = (bf16)(kk[c].x & 0xffffu); KiT[(k0 + 1) * KT_P + si] = (bf16)(kk[c].x >> 16); KiT[(k0 + 2) * KT_P + si] = (bf16)(kk[c].y & 0xffffu); KiT[(k0 + 3) * KT_P + si] = (bf16)(kk[c].y >> 16);
              KiT[(k0 + 4) * KT_P + si] = (bf16)(kk[c].z & 0xffffu); KiT[(k0 + 5) * KT_P + si] = (bf16)(kk[c].z >> 16); KiT[(k0 + 6) * KT_P + si] = (bf16)(kk[c].w & 0xffffu); KiT[(k0 + 7) * KT_P + si] = (bf16)(kk[c].w >> 16); } }
        hg_stage_v(F, Vt, rowbase, c0, hh, r32, h, DIR);
        asm volatile("s_waitcnt lgkmcnt(0)" ::: "memory");
        f32x16 att;
#pragma unroll
        for (int q = 0; q < 16; ++q) att[q] = 0.f;
#pragma unroll
        for (int ks = 0; ks < 4; ++ks) { const bf16x8 fa = *(const LAS bf16x8*)(Ki + r32 * 64 + 16 * ks + 8 * h), fb = *(const LAS bf16x8*)(Qi + r32 * 64 + 16 * ks + 8 * h);
            att = __builtin_amdgcn_mfma_f32_32x32x16_bf16(fa, fb, att, 0, 0, 0); }
#pragma unroll
        for (int q = 0; q < 16; ++q) att[q] = (crow(q, h) <= r32) ? att[q] : 0.f;
        f32x16 o[2];
#pragma unroll
        for (int vt = 0; vt < 2; ++vt)
#pragma unroll
            for (int q = 0; q < 16; ++q) o[vt][q] = 0.f;
#pragma unroll
        for (int ks = 0; ks < 2; ++ks) {
            u32x4 pa; pa.x = pk2(att[8 * ks + 0], att[8 * ks + 1]); pa.y = pk2(att[8 * ks + 2], att[8 * ks + 3]); pa.z = pk2(att[8 * ks + 4], att[8 * ks + 5]); pa.w = pk2(att[8 * ks + 6], att[8 * ks + 7]);
#pragma unroll
            for (int vt = 0; vt < 2; ++vt) { const LAS bf16* vp = Vt + (32 * vt + r32) * 32 + 16 * ks + 4 * h;
                const u32x2 lo = *(const LAS u32x2*)vp, hi2 = *(const LAS u32x2*)(vp + 8);
                u32x4 fb; fb.x = lo.x; fb.y = lo.y; fb.z = hi2.x; fb.w = hi2.y;
                o[vt] = __builtin_amdgcn_mfma_f32_32x32x16_bf16(__builtin_bit_cast(bf16x8, pa), __builtin_bit_cast(bf16x8, fb), o[vt], 0, 0, 0); } }
#pragma unroll
        for (int kt = 0; kt < 2; ++kt) {
            float e1[16];
#pragma unroll
            for (int q = 0; q < 16; ++q) e1[q] = ebr[4 * h + (32 * kt + (q & 3) + 8 * (q >> 2))];
#pragma unroll
            for (int ks = 0; ks < 2; ++ks) { const LAS bf16* qp = Qi + r32 * 64 + 32 * kt + 16 * ks + 4 * h;
                const u32x2 lo = *(const LAS u32x2*)qp, hi2 = *(const LAS u32x2*)(qp + 8);
                u32x4 fa; fa.x = lo.x; fa.y = lo.y; fa.z = hi2.x; fa.w = hi2.y;
#pragma unroll
                for (int vt = 0; vt < 2; ++vt) { u32x4 sb;
                    sb.x = pk2(S[kt][vt][8 * ks + 0] * e1[8 * ks + 0], S[kt][vt][8 * ks + 1] * e1[8 * ks + 1]); sb.y = pk2(S[kt][vt][8 * ks + 2] * e1[8 * ks + 2], S[kt][vt][8 * ks + 3] * e1[8 * ks + 3]);
                    sb.z = pk2(S[kt][vt][8 * ks + 4] * e1[8 * ks + 4], S[kt][vt][8 * ks + 5] * e1[8 * ks + 5]); sb.w = pk2(S[kt][vt][8 * ks + 6] * e1[8 * ks + 6], S[kt][vt][8 * ks + 7] * e1[8 * ks + 7]);
                    o[vt] = __builtin_amdgcn_mfma_f32_32x32x16_bf16(__builtin_bit_cast(bf16x8, fa), __builtin_bit_cast(bf16x8, sb), o[vt], 0, 0, 0); } }
        }
        { float* ob = F.OHG() + (size_t)(rowbase + c0) * 512 + DIR * 256 + hh * 64;
          const unsigned lane_o = (unsigned)((DIR ? 4 - 4 * h : 4 * h) * 512 + r32);
#pragma unroll
          for (int q = 0; q < 16; ++q) { const int iq = (q & 3) + 8 * (q >> 2); const unsigned cq = (unsigned)((DIR ? 27 - iq : iq) * 512);
              ob[lane_o + cq] = o[0][q]; ob[lane_o + cq + 32u] = o[1][q]; } }
        if (ci < nch - 1) hg_update_s(S, KiT, Vt, ebr, r32, h);
        asm volatile("s_waitcnt lgkmcnt(0)" ::: "memory");
    }
}
template <bool FULL>
__device__ __forceinline__ void ph_hgrn_fast(Ctx& F, int l) {
    for (int it = 0; it < 2; ++it) {
        const int u = it == 0 ? F.bid : 256 + (F.bid - 32);
        if (it == 0 ? (u >= 256) : (F.bid < 32 || F.bid >= 48 || F.G < 256)) continue;
        const MixUnit mu = mix_unit(u); const bool isc = mu.isc;
        if (FULL && isc && l == NL - 1) continue;
        const int rowbase = mu.rowbase + mu.t0, ntok = mu.ntok;
        __syncthreads();
        { const int hh = F.wave & 3;
          if (FULL) { if (F.wave < 4) hg_wave_c<0>(F, l, mu.ub, hh, rowbase, ntok >> 5); else hg_wave_c<1>(F, l, mu.ub, hh, rowbase, ntok >> 5); }
          else { if (F.wave < 4) hg_wave_a<0>(F, l, mu.ub, hh, rowbase, ntok >> 5); else hg_wave_a<1>(F, l, mu.ub, hh, rowbase, ntok >> 5); } }
        if (FULL) {
            __syncthreads();
#pragma unroll 4
            for (int rr = F.wave; rr < ntok; rr += NWAVES) { const size_t m = (size_t)rowbase + rr; const int col = 4 * F.lane;
                const f32x4 a = *(const f32x4*)(F.OHG() + m * 512 + col), bb = *(const f32x4*)(F.OHG() + m * 512 + 256 + col);
                const f32x4 o = a + bb;
                float ss = (o.x * o.x + o.y * o.y) + (o.z * o.z + o.w * o.w);
                ss += shx(ss, 1, F.lane); ss += shx(ss, 2, F.lane); ss += shx(ss, 4, F.lane); ss += shx(ss, 8, F.lane);
                const float rstd = 1.0f / sqrtf(ss * (1.0f / 64.0f) + EPS);
                const f32x4 g = *(const f32x4*)(F.inp(I_HNG) + l * 256 + col);
                const u32x2 ow = *(const u32x2*)(F.P() + m * INW + C_HO + col);
                const float g0 = siluf_(__uint_as_float(ow.x << 16)), g1 = siluf_(__uint_as_float(ow.x & 0xffff0000u)), g2 = siluf_(__uint_as_float(ow.y << 16)), g3 = siluf_(__uint_as_float(ow.y & 0xffff0000u));
                u32x2 w; w.x = pk2(o.x * rstd * g.x * g0, o.y * rstd * g.y * g1); w.y = pk2(o.z * rstd * g.z * g2, o.w * rstd * g.w * g3);
                *(u32x2*)(F.MIX() + m * D + 768 + col) = w; }
        }
    }
}
__device__ __forceinline__ void ph_hgrn_carry(Ctx& F) {
    const int gt = F.bid * NTHR + F.tid;
    if (gt >= 16 * 4096) return;
    const int seq = gt >> 12, e = gt & 4095, b = seq >> 3, hd = seq & 7, d = hd >> 2, kk = e >> 6;
    const float* SA = (const float*)(F.ws + WS_SAGG); float* SI = (float*)(F.ws + WS_SIN);
    float S = 0.f;
#pragma unroll 1
    for (int s0 = 0; s0 < 136; s0 += 34) {
        float dv[34], sv[34];
#pragma unroll
        for (int q = 0; q < 34; ++q) { const size_t ub = (size_t)(b * MIX_NUB + mix_order(d, s0 + q)) * 8 + hd; dv[q] = F.AGG()[AG_HG_D + ub * 64 + kk]; sv[q] = SA[ub * 4096 + e]; }
#pragma unroll
        for (int q = 0; q < 34; ++q) { const size_t ub = (size_t)(b * MIX_NUB + mix_order(d, s0 + q)) * 8 + hd; SI[ub * 4096 + e] = S; S = dv[q] * S + sv[q]; }
    }
}

constexpr int CV_GU = NE * 16 * 64, CV_DN = NE * 16 * 32, CV_ITEMS = CV_GU + CV_DN, CV_PER_WAVE = CV_ITEMS / 2048;
constexpr int PROG_OFF = 147456 - 256 + 24 * 4;
constexpr int AT_CVSCR = 2 * 2 * 64 * 144;
#ifndef ATTN_RIDE
#define ATTN_RIDE 0
#endif
constexpr int AT_KP = 144;
constexpr int AT_BUF = 2 * 64 * AT_KP;
__device__ __forceinline__ float max3f(float a, float b, float c) { float r; asm("v_max3_f32 %0, %1, %2, %3" : "=v"(r) : "v"(a), "v"(b), "v"(c)); return r; }
__device__ __forceinline__ void ph_attn_fast(Ctx& F, int l) {
    int ln_ = F.lane; asm volatile("" : "+v"(ln_));
    const int r32 = ln_ & 31, h = ln_ >> 5, g = F.wave >> 1, ph = F.wave & 1;
    const int lrow = F.tid >> 3, lch = F.tid & 7;
    const int NU = (l == 0) ? 1040 : 1024;
    for (int it = 0; it < 5; ++it) {
        const int u = it < 4 ? F.bid + 256 * it : 1024 + (F.bid - 240);
        if (it == 4 && (F.bid < 240 || NU <= 1024)) continue;
        const bool isc = u >= 1024;
        int b, kvh, jb;
        if (!isc) { b = u >> 9; kvh = (u >> 8) & 1; jb = u & 255; } else { const int v = u - 1024; b = v >> 3; kvh = (v >> 2) & 1; jb = v & 3; }
        const int q0 = jb * 64, qrowbase = isc ? ML + b * CTXL : b * SEQ, hq = kvh * 4 + g;
        int i_lo = 0, nloc = 0;
        if (!isc) { i_lo = q0 < 128 ? (128 - q0) >> 6 : 0; const int i_hi = (q0 + 192 <= SEQ) ? 4 : ((q0 + 128 <= SEQ) ? 3 : 2); nloc = i_hi - i_lo + 1; }
        const int NT = nloc + 4;
        bf16x8 qf[4];
        { const bf16* qp = F.P() + (size_t)(qrowbase + q0 + 32 * ph + r32) * INW + C_Q + hq * 64 + 8 * h;
#pragma unroll
          for (int ks = 0; ks < 4; ++ks) qf[ks] = *(const bf16x8*)(qp + 16 * ks); }
        float m_run = F.inp(I_SINK)[l * 8 + hq] * LOG2E, l_run = (h == 0) ? 1.0f : 0.0f;
        f32x16 ot[2];
#pragma unroll
        for (int dt = 0; dt < 2; ++dt)
#pragma unroll
            for (int q = 0; q < 16; ++q) ot[dt][q] = 0.f;
        u32x4 kreg, vreg;
#define AT_LOAD(ti) do { const int ti_ = (ti); const bool loc_ = ti_ < nloc; const int kst_ = loc_ ? q0 - 128 + 64 * (i_lo + ti_) : 64 * (ti_ - nloc); \
        const size_t krow_ = loc_ ? (size_t)b * SEQ + kst_ : (size_t)ML + b * CTXL + kst_; \
        kreg = *(const u32x4*)(F.P() + (krow_ + lrow) * INW + C_K + kvh * 64 + lch * 8); \
        const size_t vo_ = loc_ ? ((size_t)((b * 2 + kvh) * 64 + lrow)) * SEQ + kst_ : VT_CTX_OFF + ((size_t)((b * 2 + kvh) * 64 + lrow)) * CTXL + kst_; \
        vreg = *(const u32x4*)(F.Vt() + vo_ + lch * 8); } while (0)
#define AT_STORE(slot) do { LAS unsigned char* d_ = F.lds + (slot) * AT_BUF + lrow * AT_KP + lch * 16; *(LAS u32x4*)d_ = kreg; *(LAS u32x4*)(d_ + 64 * AT_KP) = vreg; } while (0)
#define AT_QK(P0, P1, slot) do { const LAS unsigned char* Kb_ = F.lds + (slot) * AT_BUF; \
        _Pragma("unroll") for (int q = 0; q < 16; ++q) { P0[q] = 0.f; P1[q] = 0.f; } \
        _Pragma("unroll") for (int ks = 0; ks < 4; ++ks) { \
            const bf16x8 a0 = *(const LAS bf16x8*)(Kb_ + r32 * AT_KP + (16 * ks + 8 * h) * 2), a1 = *(const LAS bf16x8*)(Kb_ + (32 + r32) * AT_KP + (16 * ks + 8 * h) * 2); \
            P0 = __builtin_amdgcn_mfma_f32_32x32x16_bf16(a0, qf[ks], P0, 0, 0, 0); P1 = __builtin_amdgcn_mfma_f32_32x32x16_bf16(a1, qf[ks], P1, 0, 0, 0); } } while (0)
        __syncthreads();
        AT_LOAD(0); AT_STORE(0); AT_LOAD(1); AT_STORE(1);
        __syncthreads();
        f32x16 p0, p1;
        AT_QK(p0, p1, 0);
        int sc_ = 0, sn_ = 1, sw_ = 2;
#pragma unroll 1
        for (int ti = 0; ti < NT; ++ti) {
            if (ti + 2 < NT) AT_LOAD(ti + 2);
            f32x16 n0, n1;
            if (ti + 1 < NT) AT_QK(n0, n1, sn_);
            else {
#pragma unroll
                for (int q = 0; q < 16; ++q) { n0[q] = 0.f; n1[q] = 0.f; } }
            const LAS unsigned char* Vb = F.lds + sc_ * AT_BUF + 64 * AT_KP;
            const int itile = (ti < nloc) ? i_lo + ti : 2;
            if (itile == 0 || itile == 4) {
                int dq = 32 * ph + r32 - 4 * h; asm volatile("" : "+v"(dq));
                if (itile == 0) {
#pragma unroll
                    for (int q = 0; q < 16; ++q) { const int cq = (q & 3) + 8 * (q >> 2); p0[q] = (cq >= dq) ? p0[q] : -1.0e30f; p1[q] = (cq + 32 >= dq) ? p1[q] : -1.0e30f; }
                } else {
#pragma unroll
                    for (int q = 0; q < 16; ++q) { const int cq = (q & 3) + 8 * (q >> 2); p0[q] = (cq <= dq) ? p0[q] : -1.0e30f; p1[q] = (cq + 32 <= dq) ? p1[q] : -1.0e30f; }
                }
            }
            float tm = max3f(p0[0], p1[0], p0[1]), tm2 = max3f(p1[1], p0[2], p1[2]);
#pragma unroll
            for (int q = 3; q < 15; q += 2) { tm = max3f(tm, p0[q], p1[q]); tm2 = max3f(tm2, p0[q + 1], p1[q + 1]); }
            tm = max3f(tm, tm2, p0[15]); tm = fmaxf(tm, p1[15]);
            tm = fmaxf(tm, shx(tm, 32, ln_));
            const float mn = fmaxf(m_run, tm);
            if (__builtin_amdgcn_ballot_w64(mn != m_run) != 0ull) {
                const float sc = __builtin_amdgcn_exp2f(m_run - mn);
                l_run *= sc;
#pragma unroll
                for (int dt = 0; dt < 2; ++dt)
#pragma unroll
                    for (int q = 0; q < 16; ++q) ot[dt][q] *= sc;
            }
            m_run = mn;
            float ls = 0.f;
#pragma unroll
            for (int q = 0; q < 16; ++q) { p0[q] = __builtin_amdgcn_exp2f(p0[q] - mn); p1[q] = __builtin_amdgcn_exp2f(p1[q] - mn); ls += p0[q] + p1[q]; }
            l_run += ls;
#pragma unroll
            for (int hk = 0; hk < 2; ++hk)
#pragma unroll
                for (int s = 0; s < 2; ++s) {
                    u32x4 pb;
                    if (hk == 0) { pb.x = pk2(p0[8 * s + 0], p0[8 * s + 1]); pb.y = pk2(p0[8 * s + 2], p0[8 * s + 3]); pb.z = pk2(p0[8 * s + 4], p0[8 * s + 5]); pb.w = pk2(p0[8 * s + 6], p0[8 * s + 7]); }
                    else { pb.x = pk2(p1[8 * s + 0], p1[8 * s + 1]); pb.y = pk2(p1[8 * s + 2], p1[8 * s + 3]); pb.z = pk2(p1[8 * s + 4], p1[8 * s + 5]); pb.w = pk2(p1[8 * s + 6], p1[8 * s + 7]); }
#pragma unroll
                    for (int dt = 0; dt < 2; ++dt) { const LAS unsigned char* vp = Vb + (32 * dt + r32) * AT_KP + (32 * hk + 16 * s + 4 * h) * 2;
                        const u32x2 lo = *(const LAS u32x2*)vp, hi2 = *(const LAS u32x2*)(vp + 16);
                        u32x4 fa; fa.x = lo.x; fa.y = lo.y; fa.z = hi2.x; fa.w = hi2.y;
                        ot[dt] = __builtin_amdgcn_mfma_f32_32x32x16_bf16(__builtin_bit_cast(bf16x8, fa), __builtin_bit_cast(bf16x8, pb), ot[dt], 0, 0, 0); } }
            if (ti + 2 < NT) AT_STORE(sw_);
            __syncthreads();
            p0 = n0; p1 = n1;
            { const int t_ = sc_; sc_ = sn_; sn_ = sw_; sw_ = t_; }
        }
#undef AT_LOAD
#undef AT_STORE
#undef AT_QK
        const float linv = 1.0f / (l_run + shx(l_run, 32, ln_));
        { bf16* op = F.MIX() + (size_t)(qrowbase + q0 + 32 * ph + r32) * D + hq * 64 + 4 * h;
#pragma unroll
          for (int dt = 0; dt < 2; ++dt)
#pragma unroll
              for (int gq = 0; gq < 4; ++gq) { u32x2 w; w.x = pk2(ot[dt][4 * gq + 0] * linv, ot[dt][4 * gq + 1] * linv); w.y = pk2(ot[dt][4 * gq + 2] * linv, ot[dt][4 * gq + 3] * linv);
                  *(u32x2*)(op + 32 * dt + 8 * gq) = w; } }
    }
}

__device__ __forceinline__ void ph_outproj_naive(Ctx& F, int l) {
    const int gw = F.bid * NWAVES + F.wave, NGW = F.G * NWAVES, r = F.lane & 31, h = F.lane >> 5;
    const int Mq = (l == 0) ? MA : ML;
    const bf16* Bt = F.WoutT() + (size_t)l * D * D;
    for (int ti = gw; ti < (Mq / 64) * (D / 64); ti += NGW) {
        const int rt = ti / (D / 64), ct = ti % (D / 64), m0 = rt * 64, c0 = ct * 64;
        f32x16 acc[2][2];
        sg_kloop(acc, F.MIX() + (size_t)(m0 + r) * D + 8 * h, F.MIX() + (size_t)(m0 + 32 + r) * D + 8 * h, Bt + (size_t)(c0 + r) * D + 8 * h, Bt + (size_t)(c0 + 32 + r) * D + 8 * h, D);
#pragma unroll
        for (int mt = 0; mt < 2; ++mt)
#pragma unroll
            for (int nt = 0; nt < 2; ++nt)
#pragma unroll
                for (int q = 0; q < 16; ++q) {
                    const int m = m0 + 32 * mt + crow(q, h), c = c0 + 32 * nt + r;
                    const float g2 = F.mods()[((size_t)l * 3 + mod_row(m)) * 6 * D + 2 * D + c];
                    F.P()[(size_t)m * D + c] = (bf16)f2bf(g2 * acc[mt][nt][q]);
                }
    }
}

__device__ __forceinline__ void ph_norm2_router(Ctx& F, int l, bool shadow = false) {
    const int Mq = (l == 0) ? MA : ML;
    LAS unsigned char* HI = F.lds; LAS unsigned char* LO = F.lds + 16512;
    constexpr int HP = 2064;
    LAS float* part = (LAS float*)(F.lds + 36864);
    LAS float* AC = (LAS float*)(F.lds + 98304);
    LAS float* BC = (LAS float*)(F.lds + 110592);
    LAS float* lg = (LAS float*)(F.lds + 122880);
    LAS float* tvi = (LAS float*)(F.lds + 123904);
    LAS int* lcnt = (LAS int*)(F.lds + 124928);
    LAS int* lbase = (LAS int*)(F.lds + 124928 + 128);
    LAS int* se = (LAS int*)(F.lds + 124928 + 256);
    LAS float* sg = (LAS float*)(F.lds + 124928 + 256 + 4096);
    const int e = F.tid & 31;
    const int fr = F.lane & 15, fq = F.lane >> 4, kw = F.wave * 128;
    bf16x8 whi[2][4], wlo[2][4];
#pragma unroll
    for (int nt = 0; nt < 2; ++nt)
#pragma unroll
        for (int ks = 0; ks < 4; ++ks) { float wv[8];
#pragma unroll
            for (int i = 0; i < 8; ++i) wv[i] = F.inp(I_RW)[((size_t)l * D + kw + 32 * ks + 8 * fq + i) * NE + 16 * nt + fr];
            u32x4 hi, lo;
            hi.x = pk2(wv[0], wv[1]); hi.y = pk2(wv[2], wv[3]); hi.z = pk2(wv[4], wv[5]); hi.w = pk2(wv[6], wv[7]);
            lo.x = pk2(wv[0] - __uint_as_float(hi.x << 16), wv[1] - __uint_as_float(hi.x & 0xffff0000u)); lo.y = pk2(wv[2] - __uint_as_float(hi.y << 16), wv[3] - __uint_as_float(hi.y & 0xffff0000u));
            lo.z = pk2(wv[4] - __uint_as_float(hi.z << 16), wv[5] - __uint_as_float(hi.z & 0xffff0000u)); lo.w = pk2(wv[6] - __uint_as_float(hi.w << 16), wv[7] - __uint_as_float(hi.w & 0xffff0000u));
            whi[nt][ks] = __builtin_bit_cast(bf16x8, hi); wlo[nt][ks] = __builtin_bit_cast(bf16x8, lo); }
    unsigned* cnt = (unsigned*)(F.ctl() + CW_CNT + l * 64 + (shadow ? 512 : 0));
    int* ltok = shadow ? (int*)(F.ws + WS_HMOE) : F.list_tok(); int* ldst = ltok + (size_t)NE * CAP; float* lgate = (float*)(ldst + (size_t)NE * CAP);
    __syncthreads();
    if (F.tid < 32) lcnt[F.tid] = 0;
    for (int i = F.tid; i < 3 * D; i += NTHR) { const int r = i >> 10, c = i & (D - 1); const float* mo = F.mods() + ((size_t)l * 3 + r) * 6 * D;
        AC[i] = F.inp(I_N2G)[l * D + c] * (1.0f + mo[4 * D + c]); BC[i] = mo[3 * D + c]; }
    f32x4 v[4]; u32x2 tv[4];
#define RT_LOAD(mm) do { const int m_ = (mm); \
        if (l == 0) { const float* s_ = m_ < ML ? F.inp(I_X) + (size_t)m_ * D : F.inp(I_CTX) + (size_t)(m_ - ML) * D; \
            _Pragma("unroll") for (int j = 0; j < 4; ++j) v[j] = *(const f32x4*)(s_ + 4 * F.lane + 256 * j); } \
        else { _Pragma("unroll") for (int j = 0; j < 4; ++j) { const u32x2 w_ = *(const u32x2*)(F.XL() + (size_t)m_ * D + 4 * F.lane + 256 * j); \
            v[j] = (f32x4){__uint_as_float(w_.x << 16), __uint_as_float(w_.x & 0xffff0000u), __uint_as_float(w_.y << 16), __uint_as_float(w_.y & 0xffff0000u)}; } } \
        _Pragma("unroll") for (int j = 0; j < 4; ++j) tv[j] = *(const u32x2*)(F.P() + (size_t)m_ * D + 4 * F.lane + 256 * j); } while (0)
    { const int m = F.bid * 8 + F.wave; if (m < Mq) RT_LOAD(m); }
    __syncthreads();
    int ti = 0;
    for (int base = F.bid * 8; base < Mq; base += F.G * 8, ++ti) {
        { const int m = base + F.wave;
          const int mr = mod_row(m);
          float ss = 0.f;
#pragma unroll
          for (int j = 0; j < 4; ++j) { v[j].x += __uint_as_float(tv[j].x << 16); v[j].y += __uint_as_float(tv[j].x & 0xffff0000u); v[j].z += __uint_as_float(tv[j].y << 16); v[j].w += __uint_as_float(tv[j].y & 0xffff0000u);
              { u32x2 xw; xw.x = pk2(v[j].x, v[j].y); xw.y = pk2(v[j].z, v[j].w); *(u32x2*)(F.XL() + (size_t)m * D + 4 * F.lane + 256 * j) = xw; }
              ss += (v[j].x * v[j].x + v[j].y * v[j].y) + (v[j].z * v[j].z + v[j].w * v[j].w); }
          const float rstd = __builtin_amdgcn_rsqf(wave_sum(ss, F.lane) * (1.0f / D) + EPS);
#pragma unroll
          for (int j = 0; j < 4; ++j) { const int col = 4 * F.lane + 256 * j;
              const f32x4 ga = *(const LAS f32x4*)(AC + mr * D + col), sh = *(const LAS f32x4*)(BC + mr * D + col);
              const f32x4 h = v[j] * rstd * ga + sh;
              if (MOE_FP8) *(unsigned*)((unsigned char*)F.H1() + (size_t)m * D + col) = pk_fp8x4(h.x, h.y, h.z, h.w);
              else { u32x2 w; w.x = pk2(h.x, h.y); w.y = pk2(h.z, h.w); *(u32x2*)(F.H1() + (size_t)m * D + col) = w; }
              { u32x2 wh, wl; wh.x = pk2(h.x, h.y); wh.y = pk2(h.z, h.w);
                wl.x = pk2(h.x - __uint_as_float(wh.x << 16), h.y - __uint_as_float(wh.x & 0xffff0000u)); wl.y = pk2(h.z - __uint_as_float(wh.y << 16), h.w - __uint_as_float(wh.y & 0xffff0000u));
                *(LAS u32x2*)(HI + F.wave * HP + col * 2) = wh; *(LAS u32x2*)(LO + F.wave * HP + col * 2) = wl; } }
          const int mn = m + F.G * 8;
          if (mn < Mq) RT_LOAD(mn); }
        __syncthreads();
        { f32x4 acc[2] = {{0.f, 0.f, 0.f, 0.f}, {0.f, 0.f, 0.f, 0.f}};
#pragma unroll
          for (int ks = 0; ks < 4; ++ks) { const int ao = (fr & 7) * HP + (kw + 32 * ks + 8 * fq) * 2;
              const bf16x8 ah = *(const LAS bf16x8*)(HI + ao), al = *(const LAS bf16x8*)(LO + ao);
#pragma unroll
              for (int nt = 0; nt < 2; ++nt) { acc[nt] = __builtin_amdgcn_mfma_f32_16x16x32_bf16(al, whi[nt][ks], acc[nt], 0, 0, 0); acc[nt] = __builtin_amdgcn_mfma_f32_16x16x32_bf16(ah, wlo[nt][ks], acc[nt], 0, 0, 0);
                  acc[nt] = __builtin_amdgcn_mfma_f32_16x16x32_bf16(ah, whi[nt][ks], acc[nt], 0, 0, 0); } }
          if (fq < 2) {
#pragma unroll
              for (int nt = 0; nt < 2; ++nt)
#pragma unroll
                  for (int j = 0; j < 4; ++j) part[(F.wave * 8 + 4 * fq + j) * 32 + 16 * nt + fr] = acc[nt][j]; } }
        __syncthreads();
        if (F.tid < 256) {
            const int rr = F.tid >> 5; float s = F.inp(I_RB)[l * NE + e];
#pragma unroll
            for (int q = 0; q < 8; ++q) s += part[(q * 8 + rr) * 32 + e];
            lg[rr * 32 + e] = s;
            asm volatile("s_waitcnt lgkmcnt(0)" ::: "memory");
            int rank = 0;
#pragma unroll
            for (int q = 0; q < 8; ++q) { const f32x4 x = *(const LAS f32x4*)(lg + rr * 32 + 4 * q);
                rank += (x.x > s || (x.x == s && 4 * q + 0 < e)) ? 1 : 0; rank += (x.y > s || (x.y == s && 4 * q + 1 < e)) ? 1 : 0;
                rank += (x.z > s || (x.z == s && 4 * q + 2 < e)) ? 1 : 0; rank += (x.w > s || (x.w == s && 4 * q + 3 < e)) ? 1 : 0; }
            if (rank < 4) { tvi[(rr * 4 + rank) * 2] = s; tvi[(rr * 4 + rank) * 2 + 1] = __int_as_float(e); }
            asm volatile("s_waitcnt lgkmcnt(0)" ::: "memory");
            const f32x4 c01 = *(const LAS f32x4*)(tvi + rr * 8), c23 = *(const LAS f32x4*)(tvi + rr * 8 + 4);
            const float p1 = __expf(c01.z - c01.x), p2 = __expf(c23.x - c01.x), p3 = __expf(c23.z - c01.x), den = 1.0f + p1 + p2 + p3;
            if (e < 4) { const float myv = e == 0 ? 1.0f : (e == 1 ? p1 : (e == 2 ? p2 : p3)); const int mye = __float_as_int(e == 0 ? c01.y : (e == 1 ? c01.w : (e == 2 ? c23.y : c23.w)));
                const int lp = __hip_atomic_fetch_add(lcnt + mye, 1, __ATOMIC_RELAXED, __HIP_MEMORY_SCOPE_WORKGROUP);
                se[ti * 32 + rr * 4 + e] = mye | (lp << 8); sg[ti * 32 + rr * 4 + e] = myv * frcp(den); }
        }
        __syncthreads();
    }
    if (F.tid < 32) lbase[F.tid] = (int)atomicAdd(cnt + F.tid, (unsigned)lcnt[F.tid]);
    __syncthreads();
    for (int i = F.tid; i < ti * 32; i += NTHR) {
        const int w = se[i], ee = w & 255, lp = w >> 8, m = F.bid * 8 + (i >> 5) * (F.G * 8) + ((i & 31) >> 2), j = i & 3;
        const size_t pos = (size_t)ee * CAP + lbase[ee] + lp;
        ltok[pos] = m; ldst[pos] = m * 4 + j; lgate[pos] = sg[i];
    }
}

#undef RT_LOAD
__device__ __forceinline__ void ph_moe_gu_naive(Ctx& F, int l) {
    const int gw = F.bid * NWAVES + F.wave, NGW = F.G * NWAVES, r = F.lane & 31, h = F.lane >> 5;
    const unsigned* cnt = (const unsigned*)(F.ctl() + CW_CNT + l * 64);
    int id0 = 0, ts256 = 0;
    for (int e = 0; e < NE; ++e) {
        const int ce = (int)__hip_atomic_load(cnt + e, __ATOMIC_RELAXED, __HIP_MEMORY_SCOPE_AGENT);
        const int nrt = (ce + 63) / 64, n = nrt * 32;
        const bf16* Bt = F.WguT() + ((size_t)l * NE + e) * 2 * FF * D;
        const float* bg = F.inp(I_BGU) + ((size_t)l * NE + e) * 2 * FF;
        int id = id0 + ((gw - id0 % NGW) + NGW) % NGW;
        for (; id < id0 + n; id += NGW) {
            const int rt = (id - id0) / 32, ft = (id - id0) % 32, pos0 = rt * 64, ff0 = ft * 32;
            const int p0 = pos0 + r, p1 = pos0 + 32 + r;
            const int t0 = p0 < ce ? F.list_tok()[(size_t)e * CAP + p0] : 0, t1 = p1 < ce ? F.list_tok()[(size_t)e * CAP + p1] : 0;
            const int ng = (ff0 >> 7) * 256 + (ff0 & 127) + r;
            f32x16 acc[2][2];
            sg_kloop(acc, F.H1() + (size_t)t0 * D + 8 * h, F.H1() + (size_t)t1 * D + 8 * h, Bt + (size_t)ng * D + 8 * h, Bt + (size_t)(ng + 128) * D + 8 * h, D);
            const float bgate = bg[ff0 + r], bup = bg[FF + ff0 + r];
#pragma unroll
            for (int mt = 0; mt < 2; ++mt)
#pragma unroll
                for (int q = 0; q < 16; ++q) {
                    const int pos = pos0 + 32 * mt + crow(q, h);
                    if (pos < ce) {
                        const float gate = fminf(acc[mt][0][q] + bgate, 7.0f), up = fminf(fmaxf(acc[mt][1][q] + bup, -7.0f), 7.0f);
                        const float glu = gate * sigmoidf_(1.702f * gate);
                        F.HMOE()[((size_t)ts256 * 256 + pos) * FF + ff0 + r] = (bf16)f2bf((up + 1.0f) * glu);
                    }
                }
        }
        id0 += n; ts256 += (ce + 255) / 256;
    }
}
__device__ __forceinline__ void ph_moe_down_naive(Ctx& F, int l) {
    const int gw = F.bid * NWAVES + F.wave, NGW = F.G * NWAVES, r = F.lane & 31, h = F.lane >> 5;
    const unsigned* cnt = (const unsigned*)(F.ctl() + CW_CNT + l * 64);
    int id0 = 0, ts256 = 0;
    for (int e = 0; e < NE; ++e) {
        const int ce = (int)__hip_atomic_load(cnt + e, __ATOMIC_RELAXED, __HIP_MEMORY_SCOPE_AGENT);
        const int nrt = (ce + 63) / 64, n = nrt * 16;
        const bf16* Bt = F.WdT() + ((size_t)l * NE + e) * D * FF;
        const float* bd = F.inp(I_BD) + ((size_t)l * NE + e) * D;
        int id = id0 + ((gw - id0 % NGW) + NGW) % NGW;
        for (; id < id0 + n; id += NGW) {
            const int rt = (id - id0) / 16, ct = (id - id0) % 16, pos0 = rt * 64, c0 = ct * 64;
            const bf16* A = F.HMOE() + ((size_t)ts256 * 256 + pos0) * FF;
            f32x16 acc[2][2];
            sg_kloop(acc, A + (size_t)r * FF + 8 * h, A + (size_t)(32 + r) * FF + 8 * h, Bt + (size_t)(c0 + r) * FF + 8 * h, Bt + (size_t)(c0 + 32 + r) * FF + 8 * h, FF);
#pragma unroll
            for (int mt = 0; mt < 2; ++mt)
#pragma unroll
                for (int q = 0; q < 16; ++q) {
                    const int pos = pos0 + 32 * mt + crow(q, h);
                    if (pos < ce) {
                        const int dst = F.list_dst()[(size_t)e * CAP + pos]; const float g = F.list_gate()[(size_t)e * CAP + pos];
#pragma unroll
                        for (int nt = 0; nt < 2; ++nt) { const int c = c0 + 32 * nt + r;
                            F.Y2()[(size_t)dst * D + c] = (bf16)f2bf(g * (acc[mt][nt][q] + bd[c])); }
                    }
                }
        }
        id0 += n; ts256 += (ce + 255) / 256;
    }
}

namespace pg8 {
constexpr int BM = 256, BK = 64, HALF = 128, HTB = HALF * BK * 2, STAGE_BYTES = 8 * HTB, NXCD = 8, WGM = 8;
__device__ __forceinline__ int lds_byte(int r, int c) { const int st = (r >> 4) * 2 + (c >> 5), rr = r & 15, cc = c & 31, ob = rr * 64 + cc * 2; return st * 1024 + (ob ^ (((ob >> 9) & 1) << 5)); }
__device__ __forceinline__ void stage_rc(int b, int& R, int& C) { const int st = b / 1024, sb = b % 1024, swz = sb ^ (((sb >> 9) & 1) << 5); R = (st >> 1) * 16 + swz / 64; C = (st & 1) * 32 + (swz % 64) / 2; }
__device__ __forceinline__ int perm32(int rho) { const int n = rho >> 4, i = rho & 15; return 8 * (i >> 2) + 4 * n + (i & 3); }
struct Unit { int pm, pn, e, pos0, ce; };
struct StaticOrder {
    int nM, nN, nwg, G, c;
    __device__ __forceinline__ void init(int M, int N, int G_, int c_) { nM = M / BM; nN = N / BM; nwg = nM * nN; G = G_; c = c_; }
    __device__ __forceinline__ bool next(int i, Unit& u) const {
        const long L = (long)i * G + c; if (L >= nwg) return false;
        int wgid = (int)L; { const int q = nwg / NXCD, r = nwg % NXCD, xcd = wgid % NXCD, off = wgid / NXCD; wgid = (xcd < r ? xcd * (q + 1) : r * (q + 1) + (xcd - r) * q) + off; }
        const int nig = WGM * nN, gid = wgid / nig, fm = gid * WGM, gsz = (nM - fm) < WGM ? (nM - fm) : WGM;
        u.pm = fm + ((wgid % nig) % gsz); u.pn = (wgid % nig) / gsz; u.e = 0; u.pos0 = 0; u.ce = 0; return true;
    }
};
__device__ __forceinline__ unsigned cvt_pk_bf16(float lo, float hi) { unsigned r; asm volatile("v_cvt_pk_bf16_f32 %0, %1, %2" : "=v"(r) : "v"(lo), "v"(hi)); return r; }
typedef f32x4 AccT[2][2][4][2];
template <class PB>
__device__ __forceinline__ void gemm_phase(LAS unsigned char* lds, const PB& pb, const int tid) {
    const int wid = __builtin_amdgcn_readfirstlane(tid >> 6), lane = tid & 63, wr = wid >> 2, wc = wid & 3, fr = lane & 15, fq = lane >> 4;
    constexpr int K = PB::K, nt = K / BK;
    unsigned voffB[2];
#pragma unroll
    for (int i = 0; i < 2; ++i) { int R, C; stage_rc(tid * 16 + i * 8192, R, C); const int Rb = PB::PERM ? ((R & ~31) + perm32(R & 31)) : R; voffB[i] = (unsigned)(Rb * K + C) * 2u; }
    constexpr size_t kstep = (size_t)(BK * 2);
    constexpr size_t hstep = (size_t)HALF * K * 2;
    const unsigned ldsw = (unsigned)wid * 1024u;
    const int aoff = lds_byte(wr * 64 + fr, fq * 8), boff = lds_byte(wc * 32 + fr, fq * 8);
#define PG8_SA(b, h) (((b) * 2 + (h)) * HTB)
#define PG8_SB(b, h) ((4 + (b) * 2 + (h)) * HTB)
#define PG8_STAGE(bufoff, gbase, voff) do { _Pragma("unroll") for (int _i = 0; _i < 2; ++_i) \
        __builtin_amdgcn_global_load_lds((const unsigned*)((const char*)(gbase) + (voff)[_i]), (LAS unsigned*)(lds + (bufoff) + ldsw + _i * 8192), 16, 0, 0); } while (0)
#define PG8_LDA(dst, b, h) do { _Pragma("unroll") for (int m = 0; m < 4; ++m) _Pragma("unroll") for (int k = 0; k < 2; ++k) dst[m][k] = *(const LAS bf16x8*)(lds + PG8_SA(b, h) + aoff + m * 2048 + k * 1024); } while (0)
#define PG8_LDB(dst, b, h) do { _Pragma("unroll") for (int n = 0; n < 2; ++n) _Pragma("unroll") for (int k = 0; k < 2; ++k) dst[n][k] = *(const LAS bf16x8*)(lds + PG8_SB(b, h) + boff + n * 2048 + k * 1024); } while (0)
#define PG8_MMA(ai, bj, At, Bt) do { __builtin_amdgcn_s_setprio(1); _Pragma("unroll") for (int m = 0; m < 4; ++m) _Pragma("unroll") for (int n = 0; n < 2; ++n) _Pragma("unroll") for (int k = 0; k < 2; ++k) \
        acc[ai][bj][m][n] = __builtin_amdgcn_mfma_f32_16x16x32_bf16(Bt[n][k], At[m][k], acc[ai][bj][m][n], 0, 0, 0); __builtin_amdgcn_s_setprio(0); } while (0)
#define PG8_WAIT_V(n) asm volatile("s_waitcnt vmcnt(" #n ")" ::: "memory")
#define PG8_WAIT_L(n) asm volatile("s_waitcnt lgkmcnt(" #n ")" ::: "memory")
#define PG8_BAR __builtin_amdgcn_s_barrier()
#define PG8_SCHED __builtin_amdgcn_sched_barrier(0)
    Unit cur, nxt; int ui = 0;
    if (!pb.next(0, cur)) return;
    f32x4 acc[2][2][4][2];
#pragma unroll
    for (int a = 0; a < 2; ++a)
#pragma unroll
        for (int b = 0; b < 2; ++b)
#pragma unroll
            for (int m = 0; m < 4; ++m)
#pragma unroll
                for (int n = 0; n < 2; ++n) acc[a][b][m][n] = (f32x4){0.f, 0.f, 0.f, 0.f};
    bf16x8 At[4][2], B0[2][2], B1[2][2];
    unsigned cv[2][2];
    pb.a_voff(cur, cv, tid);
    const char* cA = pb.a_base(cur); const char* cB = pb.b_base(cur);
    PG8_STAGE(PG8_SB(0, 0), cB, voffB); PG8_STAGE(PG8_SB(0, 1), cB + hstep, voffB); PG8_STAGE(PG8_SA(0, 0), cA, cv[0]); PG8_STAGE(PG8_SA(0, 1), cA, cv[1]);
    if (wr == 1) PG8_BAR;
    PG8_WAIT_V(2); PG8_BAR;
    PG8_STAGE(PG8_SB(1, 0), cB + kstep, voffB); PG8_STAGE(PG8_SA(1, 0), cA + kstep, cv[0]); PG8_STAGE(PG8_SB(1, 1), cB + hstep + kstep, voffB);
    PG8_WAIT_V(6); PG8_BAR;
    for (;;) {
        const bool has_next = pb.next(ui + 1, nxt);
        const char* nA = has_next ? pb.a_base(nxt) : cA; const char* nB = has_next ? pb.b_base(nxt) : cB;
        for (int t = 0; t < nt; t += 2) {
            const bool last = (t == nt - 2);
            const char* a1 = cA + (size_t)(t + 1) * kstep;
            const char* a2 = last ? nA : cA + (size_t)(t + 2) * kstep; const char* b2 = last ? nB : cB + (size_t)(t + 2) * kstep;
            const char* a3 = a2 + kstep; const char* b3 = b2 + kstep;
            if (PB::GATHER && t == nt - 4 && has_next) pb.tok_prefetch(nxt, lds, tid, wid);
            if (PB::GATHER && last && has_next) pb.a_voff_half_lds(cv[0], lds, tid, wid, 0);
            PG8_LDB(B0, 0, 0); PG8_LDB(B1, 0, 1); PG8_SCHED; PG8_LDA(At, 0, 0); PG8_STAGE(PG8_SA(1, 1), a1, cv[1]);
            if (PB::GATHER && last && has_next) pb.a_voff_half_lds(cv[1], lds, tid, wid, 1);
            PG8_WAIT_V(8); PG8_WAIT_L(0); PG8_BAR; PG8_MMA(0, 0, At, B0); PG8_MMA(0, 1, At, B1); PG8_BAR; PG8_SCHED;
            PG8_LDA(At, 0, 1); PG8_STAGE(PG8_SB(0, 0), b2, voffB); PG8_STAGE(PG8_SB(0, 1), b2 + hstep, voffB); PG8_STAGE(PG8_SA(0, 0), a2, cv[0]);
            PG8_WAIT_V(8); PG8_WAIT_L(0); PG8_BAR; PG8_MMA(1, 0, At, B0); PG8_MMA(1, 1, At, B1); PG8_BAR; PG8_SCHED;
            PG8_LDB(B0, 1, 0); PG8_LDB(B1, 1, 1); PG8_SCHED; PG8_LDA(At, 1, 0); PG8_STAGE(PG8_SA(0, 1), a2, cv[1]);
            PG8_WAIT_V(8); PG8_WAIT_L(0); PG8_BAR; PG8_MMA(0, 0, At, B0); PG8_MMA(0, 1, At, B1); PG8_BAR; PG8_SCHED;
            PG8_LDA(At, 1, 1); PG8_STAGE(PG8_SB(1, 0), b3, voffB); PG8_STAGE(PG8_SB(1, 1), b3 + hstep, voffB); PG8_STAGE(PG8_SA(1, 0), a3, cv[0]);
            PG8_WAIT_V(8); PG8_WAIT_L(0); PG8_BAR; PG8_MMA(1, 0, At, B0); PG8_MMA(1, 1, At, B1); PG8_BAR; PG8_SCHED;
        }
        if (wr == 0) PG8_BAR;
        pb.epi(acc, cur, wr, wc, fr, fq);
        if (!has_next) break;
#pragma unroll
        for (int a = 0; a < 2; ++a)
#pragma unroll
            for (int b = 0; b < 2; ++b)
#pragma unroll
                for (int m = 0; m < 4; ++m)
#pragma unroll
                    for (int n = 0; n < 2; ++n) acc[a][b][m][n] = (f32x4){0.f, 0.f, 0.f, 0.f};
        cur = nxt; cA = nA; cB = nB; ++ui;
        if (wr == 1) PG8_BAR;
    }
    PG8_WAIT_V(0);
    PG8_BAR;
#undef PG8_SA
#undef PG8_SB
#undef PG8_STAGE
#undef PG8_LDA
#undef PG8_LDB
#undef PG8_MMA
#undef PG8_WAIT_V
#undef PG8_WAIT_L
#undef PG8_BAR
#undef PG8_SCHED
}
typedef int v4i_t __attribute__((ext_vector_type(4)));
typedef int v8i_t __attribute__((ext_vector_type(8)));
template <class PB>
__device__ __forceinline__ void gemm_phase8(LAS unsigned char* lds, const PB& pb, const int tid) {
    const int wid = __builtin_amdgcn_readfirstlane(tid >> 6), lane = tid & 63, wr = wid >> 2, wc = wid & 3, fr = lane & 15, fq = lane >> 4;
    constexpr int K = PB::K  , nt = K / 128;
    unsigned vb0, va0;
    { int R, C; stage_rc(tid * 16, R, C); const int Rb = PB::PERM ? ((R & ~31) + perm32(R & 31)) : R; vb0 = (unsigned)(Rb * K + C * 2); va0 = (unsigned)(R * K + C * 2); }
    constexpr size_t kstep = (size_t)(BK * 2);
    constexpr size_t hstep = (size_t)HALF * K;
    const unsigned ldsw = (unsigned)wid * 1024u;
    const int aoff = lds_byte(wr * 64 + fr, fq * 8), boff = lds_byte(wc * 32 + fr, fq * 8);
#define PG8_SA(b, h) (((b) * 2 + (h)) * HTB)
#define PG8_SB(b, h) ((4 + (b) * 2 + (h)) * HTB)
#define PG8_STAGE_B(bufoff, gbase) do { _Pragma("unroll") for (int _i = 0; _i < 2; ++_i) \
        __builtin_amdgcn_global_load_lds((const unsigned*)((const char*)(gbase) + (size_t)(_i * 64) * K + vb0), (LAS unsigned*)(lds + (bufoff) + ldsw + _i * 8192), 16, 0, 0); } while (0)
#define PG8_STAGE_A(bufoff, gbase, h) do { _Pragma("unroll") for (int _i = 0; _i < 2; ++_i) { \
        const char* p_ = PB::GATHER ? (const char*)(gbase) + cv[h][_i] : (const char*)(gbase) + (size_t)((h) * 128 + _i * 64) * K + va0; \
        __builtin_amdgcn_global_load_lds((const unsigned*)p_, (LAS unsigned*)(lds + (bufoff) + ldsw + _i * 8192), 16, 0, 0); } } while (0)
#define PG8_LDA(dst, b, h) do { _Pragma("unroll") for (int m = 0; m < 4; ++m) { const v4i_t lo_ = *(const LAS v4i_t*)(lds + PG8_SA(b, h) + aoff + m * 2048), hi_ = *(const LAS v4i_t*)(lds + PG8_SA(b, h) + aoff + m * 2048 + 1024); dst[m] = __builtin_shufflevector(lo_, hi_, 0, 1, 2, 3, 4, 5, 6, 7); } } while (0)
#define PG8_LDB(dst, b, h) do { _Pragma("unroll") for (int n = 0; n < 2; ++n) { const v4i_t lo_ = *(const LAS v4i_t*)(lds + PG8_SB(b, h) + boff + n * 2048), hi_ = *(const LAS v4i_t*)(lds + PG8_SB(b, h) + boff + n * 2048 + 1024); dst[n] = __builtin_shufflevector(lo_, hi_, 0, 1, 2, 3, 4, 5, 6, 7); } } while (0)
#define PG8_MMA(ai, bj, At, Bt) do { __builtin_amdgcn_s_setprio(1); _Pragma("unroll") for (int m = 0; m < 4; ++m) _Pragma("unroll") for (int n = 0; n < 2; ++n) \
        asm volatile("v_mfma_scale_f32_16x16x128_f8f6f4 %0, %1, %2, %0, %3, %3 op_sel_hi:[0,0,0]" : "+v"(acc[ai][bj][m][n]) : "v"(Bt[n]), "v"(At[m]), "v"(sc1)); \
        __builtin_amdgcn_s_setprio(0); } while (0)
#define PG8_WAIT_V(n) asm volatile("s_waitcnt vmcnt(" #n ")" ::: "memory")
#define PG8_WAIT_L(n) asm volatile("s_waitcnt lgkmcnt(" #n ")" ::: "memory")
#define PG8_BAR __builtin_amdgcn_s_barrier()
#define PG8_SCHED __builtin_amdgcn_sched_barrier(0)
    Unit cur, nxt; int ui = 0;
    if (!pb.next(0, cur)) return;
    f32x4 acc[2][2][4][2];
#pragma unroll
    for (int a = 0; a < 2; ++a)
#pragma unroll
        for (int b = 0; b < 2; ++b)
#pragma unroll
            for (int m = 0; m < 4; ++m)
#pragma unroll
                for (int n = 0; n < 2; ++n) acc[a][b][m][n] = (f32x4){0.f, 0.f, 0.f, 0.f};
    v8i_t At[4], B0[2], B1[2];
    int sc1 = 0x7f7f7f7f; asm volatile("" : "+v"(sc1));
    unsigned cv[2][2];
    if (PB::GATHER) pb.a_voff(cur, cv, tid); else { cv[0][0] = cv[0][1] = cv[1][0] = cv[1][1] = 0u; }
    const char* cA = pb.a_base(cur); const char* cB = pb.b_base(cur);
    PG8_STAGE_B(PG8_SB(0, 0), cB); PG8_STAGE_B(PG8_SB(0, 1), cB + hstep); PG8_STAGE_A(PG8_SA(0, 0), cA, 0); PG8_STAGE_A(PG8_SA(0, 1), cA, 1);
    if (wr == 1) PG8_BAR;
    PG8_WAIT_V(2); PG8_BAR;
    PG8_STAGE_B(PG8_SB(1, 0), cB + kstep); PG8_STAGE_A(PG8_SA(1, 0), cA + kstep, 0); PG8_STAGE_B(PG8_SB(1, 1), cB + hstep + kstep);
    PG8_WAIT_V(6); PG8_BAR;
    for (;;) {
        const bool has_next = pb.next(ui + 1, nxt);
        const char* nA = has_next ? pb.a_base(nxt) : cA; const char* nB = has_next ? pb.b_base(nxt) : cB;
#pragma unroll 1
        for (int t = 0; t < nt; t += 2) {
            const bool last = (t == nt - 2);
            const char* a1 = cA + (size_t)(t + 1) * kstep;
            const char* a2 = last ? nA : cA + (size_t)(t + 2) * kstep; const char* b2 = last ? nB : cB + (size_t)(t + 2) * kstep;
            const char* a3 = a2 + kstep; const char* b3 = b2 + kstep;
            if (PB::GATHER && t == nt - 4 && has_next) pb.tok_prefetch(nxt, lds, tid, wid);
            if (PB::GATHER && last && has_next) pb.a_voff_half_lds(cv[0], lds, tid, wid, 0);
            PG8_LDB(B0, 0, 0); PG8_LDB(B1, 0, 1); PG8_SCHED; PG8_LDA(At, 0, 0); PG8_STAGE_A(PG8_SA(1, 1), a1, 1);
            if (PB::GATHER && last && has_next) pb.a_voff_half_lds(cv[1], lds, tid, wid, 1);
            PG8_WAIT_V(8); PG8_WAIT_L(0); PG8_BAR; PG8_MMA(0, 0, At, B0); PG8_MMA(0, 1, At, B1); PG8_BAR; PG8_SCHED;
            PG8_LDA(At, 0, 1); PG8_STAGE_B(PG8_SB(0, 0), b2); PG8_STAGE_B(PG8_SB(0, 1), b2 + hstep); PG8_STAGE_A(PG8_SA(0, 0), a2, 0);
            PG8_WAIT_V(8); PG8_WAIT_L(0); PG8_BAR; PG8_MMA(1, 0, At, B0); PG8_MMA(1, 1, At, B1); PG8_BAR; PG8_SCHED;
            PG8_LDB(B0, 1, 0); PG8_LDB(B1, 1, 1); PG8_SCHED; PG8_LDA(At, 1, 0); PG8_STAGE_A(PG8_SA(0, 1), a2, 1);
            PG8_WAIT_V(8); PG8_WAIT_L(0); PG8_BAR; PG8_MMA(0, 0, At, B0); PG8_MMA(0, 1, At, B1); PG8_BAR; PG8_SCHED;
            PG8_LDA(At, 1, 1); PG8_STAGE_B(PG8_SB(1, 0), b3); PG8_STAGE_B(PG8_SB(1, 1), b3 + hstep); PG8_STAGE_A(PG8_SA(1, 0), a3, 0);
            PG8_WAIT_V(8); PG8_WAIT_L(0); PG8_BAR; PG8_MMA(1, 0, At, B0); PG8_MMA(1, 1, At, B1); PG8_BAR; PG8_SCHED;
        }
        if (wr == 0) PG8_BAR;
        asm volatile("s_nop 15\n\ts_nop 15" ::: "memory");
        { int fr_ = fr, fq_ = fq; asm volatile("" : "+v"(fr_), "+v"(fq_));
          pb.epi(acc, cur, wr, wc, fr_, fq_); }
        if (!has_next) break;
#pragma unroll
        for (int a = 0; a < 2; ++a)
#pragma unroll
            for (int b = 0; b < 2; ++b)
#pragma unroll
                for (int m = 0; m < 4; ++m)
#pragma unroll
                    for (int n = 0; n < 2; ++n) acc[a][b][m][n] = (f32x4){0.f, 0.f, 0.f, 0.f};
        cur = nxt; cA = nA; cB = nB; ++ui;
        if (wr == 1) PG8_BAR;
    }
    PG8_WAIT_V(0);
    PG8_BAR;
#undef PG8_SA
#undef PG8_SB
#undef PG8_STAGE_A
#undef PG8_STAGE_B
#undef PG8_LDA
#undef PG8_LDB
#undef PG8_MMA
#undef PG8_WAIT_V
#undef PG8_WAIT_L
#undef PG8_BAR
#undef PG8_SCHED
}
__device__ __forceinline__ void voff_contig8(unsigned (&v)[2][2], int tid, int KB) {
#pragma unroll
    for (int i = 0; i < 2; ++i) { int R, C; stage_rc(tid * 16 + i * 8192, R, C); v[0][i] = (unsigned)(R * KB + C * 2); v[1][i] = (unsigned)((R + HALF) * KB + C * 2); }
}
__device__ __forceinline__ void voff_contig(unsigned (&v)[2][2], int tid, int K) {
#pragma unroll
    for (int i = 0; i < 2; ++i) { int R, C; stage_rc(tid * 16 + i * 8192, R, C); v[0][i] = (unsigned)(R * K + C) * 2u; v[1][i] = (unsigned)((R + HALF) * K + C) * 2u; }
}
}

struct PbInproj {
    static constexpr int K = D; static constexpr bool PERM = true, GATHER = false;
    const bf16* A; const bf16* Bt; bf16* P; bf16* Vt; const f32x2* rope; pg8::StaticOrder S;
    __device__ __forceinline__ bool next(int i, pg8::Unit& u) const { return S.next(i, u); }
    __device__ __forceinline__ const char* a_base(const pg8::Unit& u) const { return (const char*)A + (size_t)u.pm * 256 * K * 2; }
    __device__ __forceinline__ const char* b_base(const pg8::Unit& u) const { return (const char*)Bt + (size_t)u.pn * 256 * K * 2; }
    __device__ __forceinline__ void a_voff(const pg8::Unit&, unsigned (&v)[2][2], int tid) const { pg8::voff_contig(v, tid, K); }
    __device__ __forceinline__ void tok_prefetch(const pg8::Unit&, LAS unsigned char*, int, int) const {}
    __device__ __forceinline__ void a_voff_half_lds(unsigned (&)[2], LAS unsigned char*, int, int, int) const {}
    __device__ __forceinline__ void epi(const pg8::AccT& acc, const pg8::Unit& u, int wr, int wc, int fr, int fq) const {
        const int row0 = u.pm * 256 + wr * 64 + fr; const bool lat = row0 < ML;
#pragma unroll
        for (int ai = 0; ai < 2; ++ai)
#pragma unroll
            for (int m = 0; m < 4; ++m) {
                const int row = row0 + ai * 128 + m * 16; const int t = row & (SEQ - 1);
#pragma unroll
                for (int bj = 0; bj < 2; ++bj) {
                    const int c0 = u.pn * 256 + bj * 128 + wc * 32 + 8 * fq;
                    f32x4 v0 = acc[ai][bj][m][0], v1 = acc[ai][bj][m][1];
                    if (c0 < C_V) {
                        if (lat) {
                            const int pr0 = (c0 & 63) >> 1, p = pr0 >> 4, f0 = pr0 & 15, pos = p ? (t & 63) : (t >> 6);
                            const f32x4 ca = *(const f32x4*)(rope + pos * 16 + f0), cb = *(const f32x4*)(rope + pos * 16 + f0 + 2);
                            const f32x4 w0 = {v0.x * ca.x - v0.y * ca.y, v0.x * ca.y + v0.y * ca.x, v0.z * ca.z - v0.w * ca.w, v0.z * ca.w + v0.w * ca.z};
                            const f32x4 w1 = {v1.x * cb.x - v1.y * cb.y, v1.x * cb.y + v1.y * cb.x, v1.z * cb.z - v1.w * cb.w, v1.z * cb.w + v1.w * cb.z};
                            v0 = w0; v1 = w1;
                        }
                        if (c0 < C_K) { v0 *= QSCALE; v1 *= QSCALE; }
                    }
                    u32x4 w; w.x = pg8::cvt_pk_bf16(v0.x, v0.y); w.y = pg8::cvt_pk_bf16(v0.z, v0.w); w.z = pg8::cvt_pk_bf16(v1.x, v1.y); w.w = pg8::cvt_pk_bf16(v1.z, v1.w);
                    *(u32x4*)(P + (size_t)row * INW + c0) = w;
                    if (c0 >= C_V && c0 < C_LX) {
                        const size_t vi = vt_index(row, c0 - C_V); const size_t st = row < ML ? SEQ : CTXL;
                        Vt[vi] = (bf16)(w.x & 0xffffu); Vt[vi + st] = (bf16)(w.x >> 16); Vt[vi + 2 * st] = (bf16)(w.y & 0xffffu); Vt[vi + 3 * st] = (bf16)(w.y >> 16);
                        Vt[vi + 4 * st] = (bf16)(w.z & 0xffffu); Vt[vi + 5 * st] = (bf16)(w.z >> 16); Vt[vi + 6 * st] = (bf16)(w.w & 0xffffu); Vt[vi + 7 * st] = (bf16)(w.w >> 16);
                    }
                }
            }
    }
};
struct PbOutproj {
    static constexpr int K = D; static constexpr bool PERM = true, GATHER = false;
    const bf16* A; const bf16* Bt; bf16* TMP; const float* mods_l; pg8::StaticOrder S;
    __device__ __forceinline__ bool next(int i, pg8::Unit& u) const { return S.next(i, u); }
    __device__ __forceinline__ const char* a_base(const pg8::Unit& u) const { return (const char*)A + (size_t)u.pm * 256 * K * 2; }
    __device__ __forceinline__ const char* b_base(const pg8::Unit& u) const { return (const char*)Bt + (size_t)u.pn * 256 * K * 2; }
    __device__ __forceinline__ void a_voff(const pg8::Unit&, unsigned (&v)[2][2], int tid) const { pg8::voff_contig(v, tid, K); }
    __device__ __forceinline__ void tok_prefetch(const pg8::Unit&, LAS unsigned char*, int, int) const {}
    __device__ __forceinline__ void a_voff_half_lds(unsigned (&)[2], LAS unsigned char*, int, int, int) const {}
    __device__ __forceinline__ void epi(const pg8::AccT& acc, const pg8::Unit& u, int wr, int wc, int fr, int fq) const {
        const int row0 = u.pm * 256 + wr * 64 + fr;
        const float* g2 = mods_l + (size_t)mod_row(u.pm * 256) * 6 * D + 2 * D;
        f32x4 gv[2][2];
#pragma unroll
        for (int bj = 0; bj < 2; ++bj) { const int c0 = u.pn * 256 + bj * 128 + wc * 32 + 8 * fq; gv[bj][0] = *(const f32x4*)(g2 + c0); gv[bj][1] = *(const f32x4*)(g2 + c0 + 4); }
#pragma unroll
        for (int ai = 0; ai < 2; ++ai)
#pragma unroll
            for (int m = 0; m < 4; ++m) { bf16* rowp = TMP + (size_t)(row0 + ai * 128 + m * 16) * D;
#pragma unroll
                for (int bj = 0; bj < 2; ++bj) { const int c0 = u.pn * 256 + bj * 128 + wc * 32 + 8 * fq;
                    const f32x4 v0 = gv[bj][0] * acc[ai][bj][m][0], v1 = gv[bj][1] * acc[ai][bj][m][1];
                    u32x4 w; w.x = pg8::cvt_pk_bf16(v0.x, v0.y); w.y = pg8::cvt_pk_bf16(v0.z, v0.w); w.z = pg8::cvt_pk_bf16(v1.x, v1.y); w.w = pg8::cvt_pk_bf16(v1.z, v1.w);
                    *(u32x4*)(rowp + c0) = w; } }
    }
};
constexpr int TOK_LDS = 131072 + 4096;
constexpr int MOE_LDS = 131072;
__device__ __forceinline__ int moe_setup(Ctx& F, int l) {
    LAS int* cntL = (LAS int*)(F.lds + MOE_LDS); LAS int* tst = (LAS int*)(F.lds + MOE_LDS + 256); LAS unsigned short* te = (LAS unsigned short*)(F.lds + MOE_LDS + 512);
    const unsigned* cnt = (const unsigned*)(F.ctl() + CW_CNT + l * 64);
    __syncthreads();
    if (F.tid < NE) cntL[F.tid] = (int)__hip_atomic_load(cnt + F.tid, __ATOMIC_RELAXED, __HIP_MEMORY_SCOPE_AGENT);
    __syncthreads();
    if (F.tid == 0) { int s = 0; for (int e = 0; e < NE; ++e) { tst[e] = s; s += (cntL[e] + 255) >> 8; } tst[NE] = s; }
    __syncthreads();
    const int T = tst[NE];
    for (int i = F.tid; i < T; i += NTHR) { int e = 0; for (int q = 1; q < NE; ++q) e = (tst[q] <= i) ? q : e; te[i] = (unsigned short)e; }
    __syncthreads();
    return T;
}
struct MoeOrder {
    int t0, nun, rank, nper, npn; const LAS unsigned short* te; const LAS int* tst; const LAS int* cntl;
    __device__ __forceinline__ void init(const Ctx& F, int T, int npn_) {
        const int x = F.bid & 7; nper = F.G >> 3; rank = F.bid >> 3; npn = npn_;
        t0 = (x * T) >> 3; const int t1 = ((x + 1) * T) >> 3; nun = (t1 - t0) * npn;
        te = (const LAS unsigned short*)(F.lds + MOE_LDS + 512); tst = (const LAS int*)(F.lds + MOE_LDS + 256); cntl = (const LAS int*)(F.lds + MOE_LDS);
    }
    __device__ __forceinline__ bool next(int i, pg8::Unit& u) const {
        const int x = rank + i * nper; if (x >= nun) return false;
        const int rt = t0 + x / npn; u.pm = rt; u.pn = x % npn; u.e = __builtin_amdgcn_readfirstlane((int)te[rt]); u.pos0 = (rt - __builtin_amdgcn_readfirstlane(tst[u.e])) * 256; u.ce = __builtin_amdgcn_readfirstlane(cntl[u.e]); return true;
    }
};
struct PbGu {
    static constexpr int K = D; static constexpr bool PERM = true, GATHER = true;
    const bf16* A; const bf16* Bt_l; bf16* H; const float* bgu_l; const int* list_tok; MoeOrder S; const LAS int* cntL;
    __device__ __forceinline__ bool next(int i, pg8::Unit& u) const { return S.next(i, u); }
    __device__ __forceinline__ const char* a_base(const pg8::Unit&) const { return (const char*)A; }
    __device__ __forceinline__ const char* b_base(const pg8::Unit& u) const { return (const char*)Bt_l + ((size_t)u.e * 2 * FF + (size_t)u.pn * 256) * K * 2; }
    __device__ __forceinline__ void a_voff_half(const pg8::Unit& u, unsigned (&v)[2], int tid, int h) const {
        const int ce = u.ce;
#pragma unroll
        for (int i = 0; i < 2; ++i) { int R, C; pg8::stage_rc(tid * 16 + i * 8192, R, C);
            const int pos = u.pos0 + h * 128 + R; const int tok = pos < ce ? list_tok[(size_t)u.e * CAP + pos] : 0; v[i] = (unsigned)(tok * K + C) * 2u; }
    }
    __device__ __forceinline__ void a_voff(const pg8::Unit& u, unsigned (&v)[2][2], int tid) const { a_voff_half(u, v[0], tid, 0); a_voff_half(u, v[1], tid, 1); }
    __device__ __forceinline__ void tok_prefetch(const pg8::Unit& u, LAS unsigned char* lds, int tid, int wid) const {
        const int ce = u.ce;
#pragma unroll
        for (int h = 0; h < 2; ++h)
#pragma unroll
            for (int i = 0; i < 2; ++i) { int R, C; pg8::stage_rc(tid * 16 + i * 8192, R, C);
                const int pos = u.pos0 + h * 128 + R; const int* src = list_tok + (size_t)u.e * CAP + (pos < ce ? pos : 0);
                __builtin_amdgcn_global_load_lds((const unsigned*)src, (LAS unsigned*)(lds + TOK_LDS + ((h * 2 + i) * 8 + wid) * 256), 4, 0, 0); }
    }
    __device__ __forceinline__ void a_voff_half_lds(unsigned (&v)[2], LAS unsigned char* lds, int tid, int wid, int h) const {
#pragma unroll
        for (int i = 0; i < 2; ++i) { int R, C; pg8::stage_rc(tid * 16 + i * 8192, R, C);
            const int tok = *(const LAS int*)(lds + TOK_LDS + ((h * 2 + i) * 8 + wid) * 256 + (tid & 63) * 4); v[i] = (unsigned)(tok * K + C) * 2u; }
    }
    __device__ __forceinline__ void epi(const pg8::AccT& acc, const pg8::Unit& u, int wr, int wc, int fr, int fq) const {
        const int row0 = u.pm * 256 + wr * 64 + fr, ff0 = u.pn * 128 + wc * 32 + 8 * fq;
        const float* bg = bgu_l + (size_t)u.e * 2 * FF;
        const f32x4 bg0 = *(const f32x4*)(bg + ff0), bg1 = *(const f32x4*)(bg + ff0 + 4), bu0 = *(const f32x4*)(bg + FF + ff0), bu1 = *(const f32x4*)(bg + FF + ff0 + 4);
#pragma unroll
        for (int ai = 0; ai < 2; ++ai)
#pragma unroll
            for (int m = 0; m < 4; ++m) {
                float o[8];
#pragma unroll
                for (int n = 0; n < 2; ++n) { const f32x4 g = acc[ai][0][m][n] + (n ? bg1 : bg0), up = acc[ai][1][m][n] + (n ? bu1 : bu0);
#pragma unroll
                    for (int j = 0; j < 4; ++j) { const float gate = fminf(g[j], 7.0f), upc = fminf(fmaxf(up[j], -7.0f), 7.0f); o[4 * n + j] = (upc + 1.0f) * gate * sigmoidf_(1.702f * gate); } }
                u32x4 w; w.x = pg8::cvt_pk_bf16(o[0], o[1]); w.y = pg8::cvt_pk_bf16(o[2], o[3]); w.z = pg8::cvt_pk_bf16(o[4], o[5]); w.w = pg8::cvt_pk_bf16(o[6], o[7]);
                *(u32x4*)(H + (size_t)(row0 + ai * 128 + m * 16) * FF + ff0) = w;
            }
    }
};
struct PbDown {
    static constexpr int K = FF; static constexpr bool PERM = true, GATHER = false;
    const bf16* A; const bf16* Bt_l; bf16* Y2; const float* bd_l; const int* list_dst; const float* list_gate; MoeOrder S; const LAS int* cntL;
    __device__ __forceinline__ bool next(int i, pg8::Unit& u) const { return S.next(i, u); }
    __device__ __forceinline__ const char* a_base(const pg8::Unit& u) const { return (const char*)A + (size_t)u.pm * 256 * K * 2; }
    __device__ __forceinline__ const char* b_base(const pg8::Unit& u) const { return (const char*)Bt_l + ((size_t)u.e * D + (size_t)u.pn * 256) * K * 2; }
    __device__ __forceinline__ void a_voff(const pg8::Unit&, unsigned (&v)[2][2], int tid) const { pg8::voff_contig(v, tid, K); }
    __device__ __forceinline__ void tok_prefetch(const pg8::Unit&, LAS unsigned char*, int, int) const {}
    __device__ __forceinline__ void a_voff_half_lds(unsigned (&)[2], LAS unsigned char*, int, int, int) const {}
    __device__ __forceinline__ void epi(const pg8::AccT& acc, const pg8::Unit& u, int wr, int wc, int fr, int fq) const {
        const int ce = u.ce; const int p0 = u.pos0 + wr * 64 + fr; const float* bd = bd_l + (size_t)u.e * D;
        int dsts[2][4]; float gs[2][4];
#pragma unroll
        for (int ai = 0; ai < 2; ++ai)
#pragma unroll
            for (int m = 0; m < 4; ++m) { const int pos = p0 + ai * 128 + m * 16; const size_t ix = (size_t)u.e * CAP + (pos < ce ? pos : 0); dsts[ai][m] = list_dst[ix]; gs[ai][m] = list_gate[ix]; }
        f32x4 bb[2][2];
#pragma unroll
        for (int bj = 0; bj < 2; ++bj) { const int c0 = u.pn * 256 + bj * 128 + wc * 32 + 8 * fq; bb[bj][0] = *(const f32x4*)(bd + c0); bb[bj][1] = *(const f32x4*)(bd + c0 + 4); }
#pragma unroll
        for (int ai = 0; ai < 2; ++ai)
#pragma unroll
            for (int m = 0; m < 4; ++m) {
                const int pos = p0 + ai * 128 + m * 16;
                {
                    const float g = gs[ai][m]; const size_t drow = pos < ce ? (size_t)dsts[ai][m] : (size_t)(Y2_DUMMY_ROW + (pos & 255));
#pragma unroll
                    for (int bj = 0; bj < 2; ++bj) { const int c0 = u.pn * 256 + bj * 128 + wc * 32 + 8 * fq;
                        const f32x4 v0 = (acc[ai][bj][m][0] + bb[bj][0]) * g, v1 = (acc[ai][bj][m][1] + bb[bj][1]) * g;
                        u32x4 w; w.x = pg8::cvt_pk_bf16(v0.x, v0.y); w.y = pg8::cvt_pk_bf16(v0.z, v0.w); w.z = pg8::cvt_pk_bf16(v1.x, v1.y); w.w = pg8::cvt_pk_bf16(v1.z, v1.w);
                        *(u32x4*)(Y2 + drow * D + c0) = w; }
                }
            }
    }
};
struct PbGu8 {
    static constexpr int K = D; static constexpr bool PERM = true, GATHER = true;
    const unsigned char* A; const unsigned char* Bt_l; unsigned char* H; const float* bgu_l; const int* list_tok; MoeOrder S; const LAS int* cntL;
    __device__ __forceinline__ bool next(int i, pg8::Unit& u) const { return S.next(i, u); }
    __device__ __forceinline__ const char* a_base(const pg8::Unit&) const { return (const char*)A; }
    __device__ __forceinline__ const char* b_base(const pg8::Unit& u) const { return (const char*)Bt_l + ((size_t)u.e * 2 * FF + (size_t)u.pn * 256) * K; }
    __device__ __forceinline__ void a_voff_half(const pg8::Unit& u, unsigned (&v)[2], int tid, int h) const {
        const int ce = u.ce;
#pragma unroll
        for (int i = 0; i < 2; ++i) { int R, C; pg8::stage_rc(tid * 16 + i * 8192, R, C);
            const int pos = u.pos0 + h * 128 + R; const int tok = pos < ce ? list_tok[(size_t)u.e * CAP + pos] : 0; v[i] = (unsigned)(tok * K + C * 2); }
    }
    __device__ __forceinline__ void a_voff(const pg8::Unit& u, unsigned (&v)[2][2], int tid) const { a_voff_half(u, v[0], tid, 0); a_voff_half(u, v[1], tid, 1); }
    __device__ __forceinline__ void tok_prefetch(const pg8::Unit& u, LAS unsigned char* lds, int tid, int wid) const {
        const int ce = u.ce;
#pragma unroll
        for (int h = 0; h < 2; ++h)
#pragma unroll
            for (int i = 0; i < 2; ++i) { int R, C; pg8::stage_rc(tid * 16 + i * 8192, R, C);
                const int pos = u.pos0 + h * 128 + R; const int* src = list_tok + (size_t)u.e * CAP + (pos < ce ? pos : 0);
                __builtin_amdgcn_global_load_lds((const unsigned*)src, (LAS unsigned*)(lds + TOK_LDS + ((h * 2 + i) * 8 + wid) * 256), 4, 0, 0); }
    }
    __device__ __forceinline__ void a_voff_half_lds(unsigned (&v)[2], LAS unsigned char* lds, int tid, int wid, int h) const {
#pragma unroll
        for (int i = 0; i < 2; ++i) { int R, C; pg8::stage_rc(tid * 16 + i * 8192, R, C);
            const int tok = *(const LAS int*)(lds + TOK_LDS + ((h * 2 + i) * 8 + wid) * 256 + (tid & 63) * 4); v[i] = (unsigned)(tok * K + C * 2); }
    }
    __device__ __forceinline__ void epi(const pg8::AccT& acc, const pg8::Unit& u, int wr, int wc, int fr, int fq) const {
        const int row0 = u.pm * 256 + wr * 64 + fr, ff0 = u.pn * 128 + wc * 32 + 8 * fq;
        const float* bg = bgu_l + (size_t)u.e * 2 * FF;
        const f32x4 bg0 = *(const f32x4*)(bg + ff0), bg1 = *(const f32x4*)(bg + ff0 + 4), bu0 = *(const f32x4*)(bg + FF + ff0), bu1 = *(const f32x4*)(bg + FF + ff0 + 4);
#pragma unroll
        for (int ai = 0; ai < 2; ++ai)
#pragma unroll
            for (int m = 0; m < 4; ++m) {
                float o[8];
#pragma unroll
                for (int n = 0; n < 2; ++n) { const f32x4 g = acc[ai][0][m][n] * (1.0f / W8_SCALE) + (n ? bg1 : bg0), up = acc[ai][1][m][n] * (1.0f / W8_SCALE) + (n ? bu1 : bu0);
#pragma unroll
                    for (int j = 0; j < 4; ++j) { const float gate = fminf(g[j], 7.0f), upc = fminf(fmaxf(up[j], -7.0f), 7.0f); o[4 * n + j] = (upc + 1.0f) * gate * sigmoidf_(1.702f * gate); } }
                u32x2 w; w.x = pk_fp8x4(o[0], o[1], o[2], o[3]); w.y = pk_fp8x4(o[4], o[5], o[6], o[7]);
                *(u32x2*)(H + (size_t)(row0 + ai * 128 + m * 16) * FF + ff0) = w;
            }
    }
};
struct PbDown8 {
    static constexpr int K = FF; static constexpr bool PERM = true, GATHER = false;
    const unsigned char* A; const unsigned char* Bt_l; bf16* Y2; const float* bd_l; const int* list_dst; const float* list_gate; MoeOrder S; const LAS int* cntL;
    __device__ __forceinline__ bool next(int i, pg8::Unit& u) const { return S.next(i, u); }
    __device__ __forceinline__ const char* a_base(const pg8::Unit& u) const { return (const char*)A + (size_t)u.pm * 256 * K; }
    __device__ __forceinline__ const char* b_base(const pg8::Unit& u) const { return (const char*)Bt_l + ((size_t)u.e * D + (size_t)u.pn * 256) * K; }
    __device__ __forceinline__ void a_voff(const pg8::Unit&, unsigned (&v)[2][2], int tid) const { pg8::voff_contig8(v, tid, K); }
    __device__ __forceinline__ void tok_prefetch(const pg8::Unit&, LAS unsigned char*, int, int) const {}
    __device__ __forceinline__ void a_voff_half_lds(unsigned (&)[2], LAS unsigned char*, int, int, int) const {}
    __device__ __forceinline__ void epi(const pg8::AccT& acc, const pg8::Unit& u, int wr, int wc, int fr, int fq) const {
        const int ce = u.ce; const int p0 = u.pos0 + wr * 64 + fr; const float* bd = bd_l + (size_t)u.e * D;
        int dsts[2][4]; float gs[2][4];
#pragma unroll
        for (int ai = 0; ai < 2; ++ai)
#pragma unroll
            for (int m = 0; m < 4; ++m) { const int pos = p0 + ai * 128 + m * 16; const size_t ix = (size_t)u.e * CAP + (pos < ce ? pos : 0); dsts[ai][m] = list_dst[ix]; gs[ai][m] = list_gate[ix]; }
        f32x4 bb[2][2];
#pragma unroll
        for (int bj = 0; bj < 2; ++bj) { const int c0 = u.pn * 256 + bj * 128 + wc * 32 + 8 * fq; bb[bj][0] = *(const f32x4*)(bd + c0); bb[bj][1] = *(const f32x4*)(bd + c0 + 4); }
#pragma unroll
        for (int ai = 0; ai < 2; ++ai)
#pragma unroll
            for (int m = 0; m < 4; ++m) {
                const int pos = p0 + ai * 128 + m * 16;
                {
                    const float g = gs[ai][m]; const size_t drow = pos < ce ? (size_t)dsts[ai][m] : (size_t)(Y2_DUMMY_ROW + (pos & 255));
#pragma unroll
                    for (int bj = 0; bj < 2; ++bj) { const int c0 = u.pn * 256 + bj * 128 + wc * 32 + 8 * fq;
                        const f32x4 v0 = (acc[ai][bj][m][0] * (1.0f / W8_SCALE) + bb[bj][0]) * g, v1 = (acc[ai][bj][m][1] * (1.0f / W8_SCALE) + bb[bj][1]) * g;
                        if (Y2_FP8) { u32x2 w; w.x = pk_fp8x4(v0.x * Y2_SCALE, v0.y * Y2_SCALE, v0.z * Y2_SCALE, v0.w * Y2_SCALE); w.y = pk_fp8x4(v1.x * Y2_SCALE, v1.y * Y2_SCALE, v1.z * Y2_SCALE, v1.w * Y2_SCALE);
                            *(u32x2*)((unsigned char*)Y2 + drow * D + c0) = w; }
                        else { u32x4 w; w.x = pg8::cvt_pk_bf16(v0.x, v0.y); w.y = pg8::cvt_pk_bf16(v0.z, v0.w); w.z = pg8::cvt_pk_bf16(v1.x, v1.y); w.w = pg8::cvt_pk_bf16(v1.z, v1.w);
                            *(u32x4*)(Y2 + drow * D + c0) = w; } }
                }
            }
    }
};
__device__ __forceinline__ void ph_inproj_fast(Ctx& F, int l) {
    PbInproj pb; pb.A = F.H1(); pb.Bt = F.WinT() + (size_t)l * INW * D; pb.P = F.P(); pb.Vt = F.Vt(); pb.rope = F.rope(); pb.S.init(MA, INW, F.G, F.bid);
    pg8::gemm_phase(F.lds, pb, F.tid);
}
__device__ __forceinline__ void ph_outproj_fast(Ctx& F, int l) {
    PbOutproj pb; pb.A = F.MIX(); pb.Bt = F.WoutT() + (size_t)l * D * D; pb.TMP = F.P(); pb.mods_l = F.mods() + (size_t)l * 3 * 6 * D; pb.S.init(l == 0 ? MA : ML, D, F.G, F.bid);
    pg8::gemm_phase(F.lds, pb, F.tid);
}
__device__ __forceinline__ void ph_moe_gu_fast(Ctx& F, int l) {
    const int T = moe_setup(F, l);
    if (MOE_FP8) {
        PbGu8 pb; pb.A = (const unsigned char*)F.H1(); pb.Bt_l = (const unsigned char*)F.WguT() + (size_t)l * NE * 2 * FF * D; pb.H = (unsigned char*)F.HMOE(); pb.bgu_l = F.inp(I_BGU) + (size_t)l * NE * 2 * FF; pb.list_tok = F.list_tok();
        pb.S.init(F, T, 8); pb.cntL = (const LAS int*)(F.lds + MOE_LDS);
        pg8::gemm_phase8(F.lds, pb, F.tid);
    } else {
        PbGu pb; pb.A = F.H1(); pb.Bt_l = F.WguT() + (size_t)l * NE * 2 * FF * D; pb.H = F.HMOE(); pb.bgu_l = F.inp(I_BGU) + (size_t)l * NE * 2 * FF; pb.list_tok = F.list_tok();
        pb.S.init(F, T, 8); pb.cntL = (const LAS int*)(F.lds + MOE_LDS);
        pg8::gemm_phase(F.lds, pb, F.tid);
    }
}
__device__ __forceinline__ void ph_moe_down_fast(Ctx& F, int l) {
    const int T = moe_setup(F, l);
    if (MOE_FP8) {
        PbDown8 pb; pb.A = (const unsigned char*)F.HMOE(); pb.Bt_l = (const unsigned char*)F.WdT() + (size_t)l * NE * D * FF; pb.Y2 = F.Y2(); pb.bd_l = F.inp(I_BD) + (size_t)l * NE * D; pb.list_dst = F.list_dst(); pb.list_gate = F.list_gate();
        pb.S.init(F, T, 4); pb.cntL = (const LAS int*)(F.lds + MOE_LDS);
        pg8::gemm_phase8(F.lds, pb, F.tid);
    } else {
        PbDown pb; pb.A = F.HMOE(); pb.Bt_l = F.WdT() + (size_t)l * NE * D * FF; pb.Y2 = F.Y2(); pb.bd_l = F.inp(I_BD) + (size_t)l * NE * D; pb.list_dst = F.list_dst(); pb.list_gate = F.list_gate();
        pb.S.init(F, T, 4); pb.cntL = (const LAS int*)(F.lds + MOE_LDS);
        pg8::gemm_phase(F.lds, pb, F.tid);
    }
}

#define XB_TMO      128
#define XB_XCNT(j)  (256  + 64 * (j))
#define XB_XSUB(j)  (1280 + 64 * (j))
#define XB_XGEN(j)  (2304 + 64 * (j))
#define XB_TOP      3328
#define XB_TOPGEN   3392
#define XCD_BAR_WORDS 3456
#define XB_SPIN_CAP (1u << 22)
__device__ __forceinline__ unsigned xb_ld(unsigned* p)              { return __hip_atomic_load(p, __ATOMIC_RELAXED, __HIP_MEMORY_SCOPE_AGENT); }
__device__ __forceinline__ unsigned xb_add(unsigned* p, unsigned v) { return __hip_atomic_fetch_add(p, v, __ATOMIC_RELAXED, __HIP_MEMORY_SCOPE_AGENT); }
__device__ __forceinline__ unsigned xb_xcc_id() { return (unsigned)__builtin_amdgcn_s_getreg((3 << 11) | 20) & 0xFu; }
#define XB_SPIN(cond, bar) do { unsigned _sp = 0; while (cond) { __builtin_amdgcn_s_sleep(1); \
    if ((++_sp & 255u) == 0u) { if (xb_ld(&(bar)[XB_TMO])) break; if (_sp > XB_SPIN_CAP) { atomicAdd(&(bar)[XB_TMO], 1u); break; } } } } while (0)
struct XcdBarrier { unsigned* bar; unsigned x; volatile LAS unsigned* st; };
__device__ __forceinline__ XcdBarrier xcd_barrier_post(unsigned* bar, volatile LAS unsigned* st) {
    XcdBarrier b; b.bar = bar; b.x = xb_xcc_id(); b.st = st;
    if (threadIdx.x == 0) (void)xb_add(&bar[XB_XCNT(b.x)], 1u);
    return b;
}
__device__ __forceinline__ void xcd_barrier_complete(unsigned* bar, unsigned x, unsigned& nloc, unsigned& nx) {
    const unsigned G = gridDim.x * gridDim.y * gridDim.z;
    unsigned sum, cnt, mine, sp = 0u;
    for (;;) {
        sum = 0u; cnt = 0u; mine = 0u;
#pragma unroll
        for (unsigned j = 0; j < 16; ++j) { const unsigned c = xb_ld(&bar[XB_XCNT(j)]); sum += c; cnt += (c > 0u) ? 1u : 0u; mine = (j == x) ? c : mine; }
        if (sum == G) break;
        __builtin_amdgcn_s_sleep(1);
        if ((++sp & 255u) == 0u) { if (xb_ld(&bar[XB_TMO])) break; if (sp > XB_SPIN_CAP) { atomicAdd(&bar[XB_TMO], 1u); break; } }
    }
    nloc = mine > 0u ? mine : 1u; nx = cnt > 0u ? cnt : 1u;
}
__device__ __forceinline__ void xcd_barrier(const XcdBarrier& b0) {
    asm volatile("s_waitcnt vmcnt(0)" ::: "memory");
    __syncthreads();
    XcdBarrier b = b0;
    { unsigned long long p = (unsigned long long)b0.bar; unsigned xx = b0.x; asm volatile("" : "+s"(p), "+s"(xx)); b.bar = (unsigned*)p; b.x = xx; }
    if (threadIdx.x == 0) {
        unsigned* bar = b.bar;
        __builtin_amdgcn_s_waitcnt(0);
        unsigned nloc = b.st[0], nx = b.st[1];
        if (nloc == 0u) { xcd_barrier_complete(bar, b.x, nloc, nx); b.st[0] = nloc; b.st[1] = nx; }
        const unsigned old = xb_add(&bar[XB_XSUB(b.x)], 1u);
        const unsigned gen = old / nloc;
        if (old + 1u == (gen + 1u) * nloc) {
            __builtin_amdgcn_fence(__ATOMIC_RELEASE, "agent");
            asm volatile("s_waitcnt vmcnt(0)" ::: "memory");
            const unsigned og = xb_add(&bar[XB_TOP], 1u);
            const unsigned tg = og / nx;
            if (og + 1u == (tg + 1u) * nx) xb_add(&bar[XB_TOPGEN], 1u);
            else XB_SPIN(xb_ld(&bar[XB_TOPGEN]) == tg, bar);
            __builtin_amdgcn_fence(__ATOMIC_ACQUIRE, "agent");
            xb_add(&bar[XB_XGEN(b.x)], 1u);
            asm volatile("s_waitcnt vmcnt(0)" ::: "memory");
        } else {
            XB_SPIN(xb_ld(&bar[XB_XGEN(b.x)]) == gen, bar);
            __builtin_amdgcn_fence(__ATOMIC_ACQUIRE, "agent");
            asm volatile("s_waitcnt vmcnt(0)" ::: "memory");
        }
    }
    __syncthreads();
}

__device__ __forceinline__ void convert_item(Ctx& F, int l, int wi) {
    LAS float* scr = (LAS float*)(F.lds + F.wave * 8704);
    if (MOE_FP8) {
        if (wi < CV_GU) { const int le = l * NE + (wi >> 10); tr_item8<2>(F.inp(I_WGU) + (size_t)le * D * 2 * FF, D, 2 * FF, (unsigned char*)F.WguT() + (size_t)le * 2 * FF * D, scr, wi & 1023, F.lane); }
        else { const int r = wi - CV_GU; const int le = l * NE + (r >> 9); tr_item8<0>(F.inp(I_WD) + (size_t)le * FF * D, FF, D, (unsigned char*)F.WdT() + (size_t)le * D * FF, scr, r & 511, F.lane); }
        return;
    }
    if (wi < CV_GU) { const int le = l * NE + (wi >> 10); tr_item<2>(F.inp(I_WGU) + (size_t)le * D * 2 * FF, D, 2 * FF, F.WguT() + (size_t)le * 2 * FF * D, scr, wi & 1023, F.lane); }
    else { const int r = wi - CV_GU; const int le = l * NE + (r >> 9); tr_item<0>(F.inp(I_WD) + (size_t)le * FF * D, FF, D, F.WdT() + (size_t)le * D * FF, scr, r & 511, F.lane); }
}
__device__ __forceinline__ bool convert_next(Ctx& F, volatile LAS unsigned* prog, int pmax) {
    const int p = (int)prog[F.wave];
    if (p >= pmax) return false;
    convert_item(F, p / CV_PER_WAVE, (F.bid * NWAVES + F.wave) + 2048 * (p % CV_PER_WAVE));
    if (F.lane == 0) prog[F.wave] = (unsigned)(p + 1);
    return true;
}
__device__ __forceinline__ void drain_convert(Ctx& F, int l, volatile LAS unsigned* prog) {
    while (convert_next(F, prog, CV_PER_WAVE * (l + 1))) {}
}
__device__ __forceinline__ void xcd_barrier_steal(const XcdBarrier& b0, Ctx& F, volatile LAS unsigned* fl, volatile LAS unsigned* prog) {
    asm volatile("s_waitcnt vmcnt(0)" ::: "memory");
    __syncthreads();
    XcdBarrier b = b0;
    { unsigned long long p = (unsigned long long)b0.bar; unsigned xx = b0.x; asm volatile("" : "+s"(p), "+s"(xx)); b.bar = (unsigned*)p; b.x = xx; }
    unsigned* bar = b.bar;
    if (threadIdx.x == 0) {
        __builtin_amdgcn_s_waitcnt(0);
        unsigned nloc = b.st[0], nx = b.st[1];
        if (nloc == 0u) { xcd_barrier_complete(bar, b.x, nloc, nx); b.st[0] = nloc; b.st[1] = nx; }
        const unsigned old = xb_add(&bar[XB_XSUB(b.x)], 1u);
        const unsigned gen = old / nloc;
        if (old + 1u == (gen + 1u) * nloc) {
            __builtin_amdgcn_fence(__ATOMIC_RELEASE, "agent");
            asm volatile("s_waitcnt vmcnt(0)" ::: "memory");
            const unsigned og = xb_add(&bar[XB_TOP], 1u);
            const unsigned tg = og / nx;
            if (og + 1u == (tg + 1u) * nx) xb_add(&bar[XB_TOPGEN], 1u);
            else XB_SPIN(xb_ld(&bar[XB_TOPGEN]) == tg, bar);
            __builtin_amdgcn_fence(__ATOMIC_ACQUIRE, "agent");
            xb_add(&bar[XB_XGEN(b.x)], 1u);
            asm volatile("s_waitcnt vmcnt(0)" ::: "memory");
            fl[0] = 1u;
        } else { fl[0] = 0u; fl[1] = gen; }
    }
    __syncthreads();
    if (fl[0] == 0u) {
        const unsigned gen = fl[1];
        unsigned sp = 0u;
        for (;;) {
            unsigned rel = 0u;
            if (F.lane == 0) { rel = (xb_ld(&bar[XB_XGEN(b.x)]) != gen) ? 1u : 0u;
                if (!rel && (++sp & 63u) == 0u) { if (xb_ld(&bar[XB_TMO])) rel = 1u; else if (sp > XB_SPIN_CAP) { atomicAdd(&bar[XB_TMO], 1u); rel = 1u; } } }
            rel = (unsigned)__builtin_amdgcn_readfirstlane((int)rel);
            if (rel) break;
            if (!convert_next(F, prog, CV_PER_WAVE * NL)) __builtin_amdgcn_s_sleep(2);
        }
        asm volatile("s_waitcnt vmcnt(0)" ::: "memory");
        __syncthreads();
        if (threadIdx.x == 0) { __builtin_amdgcn_fence(__ATOMIC_ACQUIRE, "agent"); asm volatile("s_waitcnt vmcnt(0)" ::: "memory"); }
    }
    __syncthreads();
}

constexpr int LDS_BYTES = 147456;
constexpr int MISC_OFF = 147456 - 256;

__global__ void __launch_bounds__(NTHR, 2) fwd(Args args) {
    extern __shared__ __attribute__((aligned(16))) unsigned char lds[];
    Ctx F0;
    F0.lds = (LAS unsigned char*)lds;
    F0.tid = threadIdx.x; F0.lane = F0.tid & 63; F0.wave = __builtin_amdgcn_readfirstlane(F0.tid >> 6); F0.G = gridDim.x; F0.bid = blockIdx.x;
    F0.in = args.in; F0.out = args.out; F0.ws = args.ws;
    volatile LAS unsigned* MISC = (volatile LAS unsigned*)(F0.lds + MISC_OFF);
    if (F0.tid < 64) MISC[F0.tid] = 0u;
    __syncthreads();
    XcdBarrier bar; bar.bar = (unsigned*)(F0.ctl() + CW_BAR); bar.x = 0; bar.st = nullptr;
    if (MK_N_LAUNCHES == 1) bar = xcd_barrier_post((unsigned*)(F0.ctl() + CW_BAR), MISC + 8);
    const int lo = args.ph_lo, hi = args.ph_hi;
#define IN(k) (lo <= (k) && (k) < hi)
#define SEAM(k) do { if (IN(k) && IN((k) + 1)) { Ctx F = fresh(F0); xcd_barrier_steal(bar, F, MISC + 16, MISC + 24); } } while (0)
#define SEAM_S(k) SEAM(k)
#define PH(k, ...) do { if (IN(k)) { Ctx F = fresh(F0); __VA_ARGS__; } } while (0)

    PH(0, REPEAT(REP_PRO, ph_prologue(F))); SEAM(0);
    for (int l = 0; l < NL; ++l) {
        const int pb = 1 + 9 * l;
        PH(pb + 0, ph_norm1(F, l); if (REP_N10 > 1 && l == 0) ph_norm1(F, l)); SEAM(pb + 0);
        PH(pb + 1, REPEAT(REP_INP, if (FAST_GEMM) ph_inproj_fast(F, l); else ph_inproj_naive(F, l))); SEAM_S(pb + 1);
        if (FAST_ATTN) PH(pb + 2, REPEAT(REP_ATT, ph_attn_fast(F, l))); else PH(pb + 2, ph_attn_naive(F, l));
        if (FAST_LRU) PH(pb + 2, REPEAT(REP_LA, ph_lru_fast<false>(F, l))); else PH(pb + 2, ph_lru_gates_naive(F, l));
        if (FAST_HG) PH(pb + 2, REPEAT(REP_HA, ph_hgrn_fast<false>(F, l)));
        SEAM(pb + 2);
        if (FAST_LRU) PH(pb + 3, REPEAT(REP_CAR, ph_lru_carry(F))); else PH(pb + 3, ph_lru_scan_naive(F));
        if (FAST_HG) PH(pb + 3, REPEAT(REP_CAR, ph_hgrn_carry(F))); else PH(pb + 3, ph_hgrn_scan_naive(F, l));
        SEAM_S(pb + 3);
        if (FAST_LRU) PH(pb + 4, REPEAT(REP_LC, ph_lru_fast<true>(F, l))); else PH(pb + 4, ph_lru_out_naive(F, l));
        if (FAST_HG) PH(pb + 4, REPEAT(REP_HC, ph_hgrn_fast<true>(F, l))); else PH(pb + 4, ph_hgrn_out_naive(F, l));
        SEAM(pb + 4);
        PH(pb + 5, if (FAST_GEMM) ph_outproj_fast(F, l); else ph_outproj_naive(F, l); if (REP_OP0 > 1) ph_outproj_fast(F, l)); SEAM_S(pb + 5);
        PH(pb + 6, ph_norm2_router(F, l); __syncthreads(); drain_convert(F, l, MISC + 24)); SEAM(pb + 6);
        PH(pb + 7, REPEAT(REP_GU, if (FAST_GEMM) ph_moe_gu_fast(F, l); else ph_moe_gu_naive(F, l))); SEAM_S(pb + 7);
        PH(pb + 8, REPEAT(REP_DN, if (FAST_GEMM) ph_moe_down_fast(F, l); else ph_moe_down_naive(F, l))); SEAM_S(pb + 8);
    }
    PH(19, REPEAT(REP_FIN, ph_norm1(F, 2)));
#undef PH
#undef IN
#undef SEAM_S
#undef SEAM
}

extern "C" void kernel_launch(void* const* d_in, const int* in_sizes, int n_in, void* d_out, int out_size, void* d_ws, size_t ws_size, hipStream_t stream) {
    static int grid = 0;
    if (grid == 0) {
        if (n_in != 27 || out_size != ML * D || ws_size < WS_END) { fprintf(stderr, "kernel_launch: unexpected shapes (n_in %d out %d ws %zu)\n", n_in, out_size, ws_size); grid = -1; return; }
        int dev = 0, cus = 0, per_cu = 0;
        if (hipGetDevice(&dev) != hipSuccess || hipDeviceGetAttribute(&cus, hipDeviceAttributeMultiprocessorCount, dev) != hipSuccess) { grid = -1; return; }
        if (hipFuncSetAttribute((const void*)fwd, hipFuncAttributeMaxDynamicSharedMemorySize, LDS_BYTES) != hipSuccess) { fprintf(stderr, "kernel_launch: hipFuncSetAttribute failed\n"); grid = -1; return; }
        if (hipOccupancyMaxActiveBlocksPerMultiprocessor(&per_cu, (const void*)fwd, NTHR, LDS_BYTES) != hipSuccess || per_cu < 1) { fprintf(stderr, "kernel_launch: occupancy query says %d\n", per_cu); }
        (void)hipGetLastError();
        grid = cus;
        if (grid != 256) { fprintf(stderr, "kernel_launch: built for a 256-CU device (got %d)\n", cus); grid = -1; return; }
    }
    if (grid < 0) return;
    (void)hipMemsetAsync((char*)d_ws + WS_CTL, 0, CTL_ZERO_BYTES, stream);
    Args a{};
    for (int i = 0; i < 27; ++i) a.in[i] = (const float*)d_in[i];
    a.out = (float*)d_out; a.ws = (unsigned char*)d_ws;
    if (MK_N_LAUNCHES == 1) { a.ph_lo = 0; a.ph_hi = N_PH; hipLaunchKernelGGL(fwd, dim3(grid), dim3(NTHR), LDS_BYTES, stream, a); }
    else for (int p = 0; p < N_PH; ++p) { a.ph_lo = p; a.ph_hi = p + 1; hipLaunchKernelGGL(fwd, dim3(grid), dim3(NTHR), LDS_BYTES, stream, a); }
}
```

```cpp
#include <hip/hip_runtime.h>
#include <stdint.h>
#include <stdio.h>

#ifndef MK_N_LAUNCHES
#define MK_N_LAUNCHES 1
#endif

#ifndef MOE_FP8
#define MOE_FP8 1
#endif
#ifndef Y2_FP8
#define Y2_FP8 1
#endif
#ifndef FAST_GEMM
#define FAST_GEMM 1
#endif
#ifndef REP_PRO
#define REP_PRO 1
#endif
#ifndef REP_INP
#define REP_INP 1
#endif
#ifndef REP_ATT
#define REP_ATT 1
#endif
#ifndef REP_LA
#define REP_LA 1
#endif
#ifndef REP_HA
#define REP_HA 1
#endif
#ifndef REP_LC
#define REP_LC 1
#endif
#ifndef REP_HC
#define REP_HC 1
#endif
#ifndef REP_N10
#define REP_N10 1
#endif
#ifndef REP_FIN
#define REP_FIN 1
#endif
#ifndef REP_OP0
#define REP_OP0 1
#endif
#ifndef REP_RT
#define REP_RT 1
#endif
#ifndef REP_CAR
#define REP_CAR 1
#endif
#ifndef REP_GU
#define REP_GU 1
#endif
#ifndef REP_DN
#define REP_DN 1
#endif
#define REPEAT(n, ...) do { _Pragma("unroll 1") for (int rep_ = 0; rep_ < (n); ++rep_) { __VA_ARGS__; } } while (0)
#ifndef FAST_ATTN
#define FAST_ATTN 1
#endif
#ifndef FAST_LRU
#define FAST_LRU 1
#endif
#ifndef FAST_HG
#define FAST_HG 1
#endif
#define GAS __attribute__((address_space(1)))
#define LAS __attribute__((address_space(3)))
typedef unsigned short bf16;
typedef short bf16x8 __attribute__((ext_vector_type(8)));
typedef float f32x4 __attribute__((ext_vector_type(4)));
typedef float f32x2 __attribute__((ext_vector_type(2)));
typedef float f32x16 __attribute__((ext_vector_type(16)));
typedef unsigned u32x4 __attribute__((ext_vector_type(4)));
typedef unsigned u32x2 __attribute__((ext_vector_type(2)));
typedef GAS unsigned gu32;

constexpr int D = 1024, NB = 2, SEQ = 16384, CTXL = 256, NL = 2;
constexpr int ML = NB * SEQ, MC = NB * CTXL, MA = ML + MC;
constexpr int INW = 2560;
constexpr int C_Q = 0, C_K = 512, C_V = 640, C_LX = 768, C_LG = 1024, C_HQ = 1280, C_HF = 1536, C_HB = 1792, C_HV = 2048, C_HO = 2304;
constexpr int NE = 32, FF = 1024, CAP = MA;
constexpr float EPS = 1e-6f;
constexpr float LOG2E = 1.4426950408889634f;
constexpr float QSCALE = 0.125f * LOG2E;
constexpr int NWAVES = 8, NTHR = 512;
constexpr int N_PH = 20;

constexpr size_t MiB = 1u << 20;
constexpr size_t WS_CTL = 0, CTL_ZERO_BYTES = 65536;
constexpr size_t WS_MODS = 1 * MiB;
constexpr size_t WS_ROPE = 2 * MiB;
constexpr size_t WS_LRUW = 3 * MiB;
constexpr size_t WS_WIN = 4 * MiB;
constexpr size_t WS_WOUT = 16 * MiB;
constexpr size_t WS_WGU = 20 * MiB;
constexpr size_t WS_WD = 276 * MiB;
constexpr size_t WS_XL = 404 * MiB;
constexpr size_t WS_H1 = 534 * MiB;
constexpr size_t WS_P = 599 * MiB;
constexpr size_t WS_VT = 762 * MiB;
constexpr size_t WS_MIX = 771 * MiB;
constexpr size_t WS_HD = 836 * MiB;
constexpr size_t WS_OHG = 901 * MiB;
constexpr size_t WS_GA = 966 * MiB;
constexpr size_t WS_GB = 1031 * MiB;
constexpr size_t WS_AGG = 1096 * MiB;
constexpr size_t WS_LIST = 1136 * MiB;
constexpr size_t WS_HMOE = 1152 * MiB;
constexpr size_t WS_Y2 = 1428 * MiB;
constexpr size_t WS_QI = 1688 * MiB;
constexpr size_t WS_KI = 1721 * MiB;
constexpr size_t WS_SAGG = 1754 * MiB;
constexpr size_t WS_SIN = 1788 * MiB;
constexpr size_t WS_DUMMY = 1823 * MiB;
constexpr size_t WS_END = 1824 * MiB;
constexpr size_t Y2_DUMMY_ROW = (WS_DUMMY - WS_Y2) / (D * ((Y2_FP8 && MOE_FP8) ? 1 : 2));
constexpr size_t VT_CTX_OFF = (size_t)NB * 2 * 64 * SEQ;
constexpr int CW_CNT = 64;
constexpr int CW_BAR = 4096;

__device__ __forceinline__ float bf2f(bf16 x) { return __uint_as_float(((unsigned)x) << 16); }
__device__ __forceinline__ unsigned pk2(float lo, float hi) { unsigned r; asm("v_cvt_pk_bf16_f32 %0, %1, %2" : "=v"(r) : "v"(lo), "v"(hi)); return r; }
__device__ __forceinline__ unsigned f2bf(float f) { return pk2(f, f) & 0xffffu; }
__device__ __forceinline__ float shx(float v, int mask, int lane) { return __int_as_float(__builtin_amdgcn_ds_bpermute((lane ^ mask) << 2, __float_as_int(v))); }
__device__ __forceinline__ float wave_sum(float v, int lane) {
#pragma unroll
    for (int o = 1; o < 64; o <<= 1) v += shx(v, o, lane);
    return v;
}
__device__ __forceinline__ float wave_max(float v, int lane) {
#pragma unroll
    for (int o = 1; o < 64; o <<= 1) v = fmaxf(v, shx(v, o, lane));
    return v;
}
__device__ __forceinline__ float frcp(float x) { return __builtin_amdgcn_rcpf(x); }
__device__ __forceinline__ float sigmoidf_(float x) { return frcp(1.0f + __expf(-x)); }
__device__ __forceinline__ float siluf_(float x) { return x * frcp(1.0f + __expf(-x)); }
__device__ __forceinline__ float gelu_tanh(float x) { const float u = 0.7978845608028654f * (x + 0.044715f * x * x * x); const float t = 1.0f - 2.0f * frcp(__expf(2.0f * u) + 1.0f); return 0.5f * x * (1.0f + t); }
__device__ __forceinline__ unsigned pk_fp8x4(float a, float b, float c, float d) { int w = 0; w = __builtin_amdgcn_cvt_pk_fp8_f32(a, b, w, false); w = __builtin_amdgcn_cvt_pk_fp8_f32(c, d, w, true); return (unsigned)w; }
constexpr float Y2_SCALE = 16.0f;
constexpr float W8_SCALE = 64.0f;
__device__ __forceinline__ int crow(int r, int hi) { return (r & 3) + 8 * (r >> 2) + 4 * hi; }

struct Args { const float* in[27]; float* out; unsigned char* ws; int ph_lo, ph_hi; };
struct Ctx {
    LAS unsigned char* lds;
    int tid, lane, wave, G, bid;
    const float* const* in;
    float* out; unsigned char* ws;
#define WSACC(T, name, off) __device__ __forceinline__ T* name() const { return (T*)(ws + (off)); }
    WSACC(gu32, ctl, WS_CTL) WSACC(float, mods, WS_MODS) WSACC(f32x2, rope, WS_ROPE) WSACC(bf16, lruw, WS_LRUW) WSACC(bf16, WinT, WS_WIN) WSACC(bf16, WoutT, WS_WOUT)
    WSACC(bf16, WguT, WS_WGU) WSACC(bf16, WdT, WS_WD) WSACC(bf16, XL, WS_XL) WSACC(bf16, H1, WS_H1) WSACC(bf16, P, WS_P) WSACC(bf16, Vt, WS_VT) WSACC(bf16, MIX, WS_MIX)
    WSACC(float, HD, WS_HD) WSACC(float, OHG, WS_OHG) WSACC(float, GA, WS_GA) WSACC(float, GB, WS_GB) WSACC(float, AGG, WS_AGG)
    WSACC(int, list_tok, WS_LIST) WSACC(int, list_dst, WS_LIST + (size_t)NE * CAP * 4) WSACC(float, list_gate, WS_LIST + (size_t)NE * CAP * 8)
    WSACC(bf16, HMOE, WS_HMOE) WSACC(bf16, Y2, WS_Y2)
    __device__ __forceinline__ bf16* ws_bf16(size_t off) const { return (bf16*)(ws + off); }
    __device__ __forceinline__ const float* inp(int i) const { return (const float*)(const GAS float*)in[i]; }
    __device__ __forceinline__ float* outp() const { return (float*)(GAS float*)out; }
#undef WSACC
};
__device__ __forceinline__ Ctx fresh(const Ctx& F0) {
    Ctx F = F0; int wv = F0.wave, g = F0.G, bi = F0.bid; asm volatile("" : "+s"(wv), "+s"(g), "+s"(bi));
    int ln; asm volatile("v_mbcnt_lo_u32_b32 %0, -1, 0\n\tv_mbcnt_hi_u32_b32 %0, -1, %0" : "=v"(ln));
    F.wave = wv; F.lane = ln; F.tid = wv * 64 + ln; F.G = g; F.bid = bi;
    unsigned long long w = (unsigned long long)F0.ws;
    asm volatile("" : "+s"(w)); F.ws = (unsigned char*)(GAS unsigned char*)w;
    return F;
}
enum { I_X = 0, I_C, I_CTX, I_CCTX, I_ADAW, I_ADAB, I_N1G, I_WIN, I_SINK, I_CONVW, I_CONVB, I_WR, I_BR, I_WI, I_BI, I_LAM, I_LBL, I_HNG, I_WOUT, I_N2G, I_RW, I_RB, I_WGU, I_BGU, I_WD, I_BD, I_FG };

__device__ __forceinline__ int row_b(int m) { return m < ML ? m / SEQ : (m - ML) / CTXL; }
__device__ __forceinline__ int row_t(int m) { return m < ML ? m % SEQ : (m - ML) % CTXL; }
__device__ __forceinline__ int mod_row(int m) { return m < ML ? m / SEQ : 2; }

__device__ __forceinline__ int dest_win(int n) {
    if (n >= C_V) return n;
    const int d = n & 63, p = d >> 5, half = (d >> 4) & 1, f = d & 15;
    return (n & ~63) + 2 * (p * 16 + f) + half;
}
__device__ __forceinline__ int dest_gu(int n) {
    const int up = n >= FF ? 1 : 0, ff = n & (FF - 1);
    return (ff >> 7) * 256 + up * 128 + (ff & 127);
}
template <int MAP>
__device__ __forceinline__ void tr_item(const float* W, int K, int N, bf16* WT, LAS float* scr, int item, int lane) {
    const int nblk = N / 32, kb = item / nblk, nb = item % nblk, k0 = 64 * kb, n0 = 32 * nb;
#pragma unroll 8
    for (int i = 0; i < 32; ++i) { const int kk = 2 * i + (lane >> 5); scr[kk * 33 + (lane & 31)] = W[(size_t)(k0 + kk) * N + n0 + (lane & 31)]; }
    asm volatile("s_waitcnt lgkmcnt(0)" ::: "memory");
    const int c = lane & 7;
#pragma unroll
    for (int j = 0; j < 4; ++j) {
        const int n = (lane >> 3) + 8 * j; const LAS float* s = scr + (8 * c) * 33 + n;
        u32x4 o; o.x = pk2(s[0 * 33], s[1 * 33]); o.y = pk2(s[2 * 33], s[3 * 33]); o.z = pk2(s[4 * 33], s[5 * 33]); o.w = pk2(s[6 * 33], s[7 * 33]);
        const int nn = n0 + n; const int dr = MAP == 1 ? dest_win(nn) : (MAP == 2 ? dest_gu(nn) : nn);
        *(u32x4*)(WT + (size_t)dr * K + k0 + 8 * c) = o;
    }
    asm volatile("s_waitcnt lgkmcnt(0)" ::: "memory");
}
template <int MAP>
__device__ __forceinline__ void tr_item8(const float* W, int K, int N, unsigned char* WT, LAS float* scr, int item, int lane) {
    const int nblk = N / 32, kb = item / nblk, nb = item % nblk, k0 = 64 * kb, n0 = 32 * nb;
#pragma unroll 8
    for (int i = 0; i < 32; ++i) { const int kk = 2 * i + (lane >> 5); scr[kk * 33 + (lane & 31)] = W[(size_t)(k0 + kk) * N + n0 + (lane & 31)]; }
    asm volatile("s_waitcnt lgkmcnt(0)" ::: "memory");
    const int c = lane & 7;
#pragma unroll
    for (int j = 0; j < 4; ++j) {
        const int n = (lane >> 3) + 8 * j; const LAS float* s = scr + (8 * c) * 33 + n;
        u32x2 o; o.x = pk_fp8x4(s[0 * 33] * W8_SCALE, s[1 * 33] * W8_SCALE, s[2 * 33] * W8_SCALE, s[3 * 33] * W8_SCALE); o.y = pk_fp8x4(s[4 * 33] * W8_SCALE, s[5 * 33] * W8_SCALE, s[6 * 33] * W8_SCALE, s[7 * 33] * W8_SCALE);
        const int nn = n0 + n; const int dr = MAP == 2 ? dest_gu(nn) : nn;
        *(u32x2*)(WT + (size_t)dr * K + k0 + 8 * c) = o;
    }
    asm volatile("s_waitcnt lgkmcnt(0)" ::: "memory");
}
__device__ __forceinline__ void tr_load(const float* W, int N, int item, int lane, float (&r)[32]) {
    const int nblk = N / 32, kb = item / nblk, nb = item % nblk, k0 = 64 * kb, n0 = 32 * nb;
    const float* p = W + (size_t)(k0 + (lane >> 5)) * N + n0 + (lane & 31);
#pragma unroll
    for (int i = 0; i < 32; ++i) r[i] = p[(size_t)(2 * i) * N];
}
template <int MAP>
__device__ __forceinline__ void tr_finish(int K, int N, bf16* WT, LAS float* scr, int item, int lane, const float (&r)[32]) {
    const int nblk = N / 32, kb = item / nblk, nb = item % nblk, k0 = 64 * kb, n0 = 32 * nb;
#pragma unroll
    for (int i = 0; i < 32; ++i) scr[(2 * i + (lane >> 5)) * 33 + (lane & 31)] = r[i];
    asm volatile("s_waitcnt lgkmcnt(0)" ::: "memory");
    const int c = lane & 7;
#pragma unroll
    for (int j = 0; j < 4; ++j) {
        const int n = (lane >> 3) + 8 * j; const LAS float* s = scr + (8 * c) * 33 + n;
        u32x4 o; o.x = pk2(s[0 * 33], s[1 * 33]); o.y = pk2(s[2 * 33], s[3 * 33]); o.z = pk2(s[4 * 33], s[5 * 33]); o.w = pk2(s[6 * 33], s[7 * 33]);
        const int nn = n0 + n; const int dr = MAP == 1 ? dest_win(nn) : (MAP == 2 ? dest_gu(nn) : nn);
        *(u32x4*)(WT + (size_t)dr * K + k0 + 8 * c) = o;
    }
    asm volatile("s_waitcnt lgkmcnt(0)" ::: "memory");
}
__device__ __forceinline__ void ph_prologue(Ctx& F) {
    LAS float* scr = (LAS float*)(F.lds + F.wave * 8704);
    const int gw = F.bid * NWAVES + F.wave, NGW = F.G * NWAVES;
    constexpr int I_IN = 16 * 80, I_OUT = 16 * 32;
    constexpr int N_IN = NL * I_IN, N_OUT = NL * I_OUT;
    for (int it = gw; it < N_IN + N_OUT; it += NGW) {
        int r = it;
        if (r < N_IN) { const int l = r / I_IN; tr_item<1>(F.inp(I_WIN) + (size_t)l * D * INW, D, INW, F.WinT() + (size_t)l * INW * D, scr, r % I_IN, F.lane); continue; } r -= N_IN;
        { const int l = r / I_OUT; tr_item<0>(F.inp(I_WOUT) + (size_t)l * D * D, D, D, F.WoutT() + (size_t)l * D * D, scr, r % I_OUT, F.lane); }
    }
    const int gt = F.bid * NTHR + F.tid, NGT = F.G * NTHR;
    for (int i = gt; i < NL * 2 * 2 * 4 * 4096; i += NGT) {
        const int c = i & 63, dd = (i >> 6) & 63, n = (i >> 12) & 3, g = (i >> 14) & 1, d = (i >> 15) & 1, l = i >> 16;
        const float* src = g ? F.inp(I_WI) : F.inp(I_WR);
        F.lruw()[i] = (bf16)f2bf(src[((((size_t)l * 2 + d) * 4 + n) * 64 + c) * 64 + dd]);
    }
    for (int i = gt; i < 256 * 16; i += NGT) {
        const int pos = i >> 4, f = i & 15;
        const float invf[16] = {1.000000000e+00f, 5.623413324e-01f, 3.162277639e-01f, 1.778279394e-01f, 1.000000015e-01f, 5.623413250e-02f, 3.162277490e-02f, 1.778279431e-02f,
                                9.999999776e-03f, 5.623413250e-03f, 3.162277630e-03f, 1.778279431e-03f, 1.000000047e-03f, 5.623413017e-04f, 3.162277571e-04f, 1.778279402e-04f};
        float fr = 1.0f;
#pragma unroll
        for (int q = 0; q < 16; ++q) fr = (f == q) ? invf[q] : fr;
        const float ang = (float)pos * fr;
        double rev = (double)ang * 0.15915494309189535; rev -= floor(rev);
        F.rope()[i] = (f32x2){__builtin_amdgcn_cosf((float)rev), __builtin_amdgcn_sinf((float)rev)};
    }
    LAS float* cond = (LAS float*)(F.lds + 72 * 1024);
    LAS float* red = (LAS float*)(F.lds + 88 * 1024);
    __syncthreads();
    for (int i = F.tid; i < 3 * D; i += NTHR) { const int r = i / D, k = i % D; const float v = r < 2 ? F.inp(I_C)[r * D + k] : F.inp(I_CCTX)[k]; cond[i] = siluf_(v); }
    __syncthreads();
    for (int unit = F.bid; unit < NL * 192; unit += F.G) {
        const int l = unit / 192, col0 = (unit % 192) * 32, cl = F.tid & 31, ks = F.tid >> 5;
        const float* W = F.inp(I_ADAW) + (size_t)l * D * 6 * D + col0 + cl;
        float a0 = 0.f, a1 = 0.f, a2 = 0.f;
#pragma unroll 8
        for (int k = ks * 64; k < ks * 64 + 64; ++k) { const float w = W[(size_t)k * 6 * D]; a0 += cond[k] * w; a1 += cond[D + k] * w; a2 += cond[2 * D + k] * w; }
        red[(ks * 3 + 0) * 32 + cl] = a0; red[(ks * 3 + 1) * 32 + cl] = a1; red[(ks * 3 + 2) * 32 + cl] = a2;
        __syncthreads();
        if (F.tid < 96) { const int i = F.tid >> 5; float s = F.inp(I_ADAB)[l * 6 * D + col0 + cl];
            for (int q = 0; q < 16; ++q) s += red[(q * 3 + i) * 32 + cl];
            F.mods()[((size_t)l * 3 + i) * 6 * D + col0 + cl] = s; }
        __syncthreads();
    }
}

__device__ __forceinline__ void ph_norm1(Ctx& F, int l) {
    const int gw = F.bid * NWAVES + F.wave, NGW = F.G * NWAVES;
    const int M = (l == 2) ? ML : MA;
    for (int m = gw; m < M; m += NGW) {
        const int mr = mod_row(m);
        f32x4 v[4];
        if (l == 0) { const float* src = m < ML ? F.inp(I_X) + (size_t)m * D : F.inp(I_CTX) + (size_t)(m - ML) * D;
#pragma unroll
            for (int j = 0; j < 4; ++j) v[j] = *(const f32x4*)(src + 4 * F.lane + 256 * j); }
        else {
#pragma unroll
            for (int j = 0; j < 4; ++j) { const u32x2 w = *(const u32x2*)(F.XL() + (size_t)m * D + 4 * F.lane + 256 * j);
                v[j] = (f32x4){__uint_as_float(w.x << 16), __uint_as_float(w.x & 0xffff0000u), __uint_as_float(w.y << 16), __uint_as_float(w.y & 0xffff0000u)}; } }
        if (l > 0) {
            const float* g5 = F.mods() + ((size_t)(l - 1) * 3 + mr) * 6 * D + 5 * D;
#pragma unroll
            for (int j = 0; j < 4; ++j) {
                const int col = 4 * F.lane + 256 * j; f32x4 s = {0.f, 0.f, 0.f, 0.f};
#pragma unroll
                for (int q = 0; q < 4; ++q) {
                    if (Y2_FP8 && MOE_FP8) { const unsigned w = *(const unsigned*)((const unsigned char*)F.Y2() + ((size_t)m * 4 + q) * D + col);
                        const f32x2 lo = __builtin_amdgcn_cvt_pk_f32_fp8((int)w, false), hi = __builtin_amdgcn_cvt_pk_f32_fp8((int)w, true);
                        s.x += lo.x; s.y += lo.y; s.z += hi.x; s.w += hi.y; }
                    else { const u32x2 w = *(const u32x2*)(F.Y2() + ((size_t)m * 4 + q) * D + col);
                        s.x += __uint_as_float(w.x << 16); s.y += __uint_as_float(w.x & 0xffff0000u); s.z += __uint_as_float(w.y << 16); s.w += __uint_as_float(w.y & 0xffff0000u); } }
                const f32x4 g = *(const f32x4*)(g5 + col) * ((Y2_FP8 && MOE_FP8) ? (1.0f / Y2_SCALE) : 1.0f);
                v[j] += g * s;
            }
        }
        if (l == 1) {
#pragma unroll
            for (int j = 0; j < 4; ++j) { u32x2 w; w.x = pk2(v[j].x, v[j].y); w.y = pk2(v[j].z, v[j].w); *(u32x2*)(F.XL() + (size_t)m * D + 4 * F.lane + 256 * j) = w; }
        }
        float ss = 0.f;
#pragma unroll
        for (int j = 0; j < 4; ++j) ss += (v[j].x * v[j].x + v[j].y * v[j].y) + (v[j].z * v[j].z + v[j].w * v[j].w);
        const float rstd = 1.0f / sqrtf(wave_sum(ss, F.lane) * (1.0f / D) + EPS);
        if (l == 2) {
#pragma unroll
            for (int j = 0; j < 4; ++j) { const int col = 4 * F.lane + 256 * j; const f32x4 g = *(const f32x4*)(F.inp(I_FG) + col); *(f32x4*)(F.outp() + (size_t)m * D + col) = v[j] * rstd * g; }
        } else {
            const float* mo = F.mods() + ((size_t)l * 3 + mr) * 6 * D;
            const float* g1 = F.inp(I_N1G) + l * D;
#pragma unroll
            for (int j = 0; j < 4; ++j) { const int col = 4 * F.lane + 256 * j;
                const f32x4 g = *(const f32x4*)(g1 + col), sh = *(const f32x4*)(mo + col), sc = *(const f32x4*)(mo + D + col);
                const f32x4 h = v[j] * rstd * g * (sc + 1.0f) + sh;
                u32x2 w; w.x = pk2(h.x, h.y); w.y = pk2(h.z, h.w);
                *(u32x2*)(F.H1() + (size_t)m * D + col) = w; }
        }
    }
}

__device__ __forceinline__ void sg_kloop(f32x16 (&acc)[2][2], const bf16* a0, const bf16* a1, const bf16* b0, const bf16* b1, int K) {
#pragma unroll
    for (int i = 0; i < 2; ++i)
#pragma unroll
        for (int j = 0; j < 2; ++j)
#pragma unroll
            for (int r = 0; r < 16; ++r) acc[i][j][r] = 0.f;
#pragma unroll 4
    for (int k = 0; k < K; k += 16) {
        const bf16x8 fa0 = *(const bf16x8*)(a0 + k), fa1 = *(const bf16x8*)(a1 + k), fb0 = *(const bf16x8*)(b0 + k), fb1 = *(const bf16x8*)(b1 + k);
        acc[0][0] = __builtin_amdgcn_mfma_f32_32x32x16_bf16(fa0, fb0, acc[0][0], 0, 0, 0);
        acc[0][1] = __builtin_amdgcn_mfma_f32_32x32x16_bf16(fa0, fb1, acc[0][1], 0, 0, 0);
        acc[1][0] = __builtin_amdgcn_mfma_f32_32x32x16_bf16(fa1, fb0, acc[1][0], 0, 0, 0);
        acc[1][1] = __builtin_amdgcn_mfma_f32_32x32x16_bf16(fa1, fb1, acc[1][1], 0, 0, 0);
    }
}

__device__ __forceinline__ float inproj_fix(const Ctx& F, int m, int c, float v, float partner) {
    float o = v;
    if (c < C_V) {
        if (m < ML) {
            const int t = m % SEQ, dp = c & 63, pr = dp >> 1, p = pr >> 4, f = pr & 15, pos = p ? (t & 63) : (t >> 6);
            const f32x2 cs = F.rope()[pos * 16 + f];
            o = (dp & 1) ? (partner * cs.y + v * cs.x) : (v * cs.x - partner * cs.y);
        }
        if (c < C_K) o *= QSCALE;
    }
    return o;
}
__device__ __forceinline__ size_t vt_index(int m, int cv  ) {
    const int kvh = cv >> 6, d = cv & 63;
    if (m < ML) { const int b = m / SEQ, t = m % SEQ; return ((size_t)((b * 2 + kvh) * 64 + d)) * SEQ + t; }
    const int b = (m - ML) / CTXL, t = (m - ML) % CTXL; return VT_CTX_OFF + ((size_t)((b * 2 + kvh) * 64 + d)) * CTXL + t;
}
__device__ __forceinline__ void ph_inproj_naive(Ctx& F, int l) {
    const int gw = F.bid * NWAVES + F.wave, NGW = F.G * NWAVES, r = F.lane & 31, h = F.lane >> 5;
    const bf16* Bt = F.WinT() + (size_t)l * INW * D;
    for (int ti = gw; ti < (MA / 64) * (INW / 64); ti += NGW) {
        const int rt = ti / (INW / 64), ct = ti % (INW / 64), m0 = rt * 64, c0 = ct * 64;
        f32x16 acc[2][2];
        sg_kloop(acc, F.H1() + (size_t)(m0 + r) * D + 8 * h, F.H1() + (size_t)(m0 + 32 + r) * D + 8 * h, Bt + (size_t)(c0 + r) * D + 8 * h, Bt + (size_t)(c0 + 32 + r) * D + 8 * h, D);
#pragma unroll
        for (int mt = 0; mt < 2; ++mt)
#pragma unroll
            for (int nt = 0; nt < 2; ++nt)
#pragma unroll
                for (int q = 0; q < 16; ++q) {
                    const int m = m0 + 32 * mt + crow(q, h), c = c0 + 32 * nt + r;
                    const float v = acc[mt][nt][q], pa = shx(v, 1, F.lane);
                    const float o = inproj_fix(F, m, c, v, pa);
                    F.P()[(size_t)m * INW + c] = (bf16)f2bf(o);
                    if (c >= C_V && c < C_LX) F.Vt()[vt_index(m, c - C_V)] = (bf16)f2bf(o);
                }
    }
}

__device__ __forceinline__ float dot64(const float (&q)[64], const bf16* kp) {
    float s = 0.f;
#pragma unroll
    for (int i = 0; i < 8; ++i) { const u32x4 w = *(const u32x4*)(kp + 8 * i);
        s += q[8 * i + 0] * __uint_as_float(w.x << 16) + q[8 * i + 1] * __uint_as_float(w.x & 0xffff0000u) + q[8 * i + 2] * __uint_as_float(w.y << 16) + q[8 * i + 3] * __uint_as_float(w.y & 0xffff0000u)
           + q[8 * i + 4] * __uint_as_float(w.z << 16) + q[8 * i + 5] * __uint_as_float(w.z & 0xffff0000u) + q[8 * i + 6] * __uint_as_float(w.w << 16) + q[8 * i + 7] * __uint_as_float(w.w & 0xffff0000u); }
    return s;
}
__device__ __forceinline__ void ph_attn_naive(Ctx& F, int l) {
    const int gw = F.bid * NWAVES + F.wave, NGW = F.G * NWAVES;
    const int Mq = (l == 0) ? MA : ML;
    LAS float* pbuf = (LAS float*)(F.lds) + F.wave * 640;
    for (int u = gw; u < Mq * 8; u += NGW) {
        const int m = u >> 3, hq = u & 7, kvh = hq >> 2;
        const bool isc = m >= ML; const int b = row_b(m), t = row_t(m);
        float q[64];
        { const bf16* qp = F.P() + (size_t)m * INW + C_Q + hq * 64;
#pragma unroll
          for (int i = 0; i < 8; ++i) { const u32x4 w = *(const u32x4*)(qp + 8 * i);
              q[8 * i + 0] = __uint_as_float(w.x << 16); q[8 * i + 1] = __uint_as_float(w.x & 0xffff0000u); q[8 * i + 2] = __uint_as_float(w.y << 16); q[8 * i + 3] = __uint_as_float(w.y & 0xffff0000u);
              q[8 * i + 4] = __uint_as_float(w.z << 16); q[8 * i + 5] = __uint_as_float(w.z & 0xffff0000u); q[8 * i + 6] = __uint_as_float(w.w << 16); q[8 * i + 7] = __uint_as_float(w.w & 0xffff0000u); } }
        const int lo = isc ? 0 : (t - 128 < 0 ? 0 : t - 128), hi = isc ? -1 : (t + 128 > SEQ - 1 ? SEQ - 1 : t + 128);
        const int nloc = hi - lo + 1, nk = nloc + CTXL;
        const float sink2 = F.inp(I_SINK)[l * 8 + hq] * LOG2E;
        float s[9]; float mx = sink2;
#pragma unroll
        for (int i = 0; i < 9; ++i) { const int kk = F.lane + 64 * i; s[i] = -3.0e38f;
            if (kk < nk) { const int krow = kk < nloc ? b * SEQ + lo + kk : ML + b * CTXL + (kk - nloc);
                s[i] = dot64(q, F.P() + (size_t)krow * INW + C_K + kvh * 64); mx = fmaxf(mx, s[i]); } }
        mx = wave_max(mx, F.lane);
        float lsum = 0.f;
#pragma unroll
        for (int i = 0; i < 9; ++i) { const int kk = F.lane + 64 * i; const float p = (kk < nk) ? exp2f(s[i] - mx) : 0.f; lsum += p; pbuf[kk] = p; }
        lsum = wave_sum(lsum, F.lane) + exp2f(sink2 - mx);
        asm volatile("s_waitcnt lgkmcnt(0)" ::: "memory");
        float o = 0.f;
        for (int kk = 0; kk < nk; ++kk) { const int krow = kk < nloc ? b * SEQ + lo + kk : ML + b * CTXL + (kk - nloc);
            o += pbuf[kk] * bf2f(F.P()[(size_t)krow * INW + C_V + kvh * 64 + F.lane]); }
        F.MIX()[(size_t)m * D + hq * 64 + F.lane] = (bf16)f2bf(o / lsum);
        asm volatile("s_waitcnt lgkmcnt(0)" ::: "memory");
    }
}
__device__ __forceinline__ void ph_lru_gates_naive(Ctx& F, int l) {
    const size_t gt = (size_t)F.bid * NTHR + F.tid, NGT = (size_t)F.G * NTHR;
    for (size_t i = gt; i < (size_t)MA * 512; i += NGT) {
        const int m = (int)(i >> 9), d = (int)(i >> 8) & 1, c = (int)i & 255, n = c >> 6, cc0 = c & 63;
        const int t = row_t(m), T = m < ML ? SEQ : CTXL, rb = m - t;
        const float* wr = F.inp(I_WR) + (((size_t)l * 2 + d) * 4 + n) * 4096;
        const float* wi = F.inp(I_WI) + (((size_t)l * 2 + d) * 4 + n) * 4096;
        float rp = F.inp(I_BR)[(l * 2 + d) * 256 + c], ip = F.inp(I_BI)[(l * 2 + d) * 256 + c], us = 0.f;
        for (int cc = 0; cc < 64; ++cc) {
            const int ch = n * 64 + cc; float u = F.inp(I_CONVB)[l * 256 + ch];
#pragma unroll
            for (int j = 0; j < 4; ++j) { const int tt = t - 2 + j; if (tt >= 0 && tt < T) u += F.inp(I_CONVW)[(l * 4 + j) * 256 + ch] * bf2f(F.P()[(size_t)(rb + tt) * INW + C_LX + ch]); }
            rp += u * wr[cc * 64 + cc0]; ip += u * wi[cc * 64 + cc0];
            if (cc == cc0) us = u;
        }
        const float r = sigmoidf_(rp), ig = sigmoidf_(ip);
        const float lam = F.inp(I_LAM)[(l * 2 + d) * 256 + c];
        const float la = -8.0f * r * log1pf(expf(-lam));
        const float a = expf(la), mult = sqrtf(fmaxf(-expm1f(2.0f * la), 1e-12f));
        F.GA()[i] = a; F.GB()[i] = mult * ig * us;
    }
}
__device__ __forceinline__ void ph_lru_scan_naive(Ctx& F) {
    const int gt = F.bid * NTHR + F.tid;
    if (gt >= NB * 512) return;
    const int b = gt >> 9, d = (gt >> 8) & 1, c = gt & 255;
    float h = 0.f;
    for (int s = 0; s < CTXL + SEQ; ++s) {
        int m;
        if (s < CTXL) m = ML + b * CTXL + (d ? CTXL - 1 - s : s); else { const int t = s - CTXL; m = b * SEQ + (d ? SEQ - 1 - t : t); }
        const size_t i = (size_t)m * 512 + d * 256 + c;
        h = F.GA()[i] * h + F.GB()[i];
        F.HD()[i] = h;
    }
}
__device__ __forceinline__ void ph_lru_out_naive(Ctx& F, int l) {
    const size_t gt = (size_t)F.bid * NTHR + F.tid, NGT = (size_t)F.G * NTHR;
    const int Mq = (l == 0) ? MA : ML;
    for (size_t i = gt; i < (size_t)Mq * 256; i += NGT) {
        const int m = (int)(i >> 8), c = (int)i & 255;
        const float y = (F.HD()[(size_t)m * 512 + c] + F.HD()[(size_t)m * 512 + 256 + c]) * gelu_tanh(bf2f(F.P()[(size_t)m * INW + C_LG + c]));
        F.MIX()[(size_t)m * D + 512 + c] = (bf16)f2bf(y);
    }
}
__device__ __forceinline__ float hg_lb(const Ctx& F, int l, int d, int hk) {
    if (l == 0) return 0.f;
    const float l0 = F.inp(I_LBL)[(0 * 2 + d) * 256 + hk], l1 = F.inp(I_LBL)[(1 * 2 + d) * 256 + hk];
    return 1.0f / (1.0f + expf(l0 - l1));
}
__device__ __forceinline__ void ph_hgrn_scan_naive(Ctx& F, int l) {
    if (F.bid >= NB * 2 * 4) return;
    const int b = F.bid >> 3, d = (F.bid >> 2) & 1, hh = F.bid & 3;
    const int v = F.tid & 63, kq = F.tid >> 6;
    LAS float* part = (LAS float*)F.lds;
    float lb[8], S[8];
#pragma unroll
    for (int i = 0; i < 8; ++i) { lb[i] = hg_lb(F, l, d, hh * 64 + kq * 8 + i); S[i] = 0.f; }
    int buf = 0;
    for (int s = 0; s < CTXL + SEQ; ++s) {
        int m;
        if (s < CTXL) m = ML + b * CTXL + (d ? CTXL - 1 - s : s); else { const int t = s - CTXL; m = b * SEQ + (d ? SEQ - 1 - t : t); }
        const bf16* pr = F.P() + (size_t)m * INW;
        const u32x4 zw = *(const u32x4*)(pr + (d ? C_HB : C_HF) + hh * 64 + kq * 8), qw = *(const u32x4*)(pr + C_HQ + hh * 64 + kq * 8);
        const float vv = bf2f(pr[C_HV + hh * 64 + v]);
        float z[8], q[8];
        z[0] = __uint_as_float(zw.x << 16); z[1] = __uint_as_float(zw.x & 0xffff0000u); z[2] = __uint_as_float(zw.y << 16); z[3] = __uint_as_float(zw.y & 0xffff0000u);
        z[4] = __uint_as_float(zw.z << 16); z[5] = __uint_as_float(zw.z & 0xffff0000u); z[6] = __uint_as_float(zw.w << 16); z[7] = __uint_as_float(zw.w & 0xffff0000u);
        q[0] = __uint_as_float(qw.x << 16); q[1] = __uint_as_float(qw.x & 0xffff0000u); q[2] = __uint_as_float(qw.y << 16); q[3] = __uint_as_float(qw.y & 0xffff0000u);
        q[4] = __uint_as_float(qw.z << 16); q[5] = __uint_as_float(qw.z & 0xffff0000u); q[6] = __uint_as_float(qw.w << 16); q[7] = __uint_as_float(qw.w & 0xffff0000u);
        float pa = 0.f;
#pragma unroll
        for (int i = 0; i < 8; ++i) { const float sg = sigmoidf_(z[i]); const float f = lb[i] + (1.0f - lb[i]) * sg, kk = (1.0f - lb[i]) * (1.0f - sg);
            S[i] = f * S[i] + kk * vv; pa += S[i] * q[i]; }
        part[(buf * 8 + kq) * 64 + v] = pa;
        __syncthreads();
        if (kq == 0) { float o = 0.f;
#pragma unroll
            for (int i = 0; i < 8; ++i) o += part[(buf * 8 + i) * 64 + v];
            F.OHG()[(size_t)m * 512 + d * 256 + hh * 64 + v] = o; }
        buf ^= 1;
    }
}
__device__ __forceinline__ void ph_hgrn_out_naive(Ctx& F, int l) {
    const int gw = F.bid * NWAVES + F.wave, NGW = F.G * NWAVES;
    const int Mq = (l == 0) ? MA : ML;
    for (int m = gw; m < Mq; m += NGW) {
        const int col = 4 * F.lane;
        const f32x4 a = *(const f32x4*)(F.OHG() + (size_t)m * 512 + col), bb = *(const f32x4*)(F.OHG() + (size_t)m * 512 + 256 + col);
        const f32x4 o = a + bb;
        float ss = (o.x * o.x + o.y * o.y) + (o.z * o.z + o.w * o.w);
        ss += shx(ss, 1, F.lane); ss += shx(ss, 2, F.lane); ss += shx(ss, 4, F.lane); ss += shx(ss, 8, F.lane);
        const float rstd = 1.0f / sqrtf(ss * (1.0f / 64.0f) + EPS);
        const f32x4 g = *(const f32x4*)(F.inp(I_HNG) + l * 256 + col);
        const u32x2 ow = *(const u32x2*)(F.P() + (size_t)m * INW + C_HO + col);
        const float g0 = siluf_(__uint_as_float(ow.x << 16)), g1 = siluf_(__uint_as_float(ow.x & 0xffff0000u)), g2 = siluf_(__uint_as_float(ow.y << 16)), g3 = siluf_(__uint_as_float(ow.y & 0xffff0000u));
        u32x2 w; w.x = pk2(o.x * rstd * g.x * g0, o.y * rstd * g.y * g1); w.y = pk2(o.z * rstd * g.z * g2, o.w * rstd * g.w * g3);
        *(u32x2*)(F.MIX() + (size_t)m * D + 768 + col) = w;
    }
}

constexpr int MIX_NUB = 136, MIX_NU = 272;
constexpr int LRU_NU = MIX_NU;
struct MixUnit { int b, j, rowbase, t0, ntok, T, ub; bool isc; };
__device__ __forceinline__ MixUnit mix_unit(int g) {
    MixUnit m;
    if (g < 256) { m.b = g >> 7; m.j = g & 127; m.isc = false; m.rowbase = m.b * SEQ; m.t0 = m.j * 128; m.ntok = 128; m.T = SEQ; }
    else { const int c = g - 256; m.b = c >> 3; m.j = 128 + (c & 7); m.isc = true; m.rowbase = ML + m.b * CTXL; m.t0 = (c & 7) * 32; m.ntok = 32; m.T = CTXL; }
    m.ub = m.b * MIX_NUB + m.j; return m;
}
constexpr size_t AG_LRU_A = 0, AG_LRU_B = (size_t)LRU_NU * 512, AG_LRU_H = 2 * (size_t)LRU_NU * 512;
constexpr int U_PITCH = 528;
template <bool FULL, int DIR>
__device__ __forceinline__ void lru_wave(Ctx& F, int l, int u, int n, int rowbase, int t0, int nmt) {
    int ln_ = F.lane; asm volatile("" : "+v"(ln_));
    const int r32 = ln_ & 31, h = ln_ >> 5;
    LAS unsigned char* U = F.lds;
    const bf16* wb = F.lruw() + ((((size_t)l * 2 + DIR) * 2) * 4 + n) * 4096;
    float br[2], bi[2], c8[2], hc[2], At[2], Bt[2];
#pragma unroll
    for (int ct = 0; ct < 2; ++ct) { const int c = 64 * n + 32 * ct + r32, ix = (l * 2 + DIR) * 256 + c;
        br[ct] = FULL ? 0.f : F.inp(I_BR)[ix]; bi[ct] = FULL ? 0.f : F.inp(I_BI)[ix]; c8[ct] = FULL ? 0.f : 8.0f * log1pf(expf(-F.inp(I_LAM)[ix]));
        hc[ct] = FULL ? F.AGG()[AG_LRU_H + (size_t)u * 512 + DIR * 256 + c] : 0.f; At[ct] = 1.f; Bt[ct] = 0.f; }
#pragma unroll
    for (int ct = 0; ct < 2; ++ct) {
        const int c = 64 * n + 32 * ct + r32;
        bf16x8 Bg[2][4];
        if (!FULL) {
#pragma unroll
            for (int g = 0; g < 2; ++g) { const bf16* p = wb + (size_t)g * 4 * 4096 + (32 * ct + r32) * 64 + 8 * h;
#pragma unroll
                for (int ks = 0; ks < 4; ++ks) Bg[g][ks] = *(const bf16x8*)(p + 16 * ks); } }
        unsigned pkn[16];
        if (FULL) { const int mt0 = DIR ? nmt - 1 : 0; const size_t g0 = (size_t)(rowbase + t0 + 32 * mt0 + 4 * h) * 512 + DIR * 256 + c;
#pragma unroll
            for (int q = 0; q < 16; ++q) pkn[q] = ((const unsigned*)F.GA())[g0 + (size_t)((q & 3) + 8 * (q >> 2)) * 512]; }
#pragma unroll 1
        for (int mi = 0; mi < nmt; ++mi) {
            const int mt = DIR ? nmt - 1 - mi : mi;
            float a[16], bb[16];
            const size_t gix0 = (size_t)(rowbase + t0 + 32 * mt + 4 * h) * 512 + DIR * 256 + c;
            if (FULL) {
#pragma unroll
                for (int q = 0; q < 16; ++q) { const unsigned pk = pkn[q]; a[q] = 1.0f - __uint_as_float(pk << 16); bb[q] = __uint_as_float(pk & 0xffff0000u); }
                if (mi + 1 < nmt) { const int mtn = DIR ? nmt - 2 - mi : mi + 1; const size_t gn = (size_t)(rowbase + t0 + 32 * mtn + 4 * h) * 512 + DIR * 256 + c;
#pragma unroll
                    for (int q = 0; q < 16; ++q) pkn[q] = ((const unsigned*)F.GA())[gn + (size_t)((q & 3) + 8 * (q >> 2)) * 512]; }
            } else {
                f32x16 acc[2];
#pragma unroll
                for (int g = 0; g < 2; ++g)
#pragma unroll
                    for (int q = 0; q < 16; ++q) acc[g][q] = 0.f;
#pragma unroll
                for (int ks = 0; ks < 4; ++ks) { const bf16x8 af = *(const LAS bf16x8*)(U + (32 * mt + r32) * U_PITCH + (64 * n + 16 * ks + 8 * h) * 2);
                    acc[0] = __builtin_amdgcn_mfma_f32_32x32x16_bf16(af, Bg[0][ks], acc[0], 0, 0, 0); acc[1] = __builtin_amdgcn_mfma_f32_32x32x16_bf16(af, Bg[1][ks], acc[1], 0, 0, 0); }
#pragma unroll
                for (int q = 0; q < 16; ++q) { const int t = 32 * mt + crow(q, h);
                    const float uu = bf2f(*(const LAS bf16*)(U + t * U_PITCH + c * 2));
                    const float r = sigmoidf_(acc[0][q] + br[ct]), ig = sigmoidf_(acc[1][q] + bi[ct]);
                    a[q] = __expf(-c8[ct] * r); bb[q] = __builtin_amdgcn_sqrtf(fmaxf(1.0f - a[q] * a[q], 1e-12f)) * ig * uu;
                    const size_t ix = gix0 + (size_t)((q & 3) + 8 * (q >> 2)) * 512; const unsigned pk = pk2(1.0f - a[q], bb[q]); ((unsigned*)F.GA())[ix] = pk;
                    a[q] = 1.0f - __uint_as_float(pk << 16); bb[q] = __uint_as_float(pk & 0xffff0000u); }
            }
            float gA[4], gB[4], oA[4], oB[4];
#pragma unroll
            for (int g = 0; g < 4; ++g) { float A = 1.f, B = 0.f;
#pragma unroll
                for (int jj = 0; jj < 4; ++jj) { const int q = 4 * g + (DIR ? 3 - jj : jj); B = a[q] * B + bb[q]; A *= a[q]; }
                gA[g] = A; gB[g] = B; }
#pragma unroll
            for (int g = 0; g < 4; ++g) { oA[g] = shx(gA[g], 32, ln_); oB[g] = shx(gB[g], 32, ln_); }
            float st[4] = {0.f, 0.f, 0.f, 0.f}; float hs = hc[ct];
#pragma unroll
            for (int kk = 0; kk < 8; ++kk) { const int k = DIR ? 7 - kk : kk, g = k >> 1; const bool mine = ((k & 1) == h);
                const float Ak = mine ? gA[g] : oA[g], Bk = mine ? gB[g] : oB[g];
                if (FULL) { st[g] = mine ? hs : st[g]; hs = Ak * hs + Bk; }
                else { Bt[ct] = Ak * Bt[ct] + Bk; At[ct] *= Ak; } }
            if (FULL) {
                hc[ct] = hs;
#pragma unroll
                for (int g = 0; g < 4; ++g) { float hh = st[g];
#pragma unroll
                    for (int jj = 0; jj < 4; ++jj) { const int q = 4 * g + (DIR ? 3 - jj : jj); hh = a[q] * hh + bb[q];
                        F.HD()[(size_t)(rowbase + t0 + 32 * mt + crow(q, h)) * 512 + DIR * 256 + c] = hh; } }
            }
        }
        __builtin_amdgcn_sched_barrier(0);
    }
    if (!FULL && h == 0) {
#pragma unroll
        for (int ct = 0; ct < 2; ++ct) { const int c = 64 * n + 32 * ct + r32;
            F.AGG()[AG_LRU_A + (size_t)u * 512 + DIR * 256 + c] = At[ct]; F.AGG()[AG_LRU_B + (size_t)u * 512 + DIR * 256 + c] = Bt[ct]; }
    }
}
template <bool FULL>
__device__ __forceinline__ void ph_lru_fast(Ctx& F, int l) {
    LAS unsigned char* U = F.lds;
    for (int it = 0; it < 2; ++it) {
        const int u = it == 0 ? F.bid : 256 + (F.bid - 16);
        if (it == 0 ? (u >= 256) : (F.bid < 16 || F.bid >= 32 || F.G < 256)) continue;
        const MixUnit mu = mix_unit(u); const bool isc = mu.isc;
        if (FULL && isc && l == NL - 1) continue;
        const int rowbase = mu.rowbase, T = mu.T, t0 = mu.t0, ntok = mu.ntok;
        __syncthreads();
        if (!FULL) { const int c8 = (F.tid & 31) * 8, tr = F.tid >> 5;
          float w[4][8], cb[8];
#pragma unroll
          for (int jj = 0; jj < 4; ++jj) { const f32x4 w0 = *(const f32x4*)(F.inp(I_CONVW) + (l * 4 + jj) * 256 + c8), w1 = *(const f32x4*)(F.inp(I_CONVW) + (l * 4 + jj) * 256 + c8 + 4);
              w[jj][0] = w0.x; w[jj][1] = w0.y; w[jj][2] = w0.z; w[jj][3] = w0.w; w[jj][4] = w1.x; w[jj][5] = w1.y; w[jj][6] = w1.z; w[jj][7] = w1.w; }
          { const f32x4 b0 = *(const f32x4*)(F.inp(I_CONVB) + l * 256 + c8), b1 = *(const f32x4*)(F.inp(I_CONVB) + l * 256 + c8 + 4);
            cb[0] = b0.x; cb[1] = b0.y; cb[2] = b0.z; cb[3] = b0.w; cb[4] = b1.x; cb[5] = b1.y; cb[6] = b1.z; cb[7] = b1.w; }
#pragma unroll 4
          for (int i = 0; i < 8; ++i) { const int t = tr + 16 * i, tt = t0 + t;
              if (t >= ntok) break;
              float o[8];
#pragma unroll
              for (int e = 0; e < 8; ++e) o[e] = cb[e];
#pragma unroll
              for (int jj = 0; jj < 4; ++jj) { const int ts = tt - 2 + jj;
                  if (ts >= 0 && ts < T) { const u32x4 xw = *(const u32x4*)(F.P() + (size_t)(rowbase + ts) * INW + C_LX + c8);
                      o[0] += w[jj][0] * __uint_as_float(xw.x << 16); o[1] += w[jj][1] * __uint_as_float(xw.x & 0xffff0000u); o[2] += w[jj][2] * __uint_as_float(xw.y << 16); o[3] += w[jj][3] * __uint_as_float(xw.y & 0xffff0000u);
                      o[4] += w[jj][4] * __uint_as_float(xw.z << 16); o[5] += w[jj][5] * __uint_as_float(xw.z & 0xffff0000u); o[6] += w[jj][6] * __uint_as_float(xw.w << 16); o[7] += w[jj][7] * __uint_as_float(xw.w & 0xffff0000u); } }
              u32x4 ow; ow.x = pk2(o[0], o[1]); ow.y = pk2(o[2], o[3]); ow.z = pk2(o[4], o[5]); ow.w = pk2(o[6], o[7]);
              *(LAS u32x4*)(U + t * U_PITCH + c8 * 2) = ow; } }
        __syncthreads();
        { const int n = F.wave & 3;
          if (F.wave < 4) lru_wave<FULL, 0>(F, l, mu.ub, n, rowbase, t0, ntok >> 5); else lru_wave<FULL, 1>(F, l, mu.ub, n, rowbase, t0, ntok >> 5); }
        if (FULL) {
            __syncthreads();
#pragma unroll 4
            for (int i = F.tid; i < ntok * 64; i += NTHR) { const int t = i >> 6, c4 = (i & 63) * 4; const size_t row = (size_t)rowbase + t0 + t;
                const f32x4 hf = *(const f32x4*)(F.HD() + row * 512 + c4), hb = *(const f32x4*)(F.HD() + row * 512 + 256 + c4);
                const u32x2 gw = *(const u32x2*)(F.P() + row * INW + C_LG + c4);
                u32x2 w; w.x = pk2((hf.x + hb.x) * gelu_tanh(__uint_as_float(gw.x << 16)), (hf.y + hb.y) * gelu_tanh(__uint_as_float(gw.x & 0xffff0000u)));
                w.y = pk2((hf.z + hb.z) * gelu_tanh(__uint_as_float(gw.y << 16)), (hf.w + hb.w) * gelu_tanh(__uint_as_float(gw.y & 0xffff0000u)));
                *(u32x2*)(F.MIX() + row * D + 512 + c4) = w; }
        }
    }
}
__device__ __forceinline__ int mix_order(int d, int s) { return d ? 135 - s : (s < 8 ? 128 + s : s - 8); }
__device__ __forceinline__ void ph_lru_carry(Ctx& F) {
    const int gt = F.bid * NTHR + F.tid;
    if (gt >= NB * 512) return;
    const int b = gt >> 9, dc = gt & 511, d = dc >> 8;
    float h = 0.f;
#pragma unroll 1
    for (int s0 = 0; s0 < 136; s0 += 34) {
        float av[34], bv[34];
#pragma unroll
        for (int q = 0; q < 34; ++q) { const size_t ix = (size_t)(b * MIX_NUB + mix_order(d, s0 + q)) * 512 + dc; av[q] = F.AGG()[AG_LRU_A + ix]; bv[q] = F.AGG()[AG_LRU_B + ix]; }
#pragma unroll
        for (int q = 0; q < 34; ++q) { F.AGG()[AG_LRU_H + (size_t)(b * MIX_NUB + mix_order(d, s0 + q)) * 512 + dc] = h; h = av[q] * h + bv[q]; }
    }
}

constexpr int HG_NU = MIX_NU;
constexpr int HGW_LDS = 17152;
constexpr int KT_P = 36;
constexpr size_t AG_HG_D = 1048576, AG_HG_EBR = AG_HG_D + (size_t)HG_NU * 8 * 64;
__device__ __forceinline__ void hg_stage_v(const Ctx& F, LAS bf16* Vt, int rowbase, int c0, int hh, int r32, int h, int DIR) {
    const int t = c0 + (DIR ? 31 - r32 : r32); const bf16* vp = F.P() + (size_t)(rowbase + t) * INW + C_HV + hh * 64 + 32 * h;
#pragma unroll
    for (int c = 0; c < 4; ++c) { const u32x4 w = *(const u32x4*)(vp + 8 * c); const int v0 = 32 * h + 8 * c;
        Vt[(v0 + 0) * 32 + r32] = (bf16)(w.x & 0xffffu); Vt[(v0 + 1) * 32 + r32] = (bf16)(w.x >> 16); Vt[(v0 + 2) * 32 + r32] = (bf16)(w.y & 0xffffu); Vt[(v0 + 3) * 32 + r32] = (bf16)(w.y >> 16);
        Vt[(v0 + 4) * 32 + r32] = (bf16)(w.z & 0xffffu); Vt[(v0 + 5) * 32 + r32] = (bf16)(w.z >> 16); Vt[(v0 + 6) * 32 + r32] = (bf16)(w.w & 0xffffu); Vt[(v0 + 7) * 32 + r32] = (bf16)(w.w >> 16); }
}
__device__ __forceinline__ void hg_update_s(f32x16 (&S)[2][2], const LAS bf16* KiT, const LAS bf16* Vt, const LAS float* ebr, int r32, int h) {
#pragma unroll
    for (int kt = 0; kt < 2; ++kt) {
        float e1[16];
#pragma unroll
        for (int q = 0; q < 16; ++q) e1[q] = ebr[4 * h + (32 * kt + (q & 3) + 8 * (q >> 2))];
#pragma unroll
        for (int vt = 0; vt < 2; ++vt) { f32x16 tmp;
#pragma unroll
            for (int q = 0; q < 16; ++q) tmp[q] = 0.f;
#pragma unroll
            for (int ks = 0; ks < 2; ++ks) { const LAS bf16* kp = KiT + (32 * kt + r32) * KT_P + 16 * ks + 8 * h; const u32x2 klo = *(const LAS u32x2*)kp, khi = *(const LAS u32x2*)(kp + 4);
                u32x4 fau; fau.x = klo.x; fau.y = klo.y; fau.z = khi.x; fau.w = khi.y; const bf16x8 fa = __builtin_bit_cast(bf16x8, fau), fb = *(const LAS bf16x8*)(Vt + (32 * vt + r32) * 32 + 16 * ks + 8 * h);
                tmp = __builtin_amdgcn_mfma_f32_32x32x16_bf16(fa, fb, tmp, 0, 0, 0); }
#pragma unroll
            for (int q = 0; q < 16; ++q) S[kt][vt][q] = e1[q] * (e1[q] * S[kt][vt][q] + tmp[q]); }
    }
}
template <int DIR>
__device__ __forceinline__ void hg_wave_a(Ctx& F, int l, int u, int hh, int rowbase, int nch) {
    int ln_ = F.lane; asm volatile("" : "+v"(ln_));
    const int r32 = ln_ & 31, h = ln_ >> 5, k = ln_;
    LAS unsigned char* W = F.lds + F.wave * HGW_LDS;
    LAS bf16* Qi = (LAS bf16*)W; LAS bf16* Ki = (LAS bf16*)(W + 4096); LAS bf16* KiT = (LAS bf16*)(W + 8192); LAS bf16* Vt = (LAS bf16*)(W + 12800); LAS float* ebr = (LAS float*)(W + 16896);
    const int hd = DIR * 4 + hh;
    const float lb = hg_lb(F, l, DIR, hh * 64 + k);
    const unsigned lane_s = 4 * h * 64 + r32;
    f32x16 S[2][2];
#pragma unroll
    for (int kt = 0; kt < 2; ++kt)
#pragma unroll
        for (int vt = 0; vt < 2; ++vt)
#pragma unroll
            for (int q = 0; q < 16; ++q) S[kt][vt][q] = 0.f;
    float dsum = 0.f;
#pragma unroll 1
    for (int ci = 0; ci < nch; ++ci) {
        const int cph = DIR ? nch - 1 - ci : ci, c0 = 32 * cph;
        const int si = ln_ >> 1, sh = ln_ & 1; const int ts = c0 + (DIR ? 31 - si : si);
        { const bf16* zp = F.P() + (size_t)(rowbase + ts) * INW + (DIR ? C_HB : C_HF) + hh * 64 + 32 * sh;
          const bf16* qp = F.P() + (size_t)(rowbase + ts) * INW + C_HQ + hh * 64 + 32 * sh;
          u32x4 zz[4], qq[4];
#pragma unroll
          for (int c = 0; c < 4; ++c) { zz[c] = *(const u32x4*)(zp + 8 * c); qq[c] = *(const u32x4*)(qp + 8 * c); }
#pragma unroll
          for (int c = 0; c < 4; ++c) { *(LAS u32x4*)(Qi + si * 64 + 32 * sh + 8 * c) = zz[c]; *(LAS u32x4*)(Ki + si * 64 + 32 * sh + 8 * c) = qq[c]; } }
        hg_stage_v(F, Vt, rowbase, c0, hh, r32, h, DIR);
        asm volatile("s_waitcnt lgkmcnt(0)" ::: "memory");
        {
            float lf[32]; float run = 0.f;
#pragma unroll
            for (int i = 0; i < 32; ++i) { const float z = bf2f(Qi[i * 64 + k]); lf[i] = __logf(lb + (1.0f - lb) * sigmoidf_(z)); run += lf[i]; }
            const float bref = 0.5f * run; dsum += run;
            const float eb = __expf(bref);
            ebr[k] = eb; F.AGG()[AG_HG_EBR + (((size_t)u * 4 + cph) * 8 + hd) * 64 + k] = eb;
            float cum = 0.f;
#pragma unroll
            for (int i = 0; i < 32; ++i) {
                const float qq = bf2f(Ki[i * 64 + k]);
                cum += lf[i];
                const float e = __expf(cum - bref), ei = __expf(bref - cum);
                const unsigned kv = f2bf((1.0f - __expf(lf[i])) * ei);
                Ki[i * 64 + k] = (bf16)kv; KiT[k * KT_P + i] = (bf16)kv; Qi[i * 64 + k] = (bf16)f2bf(qq * e); }
        }
        asm volatile("s_waitcnt lgkmcnt(0)" ::: "memory");
        { bf16* qo = F.ws_bf16(WS_QI) + (size_t)(rowbase + ts) * 512 + DIR * 256 + hh * 64 + 32 * sh; bf16* ko = F.ws_bf16(WS_KI) + (size_t)(rowbase + ts) * 512 + DIR * 256 + hh * 64 + 32 * sh;
#pragma unroll
          for (int c = 0; c < 4; ++c) { *(u32x4*)(qo + 8 * c) = *(const LAS u32x4*)(Qi + si * 64 + 32 * sh + 8 * c); *(u32x4*)(ko + 8 * c) = *(const LAS u32x4*)(Ki + si * 64 + 32 * sh + 8 * c); } }
        hg_update_s(S, KiT, Vt, ebr, r32, h);
        asm volatile("s_waitcnt lgkmcnt(0)" ::: "memory");
    }
    float* sa = (float*)(F.ws + WS_SAGG) + ((size_t)u * 8 + hd) * 4096;
#pragma unroll
    for (int kt = 0; kt < 2; ++kt)
#pragma unroll
        for (int vt = 0; vt < 2; ++vt)
#pragma unroll
            for (int q = 0; q < 16; ++q) sa[lane_s + (unsigned)((32 * kt + (q & 3) + 8 * (q >> 2)) * 64 + 32 * vt)] = S[kt][vt][q];
    F.AGG()[AG_HG_D + ((size_t)u * 8 + hd) * 64 + k] = __expf(dsum);
}
template <int DIR>
__device__ __forceinline__ void hg_wave_c(Ctx& F, int l, int u, int hh, int rowbase, int nch) {
    int ln_ = F.lane; asm volatile("" : "+v"(ln_));
    const int r32 = ln_ & 31, h = ln_ >> 5, k = ln_;
    LAS unsigned char* W = F.lds + F.wave * HGW_LDS;
    LAS bf16* Qi = (LAS bf16*)W; LAS bf16* Ki = (LAS bf16*)(W + 4096); LAS bf16* KiT = (LAS bf16*)(W + 8192); LAS bf16* Vt = (LAS bf16*)(W + 12800); LAS float* ebr = (LAS float*)(W + 16896);
    const int hd = DIR * 4 + hh;
    const unsigned lane_s = 4 * h * 64 + r32;
    f32x16 S[2][2];
    { const float* sin = (const float*)(F.ws + WS_SIN) + ((size_t)u * 8 + hd) * 4096;
#pragma unroll
      for (int kt = 0; kt < 2; ++kt)
#pragma unroll
          for (int vt = 0; vt < 2; ++vt)
#pragma unroll
              for (int q = 0; q < 16; ++q) S[kt][vt][q] = sin[lane_s + (unsigned)((32 * kt + (q & 3) + 8 * (q >> 2)) * 64 + 32 * vt)]; }
#pragma unroll 1
    for (int ci = 0; ci < nch; ++ci) {
        const int cph = DIR ? nch - 1 - ci : ci, c0 = 32 * cph;
        { const int si = ln_ >> 1, sh = ln_ & 1; const int ts = c0 + (DIR ? 31 - si : si);
          const bf16* qo = F.ws_bf16(WS_QI) + (size_t)(rowbase + ts) * 512 + DIR * 256 + hh * 64 + 32 * sh; const bf16* ko = F.ws_bf16(WS_KI) + (size_t)(rowbase + ts) * 512 + DIR * 256 + hh * 64 + 32 * sh;
          u32x4 qq[4], kk[4];
#pragma unroll
          for (int c = 0; c < 4; ++c) { qq[c] = *(const u32x4*)(qo + 8 * c); kk[c] = *(const u32x4*)(ko + 8 * c); }
          ebr[k] = F.AGG()[AG_HG_EBR + (((size_t)u * 4 + cph) * 8 + hd) * 64 + k];
#pragma unroll
          for (int c = 0; c < 4; ++c) { *(LAS u32x4*)(Qi + si * 64 + 32 * sh + 8 * c) = qq[c]; *(LAS u32x4*)(Ki + si * 64 + 32 * sh + 8 * c) = kk[c];
              const int k0 = 32 * sh + 8 * c;
              KiT[(k0 + 0) * KT_P + si] = (bf16)(kk[c].x & 0xffffu); KiT[(k0 + 1) * KT_P + si] = (bf16)(kk[c].x >> 16); KiT[(k0 + 2) * KT_P + si] = (bf16)(kk[c].y & 0xffffu); KiT[(k0 + 3) * KT_P + si] = (bf16)(kk[c].y >> 16);
              KiT[(k0 + 4) * KT_P + si] = (bf16)(kk[c].z & 0xffffu); KiT[(k0 + 5) * KT_P + si] = (bf16)(kk[c].z >> 16); KiT[(k0 + 6) * KT_P + si] = (bf16)(kk[c].w & 0xffffu); KiT[(k0 + 7) * KT_P + si] = (bf16)(kk[c].w >> 16); } }
        hg_stage_v(F, Vt, rowbase, c0, hh, r32, h, DIR);
        asm volatile("s_waitcnt lgkmcnt(0)" ::: "memory");
        f32x16 att;
#pragma unroll
        for (int q = 0; q < 16; ++q) att[q] = 0.f;
#pragma unroll
        for (int ks = 0; ks < 4; ++ks) { const bf16x8 fa = *(const LAS bf16x8*)(Ki + r32 * 64 + 16 * ks + 8 * h), fb = *(const LAS bf16x8*)(Qi + r32 * 64 + 16 * ks + 8 * h);
            att = __builtin_amdgcn_mfma_f32_32x32x16_bf16(fa, fb, att, 0, 0, 0); }
#pragma unroll
        for (int q = 0; q < 16; ++q) att[q] = (crow(q, h) <= r32) ? att[q] : 0.f;
        f32x16 o[2];
#pragma unroll
        for (int vt = 0; vt < 2; ++vt)
#pragma unroll
            for (int q = 0; q < 16; ++q) o[vt][q] = 0.f;
#pragma unroll
        for (int ks = 0; ks < 2; ++ks) {
            u32x4 pa; pa.x = pk2(att[8 * ks + 0], att[8 * ks + 1]); pa.y = pk2(att[8 * ks + 2], att[8 * ks + 3]); pa.z = pk2(att[8 * ks + 4], att[8 * ks + 5]); pa.w = pk2(att[8 * ks + 6], att[8 * ks + 7]);
#pragma unroll
            for (int vt = 0; vt < 2; ++vt) { const LAS bf16* vp = Vt + (32 * vt + r32) * 32 + 16 * ks + 4 * h;
                const u32x2 lo = *(const LAS u32x2*)vp, hi2 = *(const LAS u32x2*)(vp + 8);
                u32x4 fb; fb.x = lo.x; fb.y = lo.y; fb.z = hi2.x; fb.w = hi2.y;
                o[vt] = __builtin_amdgcn_mfma_f32_32x32x16_bf16(__builtin_bit_cast(bf16x8, pa), __builtin_bit_cast(bf16x8, fb), o[vt], 0, 0, 0); } }
#pragma unroll
        for (int kt = 0; kt < 2; ++kt) {
            float e1[16];
#pragma unroll
            for (int q = 0; q < 16; ++q) e1[q] = ebr[4 * h + (32 * kt + (q & 3) + 8 * (q >> 2))];
#pragma unroll
            for (int ks = 0; ks < 2; ++ks) { const LAS bf16* qp = Qi + r32 * 64 + 32 * kt + 16 * ks + 4 * h;
                const u32x2 lo = *(const LAS u32x2*)qp, hi2 = *(const LAS u32x2*)(qp + 8);
                u32x4 fa; fa.x = lo.x; fa.y = lo.y; fa.z = hi2.x; fa.w = hi2.y;
#pragma unroll
                for (int vt = 0; vt < 2; ++vt) { u32x4 sb;
                    sb.x = pk2(S[kt][vt][8 * ks + 0] * e1[8 * ks + 0], S[kt][vt][8 * ks + 1] * e1[8 * ks + 1]); sb.y = pk2(S[kt][vt][8 * ks + 2] * e1[8 * ks + 2], S[kt][vt][8 * ks + 3] * e1[8 * ks + 3]);
                    sb.z = pk2(S[kt][vt][8 * ks + 4] * e1[8 * ks + 4], S[kt][vt][8 * ks + 5] * e1[8 * ks + 5]); sb.w = pk2(S[kt][vt][8 * ks + 6] * e1[8 * ks + 6], S[kt][vt][8 * ks + 7] * e1[8 * ks + 7]);
                    o[vt] = __builtin_amdgcn_mfma_f32_32x32x16_bf16(__builtin_bit_cast(bf16x8, fa), __builtin_bit_cast(bf16x8, sb), o[vt], 0, 0, 0); } }
        }
        { float* ob = F.OHG() + (size_t)(rowbase + c0) * 512 + DIR * 256 + hh * 64;
          const unsigned lane_o = (unsigned)((DIR ? 4 - 4 * h : 4 * h) * 512 + r32);
#pragma unroll
          for (int q = 0; q < 16; ++q) { const int iq = (q & 3) + 8 * (q >> 2); const unsigned cq = (unsigned)((DIR ? 27 - iq : iq) * 512);
              ob[lane_o + cq] = o[0][q]; ob[lane_o + cq + 32u] = o[1][q]; } }
        if (ci < nch - 1) hg_update_s(S, KiT, Vt, ebr, r32, h);
        asm volatile("s_waitcnt lgkmcnt(0)" ::: "memory");
    }
}
template <bool FULL>
__device__ __forceinline__ void ph_hgrn_fast(Ctx& F, int l) {
    for (int it = 0; it < 2; ++it) {
        const int u = it == 0 ? F.bid : 256 + (F.bid - 32);
        if (it == 0 ? (u >= 256) : (F.bid < 32 || F.bid >= 48 || F.G < 256)) continue;
        const MixUnit mu = mix_unit(u); const bool isc = mu.isc;
        if (FULL && isc && l == NL - 1) continue;
        const int rowbase = mu.rowbase + mu.t0, ntok = mu.ntok;
        __syncthreads();
        { const int hh = F.wave & 3;
          if (FULL) { if (F.wave < 4) hg_wave_c<0>(F, l, mu.ub, hh, rowbase, ntok >> 5); else hg_wave_c<1>(F, l, mu.ub, hh, rowbase, ntok >> 5); }
          else { if (F.wave < 4) hg_wave_a<0>(F, l, mu.ub, hh, rowbase, ntok >> 5); else hg_wave_a<1>(F, l, mu.ub, hh, rowbase, ntok >> 5); } }
        if (FULL) {
            __syncthreads();
#pragma unroll 4
            for (int rr = F.wave; rr < ntok; rr += NWAVES) { const size_t m = (size_t)rowbase + rr; const int col = 4 * F.lane;
                const f32x4 a = *(const f32x4*)(F.OHG() + m * 512 + col), bb = *(const f32x4*)(F.OHG() + m * 512 + 256 + col);
                const f32x4 o = a + bb;
                float ss = (o.x * o.x + o.y * o.y) + (o.z * o.z + o.w * o.w);
                ss += shx(ss, 1, F.lane); ss += shx(ss, 2, F.lane); ss += shx(ss, 4, F.lane); ss += shx(ss, 8, F.lane);
                const float rstd = 1.0f / sqrtf(ss * (1.0f / 64.0f) + EPS);
                const f32x4 g = *(const f32x4*)(F.inp(I_HNG) + l * 256 + col);
                const u32x2 ow = *(const u32x2*)(F.P() + m * INW + C_HO + col);
                const float g0 = siluf_(__uint_as_float(ow.x << 16)), g1 = siluf_(__uint_as_float(ow.x & 0xffff0000u)), g2 = siluf_(__uint_as_float(ow.y << 16)), g3 = siluf_(__uint_as_float(ow.y & 0xffff0000u));
                u32x2 w; w.x = pk2(o.x * rstd * g.x * g0, o.y * rstd * g.y * g1); w.y = pk2(o.z * rstd * g.z * g2, o.w * rstd * g.w * g3);
                *(u32x2*)(F.MIX() + m * D + 768 + col) = w; }
        }
    }
}
__device__ __forceinline__ void ph_hgrn_carry(Ctx& F) {
    const int gt = F.bid * NTHR + F.tid;
    if (gt >= 16 * 4096) return;
    const int seq = gt >> 12, e = gt & 4095, b = seq >> 3, hd = seq & 7, d = hd >> 2, kk = e >> 6;
    const float* SA = (const float*)(F.ws + WS_SAGG); float* SI = (float*)(F.ws + WS_SIN);
    float S = 0.f;
#pragma unroll 1
    for (int s0 = 0; s0 < 136; s0 += 34) {
        float dv[34], sv[34];
#pragma unroll
        for (int q = 0; q < 34; ++q) { const size_t ub = (size_t)(b * MIX_NUB + mix_order(d, s0 + q)) * 8 + hd; dv[q] = F.AGG()[AG_HG_D + ub * 64 + kk]; sv[q] = SA[ub * 4096 + e]; }
#pragma unroll
        for (int q = 0; q < 34; ++q) { const size_t ub = (size_t)(b * MIX_NUB + mix_order(d, s0 + q)) * 8 + hd; SI[ub * 4096 + e] = S; S = dv[q] * S + sv[q]; }
    }
}

constexpr int CV_GU = NE * 16 * 64, CV_DN = NE * 16 * 32, CV_ITEMS = CV_GU + CV_DN, CV_PER_WAVE = CV_ITEMS / 2048;
constexpr int PROG_OFF = 147456 - 256 + 24 * 4;
constexpr int AT_CVSCR = 2 * 2 * 64 * 144;
#ifndef ATTN_RIDE
#define ATTN_RIDE 0
#endif
constexpr int AT_KP = 144;
constexpr int AT_BUF = 2 * 64 * AT_KP;
__device__ __forceinline__ float max3f(float a, float b, float c) { float r; asm("v_max3_f32 %0, %1, %2, %3" : "=v"(r) : "v"(a), "v"(b), "v"(c)); return r; }
__device__ __forceinline__ void ph_attn_fast(Ctx& F, int l) {
    int ln_ = F.lane; asm volatile("" : "+v"(ln_));
    const int r32 = ln_ & 31, h = ln_ >> 5, g = F.wave >> 1, ph = F.wave & 1;
    const int lrow = F.tid >> 3, lch = F.tid & 7;
    const int NU = (l == 0) ? 1040 : 1024;
    for (int it = 0; it < 5; ++it) {
        const int u = it < 4 ? F.bid + 256 * it : 1024 + (F.bid - 240);
        if (it == 4 && (F.bid < 240 || NU <= 1024)) continue;
        const bool isc = u >= 1024;
        int b, kvh, jb;
        if (!isc) { b = u >> 9; kvh = (u >> 8) & 1; jb = u & 255; } else { const int v = u - 1024; b = v >> 3; kvh = (v >> 2) & 1; jb = v & 3; }
        const int q0 = jb * 64, qrowbase = isc ? ML + b * CTXL : b * SEQ, hq = kvh * 4 + g;
        int i_lo = 0, nloc = 0;
        if (!isc) { i_lo = q0 < 128 ? (128 - q0) >> 6 : 0; const int i_hi = (q0 + 192 <= SEQ) ? 4 : ((q0 + 128 <= SEQ) ? 3 : 2); nloc = i_hi - i_lo + 1; }
        const int NT = nloc + 4;
        bf16x8 qf[4];
        { const bf16* qp = F.P() + (size_t)(qrowbase + q0 + 32 * ph + r32) * INW + C_Q + hq * 64 + 8 * h;
#pragma unroll
          for (int ks = 0; ks < 4; ++ks) qf[ks] = *(const bf16x8*)(qp + 16 * ks); }
        float m_run = F.inp(I_SINK)[l * 8 + hq] * LOG2E, l_run = (h == 0) ? 1.0f : 0.0f;
        f32x16 ot[2];
#pragma unroll
        for (int dt = 0; dt < 2; ++dt)
#pragma unroll
            for (int q = 0; q < 16; ++q) ot[dt][q] = 0.f;
        u32x4 kreg, vreg;
#define AT_LOAD(ti) do { const int ti_ = (ti); const bool loc_ = ti_ < nloc; const int kst_ = loc_ ? q0 - 128 + 64 * (i_lo + ti_) : 64 * (ti_ - nloc); \
        const size_t krow_ = loc_ ? (size_t)b * SEQ + kst_ : (size_t)ML + b * CTXL + kst_; \
        kreg = *(const u32x4*)(F.P() + (krow_ + lrow) * INW + C_K + kvh * 64 + lch * 8); \
        const size_t vo_ = loc_ ? ((size_t)((b * 2 + kvh) * 64 + lrow)) * SEQ + kst_ : VT_CTX_OFF + ((size_t)((b * 2 + kvh) * 64 + lrow)) * CTXL + kst_; \
        vreg = *(const u32x4*)(F.Vt() + vo_ + lch * 8); } while (0)
#define AT_STORE(slot) do { LAS unsigned char* d_ = F.lds + (slot) * AT_BUF + lrow * AT_KP + lch * 16; *(LAS u32x4*)d_ = kreg; *(LAS u32x4*)(d_ + 64 * AT_KP) = vreg; } while (0)
#define AT_QK(P0, P1, slot) do { const LAS unsigned char* Kb_ = F.lds + (slot) * AT_BUF; \
        _Pragma("unroll") for (int q = 0; q < 16; ++q) { P0[q] = 0.f; P1[q] = 0.f; } \
        _Pragma("unroll") for (int ks = 0; ks < 4; ++ks) { \
            const bf16x8 a0 = *(const LAS bf16x8*)(Kb_ + r32 * AT_KP + (16 * ks + 8 * h) * 2), a1 = *(const LAS bf16x8*)(Kb_ + (32 + r32) * AT_KP + (16 * ks + 8 * h) * 2); \
            P0 = __builtin_amdgcn_mfma_f32_32x32x16_bf16(a0, qf[ks], P0, 0, 0, 0); P1 = __builtin_amdgcn_mfma_f32_32x32x16_bf16(a1, qf[ks], P1, 0, 0, 0); } } while (0)
        __syncthreads();
        AT_LOAD(0); AT_STORE(0); AT_LOAD(1); AT_STORE(1);
        __syncthreads();
        f32x16 p0, p1;
        AT_QK(p0, p1, 0);
        int sc_ = 0, sn_ = 1, sw_ = 2;
#pragma unroll 1
        for (int ti = 0; ti < NT; ++ti) {
            if (ti + 2 < NT) AT_LOAD(ti + 2);
            f32x16 n0, n1;
            if (ti + 1 < NT) AT_QK(n0, n1, sn_);
            else {
#pragma unroll
                for (int q = 0; q < 16; ++q) { n0[q] = 0.f; n1[q] = 0.f; } }
            const LAS unsigned char* Vb = F.lds + sc_ * AT_BUF + 64 * AT_KP;
            const int itile = (ti < nloc) ? i_lo + ti : 2;
            if (itile == 0 || itile == 4) {
                int dq = 32 * ph + r32 - 4 * h; asm volatile("" : "+v"(dq));
                if (itile == 0) {
#pragma unroll
                    for (int q = 0; q < 16; ++q) { const int cq = (q & 3) + 8 * (q >> 2); p0[q] = (cq >= dq) ? p0[q] : -1.0e30f; p1[q] = (cq + 32 >= dq) ? p1[q] : -1.0e30f; }
                } else {
#pragma unroll
                    for (int q = 0; q < 16; ++q) { const int cq = (q & 3) + 8 * (q >> 2); p0[q] = (cq <= dq) ? p0[q] : -1.0e30f; p1[q] = (cq + 32 <= dq) ? p1[q] : -1.0e30f; }
                }
            }
            float tm = max3f(p0[0], p1[0], p0[1]), tm2 = max3f(p1[1], p0[2], p1[2]);
#pragma unroll
            for (int q = 3; q < 15; q += 2) { tm = max3f(tm, p0[q], p1[q]); tm2 = max3f(tm2, p0[q + 1], p1[q + 1]); }
            tm = max3f(tm, tm2, p0[15]); tm = fmaxf(tm, p1[15]);
            tm = fmaxf(tm, shx(tm, 32, ln_));
            const float mn = fmaxf(m_run, tm);
            if (__builtin_amdgcn_ballot_w64(mn != m_run) != 0ull) {
                const float sc = __builtin_amdgcn_exp2f(m_run - mn);
                l_run *= sc;
#pragma unroll
                for (int dt = 0; dt < 2; ++dt)
#pragma unroll
                    for (int q = 0; q < 16; ++q) ot[dt][q] *= sc;
            }
            m_run = mn;
            float ls = 0.f;
#pragma unroll
            for (int q = 0; q < 16; ++q) { p0[q] = __builtin_amdgcn_exp2f(p0[q] - mn); p1[q] = __builtin_amdgcn_exp2f(p1[q] - mn); ls += p0[q] + p1[q]; }
            l_run += ls;
#pragma unroll
            for (int hk = 0; hk < 2; ++hk)
#pragma unroll
                for (int s = 0; s < 2; ++s) {
                    u32x4 pb;
                    if (hk == 0) { pb.x = pk2(p0[8 * s + 0], p0[8 * s + 1]); pb.y = pk2(p0[8 * s + 2], p0[8 * s + 3]); pb.z = pk2(p0[8 * s + 4], p0[8 * s + 5]); pb.w = pk2(p0[8 * s + 6], p0[8 * s + 7]); }
                    else { pb.x = pk2(p1[8 * s + 0], p1[8 * s + 1]); pb.y = pk2(p1[8 * s + 2], p1[8 * s + 3]); pb.z = pk2(p1[8 * s + 4], p1[8 * s + 5]); pb.w = pk2(p1[8 * s + 6], p1[8 * s + 7]); }
#pragma unroll
                    for (int dt = 0; dt < 2; ++dt) { const LAS unsigned char* vp = Vb + (32 * dt + r32) * AT_KP + (32 * hk + 16 * s + 4 * h) * 2;
                        const u32x2 lo = *(const LAS u32x2*)vp, hi2 = *(const LAS u32x2*)(vp + 16);
                        u32x4 fa; fa.x = lo.x; fa.y = lo.y; fa.z = hi2.x; fa.w = hi2.y;
                        ot[dt] = __builtin_amdgcn_mfma_f32_32x32x16_bf16(__builtin_bit_cast(bf16x8, fa), __builtin_bit_cast(bf16x8, pb), ot[dt], 0, 0, 0); } }
            if (ti + 2 < NT) AT_STORE(sw_);
            __syncthreads();
            p0 = n0; p1 = n1;
            { const int t_ = sc_; sc_ = sn_; sn_ = sw_; sw_ = t_; }
        }
#undef AT_LOAD
#undef AT_STORE
#undef AT_QK
        const float linv = 1.0f / (l_run + shx(l_run, 32, ln_));
        { bf16* op = F.MIX() + (size_t)(qrowbase + q0 + 32 * ph + r32) * D + hq * 64 + 4 * h;
#pragma unroll
          for (int dt = 0; dt < 2; ++dt)
#pragma unroll
              for (int gq = 0; gq < 4; ++gq) { u32x2 w; w.x = pk2(ot[dt][4 * gq + 0] * linv, ot[dt][4 * gq + 1] * linv); w.y = pk2(ot[dt][4 * gq + 2] * linv, ot[dt][4 * gq + 3] * linv);
                  *(u32x2*)(op + 32 * dt + 8 * gq) = w; } }
    }
}

__device__ __forceinline__ void ph_outproj_naive(Ctx& F, int l) {
    const int gw = F.bid * NWAVES + F.wave, NGW = F.G * NWAVES, r = F.lane & 31, h = F.lane >> 5;
    const int Mq = (l == 0) ? MA : ML;
    const bf16* Bt = F.WoutT() + (size_t)l * D * D;
    for (int ti = gw; ti < (Mq / 64) * (D / 64); ti += NGW) {
        const int rt = ti / (D / 64), ct = ti % (D / 64), m0 = rt * 64, c0 = ct * 64;
        f32x16 acc[2][2];
        sg_kloop(acc, F.MIX() + (size_t)(m0 + r) * D + 8 * h, F.MIX() + (size_t)(m0 + 32 + r) * D + 8 * h, Bt + (size_t)(c0 + r) * D + 8 * h, Bt + (size_t)(c0 + 32 + r) * D + 8 * h, D);
#pragma unroll
        for (int mt = 0; mt < 2; ++mt)
#pragma unroll
            for (int nt = 0; nt < 2; ++nt)
#pragma unroll
                for (int q = 0; q < 16; ++q) {
                    const int m = m0 + 32 * mt + crow(q, h), c = c0 + 32 * nt + r;
                    const float g2 = F.mods()[((size_t)l * 3 + mod_row(m)) * 6 * D + 2 * D + c];
                    F.P()[(size_t)m * D + c] = (bf16)f2bf(g2 * acc[mt][nt][q]);
                }
    }
}

__device__ __forceinline__ void ph_norm2_router(Ctx& F, int l, bool shadow = false) {
    const int Mq = (l == 0) ? MA : ML;
    LAS unsigned char* HI = F.lds; LAS unsigned char* LO = F.lds + 16512;
    constexpr int HP = 2064;
    LAS float* part = (LAS float*)(F.lds + 36864);
    LAS float* AC = (LAS float*)(F.lds + 98304);
    LAS float* BC = (LAS float*)(F.lds + 110592);
    LAS float* lg = (LAS float*)(F.lds + 122880);
    LAS float* tvi = (LAS float*)(F.lds + 123904);
    LAS int* lcnt = (LAS int*)(F.lds + 124928);
    LAS int* lbase = (LAS int*)(F.lds + 124928 + 128);
    LAS int* se = (LAS int*)(F.lds + 124928 + 256);
    LAS float* sg = (LAS float*)(F.lds + 124928 + 256 + 4096);
    const int e = F.tid & 31;
    const int fr = F.lane & 15, fq = F.lane >> 4, kw = F.wave * 128;
    bf16x8 whi[2][4], wlo[2][4];
#pragma unroll
    for (int nt = 0; nt < 2; ++nt)
#pragma unroll
        for (int ks = 0; ks < 4; ++ks) { float wv[8];
#pragma unroll
            for (int i = 0; i < 8; ++i) wv[i] = F.inp(I_RW)[((size_t)l * D + kw + 32 * ks + 8 * fq + i) * NE + 16 * nt + fr];
            u32x4 hi, lo;
            hi.x = pk2(wv[0], wv[1]); hi.y = pk2(wv[2], wv[3]); hi.z = pk2(wv[4], wv[5]); hi.w = pk2(wv[6], wv[7]);
            lo.x = pk2(wv[0] - __uint_as_float(hi.x << 16), wv[1] - __uint_as_float(hi.x & 0xffff0000u)); lo.y = pk2(wv[2] - __uint_as_float(hi.y << 16), wv[3] - __uint_as_float(hi.y & 0xffff0000u));
            lo.z = pk2(wv[4] - __uint_as_float(hi.z << 16), wv[5] - __uint_as_float(hi.z & 0xffff0000u)); lo.w = pk2(wv[6] - __uint_as_float(hi.w << 16), wv[7] - __uint_as_float(hi.w & 0xffff0000u));
            whi[nt][ks] = __builtin_bit_cast(bf16x8, hi); wlo[nt][ks] = __builtin_bit_cast(bf16x8, lo); }
    unsigned* cnt = (unsigned*)(F.ctl() + CW_CNT + l * 64 + (shadow ? 512 : 0));
    int* ltok = shadow ? (int*)(F.ws + WS_HMOE) : F.list_tok(); int* ldst = ltok + (size_t)NE * CAP; float* lgate = (float*)(ldst + (size_t)NE * CAP);
    __syncthreads();
    if (F.tid < 32) lcnt[F.tid] = 0;
    for (int i = F.tid; i < 3 * D; i += NTHR) { const int r = i >> 10, c = i & (D - 1); const float* mo = F.mods() + ((size_t)l * 3 + r) * 6 * D;
        AC[i] = F.inp(I_N2G)[l * D + c] * (1.0f + mo[4 * D + c]); BC[i] = mo[3 * D + c]; }
    f32x4 v[4]; u32x2 tv[4];
#define RT_LOAD(mm) do { const int m_ = (mm); \
        if (l == 0) { const float* s_ = m_ < ML ? F.inp(I_X) + (size_t)m_ * D : F.inp(I_CTX) + (size_t)(m_ - ML) * D; \
            _Pragma("unroll") for (int j = 0; j < 4; ++j) v[j] = *(const f32x4*)(s_ + 4 * F.lane + 256 * j); } \
        else { _Pragma("unroll") for (int j = 0; j < 4; ++j) { const u32x2 w_ = *(const u32x2*)(F.XL() + (size_t)m_ * D + 4 * F.lane + 256 * j); \
            v[j] = (f32x4){__uint_as_float(w_.x << 16), __uint_as_float(w_.x & 0xffff0000u), __uint_as_float(w_.y << 16), __uint_as_float(w_.y & 0xffff0000u)}; } } \
        _Pragma("unroll") for (int j = 0; j < 4; ++j) tv[j] = *(const u32x2*)(F.P() + (size_t)m_ * D + 4 * F.lane + 256 * j); } while (0)
    { const int m = F.bid * 8 + F.wave; if (m < Mq) RT_LOAD(m); }
    __syncthreads();
    int ti = 0;
    for (int base = F.bid * 8; base < Mq; base += F.G * 8, ++ti) {
        { const int m = base + F.wave;
          const int mr = mod_row(m);
          float ss = 0.f;
#pragma unroll
          for (int j = 0; j < 4; ++j) { v[j].x += __uint_as_float(tv[j].x << 16); v[j].y += __uint_as_float(tv[j].x & 0xffff0000u); v[j].z += __uint_as_float(tv[j].y << 16); v[j].w += __uint_as_float(tv[j].y & 0xffff0000u);
              { u32x2 xw; xw.x = pk2(v[j].x, v[j].y); xw.y = pk2(v[j].z, v[j].w); *(u32x2*)(F.XL() + (size_t)m * D + 4 * F.lane + 256 * j) = xw; }
              ss += (v[j].x * v[j].x + v[j].y * v[j].y) + (v[j].z * v[j].z + v[j].w * v[j].w); }
          const float rstd = __builtin_amdgcn_rsqf(wave_sum(ss, F.lane) * (1.0f / D) + EPS);
#pragma unroll
          for (int j = 0; j < 4; ++j) { const int col = 4 * F.lane + 256 * j;
              const f32x4 ga = *(const LAS f32x4*)(AC + mr * D + col), sh = *(const LAS f32x4*)(BC + mr * D + col);
              const f32x4 h = v[j] * rstd * ga + sh;
              if (MOE_FP8) *(unsigned*)((unsigned char*)F.H1() + (size_t)m * D + col) = pk_fp8x4(h.x, h.y, h.z, h.w);
              else { u32x2 w; w.x = pk2(h.x, h.y); w.y = pk2(h.z, h.w); *(u32x2*)(F.H1() + (size_t)m * D + col) = w; }
              { u32x2 wh, wl; wh.x = pk2(h.x, h.y); wh.y = pk2(h.z, h.w);
                wl.x = pk2(h.x - __uint_as_float(wh.x << 16), h.y - __uint_as_float(wh.x & 0xffff0000u)); wl.y = pk2(h.z - __uint_as_float(wh.y << 16), h.w - __uint_as_float(wh.y & 0xffff0000u));
                *(LAS u32x2*)(HI + F.wave * HP + col * 2) = wh; *(LAS u32x2*)(LO + F.wave * HP + col * 2) = wl; } }
          const int mn = m + F.G * 8;
          if (mn < Mq) RT_LOAD(mn); }
        __syncthreads();
        { f32x4 acc[2] = {{0.f, 0.f, 0.f, 0.f}, {0.f, 0.f, 0.f, 0.f}};
#pragma unroll
          for (int ks = 0; ks < 4; ++ks) { const int ao = (fr & 7) * HP + (kw + 32 * ks + 8 * fq) * 2;
              const bf16x8 ah = *(const LAS bf16x8*)(HI + ao), al = *(const LAS bf16x8*)(LO + ao);
#pragma unroll
              for (int nt = 0; nt < 2; ++nt) { acc[nt] = __builtin_amdgcn_mfma_f32_16x16x32_bf16(al, whi[nt][ks], acc[nt], 0, 0, 0); acc[nt] = __builtin_amdgcn_mfma_f32_16x16x32_bf16(ah, wlo[nt][ks], acc[nt], 0, 0, 0);
                  acc[nt] = __builtin_amdgcn_mfma_f32_16x16x32_bf16(ah, whi[nt][ks], acc[nt], 0, 0, 0); } }
          if (fq < 2) {
#pragma unroll
              for (int nt = 0; nt < 2; ++nt)
#pragma unroll
                  for (int j = 0; j < 4; ++j) part[(F.wave * 8 + 4 * fq + j) * 32 + 16 * nt + fr] = acc[nt][j]; } }
        __syncthreads();
        if (F.tid < 256) {
            const int rr = F.tid >> 5; float s = F.inp(I_RB)[l * NE + e];
#pragma unroll
            for (int q = 0; q < 8; ++q) s += part[(q * 8 + rr) * 32 + e];
            lg[rr * 32 + e] = s;
            asm volatile("s_waitcnt lgkmcnt(0)" ::: "memory");
            int rank = 0;
#pragma unroll
            for (int q = 0; q < 8; ++q) { const f32x4 x = *(const LAS f32x4*)(lg + rr * 32 + 4 * q);
                rank += (x.x > s || (x.x == s && 4 * q + 0 < e)) ? 1 : 0; rank += (x.y > s || (x.y == s && 4 * q + 1 < e)) ? 1 : 0;
                rank += (x.z > s || (x.z == s && 4 * q + 2 < e)) ? 1 : 0; rank += (x.w > s || (x.w == s && 4 * q + 3 < e)) ? 1 : 0; }
            if (rank < 4) { tvi[(rr * 4 + rank) * 2] = s; tvi[(rr * 4 + rank) * 2 + 1] = __int_as_float(e); }
            asm volatile("s_waitcnt lgkmcnt(0)" ::: "memory");
            const f32x4 c01 = *(const LAS f32x4*)(tvi + rr * 8), c23 = *(const LAS f32x4*)(tvi + rr * 8 + 4);
            const float p1 = __expf(c01.z - c01.x), p2 = __expf(c23.x - c01.x), p3 = __expf(c23.z - c01.x), den = 1.0f + p1 + p2 + p3;
            if (e < 4) { const float myv = e == 0 ? 1.0f : (e == 1 ? p1 : (e == 2 ? p2 : p3)); const int mye = __float_as_int(e == 0 ? c01.y : (e == 1 ? c01.w : (e == 2 ? c23.y : c23.w)));
                const int lp = __hip_atomic_fetch_add(lcnt + mye, 1, __ATOMIC_RELAXED, __HIP_MEMORY_SCOPE_WORKGROUP);
                se[ti * 32 + rr * 4 + e] = mye | (lp << 8); sg[ti * 32 + rr * 4 + e] = myv * frcp(den); }
        }
        __syncthreads();
    }
    if (F.tid < 32) lbase[F.tid] = (int)atomicAdd(cnt + F.tid, (unsigned)lcnt[F.tid]);
    __syncthreads();
    for (int i = F.tid; i < ti * 32; i += NTHR) {
        const int w = se[i], ee = w & 255, lp = w >> 8, m = F.bid * 8 + (i >> 5) * (F.G * 8) + ((i & 31) >> 2), j = i & 3;
        const size_t pos = (size_t)ee * CAP + lbase[ee] + lp;
        ltok[pos] = m; ldst[pos] = m * 4 + j; lgate[pos] = sg[i];
    }
}

#undef RT_LOAD
__device__ __forceinline__ void ph_moe_gu_naive(Ctx& F, int l) {
    const int gw = F.bid * NWAVES + F.wave, NGW = F.G * NWAVES, r = F.lane & 31, h = F.lane >> 5;
    const unsigned* cnt = (const unsigned*)(F.ctl() + CW_CNT + l * 64);
    int id0 = 0, ts256 = 0;
    for (int e = 0; e < NE; ++e) {
        const int ce = (int)__hip_atomic_load(cnt + e, __ATOMIC_RELAXED, __HIP_MEMORY_SCOPE_AGENT);
        const int nrt = (ce + 63) / 64, n = nrt * 32;
        const bf16* Bt = F.WguT() + ((size_t)l * NE + e) * 2 * FF * D;
        const float* bg = F.inp(I_BGU) + ((size_t)l * NE + e) * 2 * FF;
        int id = id0 + ((gw - id0 % NGW) + NGW) % NGW;
        for (; id < id0 + n; id += NGW) {
            const int rt = (id - id0) / 32, ft = (id - id0) % 32, pos0 = rt * 64, ff0 = ft * 32;
            const int p0 = pos0 + r, p1 = pos0 + 32 + r;
            const int t0 = p0 < ce ? F.list_tok()[(size_t)e * CAP + p0] : 0, t1 = p1 < ce ? F.list_tok()[(size_t)e * CAP + p1] : 0;
            const int ng = (ff0 >> 7) * 256 + (ff0 & 127) + r;
            f32x16 acc[2][2];
            sg_kloop(acc, F.H1() + (size_t)t0 * D + 8 * h, F.H1() + (size_t)t1 * D + 8 * h, Bt + (size_t)ng * D + 8 * h, Bt + (size_t)(ng + 128) * D + 8 * h, D);
            const float bgate = bg[ff0 + r], bup = bg[FF + ff0 + r];
#pragma unroll
            for (int mt = 0; mt < 2; ++mt)
#pragma unroll
                for (int q = 0; q < 16; ++q) {
                    const int pos = pos0 + 32 * mt + crow(q, h);
                    if (pos < ce) {
                        const float gate = fminf(acc[mt][0][q] + bgate, 7.0f), up = fminf(fmaxf(acc[mt][1][q] + bup, -7.0f), 7.0f);
                        const float glu = gate * sigmoidf_(1.702f * gate);
                        F.HMOE()[((size_t)ts256 * 256 + pos) * FF + ff0 + r] = (bf16)f2bf((up + 1.0f) * glu);
                    }
                }
        }
        id0 += n; ts256 += (ce + 255) / 256;
    }
}
__device__ __forceinline__ void ph_moe_down_naive(Ctx& F, int l) {
    const int gw = F.bid * NWAVES + F.wave, NGW = F.G * NWAVES, r = F.lane & 31, h = F.lane >> 5;
    const unsigned* cnt = (const unsigned*)(F.ctl() + CW_CNT + l * 64);
    int id0 = 0, ts256 = 0;
    for (int e = 0; e < NE; ++e) {
        const int ce = (int)__hip_atomic_load(cnt + e, __ATOMIC_RELAXED, __HIP_MEMORY_SCOPE_AGENT);
        const int nrt = (ce + 63) / 64, n = nrt * 16;
        const bf16* Bt = F.WdT() + ((size_t)l * NE + e) * D * FF;
        const float* bd = F.inp(I_BD) + ((size_t)l * NE + e) * D;
        int id = id0 + ((gw - id0 % NGW) + NGW) % NGW;
        for (; id < id0 + n; id += NGW) {
            const int rt = (id - id0) / 16, ct = (id - id0) % 16, pos0 = rt * 64, c0 = ct * 64;
            const bf16* A = F.HMOE() + ((size_t)ts256 * 256 + pos0) * FF;
            f32x16 acc[2][2];
            sg_kloop(acc, A + (size_t)r * FF + 8 * h, A + (size_t)(32 + r) * FF + 8 * h, Bt + (size_t)(c0 + r) * FF + 8 * h, Bt + (size_t)(c0 + 32 + r) * FF + 8 * h, FF);
#pragma unroll
            for (int mt = 0; mt < 2; ++mt)
#pragma unroll
                for (int q = 0; q < 16; ++q) {
                    const int pos = pos0 + 32 * mt + crow(q, h);
                    if (pos < ce) {
                        const int dst = F.list_dst()[(size_t)e * CAP + pos]; const float g = F.list_gate()[(size_t)e * CAP + pos];
#pragma unroll
                        for (int nt = 0; nt < 2; ++nt) { const int c = c0 + 32 * nt + r;
                            F.Y2()[(size_t)dst * D + c] = (bf16)f2bf(g * (acc[mt][nt][q] + bd[c])); }
                    }
                }
        }
        id0 += n; ts256 += (ce + 255) / 256;
    }
}

namespace pg8 {
constexpr int BM = 256, BK = 64, HALF = 128, HTB = HALF * BK * 2, STAGE_BYTES = 8 * HTB, NXCD = 8, WGM = 8;
__device__ __forceinline__ int lds_byte(int r, int c) { const int st = (r >> 4) * 2 + (c >> 5), rr = r & 15, cc = c & 31, ob = rr * 64 + cc * 2; return st * 1024 + (ob ^ (((ob >> 9) & 1) << 5)); }
__device__ __forceinline__ void stage_rc(int b, int& R, int& C) { const int st = b / 1024, sb = b % 1024, swz = sb ^ (((sb >> 9) & 1) << 5); R = (st >> 1) * 16 + swz / 64; C = (st & 1) * 32 + (swz % 64) / 2; }
__device__ __forceinline__ int perm32(int rho) { const int n = rho >> 4, i = rho & 15; return 8 * (i >> 2) + 4 * n + (i & 3); }
struct Unit { int pm, pn, e, pos0, ce; };
struct StaticOrder {
    int nM, nN, nwg, G, c;
    __device__ __forceinline__ void init(int M, int N, int G_, int c_) { nM = M / BM; nN = N / BM; nwg = nM * nN; G = G_; c = c_; }
    __device__ __forceinline__ bool next(int i, Unit& u) const {
        const long L = (long)i * G + c; if (L >= nwg) return false;
        int wgid = (int)L; { const int q = nwg / NXCD, r = nwg % NXCD, xcd = wgid % NXCD, off = wgid / NXCD; wgid = (xcd < r ? xcd * (q + 1) : r * (q + 1) + (xcd - r) * q) + off; }
        const int nig = WGM * nN, gid = wgid / nig, fm = gid * WGM, gsz = (nM - fm) < WGM ? (nM - fm) : WGM;
        u.pm = fm + ((wgid % nig) % gsz); u.pn = (wgid % nig) / gsz; u.e = 0; u.pos0 = 0; u.ce = 0; return true;
    }
};
__device__ __forceinline__ unsigned cvt_pk_bf16(float lo, float hi) { unsigned r; asm volatile("v_cvt_pk_bf16_f32 %0, %1, %2" : "=v"(r) : "v"(lo), "v"(hi)); return r; }
typedef f32x4 AccT[2][2][4][2];
template <class PB>
__device__ __forceinline__ void gemm_phase(LAS unsigned char* lds, const PB& pb, const int tid) {
    const int wid = __builtin_amdgcn_readfirstlane(tid >> 6), lane = tid & 63, wr = wid >> 2, wc = wid & 3, fr = lane & 15, fq = lane >> 4;
    constexpr int K = PB::K, nt = K / BK;
    unsigned voffB[2];
#pragma unroll
    for (int i = 0; i < 2; ++i) { int R, C; stage_rc(tid * 16 + i * 8192, R, C); const int Rb = PB::PERM ? ((R & ~31) + perm32(R & 31)) : R; voffB[i] = (unsigned)(Rb * K + C) * 2u; }
    constexpr size_t kstep = (size_t)(BK * 2);
    constexpr size_t hstep = (size_t)HALF * K * 2;
    const unsigned ldsw = (unsigned)wid * 1024u;
    const int aoff = lds_byte(wr * 64 + fr, fq * 8), boff = lds_byte(wc * 32 + fr, fq * 8);
#define PG8_SA(b, h) (((b) * 2 + (h)) * HTB)
#define PG8_SB(b, h) ((4 + (b) * 2 + (h)) * HTB)
#define PG8_STAGE(bufoff, gbase, voff) do { _Pragma("unroll") for (int _i = 0; _i < 2; ++_i) \
        __builtin_amdgcn_global_load_lds((const unsigned*)((const char*)(gbase) + (voff)[_i]), (LAS unsigned*)(lds + (bufoff) + ldsw + _i * 8192), 16, 0, 0); } while (0)
#define PG8_LDA(dst, b, h) do { _Pragma("unroll") for (int m = 0; m < 4; ++m) _Pragma("unroll") for (int k = 0; k < 2; ++k) dst[m][k] = *(const LAS bf16x8*)(lds + PG8_SA(b, h) + aoff + m * 2048 + k * 1024); } while (0)
#define PG8_LDB(dst, b, h) do { _Pragma("unroll") for (int n = 0; n < 2; ++n) _Pragma("unroll") for (int k = 0; k < 2; ++k) dst[n][k] = *(const LAS bf16x8*)(lds + PG8_SB(b, h) + boff + n * 2048 + k * 1024); } while (0)
#define PG8_MMA(ai, bj, At, Bt) do { __builtin_amdgcn_s_setprio(1); _Pragma("unroll") for (int m = 0; m < 4; ++m) _Pragma("unroll") for (int n = 0; n < 2; ++n) _Pragma("unroll") for (int k = 0; k < 2; ++k) \
        acc[ai][bj][m][n] = __builtin_amdgcn_mfma_f32_16x16x32_bf16(Bt[n][k], At[m][k], acc[ai][bj][m][n], 0, 0, 0); __builtin_amdgcn_s_setprio(0); } while (0)
#define PG8_WAIT_V(n) asm volatile("s_waitcnt vmcnt(" #n ")" ::: "memory")
#define PG8_WAIT_L(n) asm volatile("s_waitcnt lgkmcnt(" #n ")" ::: "memory")
#define PG8_BAR __builtin_amdgcn_s_barrier()
#define PG8_SCHED __builtin_amdgcn_sched_barrier(0)
    Unit cur, nxt; int ui = 0;
    if (!pb.next(0, cur)) return;
    f32x4 acc[2][2][4][2];
#pragma unroll
    for (int a = 0; a < 2; ++a)
#pragma unroll
        for (int b = 0; b < 2; ++b)
#pragma unroll
            for (int m = 0; m < 4; ++m)
#pragma unroll
                for (int n = 0; n < 2; ++n) acc[a][b][m][n] = (f32x4){0.f, 0.f, 0.f, 0.f};
    bf16x8 At[4][2], B0[2][2], B1[2][2];
    unsigned cv[2][2];
    pb.a_voff(cur, cv, tid);
    const char* cA = pb.a_base(cur); const char* cB = pb.b_base(cur);
    PG8_STAGE(PG8_SB(0, 0), cB, voffB); PG8_STAGE(PG8_SB(0, 1), cB + hstep, voffB); PG8_STAGE(PG8_SA(0, 0), cA, cv[0]); PG8_STAGE(PG8_SA(0, 1), cA, cv[1]);
    if (wr == 1) PG8_BAR;
    PG8_WAIT_V(2); PG8_BAR;
    PG8_STAGE(PG8_SB(1, 0), cB + kstep, voffB); PG8_STAGE(PG8_SA(1, 0), cA + kstep, cv[0]); PG8_STAGE(PG8_SB(1, 1), cB + hstep + kstep, voffB);
    PG8_WAIT_V(6); PG8_BAR;
    for (;;) {
        const bool has_next = pb.next(ui + 1, nxt);
        const char* nA = has_next ? pb.a_base(nxt) : cA; const char* nB = has_next ? pb.b_base(nxt) : cB;
        for (int t = 0; t < nt; t += 2) {
            const bool last = (t == nt - 2);
            const char* a1 = cA + (size_t)(t + 1) * kstep;
            const char* a2 = last ? nA : cA + (size_t)(t + 2) * kstep; const char* b2 = last ? nB : cB + (size_t)(t + 2) * kstep;
            const char* a3 = a2 + kstep; const char* b3 = b2 + kstep;
            if (PB::GATHER && t == nt - 4 && has_next) pb.tok_prefetch(nxt, lds, tid, wid);
            if (PB::GATHER && last && has_next) pb.a_voff_half_lds(cv[0], lds, tid, wid, 0);
            PG8_LDB(B0, 0, 0); PG8_LDB(B1, 0, 1); PG8_SCHED; PG8_LDA(At, 0, 0); PG8_STAGE(PG8_SA(1, 1), a1, cv[1]);
            if (PB::GATHER && last && has_next) pb.a_voff_half_lds(cv[1], lds, tid, wid, 1);
            PG8_WAIT_V(8); PG8_WAIT_L(0); PG8_BAR; PG8_MMA(0, 0, At, B0); PG8_MMA(0, 1, At, B1); PG8_BAR; PG8_SCHED;
            PG8_LDA(At, 0, 1); PG8_STAGE(PG8_SB(0, 0), b2, voffB); PG8_STAGE(PG8_SB(0, 1), b2 + hstep, voffB); PG8_STAGE(PG8_SA(0, 0), a2, cv[0]);
            PG8_WAIT_V(8); PG8_WAIT_L(0); PG8_BAR; PG8_MMA(1, 0, At, B0); PG8_MMA(1, 1, At, B1); PG8_BAR; PG8_SCHED;
            PG8_LDB(B0, 1, 0); PG8_LDB(B1, 1, 1); PG8_SCHED; PG8_LDA(At, 1, 0); PG8_STAGE(PG8_SA(0, 1), a2, cv[1]);
            PG8_WAIT_V(8); PG8_WAIT_L(0); PG8_BAR; PG8_MMA(0, 0, At, B0); PG8_MMA(0, 1, At, B1); PG8_BAR; PG8_SCHED;
            PG8_LDA(At, 1, 1); PG8_STAGE(PG8_SB(1, 0), b3, voffB); PG8_STAGE(PG8_SB(1, 1), b3 + hstep, voffB); PG8_STAGE(PG8_SA(1, 0), a3, cv[0]);
            PG8_WAIT_V(8); PG8_WAIT_L(0); PG8_BAR; PG8_MMA(1, 0, At, B0); PG8_MMA(1, 1, At, B1); PG8_BAR; PG8_SCHED;
        }
        if (wr == 0) PG8_BAR;
        pb.epi(acc, cur, wr, wc, fr, fq);
        if (!has_next) break;
#pragma unroll
        for (int a = 0; a < 2; ++a)
#pragma unroll
            for (int b = 0; b < 2; ++b)
#pragma unroll
                for (int m = 0; m < 4; ++m)
#pragma unroll
                    for (int n = 0; n < 2; ++n) acc[a][b][m][n] = (f32x4){0.f, 0.f, 0.f, 0.f};
        cur = nxt; cA = nA; cB = nB; ++ui;
        if (wr == 1) PG8_BAR;
    }
    PG8_WAIT_V(0);
    PG8_BAR;
#undef PG8_SA
#undef PG8_SB
#undef PG8_STAGE
#undef PG8_LDA
#undef PG8_LDB
#undef PG8_MMA
#undef PG8_WAIT_V
#undef PG8_WAIT_L
#undef PG8_BAR
#undef PG8_SCHED
}
typedef int v4i_t __attribute__((ext_vector_type(4)));
typedef int v8i_t __attribute__((ext_vector_type(8)));
template <class PB>
__device__ __forceinline__ void gemm_phase8(LAS unsigned char* lds, const PB& pb, const int tid) {
    const int wid = __builtin_amdgcn_readfirstlane(tid >> 6), lane = tid & 63, wr = wid >> 2, wc = wid & 3, fr = lane & 15, fq = lane >> 4;
    constexpr int K = PB::K  , nt = K / 128;
    unsigned vb0, va0;
    { int R, C; stage_rc(tid * 16, R, C); const int Rb = PB::PERM ? ((R & ~31) + perm32(R & 31)) : R; vb0 = (unsigned)(Rb * K + C * 2); va0 = (unsigned)(R * K + C * 2); }
    constexpr size_t kstep = (size_t)(BK * 2);
    constexpr size_t hstep = (size_t)HALF * K;
    const unsigned ldsw = (unsigned)wid * 1024u;
    const int aoff = lds_byte(wr * 64 + fr, fq * 8), boff = lds_byte(wc * 32 + fr, fq * 8);
#define PG8_SA(b, h) (((b) * 2 + (h)) * HTB)
#define PG8_SB(b, h) ((4 + (b) * 2 + (h)) * HTB)
#define PG8_STAGE_B(bufoff, gbase) do { _Pragma("unroll") for (int _i = 0; _i < 2; ++_i) \
        __builtin_amdgcn_global_load_lds((const unsigned*)((const char*)(gbase) + (size_t)(_i * 64) * K + vb0), (LAS unsigned*)(lds + (bufoff) + ldsw + _i * 8192), 16, 0, 0); } while (0)
#define PG8_STAGE_A(bufoff, gbase, h) do { _Pragma("unroll") for (int _i = 0; _i < 2; ++_i) { \
        const char* p_ = PB::GATHER ? (const char*)(gbase) + cv[h][_i] : (const char*)(gbase) + (size_t)((h) * 128 + _i * 64) * K + va0; \
        __builtin_amdgcn_global_load_lds((const unsigned*)p_, (LAS unsigned*)(lds + (bufoff) + ldsw + _i * 8192), 16, 0, 0); } } while (0)
#define PG8_LDA(dst, b, h) do { _Pragma("unroll") for (int m = 0; m < 4; ++m) { const v4i_t lo_ = *(const LAS v4i_t*)(lds + PG8_SA(b, h) + aoff + m * 2048), hi_ = *(const LAS v4i_t*)(lds + PG8_SA(b, h) + aoff + m * 2048 + 1024); dst[m] = __builtin_shufflevector(lo_, hi_, 0, 1, 2, 3, 4, 5, 6, 7); } } while (0)
#define PG8_LDB(dst, b, h) do { _Pragma("unroll") for (int n = 0; n < 2; ++n) { const v4i_t lo_ = *(const LAS v4i_t*)(lds + PG8_SB(b, h) + boff + n * 2048), hi_ = *(const LAS v4i_t*)(lds + PG8_SB(b, h) + boff + n * 2048 + 1024); dst[n] = __builtin_shufflevector(lo_, hi_, 0, 1, 2, 3, 4, 5, 6, 7); } } while (0)
#define PG8_MMA(ai, bj, At, Bt) do { __builtin_amdgcn_s_setprio(1); _Pragma("unroll") for (int m = 0; m < 4; ++m) _Pragma("unroll") for (int n = 0; n < 2; ++n) \
        asm volatile("v_mfma_scale_f32_16x16x128_f8f6f4 %0, %1, %2, %0, %3, %3 op_sel_hi:[0,0,0]" : "+v"(acc[ai][bj][m][n]) : "v"(Bt[n]), "v"(At[m]), "v"(sc1)); \
        __builtin_amdgcn_s_setprio(0); } while (0)
#define PG8_WAIT_V(n) asm volatile("s_waitcnt vmcnt(" #n ")" ::: "memory")
#define PG8_WAIT_L(n) asm volatile("s_waitcnt lgkmcnt(" #n ")" ::: "memory")
#define PG8_BAR __builtin_amdgcn_s_barrier()
#define PG8_SCHED __builtin_amdgcn_sched_barrier(0)
    Unit cur, nxt; int ui = 0;
    if (!pb.next(0, cur)) return;
    f32x4 acc[2][2][4][2];
#pragma unroll
    for (int a = 0; a < 2; ++a)
#pragma unroll
        for (int b = 0; b < 2; ++b)
#pragma unroll
            for (int m = 0; m < 4; ++m)
#pragma unroll
                for (int n = 0; n < 2; ++n) acc[a][b][m][n] = (f32x4){0.f, 0.f, 0.f, 0.f};
    v8i_t At[4], B0[2], B1[2];
    int sc1 = 0x7f7f7f7f; asm volatile("" : "+v"(sc1));
    unsigned cv[2][2];
    if (PB::GATHER) pb.a_voff(cur, cv, tid); else { cv[0][0] = cv[0][1] = cv[1][0] = cv[1][1] = 0u; }
    const char* cA = pb.a_base(cur); const char* cB = pb.b_base(cur);
    PG8_STAGE_B(PG8_SB(0, 0), cB); PG8_STAGE_B(PG8_SB(0, 1), cB + hstep); PG8_STAGE_A(PG8_SA(0, 0), cA, 0); PG8_STAGE_A(PG8_SA(0, 1), cA, 1);
    if (wr == 1) PG8_BAR;
    PG8_WAIT_V(2); PG8_BAR;
    PG8_STAGE_B(PG8_SB(1, 0), cB + kstep); PG8_STAGE_A(PG8_SA(1, 0), cA + kstep, 0); PG8_STAGE_B(PG8_SB(1, 1), cB + hstep + kstep);
    PG8_WAIT_V(6); PG8_BAR;
    for (;;) {
        const bool has_next = pb.next(ui + 1, nxt);
        const char* nA = has_next ? pb.a_base(nxt) : cA; const char* nB = has_next ? pb.b_base(nxt) : cB;
#pragma unroll 1
        for (int t = 0; t < nt; t += 2) {
            const bool last = (t == nt - 2);
            const char* a1 = cA + (size_t)(t + 1) * kstep;
            const char* a2 = last ? nA : cA + (size_t)(t + 2) * kstep; const char* b2 = last ? nB : cB + (size_t)(t + 2) * kstep;
            const char* a3 = a2 + kstep; const char* b3 = b2 + kstep;
            if (PB::GATHER && t == nt - 4 && has_next) pb.tok_prefetch(nxt, lds, tid, wid);
            if (PB::GATHER && last && has_next) pb.a_voff_half_lds(cv[0], lds, tid, wid, 0);
            PG8_LDB(B0, 0, 0); PG8_LDB(B1, 0, 1); PG8_SCHED; PG8_LDA(At, 0, 0); PG8_STAGE_A(PG8_SA(1, 1), a1, 1);
            if (PB::GATHER && last && has_next) pb.a_voff_half_lds(cv[1], lds, tid, wid, 1);
            PG8_WAIT_V(8); PG8_WAIT_L(0); PG8_BAR; PG8_MMA(0, 0, At, B0); PG8_MMA(0, 1, At, B1); PG8_BAR; PG8_SCHED;
            PG8_LDA(At, 0, 1); PG8_STAGE_B(PG8_SB(0, 0), b2); PG8_STAGE_B(PG8_SB(0, 1), b2 + hstep); PG8_STAGE_A(PG8_SA(0, 0), a2, 0);
            PG8_WAIT_V(8); PG8_WAIT_L(0); PG8_BAR; PG8_MMA(1, 0, At, B0); PG8_MMA(1, 1, At, B1); PG8_BAR; PG8_SCHED;
            PG8_LDB(B0, 1, 0); PG8_LDB(B1, 1, 1); PG8_SCHED; PG8_LDA(At, 1, 0); PG8_STAGE_A(PG8_SA(0, 1), a2, 1);
            PG8_WAIT_V(8); PG8_WAIT_L(0); PG8_BAR; PG8_MMA(0, 0, At, B0); PG8_MMA(0, 1, At, B1); PG8_BAR; PG8_SCHED;
            PG8_LDA(At, 1, 1); PG8_STAGE_B(PG8_SB(1, 0), b3); PG8_STAGE_B(PG8_SB(1, 1), b3 + hstep); PG8_STAGE_A(PG8_SA(1, 0), a3, 0);
            PG8_WAIT_V(8); PG8_WAIT_L(0); PG8_BAR; PG8_MMA(1, 0, At, B0); PG8_MMA(1, 1, At, B1); PG8_BAR; PG8_SCHED;
        }
        if (wr == 0) PG8_BAR;
        asm volatile("s_nop 15\n\ts_nop 15" ::: "memory");
        { int fr_ = fr, fq_ = fq; asm volatile("" : "+v"(fr_), "+v"(fq_));
          pb.epi(acc, cur, wr, wc, fr_, fq_); }
        if (!has_next) break;
#pragma unroll
        for (int a = 0; a < 2; ++a)
#pragma unroll
            for (int b = 0; b < 2; ++b)
#pragma unroll
                for (int m = 0; m < 4; ++m)
#pragma unroll
                    for (int n = 0; n < 2; ++n) acc[a][b][m][n] = (f32x4){0.f, 0.f, 0.f, 0.f};
        cur = nxt; cA = nA; cB = nB; ++ui;
        if (wr == 1) PG8_BAR;
    }
    PG8_WAIT_V(0);
    PG8_BAR;
#undef PG8_SA
#undef PG8_SB
#undef PG8_STAGE_A
#undef PG8_STAGE_B
#undef PG8_LDA
#undef PG8_LDB
#undef PG8_MMA
#undef PG8_WAIT_V
#undef PG8_WAIT_L
#undef PG8_BAR
#undef PG8_SCHED
}
__device__ __forceinline__ void voff_contig8(unsigned (&v)[2][2], int tid, int KB) {
#pragma unroll
    for (int i = 0; i < 2; ++i) { int R, C; stage_rc(tid * 16 + i * 8192, R, C); v[0][i] = (unsigned)(R * KB + C * 2); v[1][i] = (unsigned)((R + HALF) * KB + C * 2); }
}
__device__ __forceinline__ void voff_contig(unsigned (&v)[2][2], int tid, int K) {
#pragma unroll
    for (int i = 0; i < 2; ++i) { int R, C; stage_rc(tid * 16 + i * 8192, R, C); v[0][i] = (unsigned)(R * K + C) * 2u; v[1][i] = (unsigned)((R + HALF) * K + C) * 2u; }
}
}

struct PbInproj {
    static constexpr int K = D; static constexpr bool PERM = true, GATHER = false;
    const bf16* A; const bf16* Bt; bf16* P; bf16* Vt; const f32x2* rope; pg8::StaticOrder S;
    __device__ __forceinline__ bool next(int i, pg8::Unit& u) const { return S.next(i, u); }
    __device__ __forceinline__ const char* a_base(const pg8::Unit& u) const { return (const char*)A + (size_t)u.pm * 256 * K * 2; }
    __device__ __forceinline__ const char* b_base(const pg8::Unit& u) const { return (const char*)Bt + (size_t)u.pn * 256 * K * 2; }
    __device__ __forceinline__ void a_voff(const pg8::Unit&, unsigned (&v)[2][2], int tid) const { pg8::voff_contig(v, tid, K); }
    __device__ __forceinline__ void tok_prefetch(const pg8::Unit&, LAS unsigned char*, int, int) const {}
    __device__ __forceinline__ void a_voff_half_lds(unsigned (&)[2], LAS unsigned char*, int, int, int) const {}
    __device__ __forceinline__ void epi(const pg8::AccT& acc, const pg8::Unit& u, int wr, int wc, int fr, int fq) const {
        const int row0 = u.pm * 256 + wr * 64 + fr; const bool lat = row0 < ML;
#pragma unroll
        for (int ai = 0; ai < 2; ++ai)
#pragma unroll
            for (int m = 0; m < 4; ++m) {
                const int row = row0 + ai * 128 + m * 16; const int t = row & (SEQ - 1);
#pragma unroll
                for (int bj = 0; bj < 2; ++bj) {
                    const int c0 = u.pn * 256 + bj * 128 + wc * 32 + 8 * fq;
                    f32x4 v0 = acc[ai][bj][m][0], v1 = acc[ai][bj][m][1];
                    if (c0 < C_V) {
                        if (lat) {
                            const int pr0 = (c0 & 63) >> 1, p = pr0 >> 4, f0 = pr0 & 15, pos = p ? (t & 63) : (t >> 6);
                            const f32x4 ca = *(const f32x4*)(rope + pos * 16 + f0), cb = *(const f32x4*)(rope + pos * 16 + f0 + 2);
                            const f32x4 w0 = {v0.x * ca.x - v0.y * ca.y, v0.x * ca.y + v0.y * ca.x, v0.z * ca.z - v0.w * ca.w, v0.z * ca.w + v0.w * ca.z};
                            const f32x4 w1 = {v1.x * cb.x - v1.y * cb.y, v1.x * cb.y + v1.y * cb.x, v1.z * cb.z - v1.w * cb.w, v1.z * cb.w + v1.w * cb.z};
                            v0 = w0; v1 = w1;
                        }
                        if (c0 < C_K) { v0 *= QSCALE; v1 *= QSCALE; }
                    }
                    u32x4 w; w.x = pg8::cvt_pk_bf16(v0.x, v0.y); w.y = pg8::cvt_pk_bf16(v0.z, v0.w); w.z = pg8::cvt_pk_bf16(v1.x, v1.y); w.w = pg8::cvt_pk_bf16(v1.z, v1.w);
                    *(u32x4*)(P + (size_t)row * INW + c0) = w;
                    if (c0 >= C_V && c0 < C_LX) {
                        const size_t vi = vt_index(row, c0 - C_V); const size_t st = row < ML ? SEQ : CTXL;
                        Vt[vi] = (bf16)(w.x & 0xffffu); Vt[vi + st] = (bf16)(w.x >> 16); Vt[vi + 2 * st] = (bf16)(w.y & 0xffffu); Vt[vi + 3 * st] = (bf16)(w.y >> 16);
                        Vt[vi + 4 * st] = (bf16)(w.z & 0xffffu); Vt[vi + 5 * st] = (bf16)(w.z >> 16); Vt[vi + 6 * st] = (bf16)(w.w & 0xffffu); Vt[vi + 7 * st] = (bf16)(w.w >> 16);
                    }
                }
            }
    }
};
struct PbOutproj {
    static constexpr int K = D; static constexpr bool PERM = true, GATHER = false;
    const bf16* A; const bf16* Bt; bf16* TMP; const float* mods_l; pg8::StaticOrder S;
    __device__ __forceinline__ bool next(int i, pg8::Unit& u) const { return S.next(i, u); }
    __device__ __forceinline__ const char* a_base(const pg8::Unit& u) const { return (const char*)A + (size_t)u.pm * 256 * K * 2; }
    __device__ __forceinline__ const char* b_base(const pg8::Unit& u) const { return (const char*)Bt + (size_t)u.pn * 256 * K * 2; }
    __device__ __forceinline__ void a_voff(const pg8::Unit&, unsigned (&v)[2][2], int tid) const { pg8::voff_contig(v, tid, K); }
    __device__ __forceinline__ void tok_prefetch(const pg8::Unit&, LAS unsigned char*, int, int) const {}
    __device__ __forceinline__ void a_voff_half_lds(unsigned (&)[2], LAS unsigned char*, int, int, int) const {}
    __device__ __forceinline__ void epi(const pg8::AccT& acc, const pg8::Unit& u, int wr, int wc, int fr, int fq) const {
        const int row0 = u.pm * 256 + wr * 64 + fr;
        const float* g2 = mods_l + (size_t)mod_row(u.pm * 256) * 6 * D + 2 * D;
        f32x4 gv[2][2];
#pragma unroll
        for (int bj = 0; bj < 2; ++bj) { const int c0 = u.pn * 256 + bj * 128 + wc * 32 + 8 * fq; gv[bj][0] = *(const f32x4*)(g2 + c0); gv[bj][1] = *(const f32x4*)(g2 + c0 + 4); }
#pragma unroll
        for (int ai = 0; ai < 2; ++ai)
#pragma unroll
            for (int m = 0; m < 4; ++m) { bf16* rowp = TMP + (size_t)(row0 + ai * 128 + m * 16) * D;
#pragma unroll
                for (int bj = 0; bj < 2; ++bj) { const int c0 = u.pn * 256 + bj * 128 + wc * 32 + 8 * fq;
                    const f32x4 v0 = gv[bj][0] * acc[ai][bj][m][0], v1 = gv[bj][1] * acc[ai][bj][m][1];
                    u32x4 w; w.x = pg8::cvt_pk_bf16(v0.x, v0.y); w.y = pg8::cvt_pk_bf16(v0.z, v0.w); w.z = pg8::cvt_pk_bf16(v1.x, v1.y); w.w = pg8::cvt_pk_bf16(v1.z, v1.w);
                    *(u32x4*)(rowp + c0) = w; } }
    }
};
constexpr int TOK_LDS = 131072 + 4096;
constexpr int MOE_LDS = 131072;
__device__ __forceinline__ int moe_setup(Ctx& F, int l) {
    LAS int* cntL = (LAS int*)(F.lds + MOE_LDS); LAS int* tst = (LAS int*)(F.lds + MOE_LDS + 256); LAS unsigned short* te = (LAS unsigned short*)(F.lds + MOE_LDS + 512);
    const unsigned* cnt = (const unsigned*)(F.ctl() + CW_CNT + l * 64);
    __syncthreads();
    if (F.tid < NE) cntL[F.tid] = (int)__hip_atomic_load(cnt + F.tid, __ATOMIC_RELAXED, __HIP_MEMORY_SCOPE_AGENT);
    __syncthreads();
    if (F.tid == 0) { int s = 0; for (int e = 0; e < NE; ++e) { tst[e] = s; s += (cntL[e] + 255) >> 8; } tst[NE] = s; }
    __syncthreads();
    const int T = tst[NE];
    for (int i = F.tid; i < T; i += NTHR) { int e = 0; for (int q = 1; q < NE; ++q) e = (tst[q] <= i) ? q : e; te[i] = (unsigned short)e; }
    __syncthreads();
    return T;
}
struct MoeOrder {
    int t0, nun, rank, nper, npn; const LAS unsigned short* te; const LAS int* tst; const LAS int* cntl;
    __device__ __forceinline__ void init(const Ctx& F, int T, int npn_) {
        const int x = F.bid & 7; nper = F.G >> 3; rank = F.bid >> 3; npn = npn_;
        t0 = (x * T) >> 3; const int t1 = ((x + 1) * T) >> 3; nun = (t1 - t0) * npn;
        te = (const LAS unsigned short*)(F.lds + MOE_LDS + 512); tst = (const LAS int*)(F.lds + MOE_LDS + 256); cntl = (const LAS int*)(F.lds + MOE_LDS);
    }
    __device__ __forceinline__ bool next(int i, pg8::Unit& u) const {
        const int x = rank + i * nper; if (x >= nun) return false;
        const int rt = t0 + x / npn; u.pm = rt; u.pn = x % npn; u.e = __builtin_amdgcn_readfirstlane((int)te[rt]); u.pos0 = (rt - __builtin_amdgcn_readfirstlane(tst[u.e])) * 256; u.ce = __builtin_amdgcn_readfirstlane(cntl[u.e]); return true;
    }
};
struct PbGu {
    static constexpr int K = D; static constexpr bool PERM = true, GATHER = true;
    const bf16* A; const bf16* Bt_l; bf16* H; const float* bgu_l; const int* list_tok; MoeOrder S; const LAS int* cntL;
    __device__ __forceinline__ bool next(int i, pg8::Unit& u) const { return S.next(i, u); }
    __device__ __forceinline__ const char* a_base(const pg8::Unit&) const { return (const char*)A; }
    __device__ __forceinline__ const char* b_base(const pg8::Unit& u) const { return (const char*)Bt_l + ((size_t)u.e * 2 * FF + (size_t)u.pn * 256) * K * 2; }
    __device__ __forceinline__ void a_voff_half(const pg8::Unit& u, unsigned (&v)[2], int tid, int h) const {
        const int ce = u.ce;
#pragma unroll
        for (int i = 0; i < 2; ++i) { int R, C; pg8::stage_rc(tid * 16 + i * 8192, R, C);
            const int pos = u.pos0 + h * 128 + R; const int tok = pos < ce ? list_tok[(size_t)u.e * CAP + pos] : 0; v[i] = (unsigned)(tok * K + C) * 2u; }
    }
    __device__ __forceinline__ void a_voff(const pg8::Unit& u, unsigned (&v)[2][2], int tid) const { a_voff_half(u, v[0], tid, 0); a_voff_half(u, v[1], tid, 1); }
    __device__ __forceinline__ void tok_prefetch(const pg8::Unit& u, LAS unsigned char* lds, int tid, int wid) const {
        const int ce = u.ce;
#pragma unroll
        for (int h = 0; h < 2; ++h)
#pragma unroll
            for (int i = 0; i < 2; ++i) { int R, C; pg8::stage_rc(tid * 16 + i * 8192, R, C);
                const int pos = u.pos0 + h * 128 + R; const int* src = list_tok + (size_t)u.e * CAP + (pos < ce ? pos : 0);
                __builtin_amdgcn_global_load_lds((const unsigned*)src, (LAS unsigned*)(lds + TOK_LDS + ((h * 2 + i) * 8 + wid) * 256), 4, 0, 0); }
    }
    __device__ __forceinline__ void a_voff_half_lds(unsigned (&v)[2], LAS unsigned char* lds, int tid, int wid, int h) const {
#pragma unroll
        for (int i = 0; i < 2; ++i) { int R, C; pg8::stage_rc(tid * 16 + i * 8192, R, C);
            const int tok = *(const LAS int*)(lds + TOK_LDS + ((h * 2 + i) * 8 + wid) * 256 + (tid & 63) * 4); v[i] = (unsigned)(tok * K + C) * 2u; }
    }
    __device__ __forceinline__ void epi(const pg8::AccT& acc, const pg8::Unit& u, int wr, int wc, int fr, int fq) const {
        const int row0 = u.pm * 256 + wr * 64 + fr, ff0 = u.pn * 128 + wc * 32 + 8 * fq;
        const float* bg = bgu_l + (size_t)u.e * 2 * FF;
        const f32x4 bg0 = *(const f32x4*)(bg + ff0), bg1 = *(const f32x4*)(bg + ff0 + 4), bu0 = *(const f32x4*)(bg + FF + ff0), bu1 = *(const f32x4*)(bg + FF + ff0 + 4);
#pragma unroll
        for (int ai = 0; ai < 2; ++ai)
#pragma unroll
            for (int m = 0; m < 4; ++m) {
                float o[8];
#pragma unroll
                for (int n = 0; n < 2; ++n) { const f32x4 g = acc[ai][0][m][n] + (n ? bg1 : bg0), up = acc[ai][1][m][n] + (n ? bu1 : bu0);
#pragma unroll
                    for (int j = 0; j < 4; ++j) { const float gate = fminf(g[j], 7.0f), upc = fminf(fmaxf(up[j], -7.0f), 7.0f); o[4 * n + j] = (upc + 1.0f) * gate * sigmoidf_(1.702f * gate); } }
                u32x4 w; w.x = pg8::cvt_pk_bf16(o[0], o[1]); w.y = pg8::cvt_pk_bf16(o[2], o[3]); w.z = pg8::cvt_pk_bf16(o[4], o[5]); w.w = pg8::cvt_pk_bf16(o[6], o[7]);
                *(u32x4*)(H + (size_t)(row0 + ai * 128 + m * 16) * FF + ff0) = w;
            }
    }
};
struct PbDown {
    static constexpr int K = FF; static constexpr bool PERM = true, GATHER = false;
    const bf16* A; const bf16* Bt_l; bf16* Y2; const float* bd_l; const int* list_dst; const float* list_gate; MoeOrder S; const LAS int* cntL;
    __device__ __forceinline__ bool next(int i, pg8::Unit& u) const { return S.next(i, u); }
    __device__ __forceinline__ const char* a_base(const pg8::Unit& u) const { return (const char*)A + (size_t)u.pm * 256 * K * 2; }
    __device__ __forceinline__ const char* b_base(const pg8::Unit& u) const { return (const char*)Bt_l + ((size_t)u.e * D + (size_t)u.pn * 256) * K * 2; }
    __device__ __forceinline__ void a_voff(const pg8::Unit&, unsigned (&v)[2][2], int tid) const { pg8::voff_contig(v, tid, K); }
    __device__ __forceinline__ void tok_prefetch(const pg8::Unit&, LAS unsigned char*, int, int) const {}
    __device__ __forceinline__ void a_voff_half_lds(unsigned (&)[2], LAS unsigned char*, int, int, int) const {}
    __device__ __forceinline__ void epi(const pg8::AccT& acc, const pg8::Unit& u, int wr, int wc, int fr, int fq) const {
        const int ce = u.ce; const int p0 = u.pos0 + wr * 64 + fr; const float* bd = bd_l + (size_t)u.e * D;
        int dsts[2][4]; float gs[2][4];
#pragma unroll
        for (int ai = 0; ai < 2; ++ai)
#pragma unroll
            for (int m = 0; m < 4; ++m) { const int pos = p0 + ai * 128 + m * 16; const size_t ix = (size_t)u.e * CAP + (pos < ce ? pos : 0); dsts[ai][m] = list_dst[ix]; gs[ai][m] = list_gate[ix]; }
        f32x4 bb[2][2];
#pragma unroll
        for (int bj = 0; bj < 2; ++bj) { const int c0 = u.pn * 256 + bj * 128 + wc * 32 + 8 * fq; bb[bj][0] = *(const f32x4*)(bd + c0); bb[bj][1] = *(const f32x4*)(bd + c0 + 4); }
#pragma unroll
        for (int ai = 0; ai < 2; ++ai)
#pragma unroll
            for (int m = 0; m < 4; ++m) {
                const int pos = p0 + ai * 128 + m * 16;
                {
                    const float g = gs[ai][m]; const size_t drow = pos < ce ? (size_t)dsts[ai][m] : (size_t)(Y2_DUMMY_ROW + (pos & 255));
#pragma unroll
                    for (int bj = 0; bj < 2; ++bj) { const int c0 = u.pn * 256 + bj * 128 + wc * 32 + 8 * fq;
                        const f32x4 v0 = (acc[ai][bj][m][0] + bb[bj][0]) * g, v1 = (acc[ai][bj][m][1] + bb[bj][1]) * g;
                        u32x4 w; w.x = pg8::cvt_pk_bf16(v0.x, v0.y); w.y = pg8::cvt_pk_bf16(v0.z, v0.w); w.z = pg8::cvt_pk_bf16(v1.x, v1.y); w.w = pg8::cvt_pk_bf16(v1.z, v1.w);
                        *(u32x4*)(Y2 + drow * D + c0) = w; }
                }
            }
    }
};
struct PbGu8 {
    static constexpr int K = D; static constexpr bool PERM = true, GATHER = true;
    const unsigned char* A; const unsigned char* Bt_l; unsigned char* H; const float* bgu_l; const int* list_tok; MoeOrder S; const LAS int* cntL;
    __device__ __forceinline__ bool next(int i, pg8::Unit& u) const { return S.next(i, u); }
    __device__ __forceinline__ const char* a_base(const pg8::Unit&) const { return (const char*)A; }
    __device__ __forceinline__ const char* b_base(const pg8::Unit& u) const { return (const char*)Bt_l + ((size_t)u.e * 2 * FF + (size_t)u.pn * 256) * K; }
    __device__ __forceinline__ void a_voff_half(const pg8::Unit& u, unsigned (&v)[2], int tid, int h) const {
        const int ce = u.ce;
#pragma unroll
        for (int i = 0; i < 2; ++i) { int R, C; pg8::stage_rc(tid * 16 + i * 8192, R, C);
            const int pos = u.pos0 + h * 128 + R; const int tok = pos < ce ? list_tok[(size_t)u.e * CAP + pos] : 0; v[i] = (unsigned)(tok * K + C * 2); }
    }
    __device__ __forceinline__ void a_voff(const pg8::Unit& u, unsigned (&v)[2][2], int tid) const { a_voff_half(u, v[0], tid, 0); a_voff_half(u, v[1], tid, 1); }
    __device__ __forceinline__ void tok_prefetch(const pg8::Unit& u, LAS unsigned char* lds, int tid, int wid) const {
        const int ce = u.ce;
#pragma unroll
        for (int h = 0; h < 2; ++h)
#pragma unroll
            for (int i = 0; i < 2; ++i) { int R, C; pg8::stage_rc(tid * 16 + i * 8192, R, C);
                const int pos = u.pos0 + h * 128 + R; const int* src = list_tok + (size_t)u.e * CAP + (pos < ce ? pos : 0);
                __builtin_amdgcn_global_load_lds((const unsigned*)src, (LAS unsigned*)(lds + TOK_LDS + ((h * 2 + i) * 8 + wid) * 256), 4, 0, 0); }
    }
    __device__ __forceinline__ void a_voff_half_lds(unsigned (&v)[2], LAS unsigned char* lds, int tid, int wid, int h) const {
#pragma unroll
        for (int i = 0; i < 2; ++i) { int R, C; pg8::stage_rc(tid * 16 + i * 8192, R, C);
            const int tok = *(const LAS int*)(lds + TOK_LDS + ((h * 2 + i) * 8 + wid) * 256 + (tid & 63) * 4); v[i] = (unsigned)(tok * K + C * 2); }
    }
    __device__ __forceinline__ void epi(const pg8::AccT& acc, const pg8::Unit& u, int wr, int wc, int fr, int fq) const {
        const int row0 = u.pm * 256 + wr * 64 + fr, ff0 = u.pn * 128 + wc * 32 + 8 * fq;
        const float* bg = bgu_l + (size_t)u.e * 2 * FF;
        const f32x4 bg0 = *(const f32x4*)(bg + ff0), bg1 = *(const f32x4*)(bg + ff0 + 4), bu0 = *(const f32x4*)(bg + FF + ff0), bu1 = *(const f32x4*)(bg + FF + ff0 + 4);
#pragma unroll
        for (int ai = 0; ai < 2; ++ai)
#pragma unroll
            for (int m = 0; m < 4; ++m) {
                float o[8];
#pragma unroll
                for (int n = 0; n < 2; ++n) { const f32x4 g = acc[ai][0][m][n] * (1.0f / W8_SCALE) + (n ? bg1 : bg0), up = acc[ai][1][m][n] * (1.0f / W8_SCALE) + (n ? bu1 : bu0);
#pragma unroll
                    for (int j = 0; j < 4; ++j) { const float gate = fminf(g[j], 7.0f), upc = fminf(fmaxf(up[j], -7.0f), 7.0f); o[4 * n + j] = (upc + 1.0f) * gate * sigmoidf_(1.702f * gate); } }
                u32x2 w; w.x = pk_fp8x4(o[0], o[1], o[2], o[3]); w.y = pk_fp8x4(o[4], o[5], o[6], o[7]);
                *(u32x2*)(H + (size_t)(row0 + ai * 128 + m * 16) * FF + ff0) = w;
            }
    }
};
struct PbDown8 {
    static constexpr int K = FF; static constexpr bool PERM = true, GATHER = false;
    const unsigned char* A; const unsigned char* Bt_l; bf16* Y2; const float* bd_l; const int* list_dst; const float* list_gate; MoeOrder S; const LAS int* cntL;
    __device__ __forceinline__ bool next(int i, pg8::Unit& u) const { return S.next(i, u); }
    __device__ __forceinline__ const char* a_base(const pg8::Unit& u) const { return (const char*)A + (size_t)u.pm * 256 * K; }
    __device__ __forceinline__ const char* b_base(const pg8::Unit& u) const { return (const char*)Bt_l + ((size_t)u.e * D + (size_t)u.pn * 256) * K; }
    __device__ __forceinline__ void a_voff(const pg8::Unit&, unsigned (&v)[2][2], int tid) const { pg8::voff_contig8(v, tid, K); }
    __device__ __forceinline__ void tok_prefetch(const pg8::Unit&, LAS unsigned char*, int, int) const {}
    __device__ __forceinline__ void a_voff_half_lds(unsigned (&)[2], LAS unsigned char*, int, int, int) const {}
    __device__ __forceinline__ void epi(const pg8::AccT& acc, const pg8::Unit& u, int wr, int wc, int fr, int fq) const {
        const int ce = u.ce; const int p0 = u.pos0 + wr * 64 + fr; const float* bd = bd_l + (size_t)u.e * D;
        int dsts[2][4]; float gs[2][4];
#pragma unroll
        for (int ai = 0; ai < 2; ++ai)
#pragma unroll
            for (int m = 0; m < 4; ++m) { const int pos = p0 + ai * 128 + m * 16; const size_t ix = (size_t)u.e * CAP + (pos < ce ? pos : 0); dsts[ai][m] = list_dst[ix]; gs[ai][m] = list_gate[ix]; }
        f32x4 bb[2][2];
#pragma unroll
        for (int bj = 0; bj < 2; ++bj) { const int c0 = u.pn * 256 + bj * 128 + wc * 32 + 8 * fq; bb[bj][0] = *(const f32x4*)(bd + c0); bb[bj][1] = *(const f32x4*)(bd + c0 + 4); }
#pragma unroll
        for (int ai = 0; ai < 2; ++ai)
#pragma unroll
            for (int m = 0; m < 4; ++m) {
                const int pos = p0 + ai * 128 + m * 16;
                {
                    const float g = gs[ai][m]; const size_t drow = pos < ce ? (size_t)dsts[ai][m] : (size_t)(Y2_DUMMY_ROW + (pos & 255));
#pragma unroll
                    for (int bj = 0; bj < 2; ++bj) { const int c0 = u.pn * 256 + bj * 128 + wc * 32 + 8 * fq;
                        const f32x4 v0 = (acc[ai][bj][m][0] * (1.0f / W8_SCALE) + bb[bj][0]) * g, v1 = (acc[ai][bj][m][1] * (1.0f / W8_SCALE) + bb[bj][1]) * g;
                        if (Y2_FP8) { u32x2 w; w.x = pk_fp8x4(v0.x * Y2_SCALE, v0.y * Y2_SCALE, v0.z * Y2_SCALE, v0.w * Y2_SCALE); w.y = pk_fp8x4(v1.x * Y2_SCALE, v1.y * Y2_SCALE, v1.z * Y2_SCALE, v1.w * Y2_SCALE);
                            *(u32x2*)((unsigned char*)Y2 + drow * D + c0) = w; }
                        else { u32x4 w; w.x = pg8::cvt_pk_bf16(v0.x, v0.y); w.y = pg8::cvt_pk_bf16(v0.z, v0.w); w.z = pg8::cvt_pk_bf16(v1.x, v1.y); w.w = pg8::cvt_pk_bf16(v1.z, v1.w);
                            *(u32x4*)(Y2 + drow * D + c0) = w; } }
                }
            }
    }
};
__device__ __forceinline__ void ph_inproj_fast(Ctx& F, int l) {
    PbInproj pb; pb.A = F.H1(); pb.Bt = F.WinT() + (size_t)l * INW * D; pb.P = F.P(); pb.Vt = F.Vt(); pb.rope = F.rope(); pb.S.init(MA, INW, F.G, F.bid);
    pg8::gemm_phase(F.lds, pb, F.tid);
}
__device__ __forceinline__ void ph_outproj_fast(Ctx& F, int l) {
    PbOutproj pb; pb.A = F.MIX(); pb.Bt = F.WoutT() + (size_t)l * D * D; pb.TMP = F.P(); pb.mods_l = F.mods() + (size_t)l * 3 * 6 * D; pb.S.init(l == 0 ? MA : ML, D, F.G, F.bid);
    pg8::gemm_phase(F.lds, pb, F.tid);
}
__device__ __forceinline__ void ph_moe_gu_fast(Ctx& F, int l) {
    const int T = moe_setup(F, l);
    if (MOE_FP8) {
        PbGu8 pb; pb.A = (const unsigned char*)F.H1(); pb.Bt_l = (const unsigned char*)F.WguT() + (size_t)l * NE * 2 * FF * D; pb.H = (unsigned char*)F.HMOE(); pb.bgu_l = F.inp(I_BGU) + (size_t)l * NE * 2 * FF; pb.list_tok = F.list_tok();
        pb.S.init(F, T, 8); pb.cntL = (const LAS int*)(F.lds + MOE_LDS);
        pg8::gemm_phase8(F.lds, pb, F.tid);
    } else {
        PbGu pb; pb.A = F.H1(); pb.Bt_l = F.WguT() + (size_t)l * NE * 2 * FF * D; pb.H = F.HMOE(); pb.bgu_l = F.inp(I_BGU) + (size_t)l * NE * 2 * FF; pb.list_tok = F.list_tok();
        pb.S.init(F, T, 8); pb.cntL = (const LAS int*)(F.lds + MOE_LDS);
        pg8::gemm_phase(F.lds, pb, F.tid);
    }
}
__device__ __forceinline__ void ph_moe_down_fast(Ctx& F, int l) {
    const int T = moe_setup(F, l);
    if (MOE_FP8) {
        PbDown8 pb; pb.A = (const unsigned char*)F.HMOE(); pb.Bt_l = (const unsigned char*)F.WdT() + (size_t)l * NE * D * FF; pb.Y2 = F.Y2(); pb.bd_l = F.inp(I_BD) + (size_t)l * NE * D; pb.list_dst = F.list_dst(); pb.list_gate = F.list_gate();
        pb.S.init(F, T, 4); pb.cntL = (const LAS int*)(F.lds + MOE_LDS);
        pg8::gemm_phase8(F.lds, pb, F.tid);
    } else {
        PbDown pb; pb.A = F.HMOE(); pb.Bt_l = F.WdT() + (size_t)l * NE * D * FF; pb.Y2 = F.Y2(); pb.bd_l = F.inp(I_BD) + (size_t)l * NE * D; pb.list_dst = F.list_dst(); pb.list_gate = F.list_gate();
        pb.S.init(F, T, 4); pb.cntL = (const LAS int*)(F.lds + MOE_LDS);
        pg8::gemm_phase(F.lds, pb, F.tid);
    }
}

#define XB_TMO      128
#define XB_XCNT(j)  (256  + 64 * (j))
#define XB_XSUB(j)  (1280 + 64 * (j))
#define XB_XGEN(j)  (2304 + 64 * (j))
#define XB_TOP      3328
#define XB_TOPGEN   3392
#define XCD_BAR_WORDS 3456
#define XB_SPIN_CAP (1u << 22)
__device__ __forceinline__ unsigned xb_ld(unsigned* p)              { return __hip_atomic_load(p, __ATOMIC_RELAXED, __HIP_MEMORY_SCOPE_AGENT); }
__device__ __forceinline__ unsigned xb_add(unsigned* p, unsigned v) { return __hip_atomic_fetch_add(p, v, __ATOMIC_RELAXED, __HIP_MEMORY_SCOPE_AGENT); }
__device__ __forceinline__ unsigned xb_xcc_id() { return (unsigned)__builtin_amdgcn_s_getreg((3 << 11) | 20) & 0xFu; }
#define XB_SPIN(cond, bar) do { unsigned _sp = 0; while (cond) { __builtin_amdgcn_s_sleep(1); \
    if ((++_sp & 255u) == 0u) { if (xb_ld(&(bar)[XB_TMO])) break; if (_sp > XB_SPIN_CAP) { atomicAdd(&(bar)[XB_TMO], 1u); break; } } } } while (0)
struct XcdBarrier { unsigned* bar; unsigned x; volatile LAS unsigned* st; };
__device__ __forceinline__ XcdBarrier xcd_barrier_post(unsigned* bar, volatile LAS unsigned* st) {
    XcdBarrier b; b.bar = bar; b.x = xb_xcc_id(); b.st = st;
    if (threadIdx.x == 0) (void)xb_add(&bar[XB_XCNT(b.x)], 1u);
    return b;
}
__device__ __forceinline__ void xcd_barrier_complete(unsigned* bar, unsigned x, unsigned& nloc, unsigned& nx) {
    const unsigned G = gridDim.x * gridDim.y * gridDim.z;
    unsigned sum, cnt, mine, sp = 0u;
    for (;;) {
        sum = 0u; cnt = 0u; mine = 0u;
#pragma unroll
        for (unsigned j = 0; j < 16; ++j) { const unsigned c = xb_ld(&bar[XB_XCNT(j)]); sum += c; cnt += (c > 0u) ? 1u : 0u; mine = (j == x) ? c : mine; }
        if (sum == G) break;
        __builtin_amdgcn_s_sleep(1);
        if ((++sp & 255u) == 0u) { if (xb_ld(&bar[XB_TMO])) break; if (sp > XB_SPIN_CAP) { atomicAdd(&bar[XB_TMO], 1u); break; } }
    }
    nloc = mine > 0u ? mine : 1u; nx = cnt > 0u ? cnt : 1u;
}
__device__ __forceinline__ void xcd_barrier(const XcdBarrier& b0) {
    asm volatile("s_waitcnt vmcnt(0)" ::: "memory");
    __syncthreads();
    XcdBarrier b = b0;
    { unsigned long long p = (unsigned long long)b0.bar; unsigned xx = b0.x; asm volatile("" : "+s"(p), "+s"(xx)); b.bar = (unsigned*)p; b.x = xx; }
    if (threadIdx.x == 0) {
        unsigned* bar = b.bar;
        __builtin_amdgcn_s_waitcnt(0);
        unsigned nloc = b.st[0], nx = b.st[1];
        if (nloc == 0u) { xcd_barrier_complete(bar, b.x, nloc, nx); b.st[0] = nloc; b.st[1] = nx; }
        const unsigned old = xb_add(&bar[XB_XSUB(b.x)], 1u);
        const unsigned gen = old / nloc;
        if (old + 1u == (gen + 1u) * nloc) {
            __builtin_amdgcn_fence(__ATOMIC_RELEASE, "agent");
            asm volatile("s_waitcnt vmcnt(0)" ::: "memory");
            const unsigned og = xb_add(&bar[XB_TOP], 1u);
            const unsigned tg = og / nx;
            if (og + 1u == (tg + 1u) * nx) xb_add(&bar[XB_TOPGEN], 1u);
            else XB_SPIN(xb_ld(&bar[XB_TOPGEN]) == tg, bar);
            __builtin_amdgcn_fence(__ATOMIC_ACQUIRE, "agent");
            xb_add(&bar[XB_XGEN(b.x)], 1u);
            asm volatile("s_waitcnt vmcnt(0)" ::: "memory");
        } else {
            XB_SPIN(xb_ld(&bar[XB_XGEN(b.x)]) == gen, bar);
            __builtin_amdgcn_fence(__ATOMIC_ACQUIRE, "agent");
            asm volatile("s_waitcnt vmcnt(0)" ::: "memory");
        }
    }
    __syncthreads();
}

__device__ __forceinline__ void convert_item(Ctx& F, int l, int wi) {
    LAS float* scr = (LAS float*)(F.lds + F.wave * 8704);
    if (MOE_FP8) {
        if (wi < CV_GU) { const int le = l * NE + (wi >> 10); tr_item8<2>(F.inp(I_WGU) + (size_t)le * D * 2 * FF, D, 2 * FF, (unsigned char*)F.WguT() + (size_t)le * 2 * FF * D, scr, wi & 1023, F.lane); }
        else { const int r = wi - CV_GU; const int le = l * NE + (r >> 9); tr_item8<0>(F.inp(I_WD) + (size_t)le * FF * D, FF, D, (unsigned char*)F.WdT() + (size_t)le * D * FF, scr, r & 511, F.lane); }
        return;
    }
    if (wi < CV_GU) { const int le = l * NE + (wi >> 10); tr_item<2>(F.inp(I_WGU) + (size_t)le * D * 2 * FF, D, 2 * FF, F.WguT() + (size_t)le * 2 * FF * D, scr, wi & 1023, F.lane); }
    else { const int r = wi - CV_GU; const int le = l * NE + (r >> 9); tr_item<0>(F.inp(I_WD) + (size_t)le * FF * D, FF, D, F.WdT() + (size_t)le * D * FF, scr, r & 511, F.lane); }
}
__device__ __forceinline__ bool convert_next(Ctx& F, volatile LAS unsigned* prog, int pmax) {
    const int p = (int)prog[F.wave];
    if (p >= pmax) return false;
    convert_item(F, p / CV_PER_WAVE, (F.bid * NWAVES + F.wave) + 2048 * (p % CV_PER_WAVE));
    if (F.lane == 0) prog[F.wave] = (unsigned)(p + 1);
    return true;
}
__device__ __forceinline__ void drain_convert(Ctx& F, int l, volatile LAS unsigned* prog) {
    while (convert_next(F, prog, CV_PER_WAVE * (l + 1))) {}
}
__device__ __forceinline__ void xcd_barrier_steal(const XcdBarrier& b0, Ctx& F, volatile LAS unsigned* fl, volatile LAS unsigned* prog) {
    asm volatile("s_waitcnt vmcnt(0)" ::: "memory");
    __syncthreads();
    XcdBarrier b = b0;
    { unsigned long long p = (unsigned long long)b0.bar; unsigned xx = b0.x; asm volatile("" : "+s"(p), "+s"(xx)); b.bar = (unsigned*)p; b.x = xx; }
    unsigned* bar = b.bar;
    if (threadIdx.x == 0) {
        __builtin_amdgcn_s_waitcnt(0);
        unsigned nloc = b.st[0], nx = b.st[1];
        if (nloc == 0u) { xcd_barrier_complete(bar, b.x, nloc, nx); b.st[0] = nloc; b.st[1] = nx; }
        const unsigned old = xb_add(&bar[XB_XSUB(b.x)], 1u);
        const unsigned gen = old / nloc;
        if (old + 1u == (gen + 1u) * nloc) {
            __builtin_amdgcn_fence(__ATOMIC_RELEASE, "agent");
            asm volatile("s_waitcnt vmcnt(0)" ::: "memory");
            const unsigned og = xb_add(&bar[XB_TOP], 1u);
            const unsigned tg = og / nx;
            if (og + 1u == (tg + 1u) * nx) xb_add(&bar[XB_TOPGEN], 1u);
            else XB_SPIN(xb_ld(&bar[XB_TOPGEN]) == tg, bar);
            __builtin_amdgcn_fence(__ATOMIC_ACQUIRE, "agent");
            xb_add(&bar[XB_XGEN(b.x)], 1u);
            asm volatile("s_waitcnt vmcnt(0)" ::: "memory");
            fl[0] = 1u;
        } else { fl[0] = 0u; fl[1] = gen; }
    }
    __syncthreads();
    if (fl[0] == 0u) {
        const unsigned gen = fl[1];
        unsigned sp = 0u;
        for (;;) {
            unsigned rel = 0u;
            if (F.lane == 0) { rel = (xb_ld(&bar[XB_XGEN(b.x)]) != gen) ? 1u : 0u;
                if (!rel && (++sp & 63u) == 0u) { if (xb_ld(&bar[XB_TMO])) rel = 1u; else if (sp > XB_SPIN_CAP) { atomicAdd(&bar[XB_TMO], 1u); rel = 1u; } } }
            rel = (unsigned)__builtin_amdgcn_readfirstlane((int)rel);
            if (rel) break;
            if (!convert_next(F, prog, CV_PER_WAVE * NL)) __builtin_amdgcn_s_sleep(2);
        }
        asm volatile("s_waitcnt vmcnt(0)" ::: "memory");
        __syncthreads();
        if (threadIdx.x == 0) { __builtin_amdgcn_fence(__ATOMIC_ACQUIRE, "agent"); asm volatile("s_waitcnt vmcnt(0)" ::: "memory"); }
    }
    __syncthreads();
}

constexpr int LDS_BYTES = 147456;
constexpr int MISC_OFF = 147456 - 256;

__global__ void __launch_bounds__(NTHR, 2) fwd(Args args) {
    extern __shared__ __attribute__((aligned(16))) unsigned char lds[];
    Ctx F0;
    F0.lds = (LAS unsigned char*)lds;
    F0.tid = threadIdx.x; F0.lane = F0.tid & 63; F0.wave = __builtin_amdgcn_readfirstlane(F0.tid >> 6); F0.G = gridDim.x; F0.bid = blockIdx.x;
    F0.in = args.in; F0.out = args.out; F0.ws = args.ws;
    volatile LAS unsigned* MISC = (volatile LAS unsigned*)(F0.lds + MISC_OFF);
    if (F0.tid < 64) MISC[F0.tid] = 0u;
    __syncthreads();
    XcdBarrier bar; bar.bar = (unsigned*)(F0.ctl() + CW_BAR); bar.x = 0; bar.st = nullptr;
    if (MK_N_LAUNCHES == 1) bar = xcd_barrier_post((unsigned*)(F0.ctl() + CW_BAR), MISC + 8);
    const int lo = args.ph_lo, hi = args.ph_hi;
#define IN(k) (lo <= (k) && (k) < hi)
#define SEAM(k) do { if (IN(k) && IN((k) + 1)) { Ctx F = fresh(F0); xcd_barrier_steal(bar, F, MISC + 16, MISC + 24); } } while (0)
#define SEAM_S(k) SEAM(k)
#define PH(k, ...) do { if (IN(k)) { Ctx F = fresh(F0); __VA_ARGS__; } } while (0)

    PH(0, REPEAT(REP_PRO, ph_prologue(F))); SEAM(0);
    for (int l = 0; l < NL; ++l) {
        const int pb = 1 + 9 * l;
        PH(pb + 0, ph_norm1(F, l); if (REP_N10 > 1 && l == 0) ph_norm1(F, l)); SEAM(pb + 0);
        PH(pb + 1, REPEAT(REP_INP, if (FAST_GEMM) ph_inproj_fast(F, l); else ph_inproj_naive(F, l))); SEAM_S(pb + 1);
        if (FAST_ATTN) PH(pb + 2, REPEAT(REP_ATT, ph_attn_fast(F, l))); else PH(pb + 2, ph_attn_naive(F, l));
        if (FAST_LRU) PH(pb + 2, REPEAT(REP_LA, ph_lru_fast<false>(F, l))); else PH(pb + 2, ph_lru_gates_naive(F, l));
        if (FAST_HG) PH(pb + 2, REPEAT(REP_HA, ph_hgrn_fast<false>(F, l)));
        SEAM(pb + 2);
        if (FAST_LRU) PH(pb + 3, REPEAT(REP_CAR, ph_lru_carry(F))); else PH(pb + 3, ph_lru_scan_naive(F));
        if (FAST_HG) PH(pb + 3, REPEAT(REP_CAR, ph_hgrn_carry(F))); else PH(pb + 3, ph_hgrn_scan_naive(F, l));
        SEAM_S(pb + 3);
        if (FAST_LRU) PH(pb + 4, REPEAT(REP_LC, ph_lru_fast<true>(F, l))); else PH(pb + 4, ph_lru_out_naive(F, l));
        if (FAST_HG) PH(pb + 4, REPEAT(REP_HC, ph_hgrn_fast<true>(F, l))); else PH(pb + 4, ph_hgrn_out_naive(F, l));
        SEAM(pb + 4);
        PH(pb + 5, if (FAST_GEMM) ph_outproj_fast(F, l); else ph_outproj_naive(F, l); if (REP_OP0 > 1) ph_outproj_fast(F, l)); SEAM_S(pb + 5);
        PH(pb + 6, ph_norm2_router(F, l); __syncthreads(); drain_convert(F, l, MISC + 24)); SEAM(pb + 6);
        PH(pb + 7, REPEAT(REP_GU, if (FAST_GEMM) ph_moe_gu_fast(F, l); else ph_moe_gu_naive(F, l))); SEAM_S(pb + 7);
        PH(pb + 8, REPEAT(REP_DN, if (FAST_GEMM) ph_moe_down_fast(F, l); else ph_moe_down_naive(F, l))); SEAM_S(pb + 8);
    }
    PH(19, REPEAT(REP_FIN, ph_norm1(F, 2)));
#undef PH
#undef IN
#undef SEAM_S
#undef SEAM
}

extern "C" void kernel_launch(void* const* d_in, const int* in_sizes, int n_in, void* d_out, int out_size, void* d_ws, size_t ws_size, hipStream_t stream) {
    static int grid = 0;
    if (grid == 0) {
        if (n_in != 27 || out_size != ML * D || ws_size < WS_END) { fprintf(stderr, "kernel_launch: unexpected shapes (n_in %d out %d ws %zu)\n", n_in, out_size, ws_size); grid = -1; return; }
        int dev = 0, cus = 0, per_cu = 0;
        if (hipGetDevice(&dev) != hipSuccess || hipDeviceGetAttribute(&cus, hipDeviceAttributeMultiprocessorCount, dev) != hipSuccess) { grid = -1; return; }
        if (hipFuncSetAttribute((const void*)fwd, hipFuncAttributeMaxDynamicSharedMemorySize, LDS_BYTES) != hipSuccess) { fprintf(stderr, "kernel_launch: hipFuncSetAttribute failed\n"); grid = -1; return; }
        if (hipOccupancyMaxActiveBlocksPerMultiprocessor(&per_cu, (const void*)fwd, NTHR, LDS_BYTES) != hipSuccess || per_cu < 1) { fprintf(stderr, "kernel_launch: occupancy query says %d\n", per_cu); }
        (void)hipGetLastError();
        grid = cus;
        if (grid != 256) { fprintf(stderr, "kernel_launch: built for a 256-CU device (got %d)\n", cus); grid = -1; return; }
    }
    if (grid < 0) return;
    (void)hipMemsetAsync((char*)d_ws + WS_CTL, 0, CTL_ZERO_BYTES, stream);
    Args a{};
    for (int i = 0; i < 27; ++i) a.in[i] = (const float*)d_in[i];
    a.out = (float*)d_out; a.ws = (unsigned char*)d_ws;
    if (MK_N_LAUNCHES == 1) { a.ph_lo = 0; a.ph_hi = N_PH; hipLaunchKernelGGL(fwd, dim3(grid), dim3(NTHR), LDS_BYTES, stream, a); }
    else for (int p = 0; p < N_PH; ++p) { a.ph_lo = p; a.ph_hi = p + 1; hipLaunchKernelGGL(fwd, dim3(grid), dim3(NTHR), LDS_BYTES, stream, a); }
}
```

```cpp
#include <hip/hip_runtime.h>
#include <stdint.h>
#include <stdio.h>

#ifndef MK_N_LAUNCHES
#define MK_N_LAUNCHES 1
#endif

#ifndef MOE_FP8
#define MOE_FP8 1
#endif
#ifndef Y2_FP8
#define Y2_FP8 1
#endif
#ifndef FAST_GEMM
#define FAST_GEMM 1
#endif
#ifndef REP_PRO
#define REP_PRO 1
#endif
#ifndef REP_INP
#define REP_INP 1
#endif
#ifndef REP_ATT
#define REP_ATT 1
#endif
#ifndef REP_LA
#define REP_LA 1
#endif
#ifndef REP_HA
#define REP_HA 1
#endif
#ifndef REP_LC
#define REP_LC 1
#endif
#ifndef REP_HC
#define REP_HC 1
#endif
#ifndef REP_N10
#define REP_N10 1
#endif
#ifndef REP_FIN
#define REP_FIN 1
#endif
#ifndef REP_OP0
#define REP_OP0 1
#endif
#ifndef REP_RT
#define REP_RT 1
#endif
#ifndef REP_CAR
#define REP_CAR 1
#endif
#ifndef REP_GU
#define REP_GU 1
#endif
#ifndef REP_DN
#define REP_DN 1
#endif
#define REPEAT(n, ...) do { _Pragma("unroll 1") for (int rep_ = 0; rep_ < (n); ++rep_) { __VA_ARGS__; } } while (0)
#ifndef FAST_ATTN
#define FAST_ATTN 1
#endif
#ifndef FAST_LRU
#define FAST_LRU 1
#endif
#ifndef FAST_HG
#define FAST_HG 1
#endif
#define GAS __attribute__((address_space(1)))
#define LAS __attribute__((address_space(3)))
typedef unsigned short bf16;
typedef short bf16x8 __attribute__((ext_vector_type(8)));
typedef float f32x4 __attribute__((ext_vector_type(4)));
typedef float f32x2 __attribute__((ext_vector_type(2)));
typedef float f32x16 __attribute__((ext_vector_type(16)));
typedef unsigned u32x4 __attribute__((ext_vector_type(4)));
typedef unsigned u32x2 __attribute__((ext_vector_type(2)));
typedef GAS unsigned gu32;

constexpr int D = 1024, NB = 2, SEQ = 16384, CTXL = 256, NL = 2;
constexpr int ML = NB * SEQ, MC = NB * CTXL, MA = ML + MC;
constexpr int INW = 2560;
constexpr int C_Q = 0, C_K = 512, C_V = 640, C_LX = 768, C_LG = 1024, C_HQ = 1280, C_HF = 1536, C_HB = 1792, C_HV = 2048, C_HO = 2304;
constexpr int NE = 32, FF = 1024, CAP = MA;
constexpr float EPS = 1e-6f;
constexpr float LOG2E = 1.4426950408889634f;
constexpr float QSCALE = 0.125f * LOG2E;
constexpr int NWAVES = 8, NTHR = 512;
constexpr int N_PH = 20;

constexpr size_t MiB = 1u << 20;
constexpr size_t WS_CTL = 0, CTL_ZERO_BYTES = 65536;
constexpr size_t WS_MODS = 1 * MiB;
constexpr size_t WS_ROPE = 2 * MiB;
constexpr size_t WS_LRUW = 3 * MiB;
constexpr size_t WS_WIN = 4 * MiB;
constexpr size_t WS_WOUT = 16 * MiB;
constexpr size_t WS_WGU = 20 * MiB;
constexpr size_t WS_WD = 276 * MiB;
constexpr size_t WS_XL = 404 * MiB;
constexpr size_t WS_H1 = 534 * MiB;
constexpr size_t WS_P = 599 * MiB;
constexpr size_t WS_VT = 762 * MiB;
constexpr size_t WS_MIX = 771 * MiB;
constexpr size_t WS_HD = 836 * MiB;
constexpr size_t WS_OHG = 901 * MiB;
constexpr size_t WS_GA = 966 * MiB;
constexpr size_t WS_GB = 1031 * MiB;
constexpr size_t WS_AGG = 1096 * MiB;
constexpr size_t WS_LIST = 1136 * MiB;
constexpr size_t WS_HMOE = 1152 * MiB;
constexpr size_t WS_Y2 = 1428 * MiB;
constexpr size_t WS_QI = 1688 * MiB;
constexpr size_t WS_KI = 1721 * MiB;
constexpr size_t WS_SAGG = 1754 * MiB;
constexpr size_t WS_SIN = 1788 * MiB;
constexpr size_t WS_DUMMY = 1823 * MiB;
constexpr size_t WS_END = 1824 * MiB;
constexpr size_t Y2_DUMMY_ROW = (WS_DUMMY - WS_Y2) / (D * ((Y2_FP8 && MOE_FP8) ? 1 : 2));
constexpr size_t VT_CTX_OFF = (size_t)NB * 2 * 64 * SEQ;
constexpr int CW_CNT = 64;
constexpr int CW_BAR = 4096;

__device__ __forceinline__ float bf2f(bf16 x) { return __uint_as_float(((unsigned)x) << 16); }
__device__ __forceinline__ unsigned pk2(float lo, float hi) { unsigned r; asm("v_cvt_pk_bf16_f32 %0, %1, %2" : "=v"(r) : "v"(lo), "v"(hi)); return r; }
__device__ __forceinline__ unsigned f2bf(float f) { return pk2(f, f) & 0xffffu; }
__device__ __forceinline__ float shx(float v, int mask, int lane) { return __int_as_float(__builtin_amdgcn_ds_bpermute((lane ^ mask) << 2, __float_as_int(v))); }
__device__ __forceinline__ float wave_sum(float v, int lane) {
#pragma unroll
    for (int o = 1; o < 64; o <<= 1) v += shx(v, o, lane);
    return v;
}
__device__ __forceinline__ float wave_max(float v, int lane) {
#pragma unroll
    for (int o = 1; o < 64; o <<= 1) v = fmaxf(v, shx(v, o, lane));
    return v;
}
__device__ __forceinline__ float frcp(float x) { return __builtin_amdgcn_rcpf(x); }
__device__ __forceinline__ float sigmoidf_(float x) { return frcp(1.0f + __expf(-x)); }
__device__ __forceinline__ float siluf_(float x) { return x * frcp(1.0f + __expf(-x)); }
__device__ __forceinline__ float gelu_tanh(float x) { const float u = 0.7978845608028654f * (x + 0.044715f * x * x * x); const float t = 1.0f - 2.0f * frcp(__expf(2.0f * u) + 1.0f); return 0.5f * x * (1.0f + t); }
__device__ __forceinline__ unsigned pk_fp8x4(float a, float b, float c, float d) { int w = 0; w = __builtin_amdgcn_cvt_pk_fp8_f32(a, b, w, false); w = __builtin_amdgcn_cvt_pk_fp8_f32(c, d, w, true); return (unsigned)w; }
constexpr float Y2_SCALE = 16.0f;
constexpr float W8_SCALE = 64.0f;
__device__ __forceinline__ int crow(int r, int hi) { return (r & 3) + 8 * (r >> 2) + 4 * hi; }

struct Args { const float* in[27]; float* out; unsigned char* ws; int ph_lo, ph_hi; };
struct Ctx {
    LAS unsigned char* lds;
    int tid, lane, wave, G, bid;
    const float* const* in;
    float* out; unsigned char* ws;
#define WSACC(T, name, off) __device__ __forceinline__ T* name() const { return (T*)(ws + (off)); }
    WSACC(gu32, ctl, WS_CTL) WSACC(float, mods, WS_MODS) WSACC(f32x2, rope, WS_ROPE) WSACC(bf16, lruw, WS_LRUW) WSACC(bf16, WinT, WS_WIN) WSACC(bf16, WoutT, WS_WOUT)
    WSACC(bf16, WguT, WS_WGU) WSACC(bf16, WdT, WS_WD) WSACC(bf16, XL, WS_XL) WSACC(bf16, H1, WS_H1) WSACC(bf16, P, WS_P) WSACC(bf16, Vt, WS_VT) WSACC(bf16, MIX, WS_MIX)
    WSACC(float, HD, WS_HD) WSACC(float, OHG, WS_OHG) WSACC(float, GA, WS_GA) WSACC(float, GB, WS_GB) WSACC(float, AGG, WS_AGG)
    WSACC(int, list_tok, WS_LIST) WSACC(int, list_dst, WS_LIST + (size_t)NE * CAP * 4) WSACC(float, list_gate, WS_LIST + (size_t)NE * CAP * 8)
    WSACC(bf16, HMOE, WS_HMOE) WSACC(bf16, Y2, WS_Y2)
    __device__ __forceinline__ bf16* ws_bf16(size_t off) const { return (bf16*)(ws + off); }
    __device__ __forceinline__ const float* inp(int i) const { return (const float*)(const GAS float*)in[i]; }
    __device__ __forceinline__ float* outp() const { return (float*)(GAS float*)out; }
#undef WSACC
};
__device__ __forceinline__ Ctx fresh(const Ctx& F0) {
    Ctx F = F0; int wv = F0.wave, g = F0.G, bi = F0.bid; asm volatile("" : "+s"(wv), "+s"(g), "+s"(bi));
    int ln; asm volatile("v_mbcnt_lo_u32_b32 %0, -1, 0\n\tv_mbcnt_hi_u32_b32 %0, -1, %0" : "=v"(ln));
    F.wave = wv; F.lane = ln; F.tid = wv * 64 + ln; F.G = g; F.bid = bi;
    unsigned long long w = (unsigned long long)F0.ws;
    asm volatile("" : "+s"(w)); F.ws = (unsigned char*)(GAS unsigned char*)w;
    return F;
}
enum { I_X = 0, I_C, I_CTX, I_CCTX, I_ADAW, I_ADAB, I_N1G, I_WIN, I_SINK, I_CONVW, I_CONVB, I_WR, I_BR, I_WI, I_BI, I_LAM, I_LBL, I_HNG, I_WOUT, I_N2G, I_RW, I_RB, I_WGU, I_BGU, I_WD, I_BD, I_FG };

__device__ __forceinline__ int row_b(int m) { return m < ML ? m / SEQ : (m - ML) / CTXL; }
__device__ __forceinline__ int row_t(int m) { return m < ML ? m % SEQ : (m - ML) % CTXL; }
__device__ __forceinline__ int mod_row(int m) { return m < ML ? m / SEQ : 2; }

__device__ __forceinline__ int dest_win(int n) {
    if (n >= C_V) return n;
    const int d = n & 63, p = d >> 5, half = (d >> 4) & 1, f = d & 15;
    return (n & ~63) + 2 * (p * 16 + f) + half;
}
__device__ __forceinline__ int dest_gu(int n) {
    const int up = n >= FF ? 1 : 0, ff = n & (FF - 1);
    return (ff >> 7) * 256 + up * 128 + (ff & 127);
}
template <int MAP>
__device__ __forceinline__ void tr_item(const float* W, int K, int N, bf16* WT, LAS float* scr, int item, int lane) {
    const int nblk = N / 32, kb = item / nblk, nb = item % nblk, k0 = 64 * kb, n0 = 32 * nb;
#pragma unroll 8
    for (int i = 0; i < 32; ++i) { const int kk = 2 * i + (lane >> 5); scr[kk * 33 + (lane & 31)] = W[(size_t)(k0 + kk) * N + n0 + (lane & 31)]; }
    asm volatile("s_waitcnt lgkmcnt(0)" ::: "memory");
    const int c = lane & 7;
#pragma unroll
    for (int j = 0; j < 4; ++j) {
        const int n = (lane >> 3) + 8 * j; const LAS float* s = scr + (8 * c) * 33 + n;
        u32x4 o; o.x = pk2(s[0 * 33], s[1 * 33]); o.y = pk2(s[2 * 33], s[3 * 33]); o.z = pk2(s[4 * 33], s[5 * 33]); o.w = pk2(s[6 * 33], s[7 * 33]);
        const int nn = n0 + n; const int dr = MAP == 1 ? dest_win(nn) : (MAP == 2 ? dest_gu(nn) : nn);
        *(u32x4*)(WT + (size_t)dr * K + k0 + 8 * c) = o;
    }
    asm volatile("s_waitcnt lgkmcnt(0)" ::: "memory");
}
template <int MAP>
__device__ __forceinline__ void tr_item8(const float* W, int K, int N, unsigned char* WT, LAS float* scr, int item, int lane) {
    const int nblk = N / 32, kb = item / nblk, nb = item % nblk, k0 = 64 * kb, n0 = 32 * nb;
#pragma unroll 8
    for (int i = 0; i < 32; ++i) { const int kk = 2 * i + (lane >> 5); scr[kk * 33 + (lane & 31)] = W[(size_t)(k0 + kk) * N + n0 + (lane & 31)]; }
    asm volatile("s_waitcnt lgkmcnt(0)" ::: "memory");
    const int c = lane & 7;
#pragma unroll
    for (int j = 0; j < 4; ++j) {
        const int n = (lane >> 3) + 8 * j; const LAS float* s = scr + (8 * c) * 33 + n;
        u32x2 o; o.x = pk_fp8x4(s[0 * 33] * W8_SCALE, s[1 * 33] * W8_SCALE, s[2 * 33] * W8_SCALE, s[3 * 33] * W8_SCALE); o.y = pk_fp8x4(s[4 * 33] * W8_SCALE, s[5 * 33] * W8_SCALE, s[6 * 33] * W8_SCALE, s[7 * 33] * W8_SCALE);
        const int nn = n0 + n; const int dr = MAP == 2 ? dest_gu(nn) : nn;
        *(u32x2*)(WT + (size_t)dr * K + k0 + 8 * c) = o;
    }
    asm volatile("s_waitcnt lgkmcnt(0)" ::: "memory");
}
__device__ __forceinline__ void tr_load(const float* W, int N, int item, int lane, float (&r)[32]) {
    const int nblk = N / 32, kb = item / nblk, nb = item % nblk, k0 = 64 * kb, n0 = 32 * nb;
    const float* p = W + (size_t)(k0 + (lane >> 5)) * N + n0 + (lane & 31);
#pragma unroll
    for (int i = 0; i < 32; ++i) r[i] = p[(size_t)(2 * i) * N];
}
template <int MAP>
__device__ __forceinline__ void tr_finish(int K, int N, bf16* WT, LAS float* scr, int item, int lane, const float (&r)[32]) {
    const int nblk = N / 32, kb = item / nblk, nb = item % nblk, k0 = 64 * kb, n0 = 32 * nb;
#pragma unroll
    for (int i = 0; i < 32; ++i) scr[(2 * i + (lane >> 5)) * 33 + (lane & 31)] = r[i];
    asm volatile("s_waitcnt lgkmcnt(0)" ::: "memory");
    const int c = lane & 7;
#pragma unroll
    for (int j = 0; j < 4; ++j) {
        const int n = (lane >> 3) + 8 * j; const LAS float* s = scr + (8 * c) * 33 + n;
        u32x4 o; o.x = pk2(s[0 * 33], s[1 * 33]); o.y = pk2(s[2 * 33], s[3 * 33]); o.z = pk2(s[4 * 33], s[5 * 33]); o.w = pk2(s[6 * 33], s[7 * 33]);
        const int nn = n0 + n; const int dr = MAP == 1 ? dest_win(nn) : (MAP == 2 ? dest_gu(nn) : nn);
        *(u32x4*)(WT + (size_t)dr * K + k0 + 8 * c) = o;
    }
    asm volatile("s_waitcnt lgkmcnt(0)" ::: "memory");
}
__device__ __forceinline__ void ph_prologue(Ctx& F) {
    LAS float* scr = (LAS float*)(F.lds + F.wave * 8704);
    const int gw = F.bid * NWAVES + F.wave, NGW = F.G * NWAVES;
    constexpr int I_IN = 16 * 80, I_OUT = 16 * 32;
    constexpr int N_IN = NL * I_IN, N_OUT = NL * I_OUT;
    for (int it = gw; it < N_IN + N_OUT; it += NGW) {
        int r = it;
        if (r < N_IN) { const int l = r / I_IN; tr_item<1>(F.inp(I_WIN) + (size_t)l * D * INW, D, INW, F.WinT() + (size_t)l * INW * D, scr, r % I_IN, F.lane); continue; } r -= N_IN;
        { const int l = r / I_OUT; tr_item<0>(F.inp(I_WOUT) + (size_t)l * D * D, D, D, F.WoutT() + (size_t)l * D * D, scr, r % I_OUT, F.lane); }
    }
    const int gt = F.bid * NTHR + F.tid, NGT = F.G * NTHR;
    for (int i = gt; i < NL * 2 * 2 * 4 * 4096; i += NGT) {
        const int c = i & 63, dd = (i >> 6) & 63, n = (i >> 12) & 3, g = (i >> 14) & 1, d = (i >> 15) & 1, l = i >> 16;
        const float* src = g ? F.inp(I_WI) : F.inp(I_WR);
        F.lruw()[i] = (bf16)f2bf(src[((((size_t)l * 2 + d) * 4 + n) * 64 + c) * 64 + dd]);
    }
    for (int i = gt; i < 256 * 16; i += NGT) {
        const int pos = i >> 4, f = i & 15;
        const float invf[16] = {1.000000000e+00f, 5.623413324e-01f, 3.162277639e-01f, 1.778279394e-01f, 1.000000015e-01f, 5.623413250e-02f, 3.162277490e-02f, 1.778279431e-02f,
                                9.999999776e-03f, 5.623413250e-03f, 3.162277630e-03f, 1.778279431e-03f, 1.000000047e-03f, 5.623413017e-04f, 3.162277571e-04f, 1.778279402e-04f};
        float fr = 1.0f;
#pragma unroll
        for (int q = 0; q < 16; ++q) fr = (f == q) ? invf[q] : fr;
        const float ang = (float)pos * fr;
        double rev = (double)ang * 0.15915494309189535; rev -= floor(rev);
        F.rope()[i] = (f32x2){__builtin_amdgcn_cosf((float)rev), __builtin_amdgcn_sinf((float)rev)};
    }
    LAS float* cond = (LAS float*)(F.lds + 72 * 1024);
    LAS float* red = (LAS float*)(F.lds + 88 * 1024);
    __syncthreads();
    for (int i = F.tid; i < 3 * D; i += NTHR) { const int r = i / D, k = i % D; const float v = r < 2 ? F.inp(I_C)[r * D + k] : F.inp(I_CCTX)[k]; cond[i] = siluf_(v); }
    __syncthreads();
    for (int unit = F.bid; unit < NL * 192; unit += F.G) {
        const int l = unit / 192, col0 = (unit % 192) * 32, cl = F.tid & 31, ks = F.tid >> 5;
        const float* W = F.inp(I_ADAW) + (size_t)l * D * 6 * D + col0 + cl;
        float a0 = 0.f, a1 = 0.f, a2 = 0.f;
#pragma unroll 8
        for (int k = ks * 64; k < ks * 64 + 64; ++k) { const float w = W[(size_t)k * 6 * D]; a0 += cond[k] * w; a1 += cond[D + k] * w; a2 += cond[2 * D + k] * w; }
        red[(ks * 3 + 0) * 32 + cl] = a0; red[(ks * 3 + 1) * 32 + cl] = a1; red[(ks * 3 + 2) * 32 + cl] = a2;
        __syncthreads();
        if (F.tid < 96) { const int i = F.tid >> 5; float s = F.inp(I_ADAB)[l * 6 * D + col0 + cl];
            for (int q = 0; q < 16; ++q) s += red[(q * 3 + i) * 32 + cl];
            F.mods()[((size_t)l * 3 + i) * 6 * D + col0 + cl] = s; }
        __syncthreads();
    }
}

__device__ __forceinline__ void ph_norm1(Ctx& F, int l) {
    const int gw = F.bid * NWAVES + F.wave, NGW = F.G * NWAVES;
    const int M = (l == 2) ? ML : MA;
    for (int m = gw; m < M; m += NGW) {
        const int mr = mod_row(m);
        f32x4 v[4];
        if (l == 0) { const float* src = m < ML ? F.inp(I_X) + (size_t)m * D : F.inp(I_CTX) + (size_t)(m - ML) * D;
#pragma unroll
            for (int j = 0; j < 4; ++j) v[j] = *(const f32x4*)(src + 4 * F.lane + 256 * j); }
        else {
#pragma unroll
            for (int j = 0; j < 4; ++j) { const u32x2 w = *(const u32x2*)(F.XL() + (size_t)m * D + 4 * F.lane + 256 * j);
                v[j] = (f32x4){__uint_as_float(w.x << 16), __uint_as_float(w.x & 0xffff0000u), __uint_as_float(w.y << 16), __uint_as_float(w.y & 0xffff0000u)}; } }
        if (l > 0) {
            const float* g5 = F.mods() + ((size_t)(l - 1) * 3 + mr) * 6 * D + 5 * D;
#pragma unroll
            for (int j = 0; j < 4; ++j) {
                const int col = 4 * F.lane + 256 * j; f32x4 s = {0.f, 0.f, 0.f, 0.f};
#pragma unroll
                for (int q = 0; q < 4; ++q) {
                    if (Y2_FP8 && MOE_FP8) { const unsigned w = *(const unsigned*)((const unsigned char*)F.Y2() + ((size_t)m * 4 + q) * D + col);
                        const f32x2 lo = __builtin_amdgcn_cvt_pk_f32_fp8((int)w, false), hi = __builtin_amdgcn_cvt_pk_f32_fp8((int)w, true);
                        s.x += lo.x; s.y += lo.y; s.z += hi.x; s.w += hi.y; }
                    else { const u32x2 w = *(const u32x2*)(F.Y2() + ((size_t)m * 4 + q) * D + col);
                        s.x += __uint_as_float(w.x << 16); s.y += __uint_as_float(w.x & 0xffff0000u); s.z += __uint_as_float(w.y << 16); s.w += __uint_as_float(w.y & 0xffff0000u); } }
                const f32x4 g = *(const f32x4*)(g5 + col) * ((Y2_FP8 && MOE_FP8) ? (1.0f / Y2_SCALE) : 1.0f);
                v[j] += g * s;
            }
        }
        if (l == 1) {
#pragma unroll
            for (int j = 0; j < 4; ++j) { u32x2 w; w.x = pk2(v[j].x, v[j].y); w.y = pk2(v[j].z, v[j].w); *(u32x2*)(F.XL() + (size_t)m * D + 4 * F.lane + 256 * j) = w; }
        }
        float ss = 0.f;
#pragma unroll
        for (int j = 0; j < 4; ++j) ss += (v[j].x * v[j].x + v[j].y * v[j].y) + (v[j].z * v[j].z + v[j].w * v[j].w);
        const float rstd = 1.0f / sqrtf(wave_sum(ss, F.lane) * (1.0f / D) + EPS);
        if (l == 2) {
#pragma unroll
            for (int j = 0; j < 4; ++j) { const int col = 4 * F.lane + 256 * j; const f32x4 g = *(const f32x4*)(F.inp(I_FG) + col); *(f32x4*)(F.outp() + (size_t)m * D + col) = v[j] * rstd * g; }
        } else {
            const float* mo = F.mods() + ((size_t)l * 3 + mr) * 6 * D;
            const float* g1 = F.inp(I_N1G) + l * D;
#pragma unroll
            for (int j = 0; j < 4; ++j) { const int col = 4 * F.lane + 256 * j;
                const f32x4 g = *(const f32x4*)(g1 + col), sh = *(const f32x4*)(mo + col), sc = *(const f32x4*)(mo + D + col);
                const f32x4 h = v[j] * rstd * g * (sc + 1.0f) + sh;
                u32x2 w; w.x = pk2(h.x, h.y); w.y = pk2(h.z, h.w);
                *(u32x2*)(F.H1() + (size_t)m * D + col) = w; }
        }
    }
}

__device__ __forceinline__ void sg_kloop(f32x16 (&acc)[2][2], const bf16* a0, const bf16* a1, const bf16* b0, const bf16* b1, int K) {
#pragma unroll
    for (int i = 0; i < 2; ++i)
#pragma unroll
        for (int j = 0; j < 2; ++j)
#pragma unroll
            for (int r = 0; r < 16; ++r) acc[i][j][r] = 0.f;
#pragma unroll 4
    for (int k = 0; k < K; k += 16) {
        const bf16x8 fa0 = *(const bf16x8*)(a0 + k), fa1 = *(const bf16x8*)(a1 + k), fb0 = *(const bf16x8*)(b0 + k), fb1 = *(const bf16x8*)(b1 + k);
        acc[0][0] = __builtin_amdgcn_mfma_f32_32x32x16_bf16(fa0, fb0, acc[0][0], 0, 0, 0);
        acc[0][1] = __builtin_amdgcn_mfma_f32_32x32x16_bf16(fa0, fb1, acc[0][1], 0, 0, 0);
        acc[1][0] = __builtin_amdgcn_mfma_f32_32x32x16_bf16(fa1, fb0, acc[1][0], 0, 0, 0);
        acc[1][1] = __builtin_amdgcn_mfma_f32_32x32x16_bf16(fa1, fb1, acc[1][1], 0, 0, 0);
    }
}

__device__ __forceinline__ float inproj_fix(const Ctx& F, int m, int c, float v, float partner) {
    float o = v;
    if (c < C_V) {
        if (m < ML) {
            const int t = m % SEQ, dp = c & 63, pr = dp >> 1, p = pr >> 4, f = pr & 15, pos = p ? (t & 63) : (t >> 6);
            const f32x2 cs = F.rope()[pos * 16 + f];
            o = (dp & 1) ? (partner * cs.y + v * cs.x) : (v * cs.x - partner * cs.y);
        }
        if (c < C_K) o *= QSCALE;
    }
    return o;
}
__device__ __forceinline__ size_t vt_index(int m, int cv  ) {
    const int kvh = cv >> 6, d = cv & 63;
    if (m < ML) { const int b = m / SEQ, t = m % SEQ; return ((size_t)((b * 2 + kvh) * 64 + d)) * SEQ + t; }
    const int b = (m - ML) / CTXL, t = (m - ML) % CTXL; return VT_CTX_OFF + ((size_t)((b * 2 + kvh) * 64 + d)) * CTXL + t;
}
__device__ __forceinline__ void ph_inproj_naive(Ctx& F, int l) {
    const int gw = F.bid * NWAVES + F.wave, NGW = F.G * NWAVES, r = F.lane & 31, h = F.lane >> 5;
    const bf16* Bt = F.WinT() + (size_t)l * INW * D;
    for (int ti = gw; ti < (MA / 64) * (INW / 64); ti += NGW) {
        const int rt = ti / (INW / 64), ct = ti % (INW / 64), m0 = rt * 64, c0 = ct * 64;
        f32x16 acc[2][2];
        sg_kloop(acc, F.H1() + (size_t)(m0 + r) * D + 8 * h, F.H1() + (size_t)(m0 + 32 + r) * D + 8 * h, Bt + (size_t)(c0 + r) * D + 8 * h, Bt + (size_t)(c0 + 32 + r) * D + 8 * h, D);
#pragma unroll
        for (int mt = 0; mt < 2; ++mt)
#pragma unroll
            for (int nt = 0; nt < 2; ++nt)
#pragma unroll
                for (int q = 0; q < 16; ++q) {
                    const int m = m0 + 32 * mt + crow(q, h), c = c0 + 32 * nt + r;
                    const float v = acc[mt][nt][q], pa = shx(v, 1, F.lane);
                    const float o = inproj_fix(F, m, c, v, pa);
                    F.P()[(size_t)m * INW + c] = (bf16)f2bf(o);
                    if (c >= C_V && c < C_LX) F.Vt()[vt_index(m, c - C_V)] = (bf16)f2bf(o);
                }
    }
}

__device__ __forceinline__ float dot64(const float (&q)[64], const bf16* kp) {
    float s = 0.f;
#pragma unroll
    for (int i = 0; i < 8; ++i) { const u32x4 w = *(const u32x4*)(kp + 8 * i);
        s += q[8 * i + 0] * __uint_as_float(w.x << 16) + q[8 * i + 1] * __uint_as_float(w.x & 0xffff0000u) + q[8 * i + 2] * __uint_as_float(w.y << 16) + q[8 * i + 3] * __uint_as_float(w.y & 0xffff0000u)
           + q[8 * i + 4] * __uint_as_float(w.z << 16) + q[8 * i + 5] * __uint_as_float(w.z & 0xffff0000u) + q[8 * i + 6] * __uint_as_float(w.w << 16) + q[8 * i + 7] * __uint_as_float(w.w & 0xffff0000u); }
    return s;
}
__device__ __forceinline__ void ph_attn_naive(Ctx& F, int l) {
    const int gw = F.bid * NWAVES + F.wave, NGW = F.G * NWAVES;
    const int Mq = (l == 0) ? MA : ML;
    LAS float* pbuf = (LAS float*)(F.lds) + F.wave * 640;
    for (int u = gw; u < Mq * 8; u += NGW) {
        const int m = u >> 3, hq = u & 7, kvh = hq >> 2;
        const bool isc = m >= ML; const int b = row_b(m), t = row_t(m);
        float q[64];
        { const bf16* qp = F.P() + (size_t)m * INW + C_Q + hq * 64;
#pragma unroll
          for (int i = 0; i < 8; ++i) { const u32x4 w = *(const u32x4*)(qp + 8 * i);
              q[8 * i + 0] = __uint_as_float(w.x << 16); q[8 * i + 1] = __uint_as_float(w.x & 0xffff0000u); q[8 * i + 2] = __uint_as_float(w.y << 16); q[8 * i + 3] = __uint_as_float(w.y & 0xffff0000u);
              q[8 * i + 4] = __uint_as_float(w.z << 16); q[8 * i + 5] = __uint_as_float(w.z & 0xffff0000u); q[8 * i + 6] = __uint_as_float(w.w << 16); q[8 * i + 7] = __uint_as_float(w.w & 0xffff0000u); } }
        const int lo = isc ? 0 : (t - 128 < 0 ? 0 : t - 128), hi = isc ? -1 : (t + 128 > SEQ - 1 ? SEQ - 1 : t + 128);
        const int nloc = hi - lo + 1, nk = nloc + CTXL;
        const float sink2 = F.inp(I_SINK)[l * 8 + hq] * LOG2E;
        float s[9]; float mx = sink2;
#pragma unroll
        for (int i = 0; i < 9; ++i) { const int kk = F.lane + 64 * i; s[i] = -3.0e38f;
            if (kk < nk) { const int krow = kk < nloc ? b * SEQ + lo + kk : ML + b * CTXL + (kk - nloc);
                s[i] = dot64(q, F.P() + (size_t)krow * INW + C_K + kvh * 64); mx = fmaxf(mx, s[i]); } }
        mx = wave_max(mx, F.lane);
        float lsum = 0.f;
#pragma unroll
        for (int i = 0; i < 9; ++i) { const int kk = F.lane + 64 * i; const float p = (kk < nk) ? exp2f(s[i] - mx) : 0.f; lsum += p; pbuf[kk] = p; }
        lsum = wave_sum(lsum, F.lane) + exp2f(sink2 - mx);
        asm volatile("s_waitcnt lgkmcnt(0)" ::: "memory");
        float o = 0.f;
        for (int kk = 0; kk < nk; ++kk) { const int krow = kk < nloc ? b * SEQ + lo + kk : ML + b * CTXL + (kk - nloc);
            o += pbuf[kk] * bf2f(F.P()[(size_t)krow * INW + C_V + kvh * 64 + F.lane]); }
        F.MIX()[(size_t)m * D + hq * 64 + F.lane] = (bf16)f2bf(o / lsum);
        asm volatile("s_waitcnt lgkmcnt(0)" ::: "memory");
    }
}
__device__ __forceinline__ void ph_lru_gates_naive(Ctx& F, int l) {
    const size_t gt = (size_t)F.bid * NTHR + F.tid, NGT = (size_t)F.G * NTHR;
    for (size_t i = gt; i < (size_t)MA * 512; i += NGT) {
        const int m = (int)(i >> 9), d = (int)(i >> 8) & 1, c = (int)i & 255, n = c >> 6, cc0 = c & 63;
        const int t = row_t(m), T = m < ML ? SEQ : CTXL, rb = m - t;
        const float* wr = F.inp(I_WR) + (((size_t)l * 2 + d) * 4 + n) * 4096;
        const float* wi = F.inp(I_WI) + (((size_t)l * 2 + d) * 4 + n) * 4096;
        float rp = F.inp(I_BR)[(l * 2 + d) * 256 + c], ip = F.inp(I_BI)[(l * 2 + d) * 256 + c], us = 0.f;
        for (int cc = 0; cc < 64; ++cc) {
            const int ch = n * 64 + cc; float u = F.inp(I_CONVB)[l * 256 + ch];
#pragma unroll
            for (int j = 0; j < 4; ++j) { const int tt = t - 2 + j; if (tt >= 0 && tt < T) u += F.inp(I_CONVW)[(l * 4 + j) * 256 + ch] * bf2f(F.P()[(size_t)(rb + tt) * INW + C_LX + ch]); }
            rp += u * wr[cc * 64 + cc0]; ip += u * wi[cc * 64 + cc0];
            if (cc == cc0) us = u;
        }
        const float r = sigmoidf_(rp), ig = sigmoidf_(ip);
        const float lam = F.inp(I_LAM)[(l * 2 + d) * 256 + c];
        const float la = -8.0f * r * log1pf(expf(-lam));
        const float a = expf(la), mult = sqrtf(fmaxf(-expm1f(2.0f * la), 1e-12f));
        F.GA()[i] = a; F.GB()[i] = mult * ig * us;
    }
}
__device__ __forceinline__ void ph_lru_scan_naive(Ctx& F) {
    const int gt = F.bid * NTHR + F.tid;
    if (gt >= NB * 512) return;
    const int b = gt >> 9, d = (gt >> 8) & 1, c = gt & 255;
    float h = 0.f;
    for (int s = 0; s < CTXL + SEQ; ++s) {
        int m;
        if (s < CTXL) m = ML + b * CTXL + (d ? CTXL - 1 - s : s); else { const int t = s - CTXL; m = b * SEQ + (d ? SEQ - 1 - t : t); }
        const size_t i = (size_t)m * 512 + d * 256 + c;
        h = F.GA()[i] * h + F.GB()[i];
        F.HD()[i] = h;
    }
}
__device__ __forceinline__ void ph_lru_out_naive(Ctx& F, int l) {
    const size_t gt = (size_t)F.bid * NTHR + F.tid, NGT = (size_t)F.G * NTHR;
    const int Mq = (l == 0) ? MA : ML;
    for (size_t i = gt; i < (size_t)Mq * 256; i += NGT) {
        const int m = (int)(i >> 8), c = (int)i & 255;
        const float y = (F.HD()[(size_t)m * 512 + c] + F.HD()[(size_t)m * 512 + 256 + c]) * gelu_tanh(bf2f(F.P()[(size_t)m * INW + C_LG + c]));
        F.MIX()[(size_t)m * D + 512 + c] = (bf16)f2bf(y);
    }
}
__device__ __forceinline__ float hg_lb(const Ctx& F, int l, int d, int hk) {
    if (l == 0) return 0.f;
    const float l0 = F.inp(I_LBL)[(0 * 2 + d) * 256 + hk], l1 = F.inp(I_LBL)[(1 * 2 + d) * 256 + hk];
    return 1.0f / (1.0f + expf(l0 - l1));
}
__device__ __forceinline__ void ph_hgrn_scan_naive(Ctx& F, int l) {
    if (F.bid >= NB * 2 * 4) return;
    const int b = F.bid >> 3, d = (F.bid >> 2) & 1, hh = F.bid & 3;
    const int v = F.tid & 63, kq = F.tid >> 6;
    LAS float* part = (LAS float*)F.lds;
    float lb[8], S[8];
#pragma unroll
    for (int i = 0; i < 8; ++i) { lb[i] = hg_lb(F, l, d, hh * 64 + kq * 8 + i); S[i] = 0.f; }
    int buf = 0;
    for (int s = 0; s < CTXL + SEQ; ++s) {
        int m;
        if (s < CTXL) m = ML + b * CTXL + (d ? CTXL - 1 - s : s); else { const int t = s - CTXL; m = b * SEQ + (d ? SEQ - 1 - t : t); }
        const bf16* pr = F.P() + (size_t)m * INW;
        const u32x4 zw = *(const u32x4*)(pr + (d ? C_HB : C_HF) + hh * 64 + kq * 8), qw = *(const u32x4*)(pr + C_HQ + hh * 64 + kq * 8);
        const float vv = bf2f(pr[C_HV + hh * 64 + v]);
        float z[8], q[8];
        z[0] = __uint_as_float(zw.x << 16); z[1] = __uint_as_float(zw.x & 0xffff0000u); z[2] = __uint_as_float(zw.y << 16); z[3] = __uint_as_float(zw.y & 0xffff0000u);
        z[4] = __uint_as_float(zw.z << 16); z[5] = __uint_as_float(zw.z & 0xffff0000u); z[6] = __uint_as_float(zw.w << 16); z[7] = __uint_as_float(zw.w & 0xffff0000u);
        q[0] = __uint_as_float(qw.x << 16); q[1] = __uint_as_float(qw.x & 0xffff0000u); q[2] = __uint_as_float(qw.y << 16); q[3] = __uint_as_float(qw.y & 0xffff0000u);
        q[4] = __uint_as_float(qw.z << 16); q[5] = __uint_as_float(qw.z & 0xffff0000u); q[6] = __uint_as_float(qw.w << 16); q[7] = __uint_as_float(qw.w & 0xffff0000u);
        float pa = 0.f;
#pragma unroll
        for (int i = 0; i < 8; ++i) { const float sg = sigmoidf_(z[i]); const float f = lb[i] + (1.0f - lb[i]) * sg, kk = (1.0f - lb[i]) * (1.0f - sg);
            S[i] = f * S[i] + kk * vv; pa += S[i] * q[i]; }
        part[(buf * 8 + kq) * 64 + v] = pa;
        __syncthreads();
        if (kq == 0) { float o = 0.f;
#pragma unroll
            for (int i = 0; i < 8; ++i) o += part[(buf * 8 + i) * 64 + v];
            F.OHG()[(size_t)m * 512 + d * 256 + hh * 64 + v] = o; }
        buf ^= 1;
    }
}
__device__ __forceinline__ void ph_hgrn_out_naive(Ctx& F, int l) {
    const int gw = F.bid * NWAVES + F.wave, NGW = F.G * NWAVES;
    const int Mq = (l == 0) ? MA : ML;
    for (int m = gw; m < Mq; m += NGW) {
        const int col = 4 * F.lane;
        const f32x4 a = *(const f32x4*)(F.OHG() + (size_t)m * 512 + col), bb = *(const f32x4*)(F.OHG() + (size_t)m * 512 + 256 + col);
        const f32x4 o = a + bb;
        float ss = (o.x * o.x + o.y * o.y) + (o.z * o.z + o.w * o.w);
        ss += shx(ss, 1, F.lane); ss += shx(ss, 2, F.lane); ss += shx(ss, 4, F.lane); ss += shx(ss, 8, F.lane);
        const float rstd = 1.0f / sqrtf(ss * (1.0f / 64.0f) + EPS);
        const f32x4 g = *(const f32x4*)(F.inp(I_HNG) + l * 256 + col);
        const u32x2 ow = *(const u32x2*)(F.P() + (size_t)m * INW + C_HO + col);
        const float g0 = siluf_(__uint_as_float(ow.x << 16)), g1 = siluf_(__uint_as_float(ow.x & 0xffff0000u)), g2 = siluf_(__uint_as_float(ow.y << 16)), g3 = siluf_(__uint_as_float(ow.y & 0xffff0000u));
        u32x2 w; w.x = pk2(o.x * rstd * g.x * g0, o.y * rstd * g.y * g1); w.y = pk2(o.z * rstd * g.z * g2, o.w * rstd * g.w * g3);
        *(u32x2*)(F.MIX() + (size_t)m * D + 768 + col) = w;
    }
}

constexpr int MIX_NUB = 136, MIX_NU = 272;
constexpr int LRU_NU = MIX_NU;
struct MixUnit { int b, j, rowbase, t0, ntok, T, ub; bool isc; };
__device__ __forceinline__ MixUnit mix_unit(int g) {
    MixUnit m;
    if (g < 256) { m.b = g >> 7; m.j = g & 127; m.isc = false; m.rowbase = m.b * SEQ; m.t0 = m.j * 128; m.ntok = 128; m.T = SEQ; }
    else { const int c = g - 256; m.b = c >> 3; m.j = 128 + (c & 7); m.isc = true; m.rowbase = ML + m.b * CTXL; m.t0 = (c & 7) * 32; m.ntok = 32; m.T = CTXL; }
    m.ub = m.b * MIX_NUB + m.j; return m;
}
constexpr size_t AG_LRU_A = 0, AG_LRU_B = (size_t)LRU_NU * 512, AG_LRU_H = 2 * (size_t)LRU_NU * 512;
constexpr int U_PITCH = 528;
template <bool FULL, int DIR>
__device__ __forceinline__ void lru_wave(Ctx& F, int l, int u, int n, int rowbase, int t0, int nmt) {
    int ln_ = F.lane; asm volatile("" : "+v"(ln_));
    const int r32 = ln_ & 31, h = ln_ >> 5;
    LAS unsigned char* U = F.lds;
    const bf16* wb = F.lruw() + ((((size_t)l * 2 + DIR) * 2) * 4 + n) * 4096;
    float br[2], bi[2], c8[2], hc[2], At[2], Bt[2];
#pragma unroll
    for (int ct = 0; ct < 2; ++ct) { const int c = 64 * n + 32 * ct + r32, ix = (l * 2 + DIR) * 256 + c;
        br[ct] = FULL ? 0.f : F.inp(I_BR)[ix]; bi[ct] = FULL ? 0.f : F.inp(I_BI)[ix]; c8[ct] = FULL ? 0.f : 8.0f * log1pf(expf(-F.inp(I_LAM)[ix]));
        hc[ct] = FULL ? F.AGG()[AG_LRU_H + (size_t)u * 512 + DIR * 256 + c] : 0.f; At[ct] = 1.f; Bt[ct] = 0.f; }
#pragma unroll
    for (int ct = 0; ct < 2; ++ct) {
        const int c = 64 * n + 32 * ct + r32;
        bf16x8 Bg[2][4];
        if (!FULL) {
#pragma unroll
            for (int g = 0; g < 2; ++g) { const bf16* p = wb + (size_t)g * 4 * 4096 + (32 * ct + r32) * 64 + 8 * h;
#pragma unroll
                for (int ks = 0; ks < 4; ++ks) Bg[g][ks] = *(const bf16x8*)(p + 16 * ks); } }
        unsigned pkn[16];
        if (FULL) { const int mt0 = DIR ? nmt - 1 : 0; const size_t g0 = (size_t)(rowbase + t0 + 32 * mt0 + 4 * h) * 512 + DIR * 256 + c;
#pragma unroll
            for (int q = 0; q < 16; ++q) pkn[q] = ((const unsigned*)F.GA())[g0 + (size_t)((q & 3) + 8 * (q >> 2)) * 512]; }
#pragma unroll 1
        for (int mi = 0; mi < nmt; ++mi) {
            const int mt = DIR ? nmt - 1 - mi : mi;
            float a[16], bb[16];
            const size_t gix0 = (size_t)(rowbase + t0 + 32 * mt + 4 * h) * 512 + DIR * 256 + c;
            if (FULL) {
#pragma unroll
                for (int q = 0; q < 16; ++q) { const unsigned pk = pkn[q]; a[q] = 1.0f - __uint_as_float(pk << 16); bb[q] = __uint_as_float(pk & 0xffff0000u); }
                if (mi + 1 < nmt) { const int mtn = DIR ? nmt - 2 - mi : mi + 1; const size_t gn = (size_t)(rowbase + t0 + 32 * mtn + 4 * h) * 512 + DIR * 256 + c;
#pragma unroll
                    for (int q = 0; q < 16; ++q) pkn[q] = ((const unsigned*)F.GA())[gn + (size_t)((q & 3) + 8 * (q >> 2)) * 512]; }
            } else {
                f32x16 acc[2];
#pragma unroll
                for (int g = 0; g < 2; ++g)
#pragma unroll
                    for (int q = 0; q < 16; ++q) acc[g][q] = 0.f;
#pragma unroll
                for (int ks = 0; ks < 4; ++ks) { const bf16x8 af = *(const LAS bf16x8*)(U + (32 * mt + r32) * U_PITCH + (64 * n + 16 * ks + 8 * h) * 2);
                    acc[0] = __builtin_amdgcn_mfma_f32_32x32x16_bf16(af, Bg[0][ks], acc[0], 0, 0, 0); acc[1] = __builtin_amdgcn_mfma_f32_32x32x16_bf16(af, Bg[1][ks], acc[1], 0, 0, 0); }
#pragma unroll
                for (int q = 0; q < 16; ++q) { const int t = 32 * mt + crow(q, h);
                    const float uu = bf2f(*(const LAS bf16*)(U + t * U_PITCH + c * 2));
                    const float r = sigmoidf_(acc[0][q] + br[ct]), ig = sigmoidf_(acc[1][q] + bi[ct]);
                    a[q] = __expf(-c8[ct] * r); bb[q] = __builtin_amdgcn_sqrtf(fmaxf(1.0f - a[q] * a[q], 1e-12f)) * ig * uu;
                    const size_t ix = gix0 + (size_t)((q & 3) + 8 * (q >> 2)) * 512; const unsigned pk = pk2(1.0f - a[q], bb[q]); ((unsigned*)F.GA())[ix] = pk;
                    a[q] = 1.0f - __uint_as_float(pk << 16); bb[q] = __uint_as_float(pk & 0xffff0000u); }
            }
            float gA[4], gB[4], oA[4], oB[4];
#pragma unroll
            for (int g = 0; g < 4; ++g) { float A = 1.f, B = 0.f;
#pragma unroll
                for (int jj = 0; jj < 4; ++jj) { const int q = 4 * g + (DIR ? 3 - jj : jj); B = a[q] * B + bb[q]; A *= a[q]; }
                gA[g] = A; gB[g] = B; }
#pragma unroll
            for (int g = 0; g < 4; ++g) { oA[g] = shx(gA[g], 32, ln_); oB[g] = shx(gB[g], 32, ln_); }
            float st[4] = {0.f, 0.f, 0.f, 0.f}; float hs = hc[ct];
#pragma unroll
            for (int kk = 0; kk < 8; ++kk) { const int k = DIR ? 7 - kk : kk, g = k >> 1; const bool mine = ((k & 1) == h);
                const float Ak = mine ? gA[g] : oA[g], Bk = mine ? gB[g] : oB[g];
                if (FULL) { st[g] = mine ? hs : st[g]; hs = Ak * hs + Bk; }
                else { Bt[ct] = Ak * Bt[ct] + Bk; At[ct] *= Ak; } }
            if (FULL) {
                hc[ct] = hs;
#pragma unroll
                for (int g = 0; g < 4; ++g) { float hh = st[g];
#pragma unroll
                    for (int jj = 0; jj < 4; ++jj) { const int q = 4 * g + (DIR ? 3 - jj : jj); hh = a[q] * hh + bb[q];
                        F.HD()[(size_t)(rowbase + t0 + 32 * mt + crow(q, h)) * 512 + DIR * 256 + c] = hh; } }
            }
        }
        __builtin_amdgcn_sched_barrier(0);
    }
    if (!FULL && h == 0) {
#pragma unroll
        for (int ct = 0; ct < 2; ++ct) { const int c = 64 * n + 32 * ct + r32;
            F.AGG()[AG_LRU_A + (size_t)u * 512 + DIR * 256 + c] = At[ct]; F.AGG()[AG_LRU_B + (size_t)u * 512 + DIR * 256 + c] = Bt[ct]; }
    }
}
template <bool FULL>
__device__ __forceinline__ void ph_lru_fast(Ctx& F, int l) {
    LAS unsigned char* U = F.lds;
    for (int it = 0; it < 2; ++it) {
        const int u = it == 0 ? F.bid : 256 + (F.bid - 16);
        if (it == 0 ? (u >= 256) : (F.bid < 16 || F.bid >= 32 || F.G < 256)) continue;
        const MixUnit mu = mix_unit(u); const bool isc = mu.isc;
        if (FULL && isc && l == NL - 1) continue;
        const int rowbase = mu.rowbase, T = mu.T, t0 = mu.t0, ntok = mu.ntok;
        __syncthreads();
        if (!FULL) { const int c8 = (F.tid & 31) * 8, tr = F.tid >> 5;
          float w[4][8], cb[8];
#pragma unroll
          for (int jj = 0; jj < 4; ++jj) { const f32x4 w0 = *(const f32x4*)(F.inp(I_CONVW) + (l * 4 + jj) * 256 + c8), w1 = *(const f32x4*)(F.inp(I_CONVW) + (l * 4 + jj) * 256 + c8 + 4);
              w[jj][0] = w0.x; w[jj][1] = w0.y; w[jj][2] = w0.z; w[jj][3] = w0.w; w[jj][4] = w1.x; w[jj][5] = w1.y; w[jj][6] = w1.z; w[jj][7] = w1.w; }
          { const f32x4 b0 = *(const f32x4*)(F.inp(I_CONVB) + l * 256 + c8), b1 = *(const f32x4*)(F.inp(I_CONVB) + l * 256 + c8 + 4);
            cb[0] = b0.x; cb[1] = b0.y; cb[2] = b0.z; cb[3] = b0.w; cb[4] = b1.x; cb[5] = b1.y; cb[6] = b1.z; cb[7] = b1.w; }
#pragma unroll 4
          for (int i = 0; i < 8; ++i) { const int t = tr + 16 * i, tt = t0 + t;
              if (t >= ntok) break;
              float o[8];
#pragma unroll
              for (int e = 0; e < 8; ++e) o[e] = cb[e];
#pragma unroll
              for (int jj = 0; jj < 4; ++jj) { const int ts = tt - 2 + jj;
                  if (ts >= 0 && ts < T) { const u32x4 xw = *(const u32x4*)(F.P() + (size_t)(rowbase + ts) * INW + C_LX + c8);
                      o[0] += w[jj][0] * __uint_as_float(xw.x << 16); o[1] += w[jj][1] * __uint_as_float(xw.x & 0xffff0000u); o[2] += w[jj][2] * __uint_as_float(xw.y << 16); o[3] += w[jj][3] * __uint_as_float(xw.y & 0xffff0000u);
                      o[4] += w[jj][4] * __uint_as_float(xw.z << 16); o[5] += w[jj][5] * __uint_as_float(xw.z & 0xffff0000u); o[6] += w[jj][6] * __uint_as_float(xw.w << 16); o[7] += w[jj][7] * __uint_as_float(xw.w & 0xffff0000u); } }
              u32x4 ow; ow.x = pk2(o[0], o[1]); ow.y = pk2(o[2], o[3]); ow.z = pk2(o[4], o[5]); ow.w = pk2(o[6], o[7]);
              *(LAS u32x4*)(U + t * U_PITCH + c8 * 2) = ow; } }
        __syncthreads();
        { const int n = F.wave & 3;
          if (F.wave < 4) lru_wave<FULL, 0>(F, l, mu.ub, n, rowbase, t0, ntok >> 5); else lru_wave<FULL, 1>(F, l, mu.ub, n, rowbase, t0, ntok >> 5); }
        if (FULL) {
            __syncthreads();
#pragma unroll 4
            for (int i = F.tid; i < ntok * 64; i += NTHR) { const int t = i >> 6, c4 = (i & 63) * 4; const size_t row = (size_t)rowbase + t0 + t;
                const f32x4 hf = *(const f32x4*)(F.HD() + row * 512 + c4), hb = *(const f32x4*)(F.HD() + row * 512 + 256 + c4);
                const u32x2 gw = *(const u32x2*)(F.P() + row * INW + C_LG + c4);
                u32x2 w; w.x = pk2((hf.x + hb.x) * gelu_tanh(__uint_as_float(gw.x << 16)), (hf.y + hb.y) * gelu_tanh(__uint_as_float(gw.x & 0xffff0000u)));
                w.y = pk2((hf.z + hb.z) * gelu_tanh(__uint_as_float(gw.y << 16)), (hf.w + hb.w) * gelu_tanh(__uint_as_float(gw.y & 0xffff0000u)));
                *(u32x2*)(F.MIX() + row * D + 512 + c4) = w; }
        }
    }
}
__device__ __forceinline__ int mix_order(int d, int s) { return d ? 135 - s : (s < 8 ? 128 + s : s - 8); }
__device__ __forceinline__ void ph_lru_carry(Ctx& F) {
    const int gt = F.bid * NTHR + F.tid;
    if (gt >= NB * 512) return;
    const int b = gt >> 9, dc = gt & 511, d = dc >> 8;
    float h = 0.f;
#pragma unroll 1
    for (int s0 = 0; s0 < 136; s0 += 34) {
        float av[34], bv[34];
#pragma unroll
        for (int q = 0; q < 34; ++q) { const size_t ix = (size_t)(b * MIX_NUB + mix_order(d, s0 + q)) * 512 + dc; av[q] = F.AGG()[AG_LRU_A + ix]; bv[q] = F.AGG()[AG_LRU_B + ix]; }
#pragma unroll
        for (int q = 0; q < 34; ++q) { F.AGG()[AG_LRU_H + (size_t)(b * MIX_NUB + mix_order(d, s0 + q)) * 512 + dc] = h; h = av[q] * h + bv[q]; }
    }
}

constexpr int HG_NU = MIX_NU;
constexpr int HGW_LDS = 17152;
constexpr int KT_P = 36;
constexpr size_t AG_HG_D = 1048576, AG_HG_EBR = AG_HG_D + (size_t)HG_NU * 8 * 64;
__device__ __forceinline__ void hg_stage_v(const Ctx& F, LAS bf16* Vt, int rowbase, int c0, int hh, int r32, int h, int DIR) {
    const int t = c0 + (DIR ? 31 - r32 : r32); const bf16* vp = F.P() + (size_t)(rowbase + t) * INW + C_HV + hh * 64 + 32 * h;
#pragma unroll
    for (int c = 0; c < 4; ++c) { const u32x4 w = *(const u32x4*)(vp + 8 * c); const int v0 = 32 * h + 8 * c;
        Vt[(v0 + 0) * 32 + r32] = (bf16)(w.x & 0xffffu); Vt[(v0 + 1) * 32 + r32] = (bf16)(w.x >> 16); Vt[(v0 + 2) * 32 + r32] = (bf16)(w.y & 0xffffu); Vt[(v0 + 3) * 32 + r32] = (bf16)(w.y >> 16);
        Vt[(v0 + 4) * 32 + r32] = (bf16)(w.z & 0xffffu); Vt[(v0 + 5) * 32 + r32] = (bf16)(w.z >> 16); Vt[(v0 + 6) * 32 + r32] = (bf16)(w.w & 0xffffu); Vt[(v0 + 7) * 32 + r32] = (bf16)(w.w >> 16); }
}
__device__ __forceinline__ void hg_update_s(f32x16 (&S)[2][2], const LAS bf16* KiT, const LAS bf16* Vt, const LAS float* ebr, int r32, int h) {
#pragma unroll
    for (int kt = 0; kt < 2; ++kt) {
        float e1[16];
#pragma unroll
        for (int q = 0; q < 16; ++q) e1[q] = ebr[4 * h + (32 * kt + (q & 3) + 8 * (q >> 2))];
#pragma unroll
        for (int vt = 0; vt < 2; ++vt) { f32x16 tmp;
#pragma unroll
            for (int q = 0; q < 16; ++q) tmp[q] = 0.f;
#pragma unroll
            for (int ks = 0; ks < 2; ++ks) { const LAS bf16* kp = KiT + (32 * kt + r32) * KT_P + 16 * ks + 8 * h; const u32x2 klo = *(const LAS u32x2*)kp, khi = *(const LAS u32x2*)(kp + 4);
                u32x4 fau; fau.x = klo.x; fau.y = klo.y; fau.z = khi.x; fau.w = khi.y; const bf16x8 fa = __builtin_bit_cast(bf16x8, fau), fb = *(const LAS bf16x8*)(Vt + (32 * vt + r32) * 32 + 16 * ks + 8 * h);
                tmp = __builtin_amdgcn_mfma_f32_32x32x16_bf16(fa, fb, tmp, 0, 0, 0); }
#pragma unroll
            for (int q = 0; q < 16; ++q) S[kt][vt][q] = e1[q] * (e1[q] * S[kt][vt][q] + tmp[q]); }
    }
}
template <int DIR>
__device__ __forceinline__ void hg_wave_a(Ctx& F, int l, int u, int hh, int rowbase, int nch) {
    int ln_ = F.lane; asm volatile("" : "+v"(ln_));
    const int r32 = ln_ & 31, h = ln_ >> 5, k = ln_;
    LAS unsigned char* W = F.lds + F.wave * HGW_LDS;
    LAS bf16* Qi = (LAS bf16*)W; LAS bf16* Ki = (LAS bf16*)(W + 4096); LAS bf16* KiT = (LAS bf16*)(W + 8192); LAS bf16* Vt = (LAS bf16*)(W + 12800); LAS float* ebr = (LAS float*)(W + 16896);
    const int hd = DIR * 4 + hh;
    const float lb = hg_lb(F, l, DIR, hh * 64 + k);
    const unsigned lane_s = 4 * h * 64 + r32;
    f32x16 S[2][2];
#pragma unroll
    for (int kt = 0; kt < 2; ++kt)
#pragma unroll
        for (int vt = 0; vt < 2; ++vt)
#pragma unroll
            for (int q = 0; q < 16; ++q) S[kt][vt][q] = 0.f;
    float dsum = 0.f;
    const int si = ln_ >> 1, sh = ln_ & 1;
    u32x4 zn[4], qn[4];
#define HGA_ISSUE(ci_) do { const int c0_ = 32 * (DIR ? nch - 1 - (ci_) : (ci_)); const int ts_ = c0_ + (DIR ? 31 - si : si); \
        const bf16* zp_ = F.P() + (size_t)(rowbase + ts_) * INW + (DIR ? C_HB : C_HF) + hh * 64 + 32 * sh; const bf16* qp_ = F.P() + (size_t)(rowbase + ts_) * INW + C_HQ + hh * 64 + 32 * sh; \
        _Pragma("unroll") for (int c = 0; c < 4; ++c) { zn[c] = *(const u32x4*)(zp_ + 8 * c); qn[c] = *(const u32x4*)(qp_ + 8 * c); } \
        } while (0)
#define HG_STAGE_V() do { _Pragma("unroll") for (int c = 0; c < 4; ++c) { const u32x4 w = vn[c]; const int v0 = 32 * h + 8 * c; \
        Vt[(v0 + 0) * 32 + r32] = (bf16)(w.x & 0xffffu); Vt[(v0 + 1) * 32 + r32] = (bf16)(w.x >> 16); Vt[(v0 + 2) * 32 + r32] = (bf16)(w.y & 0xffffu); Vt[(v0 + 3) * 32 + r32] = (bf16)(w.y >> 16); \
        Vt[(v0 + 4) * 32 + r32] = (bf16)(w.z & 0xffffu); Vt[(v0 + 5) * 32 + r32] = (bf16)(w.z >> 16); Vt[(v0 + 6) * 32 + r32] = (bf16)(w.w & 0xffffu); Vt[(v0 + 7) * 32 + r32] = (bf16)(w.w >> 16); } } while (0)
    HGA_ISSUE(0);
#pragma unroll 1
    for (int ci = 0; ci < nch; ++ci) {
        const int cph = DIR ? nch - 1 - ci : ci, c0 = 32 * cph;
        const int ts = c0 + (DIR ? 31 - si : si);
#pragma unroll
        for (int c = 0; c < 4; ++c) { *(LAS u32x4*)(Qi + si * 64 + 32 * sh + 8 * c) = zn[c]; *(LAS u32x4*)(Ki + si * 64 + 32 * sh + 8 * c) = qn[c]; }
        hg_stage_v(F, Vt, rowbase, c0, hh, r32, h, DIR);
        if (ci + 1 < nch) HGA_ISSUE(ci + 1);
        asm volatile("s_waitcnt lgkmcnt(0)" ::: "memory");
        {
            float lf[32]; float run = 0.f;
#pragma unroll
            for (int i = 0; i < 32; ++i) { const float z = bf2f(Qi[i * 64 + k]); lf[i] = __logf(lb + (1.0f - lb) * sigmoidf_(z)); run += lf[i]; }
            const float bref = 0.5f * run; dsum += run;
            const float eb = __expf(bref);
            ebr[k] = eb; F.AGG()[AG_HG_EBR + (((size_t)u * 4 + cph) * 8 + hd) * 64 + k] = eb;
            float cum = 0.f;
#pragma unroll
            for (int i = 0; i < 32; ++i) {
                const float qq = bf2f(Ki[i * 64 + k]);
                cum += lf[i];
                const float e = __expf(cum - bref), ei = __expf(bref - cum);
                const unsigned kv = f2bf((1.0f - __expf(lf[i])) * ei);
                Ki[i * 64 + k] = (bf16)kv; KiT[k * KT_P + i] = (bf16)kv; Qi[i * 64 + k] = (bf16)f2bf(qq * e); }
        }
        asm volatile("s_waitcnt lgkmcnt(0)" ::: "memory");
        { bf16* qo = F.ws_bf16(WS_QI) + (size_t)(rowbase + ts) * 512 + DIR * 256 + hh * 64 + 32 * sh; bf16* ko = F.ws_bf16(WS_KI) + (size_t)(rowbase + ts) * 512 + DIR * 256 + hh * 64 + 32 * sh;
#pragma unroll
          for (int c = 0; c < 4; ++c) { *(u32x4*)(qo + 8 * c) = *(const LAS u32x4*)(Qi + si * 64 + 32 * sh + 8 * c); *(u32x4*)(ko + 8 * c) = *(const LAS u32x4*)(Ki + si * 64 + 32 * sh + 8 * c); } }
        hg_update_s(S, KiT, Vt, ebr, r32, h);
        asm volatile("s_waitcnt lgkmcnt(0)" ::: "memory");
    }
    float* sa = (float*)(F.ws + WS_SAGG) + ((size_t)u * 8 + hd) * 4096;
#pragma unroll
    for (int kt = 0; kt < 2; ++kt)
#pragma unroll
        for (int vt = 0; vt < 2; ++vt)
#pragma unroll
            for (int q = 0; q < 16; ++q) sa[lane_s + (unsigned)((32 * kt + (q & 3) + 8 * (q >> 2)) * 64 + 32 * vt)] = S[kt][vt][q];
    F.AGG()[AG_HG_D + ((size_t)u * 8 + hd) * 64 + k] = __expf(dsum);
}
template <int DIR>
__device__ __forceinline__ void hg_wave_c(Ctx& F, int l, int u, int hh, int rowbase, int nch) {
    int ln_ = F.lane; asm volatile("" : "+v"(ln_));
    const int r32 = ln_ & 31, h = ln_ >> 5, k = ln_;
    LAS unsigned char* W = F.lds + F.wave * HGW_LDS;
    LAS bf16* Qi = (LAS bf16*)W; LAS bf16* Ki = (LAS bf16*)(W + 4096); LAS bf16* KiT = (LAS bf16*)(W + 8192); LAS bf16* Vt = (LAS bf16*)(W + 12800); LAS float* ebr = (LAS float*)(W + 16896);
    const int hd = DIR * 4 + hh;
    const unsigned lane_s = 4 * h * 64 + r32;
    f32x16 S[2][2];
    { const float* sin = (const float*)(F.ws + WS_SIN) + ((size_t)u * 8 + hd) * 4096;
#pragma unroll
      for (int kt = 0; kt < 2; ++kt)
#pragma unroll
          for (int vt = 0; vt < 2; ++vt)
#pragma unroll
              for (int q = 0; q < 16; ++q) S[kt][vt][q] = sin[lane_s + (unsigned)((32 * kt + (q & 3) + 8 * (q >> 2)) * 64 + 32 * vt)]; }
#pragma unroll 1
    for (int ci = 0; ci < nch; ++ci) {
        const int cph = DIR ? nch - 1 - ci : ci, c0 = 32 * cph;
        { const int si = ln_ >> 1, sh = ln_ & 1; const int ts = c0 + (DIR ? 31 - si : si);
          const bf16* qo = F.ws_bf16(WS_QI) + (size_t)(rowbase + ts) * 512 + DIR * 256 + hh * 64 + 32 * sh; const bf16* ko = F.ws_bf16(WS_KI) + (size_t)(rowbase + ts) * 512 + DIR * 256 + hh * 64 + 32 * sh;
          u32x4 qq[4], kk[4];
#pragma unroll
          for (int c = 0; c < 4; ++c) { qq[c] = *(const u32x4*)(qo + 8 * c); kk[c] = *(const u32x4*)(ko + 8 * c); }
          ebr[k] = F.AGG()[AG_HG_EBR + (((size_t)u * 4 + cph) * 8 + hd) * 64 + k];
#pragma unroll
          for (int c = 0; c < 4; ++c) { *(LAS u32x4*)(Qi + si * 64 + 32 * sh + 8 * c) = qq[c]; *(LAS u32x4*)(Ki + si * 64 + 32 * sh + 8 * c) = kk[c];
              const int k0 = 32 * sh + 8 * c;
              KiT[(k0 + 0) * KT_P + si] = (bf16)(kk[c].x & 0xffffu); KiT[(k0 + 1) * KT_P + si] = (bf16)(kk[c].x >> 16); KiT[(k0 + 2) * KT_P + si] = (bf16)(kk[c].y & 0xffffu); KiT[(k0 + 3) * KT_P + si] = (bf16)(kk[c].y >> 16);
              KiT[(k0 + 4) * KT_P + si] = (bf16)(kk[c].z & 0xffffu); KiT[(k0 + 5) * KT_P + si] = (bf16)(kk[c].z >> 16); KiT[(k0 + 6) * KT_P + si] = (bf16)(kk[c].w & 0xffffu); KiT[(k0 + 7) * KT_P + si] = (bf16)(kk[c].w >> 16); } }
        hg_stage_v(F, Vt, rowbase, c0, hh, r32, h, DIR);
        asm volatile("s_waitcnt lgkmcnt(0)" ::: "memory");
        f32x16 att;
#pragma unroll
        for (int q = 0; q < 16; ++q) att[q] = 0.f;
#pragma unroll
        for (int ks = 0; ks < 4; ++ks) { const bf16x8 fa = *(const LAS bf16x8*)(Ki + r32 * 64 + 16 * ks + 8 * h), fb = *(const LAS bf16x8*)(Qi + r32 * 64 + 16 * ks + 8 * h);
            att = __builtin_amdgcn_mfma_f32_32x32x16_bf16(fa, fb, att, 0, 0, 0); }
#pragma unroll
        for (int q = 0; q < 16; ++q) att[q] = (crow(q, h) <= r32) ? att[q] : 0.f;
        f32x16 o[2];
#pragma unroll
        for (int vt = 0; vt < 2; ++vt)
#pragma unroll
            for (int q = 0; q < 16; ++q) o[vt][q] = 0.f;
#pragma unroll
        for (int ks = 0; ks < 2; ++ks) {
            u32x4 pa; pa.x = pk2(att[8 * ks + 0], att[8 * ks + 1]); pa.y = pk2(att[8 * ks + 2], att[8 * ks + 3]); pa.z = pk2(att[8 * ks + 4], att[8 * ks + 5]); pa.w = pk2(att[8 * ks + 6], att[8 * ks + 7]);
#pragma unroll
            for (int vt = 0; vt < 2; ++vt) { const LAS bf16* vp = Vt + (32 * vt + r32) * 32 + 16 * ks + 4 * h;
                const u32x2 lo = *(const LAS u32x2*)vp, hi2 = *(const LAS u32x2*)(vp + 8);
                u32x4 fb; fb.x = lo.x; fb.y = lo.y; fb.z = hi2.x; fb.w = hi2.y;
                o[vt] = __builtin_amdgcn_mfma_f32_32x32x16_bf16(__builtin_bit_cast(bf16x8, pa), __builtin_bit_cast(bf16x8, fb), o[vt], 0, 0, 0); } }
#pragma unroll
        for (int kt = 0; kt < 2; ++kt) {
            float e1[16];
#pragma unroll
            for (int q = 0; q < 16; ++q) e1[q] = ebr[4 * h + (32 * kt + (q & 3) + 8 * (q >> 2))];
#pragma unroll
            for (int ks = 0; ks < 2; ++ks) { const LAS bf16* qp = Qi + r32 * 64 + 32 * kt + 16 * ks + 4 * h;
                const u32x2 lo = *(const LAS u32x2*)qp, hi2 = *(const LAS u32x2*)(qp + 8);
                u32x4 fa; fa.x = lo.x; fa.y = lo.y; fa.z = hi2.x; fa.w = hi2.y;
#pragma unroll
                for (int vt = 0; vt < 2; ++vt) { u32x4 sb;
                    sb.x = pk2(S[kt][vt][8 * ks + 0] * e1[8 * ks + 0], S[kt][vt][8 * ks + 1] * e1[8 * ks + 1]); sb.y = pk2(S[kt][vt][8 * ks + 2] * e1[8 * ks + 2], S[kt][vt][8 * ks + 3] * e1[8 * ks + 3]);
                    sb.z = pk2(S[kt][vt][8 * ks + 4] * e1[8 * ks + 4], S[kt][vt][8 * ks + 5] * e1[8 * ks + 5]); sb.w = pk2(S[kt][vt][8 * ks + 6] * e1[8 * ks + 6], S[kt][vt][8 * ks + 7] * e1[8 * ks + 7]);
                    o[vt] = __builtin_amdgcn_mfma_f32_32x32x16_bf16(__builtin_bit_cast(bf16x8, fa), __builtin_bit_cast(bf16x8, sb), o[vt], 0, 0, 0); } }
        }
        { float* ob = F.OHG() + (size_t)(rowbase + c0) * 512 + DIR * 256 + hh * 64;
          const unsigned lane_o = (unsigned)((DIR ? 4 - 4 * h : 4 * h) * 512 + r32);
#pragma unroll
          for (int q = 0; q < 16; ++q) { const int iq = (q & 3) + 8 * (q >> 2); const unsigned cq = (unsigned)((DIR ? 27 - iq : iq) * 512);
              ob[lane_o + cq] = o[0][q]; ob[lane_o + cq + 32u] = o[1][q]; } }
        if (ci < nch - 1) hg_update_s(S, KiT, Vt, ebr, r32, h);
        asm volatile("s_waitcnt lgkmcnt(0)" ::: "memory");
    }
}
template <bool FULL>
__device__ __forceinline__ void ph_hgrn_fast(Ctx& F, int l) {
    for (int it = 0; it < 2; ++it) {
        const int u = it == 0 ? F.bid : 256 + (F.bid - 32);
        if (it == 0 ? (u >= 256) : (F.bid < 32 || F.bid >= 48 || F.G < 256)) continue;
        const MixUnit mu = mix_unit(u); const bool isc = mu.isc;
        if (FULL && isc && l == NL - 1) continue;
        const int rowbase = mu.rowbase + mu.t0, ntok = mu.ntok;
        __syncthreads();
        { const int hh = F.wave & 3;
          if (FULL) { if (F.wave < 4) hg_wave_c<0>(F, l, mu.ub, hh, rowbase, ntok >> 5); else hg_wave_c<1>(F, l, mu.ub, hh, rowbase, ntok >> 5); }
          else { if (F.wave < 4) hg_wave_a<0>(F, l, mu.ub, hh, rowbase, ntok >> 5); else hg_wave_a<1>(F, l, mu.ub, hh, rowbase, ntok >> 5); } }
        if (FULL) {
            __syncthreads();
#pragma unroll 4
            for (int rr = F.wave; rr < ntok; rr += NWAVES) { const size_t m = (size_t)rowbase + rr; const int col = 4 * F.lane;
                const f32x4 a = *(const f32x4*)(F.OHG() + m * 512 + col), bb = *(const f32x4*)(F.OHG() + m * 512 + 256 + col);
                const f32x4 o = a + bb;
                float ss = (o.x * o.x + o.y * o.y) + (o.z * o.z + o.w * o.w);
                ss += shx(ss, 1, F.lane); ss += shx(ss, 2, F.lane); ss += shx(ss, 4, F.lane); ss += shx(ss, 8, F.lane);
                const float rstd = 1.0f / sqrtf(ss * (1.0f / 64.0f) + EPS);
                const f32x4 g = *(const f32x4*)(F.inp(I_HNG) + l * 256 + col);
                const u32x2 ow = *(const u32x2*)(F.P() + m * INW + C_HO + col);
                const float g0 = siluf_(__uint_as_float(ow.x << 16)), g1 = siluf_(__uint_as_float(ow.x & 0xffff0000u)), g2 = siluf_(__uint_as_float(ow.y << 16)), g3 = siluf_(__uint_as_float(ow.y & 0xffff0000u));
                u32x2 w; w.x = pk2(o.x * rstd * g.x * g0, o.y * rstd * g.y * g1); w.y = pk2(o.z * rstd * g.z * g2, o.w * rstd * g.w * g3);
                *(u32x2*)(F.MIX() + m * D + 768 + col) = w; }
        }
    }
}
__device__ __forceinline__ void ph_hgrn_carry(Ctx& F) {
    const int gt = F.bid * NTHR + F.tid;
    if (gt >= 16 * 4096) return;
    const int seq = gt >> 12, e = gt & 4095, b = seq >> 3, hd = seq & 7, d = hd >> 2, kk = e >> 6;
    const float* SA = (const float*)(F.ws + WS_SAGG); float* SI = (float*)(F.ws + WS_SIN);
    float S = 0.f;
#pragma unroll 1
    for (int s0 = 0; s0 < 136; s0 += 34) {
        float dv[34], sv[34];
#pragma unroll
        for (int q = 0; q < 34; ++q) { const size_t ub = (size_t)(b * MIX_NUB + mix_order(d, s0 + q)) * 8 + hd; dv[q] = F.AGG()[AG_HG_D + ub * 64 + kk]; sv[q] = SA[ub * 4096 + e]; }
#pragma unroll
        for (int q = 0; q < 34; ++q) { const size_t ub = (size_t)(b * MIX_NUB + mix_order(d, s0 + q)) * 8 + hd; SI[ub * 4096 + e] = S; S = dv[q] * S + sv[q]; }
    }
}

constexpr int CV_GU = NE * 16 * 64, CV_DN = NE * 16 * 32, CV_ITEMS = CV_GU + CV_DN, CV_PER_WAVE = CV_ITEMS / 2048;
constexpr int PROG_OFF = 147456 - 256 + 24 * 4;
constexpr int AT_CVSCR = 2 * 2 * 64 * 144;
#ifndef ATTN_RIDE
#define ATTN_RIDE 0
#endif
constexpr int AT_KP = 144;
constexpr int AT_BUF = 2 * 64 * AT_KP;
__device__ __forceinline__ float max3f(float a, float b, float c) { float r; asm("v_max3_f32 %0, %1, %2, %3" : "=v"(r) : "v"(a), "v"(b), "v"(c)); return r; }
__device__ __forceinline__ void ph_attn_fast(Ctx& F, int l) {
    int ln_ = F.lane; asm volatile("" : "+v"(ln_));
    const int r32 = ln_ & 31, h = ln_ >> 5, g = F.wave >> 1, ph = F.wave & 1;
    const int lrow = F.tid >> 3, lch = F.tid & 7;
    const int NU = (l == 0) ? 1040 : 1024;
    for (int it = 0; it < 5; ++it) {
        const int u = it < 4 ? F.bid + 256 * it : 1024 + (F.bid - 240);
        if (it == 4 && (F.bid < 240 || NU <= 1024)) continue;
        const bool isc = u >= 1024;
        int b, kvh, jb;
        if (!isc) { b = u >> 9; kvh = (u >> 8) & 1; jb = u & 255; } else { const int v = u - 1024; b = v >> 3; kvh = (v >> 2) & 1; jb = v & 3; }
        const int q0 = jb * 64, qrowbase = isc ? ML + b * CTXL : b * SEQ, hq = kvh * 4 + g;
        int i_lo = 0, nloc = 0;
        if (!isc) { i_lo = q0 < 128 ? (128 - q0) >> 6 : 0; const int i_hi = (q0 + 192 <= SEQ) ? 4 : ((q0 + 128 <= SEQ) ? 3 : 2); nloc = i_hi - i_lo + 1; }
        const int NT = nloc + 4;
        bf16x8 qf[4];
        { const bf16* qp = F.P() + (size_t)(qrowbase + q0 + 32 * ph + r32) * INW + C_Q + hq * 64 + 8 * h;
#pragma unroll
          for (int ks = 0; ks < 4; ++ks) qf[ks] = *(const bf16x8*)(qp + 16 * ks); }
        float m_run = F.inp(I_SINK)[l * 8 + hq] * LOG2E, l_run = (h == 0) ? 1.0f : 0.0f;
        f32x16 ot[2];
#pragma unroll
        for (int dt = 0; dt < 2; ++dt)
#pragma unroll
            for (int q = 0; q < 16; ++q) ot[dt][q] = 0.f;
        u32x4 kreg, vreg;
#define AT_LOAD(ti) do { const int ti_ = (ti); const bool loc_ = ti_ < nloc; const int kst_ = loc_ ? q0 - 128 + 64 * (i_lo + ti_) : 64 * (ti_ - nloc); \
        const size_t krow_ = loc_ ? (size_t)b * SEQ + kst_ : (size_t)ML + b * CTXL + kst_; \
        kreg = *(const u32x4*)(F.P() + (krow_ + lrow) * INW + C_K + kvh * 64 + lch * 8); \
        const size_t vo_ = loc_ ? ((size_t)((b * 2 + kvh) * 64 + lrow)) * SEQ + kst_ : VT_CTX_OFF + ((size_t)((b * 2 + kvh) * 64 + lrow)) * CTXL + kst_; \
        vreg = *(const u32x4*)(F.Vt() + vo_ + lch * 8); } while (0)
#define AT_STORE(slot) do { LAS unsigned char* d_ = F.lds + (slot) * AT_BUF + lrow * AT_KP + lch * 16; *(LAS u32x4*)d_ = kreg; *(LAS u32x4*)(d_ + 64 * AT_KP) = vreg; } while (0)
#define AT_QK(P0, P1, slot) do { const LAS unsigned char* Kb_ = F.lds + (slot) * AT_BUF; \
        _Pragma("unroll") for (int q = 0; q < 16; ++q) { P0[q] = 0.f; P1[q] = 0.f; } \
        _Pragma("unroll") for (int ks = 0; ks < 4; ++ks) { \
            const bf16x8 a0 = *(const LAS bf16x8*)(Kb_ + r32 * AT_KP + (16 * ks + 8 * h) * 2), a1 = *(const LAS bf16x8*)(Kb_ + (32 + r32) * AT_KP + (16 * ks + 8 * h) * 2); \
            P0 = __builtin_amdgcn_mfma_f32_32x32x16_bf16(a0, qf[ks], P0, 0, 0, 0); P1 = __builtin_amdgcn_mfma_f32_32x32x16_bf16(a1, qf[ks], P1, 0, 0, 0); } } while (0)
        __syncthreads();
        AT_LOAD(0); AT_STORE(0); AT_LOAD(1); AT_STORE(1);
        __syncthreads();
        f32x16 p0, p1;
        AT_QK(p0, p1, 0);
        int sc_ = 0, sn_ = 1, sw_ = 2;
#pragma unroll 1
        for (int ti = 0; ti < NT; ++ti) {
            if (ti + 2 < NT) AT_LOAD(ti + 2);
            f32x16 n0, n1;
            if (ti + 1 < NT) AT_QK(n0, n1, sn_);
            else {
#pragma unroll
                for (int q = 0; q < 16; ++q) { n0[q] = 0.f; n1[q] = 0.f; } }
            const LAS unsigned char* Vb = F.lds + sc_ * AT_BUF + 64 * AT_KP;
            const int itile = (ti < nloc) ? i_lo + ti : 2;
            if (itile == 0 || itile == 4) {
                int dq = 32 * ph + r32 - 4 * h; asm volatile("" : "+v"(dq));
                if (itile == 0) {
#pragma unroll
                    for (int q = 0; q < 16; ++q) { const int cq = (q & 3) + 8 * (q >> 2); p0[q] = (cq >= dq) ? p0[q] : -1.0e30f; p1[q] = (cq + 32 >= dq) ? p1[q] : -1.0e30f; }
                } else {
#pragma unroll
                    for (int q = 0; q < 16; ++q) { const int cq = (q & 3) + 8 * (q >> 2); p0[q] = (cq <= dq) ? p0[q] : -1.0e30f; p1[q] = (cq + 32 <= dq) ? p1[q] : -1.0e30f; }
                }
            }
            float tm = max3f(p0[0], p1[0], p0[1]), tm2 = max3f(p1[1], p0[2], p1[2]);
#pragma unroll
            for (int q = 3; q < 15; q += 2) { tm = max3f(tm, p0[q], p1[q]); tm2 = max3f(tm2, p0[q + 1], p1[q + 1]); }
            tm = max3f(tm, tm2, p0[15]); tm = fmaxf(tm, p1[15]);
            tm = fmaxf(tm, shx(tm, 32, ln_));
            const float mn = fmaxf(m_run, tm);
            if (__builtin_amdgcn_ballot_w64(mn != m_run) != 0ull) {
                const float sc = __builtin_amdgcn_exp2f(m_run - mn);
                l_run *= sc;
#pragma unroll
                for (int dt = 0; dt < 2; ++dt)
#pragma unroll
                    for (int q = 0; q < 16; ++q) ot[dt][q] *= sc;
            }
            m_run = mn;
            float ls = 0.f;
#pragma unroll
            for (int q = 0; q < 16; ++q) { p0[q] = __builtin_amdgcn_exp2f(p0[q] - mn); p1[q] = __builtin_amdgcn_exp2f(p1[q] - mn); ls += p0[q] + p1[q]; }
            l_run += ls;
#pragma unroll
            for (int hk = 0; hk < 2; ++hk)
#pragma unroll
                for (int s = 0; s < 2; ++s) {
                    u32x4 pb;
                    if (hk == 0) { pb.x = pk2(p0[8 * s + 0], p0[8 * s + 1]); pb.y = pk2(p0[8 * s + 2], p0[8 * s + 3]); pb.z = pk2(p0[8 * s + 4], p0[8 * s + 5]); pb.w = pk2(p0[8 * s + 6], p0[8 * s + 7]); }
                    else { pb.x = pk2(p1[8 * s + 0], p1[8 * s + 1]); pb.y = pk2(p1[8 * s + 2], p1[8 * s + 3]); pb.z = pk2(p1[8 * s + 4], p1[8 * s + 5]); pb.w = pk2(p1[8 * s + 6], p1[8 * s + 7]); }
#pragma unroll
                    for (int dt = 0; dt < 2; ++dt) { const LAS unsigned char* vp = Vb + (32 * dt + r32) * AT_KP + (32 * hk + 16 * s + 4 * h) * 2;
                        const u32x2 lo = *(const LAS u32x2*)vp, hi2 = *(const LAS u32x2*)(vp + 16);
                        u32x4 fa; fa.x = lo.x; fa.y = lo.y; fa.z = hi2.x; fa.w = hi2.y;
                        ot[dt] = __builtin_amdgcn_mfma_f32_32x32x16_bf16(__builtin_bit_cast(bf16x8, fa), __builtin_bit_cast(bf16x8, pb), ot[dt], 0, 0, 0); } }
            if (ti + 2 < NT) AT_STORE(sw_);
            __syncthreads();
            p0 = n0; p1 = n1;
            { const int t_ = sc_; sc_ = sn_; sn_ = sw_; sw_ = t_; }
        }
#undef AT_LOAD
#undef AT_STORE
#undef AT_QK
        const float linv = 1.0f / (l_run + shx(l_run, 32, ln_));
        { bf16* op = F.MIX() + (size_t)(qrowbase + q0 + 32 * ph + r32) * D + hq * 64 + 4 * h;
#pragma unroll
          for (int dt = 0; dt < 2; ++dt)
#pragma unroll
              for (int gq = 0; gq < 4; ++gq) { u32x2 w; w.x = pk2(ot[dt][4 * gq + 0] * linv, ot[dt][4 * gq + 1] * linv); w.y = pk2(ot[dt][4 * gq + 2] * linv, ot[dt][4 * gq + 3] * linv);
                  *(u32x2*)(op + 32 * dt + 8 * gq) = w; } }
    }
}

__device__ __forceinline__ void ph_outproj_naive(Ctx& F, int l) {
    const int gw = F.bid * NWAVES + F.wave, NGW = F.G * NWAVES, r = F.lane & 31, h = F.lane >> 5;
    const int Mq = (l == 0) ? MA : ML;
    const bf16* Bt = F.WoutT() + (size_t)l * D * D;
    for (int ti = gw; ti < (Mq / 64) * (D / 64); ti += NGW) {
        const int rt = ti / (D / 64), ct = ti % (D / 64), m0 = rt * 64, c0 = ct * 64;
        f32x16 acc[2][2];
        sg_kloop(acc, F.MIX() + (size_t)(m0 + r) * D + 8 * h, F.MIX() + (size_t)(m0 + 32 + r) * D + 8 * h, Bt + (size_t)(c0 + r) * D + 8 * h, Bt + (size_t)(c0 + 32 + r) * D + 8 * h, D);
#pragma unroll
        for (int mt = 0; mt < 2; ++mt)
#pragma unroll
            for (int nt = 0; nt < 2; ++nt)
#pragma unroll
                for (int q = 0; q < 16; ++q) {
                    const int m = m0 + 32 * mt + crow(q, h), c = c0 + 32 * nt + r;
                    const float g2 = F.mods()[((size_t)l * 3 + mod_row(m)) * 6 * D + 2 * D + c];
                    F.P()[(size_t)m * D + c] = (bf16)f2bf(g2 * acc[mt][nt][q]);
                }
    }
}

__device__ __forceinline__ void ph_norm2_router(Ctx& F, int l, bool shadow = false) {
    const int Mq = (l == 0) ? MA : ML;
    LAS unsigned char* HI = F.lds; LAS unsigned char* LO = F.lds + 16512;
    constexpr int HP = 2064;
    LAS float* part = (LAS float*)(F.lds + 36864);
    LAS float* AC = (LAS float*)(F.lds + 98304);
    LAS float* BC = (LAS float*)(F.lds + 110592);
    LAS float* lg = (LAS float*)(F.lds + 122880);
    LAS float* tvi = (LAS float*)(F.lds + 123904);
    LAS int* lcnt = (LAS int*)(F.lds + 124928);
    LAS int* lbase = (LAS int*)(F.lds + 124928 + 128);
    LAS int* se = (LAS int*)(F.lds + 124928 + 256);
    LAS float* sg = (LAS float*)(F.lds + 124928 + 256 + 4096);
    const int e = F.tid & 31;
    const int fr = F.lane & 15, fq = F.lane >> 4, kw = F.wave * 128;
    bf16x8 whi[2][4], wlo[2][4];
#pragma unroll
    for (int nt = 0; nt < 2; ++nt)
#pragma unroll
        for (int ks = 0; ks < 4; ++ks) { float wv[8];
#pragma unroll
            for (int i = 0; i < 8; ++i) wv[i] = F.inp(I_RW)[((size_t)l * D + kw + 32 * ks + 8 * fq + i) * NE + 16 * nt + fr];
            u32x4 hi, lo;
            hi.x = pk2(wv[0], wv[1]); hi.y = pk2(wv[2], wv[3]); hi.z = pk2(wv[4], wv[5]); hi.w = pk2(wv[6], wv[7]);
            lo.x = pk2(wv[0] - __uint_as_float(hi.x << 16), wv[1] - __uint_as_float(hi.x & 0xffff0000u)); lo.y = pk2(wv[2] - __uint_as_float(hi.y << 16), wv[3] - __uint_as_float(hi.y & 0xffff0000u));
            lo.z = pk2(wv[4] - __uint_as_float(hi.z << 16), wv[5] - __uint_as_float(hi.z & 0xffff0000u)); lo.w = pk2(wv[6] - __uint_as_float(hi.w << 16), wv[7] - __uint_as_float(hi.w & 0xffff0000u));
            whi[nt][ks] = __builtin_bit_cast(bf16x8, hi); wlo[nt][ks] = __builtin_bit_cast(bf16x8, lo); }
    unsigned* cnt = (unsigned*)(F.ctl() + CW_CNT + l * 64 + (shadow ? 512 : 0));
    int* ltok = shadow ? (int*)(F.ws + WS_HMOE) : F.list_tok(); int* ldst = ltok + (size_t)NE * CAP; float* lgate = (float*)(ldst + (size_t)NE * CAP);
    __syncthreads();
    if (F.tid < 32) lcnt[F.tid] = 0;
    for (int i = F.tid; i < 3 * D; i += NTHR) { const int r = i >> 10, c = i & (D - 1); const float* mo = F.mods() + ((size_t)l * 3 + r) * 6 * D;
        AC[i] = F.inp(I_N2G)[l * D + c] * (1.0f + mo[4 * D + c]); BC[i] = mo[3 * D + c]; }
    f32x4 v[4]; u32x2 tv[4];
#define RT_LOAD(mm) do { const int m_ = (mm); \
        if (l == 0) { const float* s_ = m_ < ML ? F.inp(I_X) + (size_t)m_ * D : F.inp(I_CTX) + (size_t)(m_ - ML) * D; \
            _Pragma("unroll") for (int j = 0; j < 4; ++j) v[j] = *(const f32x4*)(s_ + 4 * F.lane + 256 * j); } \
        else { _Pragma("unroll") for (int j = 0; j < 4; ++j) { const u32x2 w_ = *(const u32x2*)(F.XL() + (size_t)m_ * D + 4 * F.lane + 256 * j); \
            v[j] = (f32x4){__uint_as_float(w_.x << 16), __uint_as_float(w_.x & 0xffff0000u), __uint_as_float(w_.y << 16), __uint_as_float(w_.y & 0xffff0000u)}; } } \
        _Pragma("unroll") for (int j = 0; j < 4; ++j) tv[j] = *(const u32x2*)(F.P() + (size_t)m_ * D + 4 * F.lane + 256 * j); } while (0)
    { const int m = F.bid * 8 + F.wave; if (m < Mq) RT_LOAD(m); }
    __syncthreads();
    int ti = 0;
    for (int base = F.bid * 8; base < Mq; base += F.G * 8, ++ti) {
        { const int m = base + F.wave;
          const int mr = mod_row(m);
          float ss = 0.f;
#pragma unroll
          for (int j = 0; j < 4; ++j) { v[j].x += __uint_as_float(tv[j].x << 16); v[j].y += __uint_as_float(tv[j].x & 0xffff0000u); v[j].z += __uint_as_float(tv[j].y << 16); v[j].w += __uint_as_float(tv[j].y & 0xffff0000u);
              { u32x2 xw; xw.x = pk2(v[j].x, v[j].y); xw.y = pk2(v[j].z, v[j].w); *(u32x2*)(F.XL() + (size_t)m * D + 4 * F.lane + 256 * j) = xw; }
              ss += (v[j].x * v[j].x + v[j].y * v[j].y) + (v[j].z * v[j].z + v[j].w * v[j].w); }
          const float rstd = __builtin_amdgcn_rsqf(wave_sum(ss, F.lane) * (1.0f / D) + EPS);
#pragma unroll
          for (int j = 0; j < 4; ++j) { const int col = 4 * F.lane + 256 * j;
              const f32x4 ga = *(const LAS f32x4*)(AC + mr * D + col), sh = *(const LAS f32x4*)(BC + mr * D + col);
              const f32x4 h = v[j] * rstd * ga + sh;
              if (MOE_FP8) *(unsigned*)((unsigned char*)F.H1() + (size_t)m * D + col) = pk_fp8x4(h.x, h.y, h.z, h.w);
              else { u32x2 w; w.x = pk2(h.x, h.y); w.y = pk2(h.z, h.w); *(u32x2*)(F.H1() + (size_t)m * D + col) = w; }
              { u32x2 wh, wl; wh.x = pk2(h.x, h.y); wh.y = pk2(h.z, h.w);
                wl.x = pk2(h.x - __uint_as_float(wh.x << 16), h.y - __uint_as_float(wh.x & 0xffff0000u)); wl.y = pk2(h.z - __uint_as_float(wh.y << 16), h.w - __uint_as_float(wh.y & 0xffff0000u));
                *(LAS u32x2*)(HI + F.wave * HP + col * 2) = wh; *(LAS u32x2*)(LO + F.wave * HP + col * 2) = wl; } }
          const int mn = m + F.G * 8;
          if (mn < Mq) RT_LOAD(mn); }
        __syncthreads();
        { f32x4 acc[2] = {{0.f, 0.f, 0.f, 0.f}, {0.f, 0.f, 0.f, 0.f}};
#pragma unroll
          for (int ks = 0; ks < 4; ++ks) { const int ao = (fr & 7) * HP + (kw + 32 * ks + 8 * fq) * 2;
              const bf16x8 ah = *(const LAS bf16x8*)(HI + ao), al = *(const LAS bf16x8*)(LO + ao);
#pragma unroll
              for (int nt = 0; nt < 2; ++nt) { acc[nt] = __builtin_amdgcn_mfma_f32_16x16x32_bf16(al, whi[nt][ks], acc[nt], 0, 0, 0); acc[nt] = __builtin_amdgcn_mfma_f32_16x16x32_bf16(ah, wlo[nt][ks], acc[nt], 0, 0, 0);
                  acc[nt] = __builtin_amdgcn_mfma_f32_16x16x32_bf16(ah, whi[nt][ks], acc[nt], 0, 0, 0); } }
          if (fq < 2) {
#pragma unroll
              for (int nt = 0; nt < 2; ++nt)
#pragma unroll
                  for (int j = 0; j < 4; ++j) part[(F.wave * 8 + 4 * fq + j) * 32 + 16 * nt + fr] = acc[nt][j]; } }
        __syncthreads();
        if (F.tid < 256) {
            const int rr = F.tid >> 5; float s = F.inp(I_RB)[l * NE + e];
#pragma unroll
            for (int q = 0; q < 8; ++q) s += part[(q * 8 + rr) * 32 + e];
            lg[rr * 32 + e] = s;
            asm volatile("s_waitcnt lgkmcnt(0)" ::: "memory");
            int rank = 0;
#pragma unroll
            for (int q = 0; q < 8; ++q) { const f32x4 x = *(const LAS f32x4*)(lg + rr * 32 + 4 * q);
                rank += (x.x > s || (x.x == s && 4 * q + 0 < e)) ? 1 : 0; rank += (x.y > s || (x.y == s && 4 * q + 1 < e)) ? 1 : 0;
                rank += (x.z > s || (x.z == s && 4 * q + 2 < e)) ? 1 : 0; rank += (x.w > s || (x.w == s && 4 * q + 3 < e)) ? 1 : 0; }
            if (rank < 4) { tvi[(rr * 4 + rank) * 2] = s; tvi[(rr * 4 + rank) * 2 + 1] = __int_as_float(e); }
            asm volatile("s_waitcnt lgkmcnt(0)" ::: "memory");
            const f32x4 c01 = *(const LAS f32x4*)(tvi + rr * 8), c23 = *(const LAS f32x4*)(tvi + rr * 8 + 4);
            const float p1 = __expf(c01.z - c01.x), p2 = __expf(c23.x - c01.x), p3 = __expf(c23.z - c01.x), den = 1.0f + p1 + p2 + p3;
            if (e < 4) { const float myv = e == 0 ? 1.0f : (e == 1 ? p1 : (e == 2 ? p2 : p3)); const int mye = __float_as_int(e == 0 ? c01.y : (e == 1 ? c01.w : (e == 2 ? c23.y : c23.w)));
                const int lp = __hip_atomic_fetch_add(lcnt + mye, 1, __ATOMIC_RELAXED, __HIP_MEMORY_SCOPE_WORKGROUP);
                se[ti * 32 + rr * 4 + e] = mye | (lp << 8); sg[ti * 32 + rr * 4 + e] = myv * frcp(den); }
        }
        __syncthreads();
    }
    if (F.tid < 32) lbase[F.tid] = (int)atomicAdd(cnt + F.tid, (unsigned)lcnt[F.tid]);
    __syncthreads();
    for (int i = F.tid; i < ti * 32; i += NTHR) {
        const int w = se[i], ee = w & 255, lp = w >> 8, m = F.bid * 8 + (i >> 5) * (F.G * 8) + ((i & 31) >> 2), j = i & 3;
        const size_t pos = (size_t)ee * CAP + lbase[ee] + lp;
        ltok[pos] = m; ldst[pos] = m * 4 + j; lgate[pos] = sg[i];
    }
}

#undef RT_LOAD
__device__ __forceinline__ void ph_moe_gu_naive(Ctx& F, int l) {
    const int gw = F.bid * NWAVES + F.wave, NGW = F.G * NWAVES, r = F.lane & 31, h = F.lane >> 5;
    const unsigned* cnt = (const unsigned*)(F.ctl() + CW_CNT + l * 64);
    int id0 = 0, ts256 = 0;
    for (int e = 0; e < NE; ++e) {
        const int ce = (int)__hip_atomic_load(cnt + e, __ATOMIC_RELAXED, __HIP_MEMORY_SCOPE_AGENT);
        const int nrt = (ce + 63) / 64, n = nrt * 32;
        const bf16* Bt = F.WguT() + ((size_t)l * NE + e) * 2 * FF * D;
        const float* bg = F.inp(I_BGU) + ((size_t)l * NE + e) * 2 * FF;
        int id = id0 + ((gw - id0 % NGW) + NGW) % NGW;
        for (; id < id0 + n; id += NGW) {
            const int rt = (id - id0) / 32, ft = (id - id0) % 32, pos0 = rt * 64, ff0 = ft * 32;
            const int p0 = pos0 + r, p1 = pos0 + 32 + r;
            const int t0 = p0 < ce ? F.list_tok()[(size_t)e * CAP + p0] : 0, t1 = p1 < ce ? F.list_tok()[(size_t)e * CAP + p1] : 0;
            const int ng = (ff0 >> 7) * 256 + (ff0 & 127) + r;
            f32x16 acc[2][2];
            sg_kloop(acc, F.H1() + (size_t)t0 * D + 8 * h, F.H1() + (size_t)t1 * D + 8 * h, Bt + (size_t)ng * D + 8 * h, Bt + (size_t)(ng + 128) * D + 8 * h, D);
            const float bgate = bg[ff0 + r], bup = bg[FF + ff0 + r];
#pragma unroll
            for (int mt = 0; mt < 2; ++mt)
#pragma unroll
                for (int q = 0; q < 16; ++q) {
                    const int pos = pos0 + 32 * mt + crow(q, h);
                    if (pos < ce) {
                        const float gate = fminf(acc[mt][0][q] + bgate, 7.0f), up = fminf(fmaxf(acc[mt][1][q] + bup, -7.0f), 7.0f);
                        const float glu = gate * sigmoidf_(1.702f * gate);
                        F.HMOE()[((size_t)ts256 * 256 + pos) * FF + ff0 + r] = (bf16)f2bf((up + 1.0f) * glu);
                    }
                }
        }
        id0 += n; ts256 += (ce + 255) / 256;
    }
}
__device__ __forceinline__ void ph_moe_down_naive(Ctx& F, int l) {
    const int gw = F.bid * NWAVES + F.wave, NGW = F.G * NWAVES, r = F.lane & 31, h = F.lane >> 5;
    const unsigned* cnt = (const unsigned*)(F.ctl() + CW_CNT + l * 64);
    int id0 = 0, ts256 = 0;
    for (int e = 0; e < NE; ++e) {
        const int ce = (int)__hip_atomic_load(cnt + e, __ATOMIC_RELAXED, __HIP_MEMORY_SCOPE_AGENT);
        const int nrt = (ce + 63) / 64, n = nrt * 16;
        const bf16* Bt = F.WdT() + ((size_t)l * NE + e) * D * FF;
        const float* bd = F.inp(I_BD) + ((size_t)l * NE + e) * D;
        int id = id0 + ((gw - id0 % NGW) + NGW) % NGW;
        for (; id < id0 + n; id += NGW) {
            const int rt = (id - id0) / 16, ct = (id - id0) % 16, pos0 = rt * 64, c0 = ct * 64;
            const bf16* A = F.HMOE() + ((size_t)ts256 * 256 + pos0) * FF;
            f32x16 acc[2][2];
            sg_kloop(acc, A + (size_t)r * FF + 8 * h, A + (size_t)(32 + r) * FF + 8 * h, Bt + (size_t)(c0 + r) * FF + 8 * h, Bt + (size_t)(c0 + 32 + r) * FF + 8 * h, FF);
#pragma unroll
            for (int mt = 0; mt < 2; ++mt)
#pragma unroll
                for (int q = 0; q < 16; ++q) {
                    const int pos = pos0 + 32 * mt + crow(q, h);
                    if (pos < ce) {
                        const int dst = F.list_dst()[(size_t)e * CAP + pos]; const float g = F.list_gate()[(size_t)e * CAP + pos];
#pragma unroll
                        for (int nt = 0; nt < 2; ++nt) { const int c = c0 + 32 * nt + r;
                            F.Y2()[(size_t)dst * D + c] = (bf16)f2bf(g * (acc[mt][nt][q] + bd[c])); }
                    }
                }
        }
        id0 += n; ts256 += (ce + 255) / 256;
    }
}

namespace pg8 {
constexpr int BM = 256, BK = 64, HALF = 128, HTB = HALF * BK * 2, STAGE_BYTES = 8 * HTB, NXCD = 8, WGM = 8;
__device__ __forceinline__ int lds_byte(int r, int c) { const int st = (r >> 4) * 2 + (c >> 5), rr = r & 15, cc = c & 31, ob = rr * 64 + cc * 2; return st * 1024 + (ob ^ (((ob >> 9) & 1) << 5)); }
__device__ __forceinline__ void stage_rc(int b, int& R, int& C) { const int st = b / 1024, sb = b % 1024, swz = sb ^ (((sb >> 9) & 1) << 5); R = (st >> 1) * 16 + swz / 64; C = (st & 1) * 32 + (swz % 64) / 2; }
__device__ __forceinline__ int perm32(int rho) { const int n = rho >> 4, i = rho & 15; return 8 * (i >> 2) + 4 * n + (i & 3); }
struct Unit { int pm, pn, e, pos0, ce; };
struct StaticOrder {
    int nM, nN, nwg, G, c;
    __device__ __forceinline__ void init(int M, int N, int G_, int c_) { nM = M / BM; nN = N / BM; nwg = nM * nN; G = G_; c = c_; }
    __device__ __forceinline__ bool next(int i, Unit& u) const {
        const long L = (long)i * G + c; if (L >= nwg) return false;
        int wgid = (int)L; { const int q = nwg / NXCD, r = nwg % NXCD, xcd = wgid % NXCD, off = wgid / NXCD; wgid = (xcd < r ? xcd * (q + 1) : r * (q + 1) + (xcd - r) * q) + off; }
        const int nig = WGM * nN, gid = wgid / nig, fm = gid * WGM, gsz = (nM - fm) < WGM ? (nM - fm) : WGM;
        u.pm = fm + ((wgid % nig) % gsz); u.pn = (wgid % nig) / gsz; u.e = 0; u.pos0 = 0; u.ce = 0; return true;
    }
};
__device__ __forceinline__ unsigned cvt_pk_bf16(float lo, float hi) { unsigned r; asm volatile("v_cvt_pk_bf16_f32 %0, %1, %2" : "=v"(r) : "v"(lo), "v"(hi)); return r; }
typedef f32x4 AccT[2][2][4][2];
template <class PB>
__device__ __forceinline__ void gemm_phase(LAS unsigned char* lds, const PB& pb, const int tid) {
    const int wid = __builtin_amdgcn_readfirstlane(tid >> 6), lane = tid & 63, wr = wid >> 2, wc = wid & 3, fr = lane & 15, fq = lane >> 4;
    constexpr int K = PB::K, nt = K / BK;
    unsigned voffB[2];
#pragma unroll
    for (int i = 0; i < 2; ++i) { int R, C; stage_rc(tid * 16 + i * 8192, R, C); const int Rb = PB::PERM ? ((R & ~31) + perm32(R & 31)) : R; voffB[i] = (unsigned)(Rb * K + C) * 2u; }
    constexpr size_t kstep = (size_t)(BK * 2);
    constexpr size_t hstep = (size_t)HALF * K * 2;
    const unsigned ldsw = (unsigned)wid * 1024u;
    const int aoff = lds_byte(wr * 64 + fr, fq * 8), boff = lds_byte(wc * 32 + fr, fq * 8);
#define PG8_SA(b, h) (((b) * 2 + (h)) * HTB)
#define PG8_SB(b, h) ((4 + (b) * 2 + (h)) * HTB)
#define PG8_STAGE(bufoff, gbase, voff) do { _Pragma("unroll") for (int _i = 0; _i < 2; ++_i) \
        __builtin_amdgcn_global_load_lds((const unsigned*)((const char*)(gbase) + (voff)[_i]), (LAS unsigned*)(lds + (bufoff) + ldsw + _i * 8192), 16, 0, 0); } while (0)
#define PG8_LDA(dst, b, h) do { _Pragma("unroll") for (int m = 0; m < 4; ++m) _Pragma("unroll") for (int k = 0; k < 2; ++k) dst[m][k] = *(const LAS bf16x8*)(lds + PG8_SA(b, h) + aoff + m * 2048 + k * 1024); } while (0)
#define PG8_LDB(dst, b, h) do { _Pragma("unroll") for (int n = 0; n < 2; ++n) _Pragma("unroll") for (int k = 0; k < 2; ++k) dst[n][k] = *(const LAS bf16x8*)(lds + PG8_SB(b, h) + boff + n * 2048 + k * 1024); } while (0)
#define PG8_MMA(ai, bj, At, Bt) do { __builtin_amdgcn_s_setprio(1); _Pragma("unroll") for (int m = 0; m < 4; ++m) _Pragma("unroll") for (int n = 0; n < 2; ++n) _Pragma("unroll") for (int k = 0; k < 2; ++k) \
        acc[ai][bj][m][n] = __builtin_amdgcn_mfma_f32_16x16x32_bf16(Bt[n][k], At[m][k], acc[ai][bj][m][n], 0, 0, 0); __builtin_amdgcn_s_setprio(0); } while (0)
#define PG8_WAIT_V(n) asm volatile("s_waitcnt vmcnt(" #n ")" ::: "memory")
#define PG8_WAIT_L(n) asm volatile("s_waitcnt lgkmcnt(" #n ")" ::: "memory")
#define PG8_BAR __builtin_amdgcn_s_barrier()
#define PG8_SCHED __builtin_amdgcn_sched_barrier(0)
    Unit cur, nxt; int ui = 0;
    if (!pb.next(0, cur)) return;
    f32x4 acc[2][2][4][2];
#pragma unroll
    for (int a = 0; a < 2; ++a)
#pragma unroll
        for (int b = 0; b < 2; ++b)
#pragma unroll
            for (int m = 0; m < 4; ++m)
#pragma unroll
                for (int n = 0; n < 2; ++n) acc[a][b][m][n] = (f32x4){0.f, 0.f, 0.f, 0.f};
    bf16x8 At[4][2], B0[2][2], B1[2][2];
    unsigned cv[2][2];
    pb.a_voff(cur, cv, tid);
    const char* cA = pb.a_base(cur); const char* cB = pb.b_base(cur);
    PG8_STAGE(PG8_SB(0, 0), cB, voffB); PG8_STAGE(PG8_SB(0, 1), cB + hstep, voffB); PG8_STAGE(PG8_SA(0, 0), cA, cv[0]); PG8_STAGE(PG8_SA(0, 1), cA, cv[1]);
    if (wr == 1) PG8_BAR;
    PG8_WAIT_V(2); PG8_BAR;
    PG8_STAGE(PG8_SB(1, 0), cB + kstep, voffB); PG8_STAGE(PG8_SA(1, 0), cA + kstep, cv[0]); PG8_STAGE(PG8_SB(1, 1), cB + hstep + kstep, voffB);
    PG8_WAIT_V(6); PG8_BAR;
    for (;;) {
        const bool has_next = pb.next(ui + 1, nxt);
        const char* nA = has_next ? pb.a_base(nxt) : cA; const char* nB = has_next ? pb.b_base(nxt) : cB;
        for (int t = 0; t < nt; t += 2) {
            const bool last = (t == nt - 2);
            const char* a1 = cA + (size_t)(t + 1) * kstep;
            const char* a2 = last ? nA : cA + (size_t)(t + 2) * kstep; const char* b2 = last ? nB : cB + (size_t)(t + 2) * kstep;
            const char* a3 = a2 + kstep; const char* b3 = b2 + kstep;
            if (PB::GATHER && t == nt - 4 && has_next) pb.tok_prefetch(nxt, lds, tid, wid);
            if (PB::GATHER && last && has_next) pb.a_voff_half_lds(cv[0], lds, tid, wid, 0);
            PG8_LDB(B0, 0, 0); PG8_LDB(B1, 0, 1); PG8_SCHED; PG8_LDA(At, 0, 0); PG8_STAGE(PG8_SA(1, 1), a1, cv[1]);
            if (PB::GATHER && last && has_next) pb.a_voff_half_lds(cv[1], lds, tid, wid, 1);
            PG8_WAIT_V(8); PG8_WAIT_L(0); PG8_BAR; PG8_MMA(0, 0, At, B0); PG8_MMA(0, 1, At, B1); PG8_BAR; PG8_SCHED;
            PG8_LDA(At, 0, 1); PG8_STAGE(PG8_SB(0, 0), b2, voffB); PG8_STAGE(PG8_SB(0, 1), b2 + hstep, voffB); PG8_STAGE(PG8_SA(0, 0), a2, cv[0]);
            PG8_WAIT_V(8); PG8_WAIT_L(0); PG8_BAR; PG8_MMA(1, 0, At, B0); PG8_MMA(1, 1, At, B1); PG8_BAR; PG8_SCHED;
            PG8_LDB(B0, 1, 0); PG8_LDB(B1, 1, 1); PG8_SCHED; PG8_LDA(At, 1, 0); PG8_STAGE(PG8_SA(0, 1), a2, cv[1]);
            PG8_WAIT_V(8); PG8_WAIT_L(0); PG8_BAR; PG8_MMA(0, 0, At, B0); PG8_MMA(0, 1, At, B1); PG8_BAR; PG8_SCHED;
            PG8_LDA(At, 1, 1); PG8_STAGE(PG8_SB(1, 0), b3, voffB); PG8_STAGE(PG8_SB(1, 1), b3 + hstep, voffB); PG8_STAGE(PG8_SA(1, 0), a3, cv[0]);
            PG8_WAIT_V(8); PG8_WAIT_L(0); PG8_BAR; PG8_MMA(1, 0, At, B0); PG8_MMA(1, 1, At, B1); PG8_BAR; PG8_SCHED;
        }
        if (wr == 0) PG8_BAR;
        pb.epi(acc, cur, wr, wc, fr, fq);
        if (!has_next) break;
#pragma unroll
        for (int a = 0; a < 2; ++a)
#pragma unroll
            for (int b = 0; b < 2; ++b)
#pragma unroll
                for (int m = 0; m < 4; ++m)
#pragma unroll
                    for (int n = 0; n < 2; ++n) acc[a][b][m][n] = (f32x4){0.f, 0.f, 0.f, 0.f};
        cur = nxt; cA = nA; cB = nB; ++ui;
        if (wr == 1) PG8_BAR;
    }
    PG8_WAIT_V(0);
    PG8_BAR;
#undef PG8_SA
#undef PG8_SB
#undef PG8_STAGE
#undef PG8_LDA
#undef PG8_LDB
#undef PG8_MMA
#undef PG8_WAIT_V
#undef PG8_WAIT_L
#undef PG8_BAR
#undef PG8_SCHED
}
typedef int v4i_t __attribute__((ext_vector_type(4)));
typedef int v8i_t __attribute__((ext_vector_type(8)));
template <class PB>
__device__ __forceinline__ void gemm_phase8(LAS unsigned char* lds, const PB& pb, const int tid) {
    const int wid = __builtin_amdgcn_readfirstlane(tid >> 6), lane = tid & 63, wr = wid >> 2, wc = wid & 3, fr = lane & 15, fq = lane >> 4;
    constexpr int K = PB::K  , nt = K / 128;
    unsigned vb0, va0;
    { int R, C; stage_rc(tid * 16, R, C); const int Rb = PB::PERM ? ((R & ~31) + perm32(R & 31)) : R; vb0 = (unsigned)(Rb * K + C * 2); va0 = (unsigned)(R * K + C * 2); }
    constexpr size_t kstep = (size_t)(BK * 2);
    constexpr size_t hstep = (size_t)HALF * K;
    const unsigned ldsw = (unsigned)wid * 1024u;
    const int aoff = lds_byte(wr * 64 + fr, fq * 8), boff = lds_byte(wc * 32 + fr, fq * 8);
#define PG8_SA(b, h) (((b) * 2 + (h)) * HTB)
#define PG8_SB(b, h) ((4 + (b) * 2 + (h)) * HTB)
#define PG8_STAGE_B(bufoff, gbase) do { _Pragma("unroll") for (int _i = 0; _i < 2; ++_i) \
        __builtin_amdgcn_global_load_lds((const unsigned*)((const char*)(gbase) + (size_t)(_i * 64) * K + vb0), (LAS unsigned*)(lds + (bufoff) + ldsw + _i * 8192), 16, 0, 0); } while (0)
#define PG8_STAGE_A(bufoff, gbase, h) do { _Pragma("unroll") for (int _i = 0; _i < 2; ++_i) { \
        const char* p_ = PB::GATHER ? (const char*)(gbase) + cv[h][_i] : (const char*)(gbase) + (size_t)((h) * 128 + _i * 64) * K + va0; \
        __builtin_amdgcn_global_load_lds((const unsigned*)p_, (LAS unsigned*)(lds + (bufoff) + ldsw + _i * 8192), 16, 0, 0); } } while (0)
#define PG8_LDA(dst, b, h) do { _Pragma("unroll") for (int m = 0; m < 4; ++m) { const v4i_t lo_ = *(const LAS v4i_t*)(lds + PG8_SA(b, h) + aoff + m * 2048), hi_ = *(const LAS v4i_t*)(lds + PG8_SA(b, h) + aoff + m * 2048 + 1024); dst[m] = __builtin_shufflevector(lo_, hi_, 0, 1, 2, 3, 4, 5, 6, 7); } } while (0)
#define PG8_LDB(dst, b, h) do { _Pragma("unroll") for (int n = 0; n < 2; ++n) { const v4i_t lo_ = *(const LAS v4i_t*)(lds + PG8_SB(b, h) + boff + n * 2048), hi_ = *(const LAS v4i_t*)(lds + PG8_SB(b, h) + boff + n * 2048 + 1024); dst[n] = __builtin_shufflevector(lo_, hi_, 0, 1, 2, 3, 4, 5, 6, 7); } } while (0)
#define PG8_MMA(ai, bj, At, Bt) do { __builtin_amdgcn_s_setprio(1); _Pragma("unroll") for (int m = 0; m < 4; ++m) _Pragma("unroll") for (int n = 0; n < 2; ++n) \
        asm volatile("v_mfma_scale_f32_16x16x128_f8f6f4 %0, %1, %2, %0, %3, %3 op_sel_hi:[0,0,0]" : "+v"(acc[ai][bj][m][n]) : "v"(Bt[n]), "v"(At[m]), "v"(sc1)); \
        __builtin_amdgcn_s_setprio(0); } while (0)
#define PG8_WAIT_V(n) asm volatile("s_waitcnt vmcnt(" #n ")" ::: "memory")
#define PG8_WAIT_L(n) asm volatile("s_waitcnt lgkmcnt(" #n ")" ::: "memory")
#define PG8_BAR __builtin_amdgcn_s_barrier()
#define PG8_SCHED __builtin_amdgcn_sched_barrier(0)
    Unit cur, nxt; int ui = 0;
    if (!pb.next(0, cur)) return;
    f32x4 acc[2][2][4][2];
#pragma unroll
    for (int a = 0; a < 2; ++a)
#pragma unroll
        for (int b = 0; b < 2; ++b)
#pragma unroll
            for (int m = 0; m < 4; ++m)
#pragma unroll
                for (int n = 0; n < 2; ++n) acc[a][b][m][n] = (f32x4){0.f, 0.f, 0.f, 0.f};
    v8i_t At[4], B0[2], B1[2];
    int sc1 = 0x7f7f7f7f; asm volatile("" : "+v"(sc1));
    unsigned cv[2][2];
    if (PB::GATHER) pb.a_voff(cur, cv, tid); else { cv[0][0] = cv[0][1] = cv[1][0] = cv[1][1] = 0u; }
    const char* cA = pb.a_base(cur); const char* cB = pb.b_base(cur);
    PG8_STAGE_B(PG8_SB(0, 0), cB); PG8_STAGE_B(PG8_SB(0, 1), cB + hstep); PG8_STAGE_A(PG8_SA(0, 0), cA, 0); PG8_STAGE_A(PG8_SA(0, 1), cA, 1);
    if (wr == 1) PG8_BAR;
    PG8_WAIT_V(2); PG8_BAR;
    PG8_STAGE_B(PG8_SB(1, 0), cB + kstep); PG8_STAGE_A(PG8_SA(1, 0), cA + kstep, 0); PG8_STAGE_B(PG8_SB(1, 1), cB + hstep + kstep);
    PG8_WAIT_V(6); PG8_BAR;
    for (;;) {
        const bool has_next = pb.next(ui + 1, nxt);
        const char* nA = has_next ? pb.a_base(nxt) : cA; const char* nB = has_next ? pb.b_base(nxt) : cB;
#pragma unroll 1
        for (int t = 0; t < nt; t += 2) {
            const bool last = (t == nt - 2);
            const char* a1 = cA + (size_t)(t + 1) * kstep;
            const char* a2 = last ? nA : cA + (size_t)(t + 2) * kstep; const char* b2 = last ? nB : cB + (size_t)(t + 2) * kstep;
            const char* a3 = a2 + kstep; const char* b3 = b2 + kstep;
            if (PB::GATHER && t == nt - 4 && has_next) pb.tok_prefetch(nxt, lds, tid, wid);
            if (PB::GATHER && last && has_next) pb.a_voff_half_lds(cv[0], lds, tid, wid, 0);
            PG8_LDB(B0, 0, 0); PG8_LDB(B1, 0, 1); PG8_SCHED; PG8_LDA(At, 0, 0); PG8_STAGE_A(PG8_SA(1, 1), a1, 1);
            if (PB::GATHER && last && has_next) pb.a_voff_half_lds(cv[1], lds, tid, wid, 1);
            PG8_WAIT_V(8); PG8_WAIT_L(0); PG8_BAR; PG8_MMA(0, 0, At, B0); PG8_MMA(0, 1, At, B1); PG8_BAR; PG8_SCHED;
            PG8_LDA(At, 0, 1); PG8_STAGE_B(PG8_SB(0, 0), b2); PG8_STAGE_B(PG8_SB(0, 1), b2 + hstep); PG8_STAGE_A(PG8_SA(0, 0), a2, 0);
            PG8_WAIT_V(8); PG8_WAIT_L(0); PG8_BAR; PG8_MMA(1, 0, At, B0); PG8_MMA(1, 1, At, B1); PG8_BAR; PG8_SCHED;
            PG8_LDB(B0, 1, 0); PG8_LDB(B1, 1, 1); PG8_SCHED; PG8_LDA(At, 1, 0); PG8_STAGE_A(PG8_SA(0, 1), a2, 1);
            PG8_WAIT_V(8); PG8_WAIT_L(0); PG8_BAR; PG8_MMA(0, 0, At, B0); PG8_MMA(0, 1, At, B1); PG8_BAR; PG8_SCHED;
            PG8_LDA(At, 1, 1); PG8_STAGE_B(PG8_SB(1, 0), b3); PG8_STAGE_B(PG8_SB(1, 1), b3 + hstep); PG8_STAGE_A(PG8_SA(1, 0), a3, 0);
            PG8_WAIT_V(8); PG8_WAIT_L(0); PG8_BAR; PG8_MMA(1, 0, At, B0); PG8_MMA(1, 1, At, B1); PG8_BAR; PG8_SCHED;
        }
        if (wr == 0) PG8_BAR;
        asm volatile("s_nop 15\n\ts_nop 15" ::: "memory");
        { int fr_ = fr, fq_ = fq; asm volatile("" : "+v"(fr_), "+v"(fq_));
          pb.epi(acc, cur, wr, wc, fr_, fq_); }
        if (!has_next) break;
#pragma unroll
        for (int a = 0; a < 2; ++a)
#pragma unroll
            for (int b = 0; b < 2; ++b)
#pragma unroll
                for (int m = 0; m < 4; ++m)
#pragma unroll
                    for (int n = 0; n < 2; ++n) acc[a][b][m][n] = (f32x4){0.f, 0.f, 0.f, 0.f};
        cur = nxt; cA = nA; cB = nB; ++ui;
        if (wr == 1) PG8_BAR;
    }
    PG8_WAIT_V(0);
    PG8_BAR;
#undef PG8_SA
#undef PG8_SB
#undef PG8_STAGE_A
#undef PG8_STAGE_B
#undef PG8_LDA
#undef PG8_LDB
#undef PG8_MMA
#undef PG8_WAIT_V
#undef PG8_WAIT_L
#undef PG8_BAR
#undef PG8_SCHED
}
__device__ __forceinline__ void voff_contig8(unsigned (&v)[2][2], int tid, int KB) {
#pragma unroll
    for (int i = 0; i < 2; ++i) { int R, C; stage_rc(tid * 16 + i * 8192, R, C); v[0][i] = (unsigned)(R * KB + C * 2); v[1][i] = (unsigned)((R + HALF) * KB + C * 2); }
}
__device__ __forceinline__ void voff_contig(unsigned (&v)[2][2], int tid, int K) {
#pragma unroll
    for (int i = 0; i < 2; ++i) { int R, C; stage_rc(tid * 16 + i * 8192, R, C); v[0][i] = (unsigned)(R * K + C) * 2u; v[1][i] = (unsigned)((R + HALF) * K + C) * 2u; }
}
}

struct PbInproj {
    static constexpr int K = D; static constexpr bool PERM = true, GATHER = false;
    const bf16* A; const bf16* Bt; bf16* P; bf16* Vt; const f32x2* rope; pg8::StaticOrder S;
    __device__ __forceinline__ bool next(int i, pg8::Unit& u) const { return S.next(i, u); }
    __device__ __forceinline__ const char* a_base(const pg8::Unit& u) const { return (const char*)A + (size_t)u.pm * 256 * K * 2; }
    __device__ __forceinline__ const char* b_base(const pg8::Unit& u) const { return (const char*)Bt + (size_t)u.pn * 256 * K * 2; }
    __device__ __forceinline__ void a_voff(const pg8::Unit&, unsigned (&v)[2][2], int tid) const { pg8::voff_contig(v, tid, K); }
    __device__ __forceinline__ void tok_prefetch(const pg8::Unit&, LAS unsigned char*, int, int) const {}
    __device__ __forceinline__ void a_voff_half_lds(unsigned (&)[2], LAS unsigned char*, int, int, int) const {}
    __device__ __forceinline__ void epi(const pg8::AccT& acc, const pg8::Unit& u, int wr, int wc, int fr, int fq) const {
        const int row0 = u.pm * 256 + wr * 64 + fr; const bool lat = row0 < ML;
#pragma unroll
        for (int ai = 0; ai < 2; ++ai)
#pragma unroll
            for (int m = 0; m < 4; ++m) {
                const int row = row0 + ai * 128 + m * 16; const int t = row & (SEQ - 1);
#pragma unroll
                for (int bj = 0; bj < 2; ++bj) {
                    const int c0 = u.pn * 256 + bj * 128 + wc * 32 + 8 * fq;
                    f32x4 v0 = acc[ai][bj][m][0], v1 = acc[ai][bj][m][1];
                    if (c0 < C_V) {
                        if (lat) {
                            const int pr0 = (c0 & 63) >> 1, p = pr0 >> 4, f0 = pr0 & 15, pos = p ? (t & 63) : (t >> 6);
                            const f32x4 ca = *(const f32x4*)(rope + pos * 16 + f0), cb = *(const f32x4*)(rope + pos * 16 + f0 + 2);
                            const f32x4 w0 = {v0.x * ca.x - v0.y * ca.y, v0.x * ca.y + v0.y * ca.x, v0.z * ca.z - v0.w * ca.w, v0.z * ca.w + v0.w * ca.z};
                            const f32x4 w1 = {v1.x * cb.x - v1.y * cb.y, v1.x * cb.y + v1.y * cb.x, v1.z * cb.z - v1.w * cb.w, v1.z * cb.w + v1.w * cb.z};
                            v0 = w0; v1 = w1;
                        }
                        if (c0 < C_K) { v0 *= QSCALE; v1 *= QSCALE; }
                    }
                    u32x4 w; w.x = pg8::cvt_pk_bf16(v0.x, v0.y); w.y = pg8::cvt_pk_bf16(v0.z, v0.w); w.z = pg8::cvt_pk_bf16(v1.x, v1.y); w.w = pg8::cvt_pk_bf16(v1.z, v1.w);
                    *(u32x4*)(P + (size_t)row * INW + c0) = w;
                    if (c0 >= C_V && c0 < C_LX) {
                        const size_t vi = vt_index(row, c0 - C_V); const size_t st = row < ML ? SEQ : CTXL;
                        Vt[vi] = (bf16)(w.x & 0xffffu); Vt[vi + st] = (bf16)(w.x >> 16); Vt[vi + 2 * st] = (bf16)(w.y & 0xffffu); Vt[vi + 3 * st] = (bf16)(w.y >> 16);
                        Vt[vi + 4 * st] = (bf16)(w.z & 0xffffu); Vt[vi + 5 * st] = (bf16)(w.z >> 16); Vt[vi + 6 * st] = (bf16)(w.w & 0xffffu); Vt[vi + 7 * st] = (bf16)(w.w >> 16);
                    }
                }
            }
    }
};
struct PbOutproj {
    static constexpr int K = D; static constexpr bool PERM = true, GATHER = false;
    const bf16* A; const bf16* Bt; bf16* TMP; const float* mods_l; pg8::StaticOrder S;
    __device__ __forceinline__ bool next(int i, pg8::Unit& u) const { return S.next(i, u); }
    __device__ __forceinline__ const char* a_base(const pg8::Unit& u) const { return (const char*)A + (size_t)u.pm * 256 * K * 2; }
    __device__ __forceinline__ const char* b_base(const pg8::Unit& u) const { return (const char*)Bt + (size_t)u.pn * 256 * K * 2; }
    __device__ __forceinline__ void a_voff(const pg8::Unit&, unsigned (&v)[2][2], int tid) const { pg8::voff_contig(v, tid, K); }
    __device__ __forceinline__ void tok_prefetch(const pg8::Unit&, LAS unsigned char*, int, int) const {}
    __device__ __forceinline__ void a_voff_half_lds(unsigned (&)[2], LAS unsigned char*, int, int, int) const {}
    __device__ __forceinline__ void epi(const pg8::AccT& acc, const pg8::Unit& u, int wr, int wc, int fr, int fq) const {
        const int row0 = u.pm * 256 + wr * 64 + fr;
        const float* g2 = mods_l + (size_t)mod_row(u.pm * 256) * 6 * D + 2 * D;
        f32x4 gv[2][2];
#pragma unroll
        for (int bj = 0; bj < 2; ++bj) { const int c0 = u.pn * 256 + bj * 128 + wc * 32 + 8 * fq; gv[bj][0] = *(const f32x4*)(g2 + c0); gv[bj][1] = *(const f32x4*)(g2 + c0 + 4); }
#pragma unroll
        for (int ai = 0; ai < 2; ++ai)
#pragma unroll
            for (int m = 0; m < 4; ++m) { bf16* rowp = TMP + (size_t)(row0 + ai * 128 + m * 16) * D;
#pragma unroll
                for (int bj = 0; bj < 2; ++bj) { const int c0 = u.pn * 256 + bj * 128 + wc * 32 + 8 * fq;
                    const f32x4 v0 = gv[bj][0] * acc[ai][bj][m][0], v1 = gv[bj][1] * acc[ai][bj][m][1];
                    u32x4 w; w.x = pg8::cvt_pk_bf16(v0.x, v0.y); w.y = pg8::cvt_pk_bf16(v0.z, v0.w); w.z = pg8::cvt_pk_bf16(v1.x, v1.y); w.w = pg8::cvt_pk_bf16(v1.z, v1.w);
                    *(u32x4*)(rowp + c0) = w; } }
    }
};
constexpr int TOK_LDS = 131072 + 4096;
constexpr int MOE_LDS = 131072;
__device__ __forceinline__ int moe_setup(Ctx& F, int l) {
    LAS int* cntL = (LAS int*)(F.lds + MOE_LDS); LAS int* tst = (LAS int*)(F.lds + MOE_LDS + 256); LAS unsigned short* te = (LAS unsigned short*)(F.lds + MOE_LDS + 512);
    const unsigned* cnt = (const unsigned*)(F.ctl() + CW_CNT + l * 64);
    __syncthreads();
    if (F.tid < NE) cntL[F.tid] = (int)__hip_atomic_load(cnt + F.tid, __ATOMIC_RELAXED, __HIP_MEMORY_SCOPE_AGENT);
    __syncthreads();
    if (F.tid == 0) { int s = 0; for (int e = 0; e < NE; ++e) { tst[e] = s; s += (cntL[e] + 255) >> 8; } tst[NE] = s; }
    __syncthreads();
    const int T = tst[NE];
    for (int i = F.tid; i < T; i += NTHR) { int e = 0; for (int q = 1; q < NE; ++q) e = (tst[q] <= i) ? q : e; te[i] = (unsigned short)e; }
    __syncthreads();
    return T;
}
struct MoeOrder {
    int t0, nun, rank, nper, npn; const LAS unsigned short* te; const LAS int* tst; const LAS int* cntl;
    __device__ __forceinline__ void init(const Ctx& F, int T, int npn_) {
        const int x = F.bid & 7; nper = F.G >> 3; rank = F.bid >> 3; npn = npn_;
        t0 = (x * T) >> 3; const int t1 = ((x + 1) * T) >> 3; nun = (t1 - t0) * npn;
        te = (const LAS unsigned short*)(F.lds + MOE_LDS + 512); tst = (const LAS int*)(F.lds + MOE_LDS + 256); cntl = (const LAS int*)(F.lds + MOE_LDS);
    }
    __device__ __forceinline__ bool next(int i, pg8::Unit& u) const {
        const int x = rank + i * nper; if (x >= nun) return false;
        const int rt = t0 + x / npn; u.pm = rt; u.pn = x % npn; u.e = __builtin_amdgcn_readfirstlane((int)te[rt]); u.pos0 = (rt - __builtin_amdgcn_readfirstlane(tst[u.e])) * 256; u.ce = __builtin_amdgcn_readfirstlane(cntl[u.e]); return true;
    }
};
struct PbGu {
    static constexpr int K = D; static constexpr bool PERM = true, GATHER = true;
    const bf16* A; const bf16* Bt_l; bf16* H; const float* bgu_l; const int* list_tok; MoeOrder S; const LAS int* cntL;
    __device__ __forceinline__ bool next(int i, pg8::Unit& u) const { return S.next(i, u); }
    __device__ __forceinline__ const char* a_base(const pg8::Unit&) const { return (const char*)A; }
    __device__ __forceinline__ const char* b_base(const pg8::Unit& u) const { return (const char*)Bt_l + ((size_t)u.e * 2 * FF + (size_t)u.pn * 256) * K * 2; }
    __device__ __forceinline__ void a_voff_half(const pg8::Unit& u, unsigned (&v)[2], int tid, int h) const {
        const int ce = u.ce;
#pragma unroll
        for (int i = 0; i < 2; ++i) { int R, C; pg8::stage_rc(tid * 16 + i * 8192, R, C);
            const int pos = u.pos0 + h * 128 + R; const int tok = pos < ce ? list_tok[(size_t)u.e * CAP + pos] : 0; v[i] = (unsigned)(tok * K + C) * 2u; }
    }
    __device__ __forceinline__ void a_voff(const pg8::Unit& u, unsigned (&v)[2][2], int tid) const { a_voff_half(u, v[0], tid, 0); a_voff_half(u, v[1], tid, 1); }
    __device__ __forceinline__ void tok_prefetch(const pg8::Unit& u, LAS unsigned char* lds, int tid, int wid) const {
        const int ce = u.ce;
#pragma unroll
        for (int h = 0; h < 2; ++h)
#pragma unroll
            for (int i = 0; i < 2; ++i) { int R, C; pg8::stage_rc(tid * 16 + i * 8192, R, C);
                const int pos = u.pos0 + h * 128 + R; const int* src = list_tok + (size_t)u.e * CAP + (pos < ce ? pos : 0);
                __builtin_amdgcn_global_load_lds((const unsigned*)src, (LAS unsigned*)(lds + TOK_LDS + ((h * 2 + i) * 8 + wid) * 256), 4, 0, 0); }
    }
    __device__ __forceinline__ void a_voff_half_lds(unsigned (&v)[2], LAS unsigned char* lds, int tid, int wid, int h) const {
#pragma unroll
        for (int i = 0; i < 2; ++i) { int R, C; pg8::stage_rc(tid * 16 + i * 8192, R, C);
            const int tok = *(const LAS int*)(lds + TOK_LDS + ((h * 2 + i) * 8 + wid) * 256 + (tid & 63) * 4); v[i] = (unsigned)(tok * K + C) * 2u; }
    }
    __device__ __forceinline__ void epi(const pg8::AccT& acc, const pg8::Unit& u, int wr, int wc, int fr, int fq) const {
        const int row0 = u.pm * 256 + wr * 64 + fr, ff0 = u.pn * 128 + wc * 32 + 8 * fq;
        const float* bg = bgu_l + (size_t)u.e * 2 * FF;
        const f32x4 bg0 = *(const f32x4*)(bg + ff0), bg1 = *(const f32x4*)(bg + ff0 + 4), bu0 = *(const f32x4*)(bg + FF + ff0), bu1 = *(const f32x4*)(bg + FF + ff0 + 4);
#pragma unroll
        for (int ai = 0; ai < 2; ++ai)
#pragma unroll
            for (int m = 0; m < 4; ++m) {
                float o[8];
#pragma unroll
                for (int n = 0; n < 2; ++n) { const f32x4 g = acc[ai][0][m][n] + (n ? bg1 : bg0), up = acc[ai][1][m][n] + (n ? bu1 : bu0);
#pragma unroll
                    for (int j = 0; j < 4; ++j) { const float gate = fminf(g[j], 7.0f), upc = fminf(fmaxf(up[j], -7.0f), 7.0f); o[4 * n + j] = (upc + 1.0f) * gate * sigmoidf_(1.702f * gate); } }
                u32x4 w; w.x = pg8::cvt_pk_bf16(o[0], o[1]); w.y = pg8::cvt_pk_bf16(o[2], o[3]); w.z = pg8::cvt_pk_bf16(o[4], o[5]); w.w = pg8::cvt_pk_bf16(o[6], o[7]);
                *(u32x4*)(H + (size_t)(row0 + ai * 128 + m * 16) * FF + ff0) = w;
            }
    }
};
struct PbDown {
    static constexpr int K = FF; static constexpr bool PERM = true, GATHER = false;
    const bf16* A; const bf16* Bt_l; bf16* Y2; const float* bd_l; const int* list_dst; const float* list_gate; MoeOrder S; const LAS int* cntL;
    __device__ __forceinline__ bool next(int i, pg8::Unit& u) const { return S.next(i, u); }
    __device__ __forceinline__ const char* a_base(const pg8::Unit& u) const { return (const char*)A + (size_t)u.pm * 256 * K * 2; }
    __device__ __forceinline__ const char* b_base(const pg8::Unit& u) const { return (const char*)Bt_l + ((size_t)u.e * D + (size_t)u.pn * 256) * K * 2; }
    __device__ __forceinline__ void a_voff(const pg8::Unit&, unsigned (&v)[2][2], int tid) const { pg8::voff_contig(v, tid, K); }
    __device__ __forceinline__ void tok_prefetch(const pg8::Unit&, LAS unsigned char*, int, int) const {}
    __device__ __forceinline__ void a_voff_half_lds(unsigned (&)[2], LAS unsigned char*, int, int, int) const {}
    __device__ __forceinline__ void epi(const pg8::AccT& acc, const pg8::Unit& u, int wr, int wc, int fr, int fq) const {
        const int ce = u.ce; const int p0 = u.pos0 + wr * 64 + fr; const float* bd = bd_l + (size_t)u.e * D;
        int dsts[2][4]; float gs[2][4];
#pragma unroll
        for (int ai = 0; ai < 2; ++ai)
#pragma unroll
            for (int m = 0; m < 4; ++m) { const int pos = p0 + ai * 128 + m * 16; const size_t ix = (size_t)u.e * CAP + (pos < ce ? pos : 0); dsts[ai][m] = list_dst[ix]; gs[ai][m] = list_gate[ix]; }
        f32x4 bb[2][2];
#pragma unroll
        for (int bj = 0; bj < 2; ++bj) { const int c0 = u.pn * 256 + bj * 128 + wc * 32 + 8 * fq; bb[bj][0] = *(const f32x4*)(bd + c0); bb[bj][1] = *(const f32x4*)(bd + c0 + 4); }
#pragma unroll
        for (int ai = 0; ai < 2; ++ai)
#pragma unroll
            for (int m = 0; m < 4; ++m) {
                const int pos = p0 + ai * 128 + m * 16;
                {
                    const float g = gs[ai][m]; const size_t drow = pos < ce ? (size_t)dsts[ai][m] : (size_t)(Y2_DUMMY_ROW + (pos & 255));
#pragma unroll
                    for (int bj = 0; bj < 2; ++bj) { const int c0 = u.pn * 256 + bj * 128 + wc * 32 + 8 * fq;
                        const f32x4 v0 = (acc[ai][bj][m][0] + bb[bj][0]) * g, v1 = (acc[ai][bj][m][1] + bb[bj][1]) * g;
                        u32x4 w; w.x = pg8::cvt_pk_bf16(v0.x, v0.y); w.y = pg8::cvt_pk_bf16(v0.z, v0.w); w.z = pg8::cvt_pk_bf16(v1.x, v1.y); w.w = pg8::cvt_pk_bf16(v1.z, v1.w);
                        *(u32x4*)(Y2 + drow * D + c0) = w; }
                }
            }
    }
};
struct PbGu8 {
    static constexpr int K = D; static constexpr bool PERM = true, GATHER = true;
    const unsigned char* A; const unsigned char* Bt_l; unsigned char* H; const float* bgu_l; const int* list_tok; MoeOrder S; const LAS int* cntL;
    __device__ __forceinline__ bool next(int i, pg8::Unit& u) const { return S.next(i, u); }
    __device__ __forceinline__ const char* a_base(const pg8::Unit&) const { return (const char*)A; }
    __device__ __forceinline__ const char* b_base(const pg8::Unit& u) const { return (const char*)Bt_l + ((size_t)u.e * 2 * FF + (size_t)u.pn * 256) * K; }
    __device__ __forceinline__ void a_voff_half(const pg8::Unit& u, unsigned (&v)[2], int tid, int h) const {
        const int ce = u.ce;
#pragma unroll
        for (int i = 0; i < 2; ++i) { int R, C; pg8::stage_rc(tid * 16 + i * 8192, R, C);
            const int pos = u.pos0 + h * 128 + R; const int tok = pos < ce ? list_tok[(size_t)u.e * CAP + pos] : 0; v[i] = (unsigned)(tok * K + C * 2); }
    }
    __device__ __forceinline__ void a_voff(const pg8::Unit& u, unsigned (&v)[2][2], int tid) const { a_voff_half(u, v[0], tid, 0); a_voff_half(u, v[1], tid, 1); }
    __device__ __forceinline__ void tok_prefetch(const pg8::Unit& u, LAS unsigned char* lds, int tid, int wid) const {
        const int ce = u.ce;
#pragma unroll
        for (int h = 0; h < 2; ++h)
#pragma unroll
            for (int i = 0; i < 2; ++i) { int R, C; pg8::stage_rc(tid * 16 + i * 8192, R, C);
                const int pos = u.pos0 + h * 128 + R; const int* src = list_tok + (size_t)u.e * CAP + (pos < ce ? pos : 0);
                __builtin_amdgcn_global_load_lds((const unsigned*)src, (LAS unsigned*)(lds + TOK_LDS + ((h * 2 + i) * 8 + wid) * 256), 4, 0, 0); }
    }
    __device__ __forceinline__ void a_voff_half_lds(unsigned (&v)[2], LAS unsigned char* lds, int tid, int wid, int h) const {
#pragma unroll
        for (int i = 0; i < 2; ++i) { int R, C; pg8::stage_rc(tid * 16 + i * 8192, R, C);
            const int tok = *(const LAS int*)(lds + TOK_LDS + ((h * 2 + i) * 8 + wid) * 256 + (tid & 63) * 4); v[i] = (unsigned)(tok * K + C * 2); }
    }
    __device__ __forceinline__ void epi(const pg8::AccT& acc, const pg8::Unit& u, int wr, int wc, int fr, int fq) const {
        const int row0 = u.pm * 256 + wr * 64 + fr, ff0 = u.pn * 128 + wc * 32 + 8 * fq;
        const float* bg = bgu_l + (size_t)u.e * 2 * FF;
        const f32x4 bg0 = *(const f32x4*)(bg + ff0), bg1 = *(const f32x4*)(bg + ff0 + 4), bu0 = *(const f32x4*)(bg + FF + ff0), bu1 = *(const f32x4*)(bg + FF + ff0 + 4);
#pragma unroll
        for (int ai = 0; ai < 2; ++ai)
#pragma unroll
            for (int m = 0; m < 4; ++m) {
                float o[8];
#pragma unroll
                for (int n = 0; n < 2; ++n) { const f32x4 g = acc[ai][0][m][n] * (1.0f / W8_SCALE) + (n ? bg1 : bg0), up = acc[ai][1][m][n] * (1.0f / W8_SCALE) + (n ? bu1 : bu0);
#pragma unroll
                    for (int j = 0; j < 4; ++j) { const float gate = fminf(g[j], 7.0f), upc = fminf(fmaxf(up[j], -7.0f), 7.0f); o[4 * n + j] = (upc + 1.0f) * gate * sigmoidf_(1.702f * gate); } }
                u32x2 w; w.x = pk_fp8x4(o[0], o[1], o[2], o[3]); w.y = pk_fp8x4(o[4], o[5], o[6], o[7]);
                *(u32x2*)(H + (size_t)(row0 + ai * 128 + m * 16) * FF + ff0) = w;
            }
    }
};
struct PbDown8 {
    static constexpr int K = FF; static constexpr bool PERM = true, GATHER = false;
    const unsigned char* A; const unsigned char* Bt_l; bf16* Y2; const float* bd_l; const int* list_dst; const float* list_gate; MoeOrder S; const LAS int* cntL;
    __device__ __forceinline__ bool next(int i, pg8::Unit& u) const { return S.next(i, u); }
    __device__ __forceinline__ const char* a_base(const pg8::Unit& u) const { return (const char*)A + (size_t)u.pm * 256 * K; }
    __device__ __forceinline__ const char* b_base(const pg8::Unit& u) const { return (const char*)Bt_l + ((size_t)u.e * D + (size_t)u.pn * 256) * K; }
    __device__ __forceinline__ void a_voff(const pg8::Unit&, unsigned (&v)[2][2], int tid) const { pg8::voff_contig8(v, tid, K); }
    __device__ __forceinline__ void tok_prefetch(const pg8::Unit&, LAS unsigned char*, int, int) const {}
    __device__ __forceinline__ void a_voff_half_lds(unsigned (&)[2], LAS unsigned char*, int, int, int) const {}
    __device__ __forceinline__ void epi(const pg8::AccT& acc, const pg8::Unit& u, int wr, int wc, int fr, int fq) const {
        const int ce = u.ce; const int p0 = u.pos0 + wr * 64 + fr; const float* bd = bd_l + (size_t)u.e * D;
        int dsts[2][4]; float gs[2][4];
#pragma unroll
        for (int ai = 0; ai < 2; ++ai)
#pragma unroll
            for (int m = 0; m < 4; ++m) { const int pos = p0 + ai * 128 + m * 16; const size_t ix = (size_t)u.e * CAP + (pos < ce ? pos : 0); dsts[ai][m] = list_dst[ix]; gs[ai][m] = list_gate[ix]; }
        f32x4 bb[2][2];
#pragma unroll
        for (int bj = 0; bj < 2; ++bj) { const int c0 = u.pn * 256 + bj * 128 + wc * 32 + 8 * fq; bb[bj][0] = *(const f32x4*)(bd + c0); bb[bj][1] = *(const f32x4*)(bd + c0 + 4); }
#pragma unroll
        for (int ai = 0; ai < 2; ++ai)
#pragma unroll
            for (int m = 0; m < 4; ++m) {
                const int pos = p0 + ai * 128 + m * 16;
                {
                    const float g = gs[ai][m]; const size_t drow = pos < ce ? (size_t)dsts[ai][m] : (size_t)(Y2_DUMMY_ROW + (pos & 255));
#pragma unroll
                    for (int bj = 0; bj < 2; ++bj) { const int c0 = u.pn * 256 + bj * 128 + wc * 32 + 8 * fq;
                        const f32x4 v0 = (acc[ai][bj][m][0] * (1.0f / W8_SCALE) + bb[bj][0]) * g, v1 = (acc[ai][bj][m][1] * (1.0f / W8_SCALE) + bb[bj][1]) * g;
                        if (Y2_FP8) { u32x2 w; w.x = pk_fp8x4(v0.x * Y2_SCALE, v0.y * Y2_SCALE, v0.z * Y2_SCALE, v0.w * Y2_SCALE); w.y = pk_fp8x4(v1.x * Y2_SCALE, v1.y * Y2_SCALE, v1.z * Y2_SCALE, v1.w * Y2_SCALE);
                            *(u32x2*)((unsigned char*)Y2 + drow * D + c0) = w; }
                        else { u32x4 w; w.x = pg8::cvt_pk_bf16(v0.x, v0.y); w.y = pg8::cvt_pk_bf16(v0.z, v0.w); w.z = pg8::cvt_pk_bf16(v1.x, v1.y); w.w = pg8::cvt_pk_bf16(v1.z, v1.w);
                            *(u32x4*)(Y2 + drow * D + c0) = w; } }
                }
            }
    }
};
__device__ __forceinline__ void ph_inproj_fast(Ctx& F, int l) {
    PbInproj pb; pb.A = F.H1(); pb.Bt = F.WinT() + (size_t)l * INW * D; pb.P = F.P(); pb.Vt = F.Vt(); pb.rope = F.rope(); pb.S.init(MA, INW, F.G, F.bid);
    pg8::gemm_phase(F.lds, pb, F.tid);
}
__device__ __forceinline__ void ph_outproj_fast(Ctx& F, int l) {
    PbOutproj pb; pb.A = F.MIX(); pb.Bt = F.WoutT() + (size_t)l * D * D; pb.TMP = F.P(); pb.mods_l = F.mods() + (size_t)l * 3 * 6 * D; pb.S.init(l == 0 ? MA : ML, D, F.G, F.bid);
    pg8::gemm_phase(F.lds, pb, F.tid);
}
__device__ __forceinline__ void ph_moe_gu_fast(Ctx& F, int l) {
    const int T = moe_setup(F, l);
    if (MOE_FP8) {
        PbGu8 pb; pb.A = (const unsigned char*)F.H1(); pb.Bt_l = (const unsigned char*)F.WguT() + (size_t)l * NE * 2 * FF * D; pb.H = (unsigned char*)F.HMOE(); pb.bgu_l = F.inp(I_BGU) + (size_t)l * NE * 2 * FF; pb.list_tok = F.list_tok();
        pb.S.init(F, T, 8); pb.cntL = (const LAS int*)(F.lds + MOE_LDS);
        pg8::gemm_phase8(F.lds, pb, F.tid);
    } else {
        PbGu pb; pb.A = F.H1(); pb.Bt_l = F.WguT() + (size_t)l * NE * 2 * FF * D; pb.H = F.HMOE(); pb.bgu_l = F.inp(I_BGU) + (size_t)l * NE * 2 * FF; pb.list_tok = F.list_tok();
        pb.S.init(F, T, 8); pb.cntL = (const LAS int*)(F.lds + MOE_LDS);
        pg8::gemm_phase(F.lds, pb, F.tid);
    }
}
__device__ __forceinline__ void ph_moe_down_fast(Ctx& F, int l) {
    const int T = moe_setup(F, l);
    if (MOE_FP8) {
        PbDown8 pb; pb.A = (const unsigned char*)F.HMOE(); pb.Bt_l = (const unsigned char*)F.WdT() + (size_t)l * NE * D * FF; pb.Y2 = F.Y2(); pb.bd_l = F.inp(I_BD) + (size_t)l * NE * D; pb.list_dst = F.list_dst(); pb.list_gate = F.list_gate();
        pb.S.init(F, T, 4); pb.cntL = (const LAS int*)(F.lds + MOE_LDS);
        pg8::gemm_phase8(F.lds, pb, F.tid);
    } else {
        PbDown pb; pb.A = F.HMOE(); pb.Bt_l = F.WdT() + (size_t)l * NE * D * FF; pb.Y2 = F.Y2(); pb.bd_l = F.inp(I_BD) + (size_t)l * NE * D; pb.list_dst = F.list_dst(); pb.list_gate = F.list_gate();
        pb.S.init(F, T, 4); pb.cntL = (const LAS int*)(F.lds + MOE_LDS);
        pg8::gemm_phase(F.lds, pb, F.tid);
    }
}

#define XB_TMO      128
#define XB_XCNT(j)  (256  + 64 * (j))
#define XB_XSUB(j)  (1280 + 64 * (j))
#define XB_XGEN(j)  (2304 + 64 * (j))
#define XB_TOP      3328
#define XB_TOPGEN   3392
#define XCD_BAR_WORDS 3456
#define XB_SPIN_CAP (1u << 22)
__device__ __forceinline__ unsigned xb_ld(unsigned* p)              { return __hip_atomic_load(p, __ATOMIC_RELAXED, __HIP_MEMORY_SCOPE_AGENT); }
__device__ __forceinline__ unsigned xb_add(unsigned* p, unsigned v) { return __hip_atomic_fetch_add(p, v, __ATOMIC_RELAXED, __HIP_MEMORY_SCOPE_AGENT); }
__device__ __forceinline__ unsigned xb_xcc_id() { return (unsigned)__builtin_amdgcn_s_getreg((3 << 11) | 20) & 0xFu; }
#define XB_SPIN(cond, bar) do { unsigned _sp = 0; while (cond) { __builtin_amdgcn_s_sleep(1); \
    if ((++_sp & 255u) == 0u) { if (xb_ld(&(bar)[XB_TMO])) break; if (_sp > XB_SPIN_CAP) { atomicAdd(&(bar)[XB_TMO], 1u); break; } } } } while (0)
struct XcdBarrier { unsigned* bar; unsigned x; volatile LAS unsigned* st; };
__device__ __forceinline__ XcdBarrier xcd_barrier_post(unsigned* bar, volatile LAS unsigned* st) {
    XcdBarrier b; b.bar = bar; b.x = xb_xcc_id(); b.st = st;
    if (threadIdx.x == 0) (void)xb_add(&bar[XB_XCNT(b.x)], 1u);
    return b;
}
__device__ __forceinline__ void xcd_barrier_complete(unsigned* bar, unsigned x, unsigned& nloc, unsigned& nx) {
    const unsigned G = gridDim.x * gridDim.y * gridDim.z;
    unsigned sum, cnt, mine, sp = 0u;
    for (;;) {
        sum = 0u; cnt = 0u; mine = 0u;
#pragma unroll
        for (unsigned j = 0; j < 16; ++j) { const unsigned c = xb_ld(&bar[XB_XCNT(j)]); sum += c; cnt += (c > 0u) ? 1u : 0u; mine = (j == x) ? c : mine; }
        if (sum == G) break;
        __builtin_amdgcn_s_sleep(1);
        if ((++sp & 255u) == 0u) { if (xb_ld(&bar[XB_TMO])) break; if (sp > XB_SPIN_CAP) { atomicAdd(&bar[XB_TMO], 1u); break; } }
    }
    nloc = mine > 0u ? mine : 1u; nx = cnt > 0u ? cnt : 1u;
}
__device__ __forceinline__ void xcd_barrier(const XcdBarrier& b0) {
    asm volatile("s_waitcnt vmcnt(0)" ::: "memory");
    __syncthreads();
    XcdBarrier b = b0;
    { unsigned long long p = (unsigned long long)b0.bar; unsigned xx = b0.x; asm volatile("" : "+s"(p), "+s"(xx)); b.bar = (unsigned*)p; b.x = xx; }
    if (threadIdx.x == 0) {
        unsigned* bar = b.bar;
        __builtin_amdgcn_s_waitcnt(0);
        unsigned nloc = b.st[0], nx = b.st[1];
        if (nloc == 0u) { xcd_barrier_complete(bar, b.x, nloc, nx); b.st[0] = nloc; b.st[1] = nx; }
        const unsigned old = xb_add(&bar[XB_XSUB(b.x)], 1u);
        const unsigned gen = old / nloc;
        if (old + 1u == (gen + 1u) * nloc) {
            __builtin_amdgcn_fence(__ATOMIC_RELEASE, "agent");
            asm volatile("s_waitcnt vmcnt(0)" ::: "memory");
            const unsigned og = xb_add(&bar[XB_TOP], 1u);
            const unsigned tg = og / nx;
            if (og + 1u == (tg + 1u) * nx) xb_add(&bar[XB_TOPGEN], 1u);
            else XB_SPIN(xb_ld(&bar[XB_TOPGEN]) == tg, bar);
            __builtin_amdgcn_fence(__ATOMIC_ACQUIRE, "agent");
            xb_add(&bar[XB_XGEN(b.x)], 1u);
            asm volatile("s_waitcnt vmcnt(0)" ::: "memory");
        } else {
            XB_SPIN(xb_ld(&bar[XB_XGEN(b.x)]) == gen, bar);
            __builtin_amdgcn_fence(__ATOMIC_ACQUIRE, "agent");
            asm volatile("s_waitcnt vmcnt(0)" ::: "memory");
        }
    }
    __syncthreads();
}

__device__ __forceinline__ void convert_item(Ctx& F, int l, int wi) {
    LAS float* scr = (LAS float*)(F.lds + F.wave * 8704);
    if (MOE_FP8) {
        if (wi < CV_GU) { const int le = l * NE + (wi >> 10); tr_item8<2>(F.inp(I_WGU) + (size_t)le * D * 2 * FF, D, 2 * FF, (unsigned char*)F.WguT() + (size_t)le * 2 * FF * D, scr, wi & 1023, F.lane); }
        else { const int r = wi - CV_GU; const int le = l * NE + (r >> 9); tr_item8<0>(F.inp(I_WD) + (size_t)le * FF * D, FF, D, (unsigned char*)F.WdT() + (size_t)le * D * FF, scr, r & 511, F.lane); }
        return;
    }
    if (wi < CV_GU) { const int le = l * NE + (wi >> 10); tr_item<2>(F.inp(I_WGU) + (size_t)le * D * 2 * FF, D, 2 * FF, F.WguT() + (size_t)le * 2 * FF * D, scr, wi & 1023, F.lane); }
    else { const int r = wi - CV_GU; const int le = l * NE + (r >> 9); tr_item<0>(F.inp(I_WD) + (size_t)le * FF * D, FF, D, F.WdT() + (size_t)le * D * FF, scr, r & 511, F.lane); }
}
__device__ __forceinline__ bool convert_next(Ctx& F, volatile LAS unsigned* prog, int pmax) {
    const int p = (int)prog[F.wave];
    if (p >= pmax) return false;
    convert_item(F, p / CV_PER_WAVE, (F.bid * NWAVES + F.wave) + 2048 * (p % CV_PER_WAVE));
    if (F.lane == 0) prog[F.wave] = (unsigned)(p + 1);
    return true;
}
__device__ __forceinline__ void drain_convert(Ctx& F, int l, volatile LAS unsigned* prog) {
    while (convert_next(F, prog, CV_PER_WAVE * (l + 1))) {}
}
__device__ __forceinline__ void xcd_barrier_steal(const XcdBarrier& b0, Ctx& F, volatile LAS unsigned* fl, volatile LAS unsigned* prog) {
    asm volatile("s_waitcnt vmcnt(0)" ::: "memory");
    __syncthreads();
    XcdBarrier b = b0;
    { unsigned long long p = (unsigned long long)b0.bar; unsigned xx = b0.x; asm volatile("" : "+s"(p), "+s"(xx)); b.bar = (unsigned*)p; b.x = xx; }
    unsigned* bar = b.bar;
    if (threadIdx.x == 0) {
        __builtin_amdgcn_s_waitcnt(0);
        unsigned nloc = b.st[0], nx = b.st[1];
        if (nloc == 0u) { xcd_barrier_complete(bar, b.x, nloc, nx); b.st[0] = nloc; b.st[1] = nx; }
        const unsigned old = xb_add(&bar[XB_XSUB(b.x)], 1u);
        const unsigned gen = old / nloc;
        if (old + 1u == (gen + 1u) * nloc) {
            __builtin_amdgcn_fence(__ATOMIC_RELEASE, "agent");
            asm volatile("s_waitcnt vmcnt(0)" ::: "memory");
            const unsigned og = xb_add(&bar[XB_TOP], 1u);
            const unsigned tg = og / nx;
            if (og + 1u == (tg + 1u) * nx) xb_add(&bar[XB_TOPGEN], 1u);
            else XB_SPIN(xb_ld(&bar[XB_TOPGEN]) == tg, bar);
            __builtin_amdgcn_fence(__ATOMIC_ACQUIRE, "agent");
            xb_add(&bar[XB_XGEN(b.x)], 1u);
            asm volatile("s_waitcnt vmcnt(0)" ::: "memory");
            fl[0] = 1u;
        } else { fl[0] = 0u; fl[1] = gen; }
    }
    __syncthreads();
    if (fl[0] == 0u) {
        const unsigned gen = fl[1];
        unsigned sp = 0u;
        for (;;) {
            unsigned rel = 0u;
            if (F.lane == 0) { rel = (xb_ld(&bar[XB_XGEN(b.x)]) != gen) ? 1u : 0u;
                if (!rel && (++sp & 63u) == 0u) { if (xb_ld(&bar[XB_TMO])) rel = 1u; else if (sp > XB_SPIN_CAP) { atomicAdd(&bar[XB_TMO], 1u); rel = 1u; } } }
            rel = (unsigned)__builtin_amdgcn_readfirstlane((int)rel);
            if (rel) break;
            if (!convert_next(F, prog, CV_PER_WAVE * NL)) __builtin_amdgcn_s_sleep(2);
        }
        asm volatile("s_waitcnt vmcnt(0)" ::: "memory");
        __syncthreads();
        if (threadIdx.x == 0) { __builtin_amdgcn_fence(__ATOMIC_ACQUIRE, "agent"); asm volatile("s_waitcnt vmcnt(0)" ::: "memory"); }
    }
    __syncthreads();
}

constexpr int LDS_BYTES = 147456;
constexpr int MISC_OFF = 147456 - 256;

__global__ void __launch_bounds__(NTHR, 2) fwd(Args args) {
    extern __shared__ __attribute__((aligned(16))) unsigned char lds[];
    Ctx F0;
    F0.lds = (LAS unsigned char*)lds;
    F0.tid = threadIdx.x; F0.lane = F0.tid & 63; F0.wave = __builtin_amdgcn_readfirstlane(F0.tid >> 6); F0.G = gridDim.x; F0.bid = blockIdx.x;
    F0.in = args.in; F0.out = args.out; F0.ws = args.ws;
    volatile LAS unsigned* MISC = (volatile LAS unsigned*)(F0.lds + MISC_OFF);
    if (F0.tid < 64) MISC[F0.tid] = 0u;
    __syncthreads();
    XcdBarrier bar; bar.bar = (unsigned*)(F0.ctl() + CW_BAR); bar.x = 0; bar.st = nullptr;
    if (MK_N_LAUNCHES == 1) bar = xcd_barrier_post((unsigned*)(F0.ctl() + CW_BAR), MISC + 8);
    const int lo = args.ph_lo, hi = args.ph_hi;
#define IN(k) (lo <= (k) && (k) < hi)
#define SEAM(k) do { if (IN(k) && IN((k) + 1)) { Ctx F = fresh(F0); xcd_barrier_steal(bar, F, MISC + 16, MISC + 24); } } while (0)
#define SEAM_S(k) SEAM(k)
#define PH(k, ...) do { if (IN(k)) { Ctx F = fresh(F0); __VA_ARGS__; } } while (0)

    PH(0, REPEAT(REP_PRO, ph_prologue(F))); SEAM(0);
    for (int l = 0; l < NL; ++l) {
        const int pb = 1 + 9 * l;
        PH(pb + 0, ph_norm1(F, l); if (REP_N10 > 1 && l == 0) ph_norm1(F, l)); SEAM(pb + 0);
        PH(pb + 1, REPEAT(REP_INP, if (FAST_GEMM) ph_inproj_fast(F, l); else ph_inproj_naive(F, l))); SEAM_S(pb + 1);
        if (FAST_ATTN) PH(pb + 2, REPEAT(REP_ATT, ph_attn_fast(F, l))); else PH(pb + 2, ph_attn_naive(F, l));
        if (FAST_LRU) PH(pb + 2, REPEAT(REP_LA, ph_lru_fast<false>(F, l))); else PH(pb + 2, ph_lru_gates_naive(F, l));
        if (FAST_HG) PH(pb + 2, REPEAT(REP_HA, ph_hgrn_fast<false>(F, l)));
        SEAM(pb + 2);
        if (FAST_LRU) PH(pb + 3, REPEAT(REP_CAR, ph_lru_carry(F))); else PH(pb + 3, ph_lru_scan_naive(F));
        if (FAST_HG) PH(pb + 3, REPEAT(REP_CAR, ph_hgrn_carry(F))); else PH(pb + 3, ph_hgrn_scan_naive(F, l));
        SEAM_S(pb + 3);
        if (FAST_LRU) PH(pb + 4, REPEAT(REP_LC, ph_lru_fast<true>(F, l))); else PH(pb + 4, ph_lru_out_naive(F, l));
        if (FAST_HG) PH(pb + 4, REPEAT(REP_HC, ph_hgrn_fast<true>(F, l))); else PH(pb + 4, ph_hgrn_out_naive(F, l));
        SEAM(pb + 4);
        PH(pb + 5, if (FAST_GEMM) ph_outproj_fast(F, l); else ph_outproj_naive(F, l); if (REP_OP0 > 1) ph_outproj_fast(F, l)); SEAM_S(pb + 5);
        PH(pb + 6, ph_norm2_router(F, l); __syncthreads(); drain_convert(F, l, MISC + 24)); SEAM(pb + 6);
        PH(pb + 7, REPEAT(REP_GU, if (FAST_GEMM) ph_moe_gu_fast(F, l); else ph_moe_gu_naive(F, l))); SEAM_S(pb + 7);
        PH(pb + 8, REPEAT(REP_DN, if (FAST_GEMM) ph_moe_down_fast(F, l); else ph_moe_down_naive(F, l))); SEAM_S(pb + 8);
    }
    PH(19, REPEAT(REP_FIN, ph_norm1(F, 2)));
#undef PH
#undef IN
#undef SEAM_S
#undef SEAM
}

extern "C" void kernel_launch(void* const* d_in, const int* in_sizes, int n_in, void* d_out, int out_size, void* d_ws, size_t ws_size, hipStream_t stream) {
    static int grid = 0;
    if (grid == 0) {
        if (n_in != 27 || out_size != ML * D || ws_size < WS_END) { fprintf(stderr, "kernel_launch: unexpected shapes (n_in %d out %d ws %zu)\n", n_in, out_size, ws_size); grid = -1; return; }
        int dev = 0, cus = 0, per_cu = 0;
        if (hipGetDevice(&dev) != hipSuccess || hipDeviceGetAttribute(&cus, hipDeviceAttributeMultiprocessorCount, dev) != hipSuccess) { grid = -1; return; }
        if (hipFuncSetAttribute((const void*)fwd, hipFuncAttributeMaxDynamicSharedMemorySize, LDS_BYTES) != hipSuccess) { fprintf(stderr, "kernel_launch: hipFuncSetAttribute failed\n"); grid = -1; return; }
        if (hipOccupancyMaxActiveBlocksPerMultiprocessor(&per_cu, (const void*)fwd, NTHR, LDS_BYTES) != hipSuccess || per_cu < 1) { fprintf(stderr, "kernel_launch: occupancy query says %d\n", per_cu); }
        (void)hipGetLastError();
        grid = cus;
        if (grid != 256) { fprintf(stderr, "kernel_launch: built for a 256-CU device (got %d)\n", cus); grid = -1; return; }
    }
    if (grid < 0) return;
    (void)hipMemsetAsync((char*)d_ws + WS_CTL, 0, CTL_ZERO_BYTES, stream);
    Args a{};
    for (int i = 0; i < 27; ++i) a.in[i] = (const float*)d_in[i];
    a.out = (float*)d_out; a.ws = (unsigned char*)d_ws;
    if (MK_N_LAUNCHES == 1) { a.ph_lo = 0; a.ph_hi = N_PH; hipLaunchKernelGGL(fwd, dim3(grid), dim3(NTHR), LDS_BYTES, stream, a); }
    else for (int p = 0; p < N_PH; ++p) { a.ph_lo = p; a.ph_hi = p + 1; hipLaunchKernelGGL(fwd, dim3(grid), dim3(NTHR), LDS_BYTES, stream, a); }
}
```
